# Optimizing an MI355X kernel written in HIP

```python
import jax
import jax.numpy as jnp
from jax import lax
import numpy as np

D_MODEL = 1024
BATCH = 16
SEQ = 2048
DEPTH = 4

HEAD_DIM = 64
N_HEADS_SB = 4
N_HEADS_GM = 4
N_HEADS_RW = 4
N_HEADS_FX = 4
W_SB = N_HEADS_SB * HEAD_DIM
W_GM = N_HEADS_GM * HEAD_DIM
W_RW = N_HEADS_RW * HEAD_DIM
W_FX = N_HEADS_FX * HEAD_DIM
D_MIX = W_SB + W_GM + W_RW + W_FX
BLOCK_Q = 128
CHUNK = 128
RW_DECAY_LORA = 64
RW_AAA_LORA = 64
RW_GATE_LORA = 128
SB_COLS = 3 * W_SB
GM_COLS = 2 * W_GM
RW_COLS = 3 * W_RW + RW_DECAY_LORA + RW_AAA_LORA + RW_GATE_LORA
FX_COLS = 3 * W_FX + N_HEADS_FX
D_IN_PROJ = SB_COLS + GM_COLS + RW_COLS + FX_COLS
N_EXPERT_GROUPS = 4
EXPERTS_PER_GROUP = 8
N_EXPERTS = N_EXPERT_GROUPS * EXPERTS_PER_GROUP
TOP_K = 2
EXPERT_HIDDEN = 512
MOE_BLOCK = 128
RMS_EPS = 1e-6
LN_EPS = 1e-5
GN_EPS = 64e-5
L2_EPS = 1e-12

kernel_name = 'hymba_style_sb_gmlp_rwkv7_fox_hiermoe'


def rms_norm(x, g):
    xf = x.astype(jnp.float32)
    y = xf * lax.rsqrt(jnp.mean(xf * xf, axis=-1, keepdims=True) + RMS_EPS)
    return (y * g.astype(jnp.float32)).astype(x.dtype)


def split_heads(t, n_heads):
    bsz, seq, _ = t.shape
    return t.reshape(bsz, seq, n_heads, HEAD_DIM).transpose(0, 2, 1, 3)


def merge_heads(t):
    bsz, n_heads, seq, dh = t.shape
    return t.transpose(0, 2, 1, 3).reshape(bsz, seq, n_heads * dh)


def qkv_heads(p, n_heads, width):
    q = split_heads(p[..., 0:width], n_heads)
    k = split_heads(p[..., width:2 * width], n_heads)
    v = split_heads(p[..., 2 * width:3 * width], n_heads)
    return q, k, v


def stick_breaking_attention(q, k, v):
    seq = q.shape[2]
    scale = HEAD_DIM ** -0.5
    outs = []
    for q0 in range(0, seq, BLOCK_Q):
        k_end = q0 + BLOCK_Q
        z = jnp.einsum('bhqd,bhkd->bhqk', q[:, :, q0:k_end], k[:, :, :k_end]).astype(jnp.float32) * scale
        strict = jnp.arange(k_end)[None, :] < (q0 + jnp.arange(BLOCK_Q))[:, None]
        log_one_minus = jnp.where(strict, jax.nn.log_sigmoid(-z), 0.0)
        between = lax.cumsum(log_one_minus, axis=3, reverse=True) - log_one_minus
        attn = jnp.where(strict, jnp.exp(jax.nn.log_sigmoid(z) + between), 0.0)
        outs.append(jnp.einsum('bhqk,bhkd->bhqd', attn.astype(v.dtype), v[:, :, :k_end]))
    return jnp.concatenate(outs, axis=2)


def forgetting_attention(q, k, v, log_f):
    seq = q.shape[2]
    scale = HEAD_DIM ** -0.5
    cum = lax.cumsum(log_f, axis=2)
    outs = []
    for q0 in range(0, seq, BLOCK_Q):
        k_end = q0 + BLOCK_Q
        logits = jnp.einsum('bhqd,bhkd->bhqk', q[:, :, q0:k_end], k[:, :, :k_end]).astype(jnp.float32) * scale
        logits = logits + cum[:, :, q0:k_end, None] - cum[:, :, None, :k_end]
        causal = jnp.arange(k_end)[None, :] <= (q0 + jnp.arange(BLOCK_Q))[:, None]
        probs = jax.nn.softmax(jnp.where(causal, logits, -jnp.inf), axis=-1)
        outs.append(jnp.einsum('bhqk,bhkd->bhqd', probs.astype(v.dtype), v[:, :, :k_end]))
    return jnp.concatenate(outs, axis=2)


def chunked_spatial_gating(p, w_s, b_s):
    bsz, seq, _ = p.shape
    hid = jax.nn.gelu(p)
    u, v = hid[..., :W_GM], hid[..., W_GM:]
    v = v.reshape(bsz, seq // CHUNK, CHUNK, N_HEADS_GM, HEAD_DIM).astype(jnp.float32)
    mean = jnp.mean(v, axis=-1, keepdims=True)
    var = jnp.mean(jnp.square(v - mean), axis=-1, keepdims=True)
    v = (v - mean) * lax.rsqrt(var + LN_EPS)
    w_causal = jnp.tril(w_s.astype(jnp.float32))
    mixed = jnp.einsum('gts,bcsgd->bctgd', w_causal, v) + b_s.astype(jnp.float32).T[None, None, :, :, None]
    return u * mixed.reshape(bsz, seq, W_GM).astype(p.dtype)


def rwkv7_time_mix(p, mu, w0, w2, a0, a2, g2, k_k, k_a, r_k, gn_w, gn_b):
    bsz, seq, _ = p.shape
    f32 = jnp.float32
    p = p.astype(f32)
    prev = jnp.pad(p, ((0, 0), (1, 0), (0, 0)))[:, :-1]
    p = p + (prev - p) * mu.astype(f32)
    r = p[..., 0:W_RW]
    k = p[..., W_RW:2 * W_RW]
    v = p[..., 2 * W_RW:3 * W_RW]
    o = 3 * W_RW
    xw = p[..., o:o + RW_DECAY_LORA]
    o = o + RW_DECAY_LORA
    xa = p[..., o:o + RW_AAA_LORA]
    o = o + RW_AAA_LORA
    xg = p[..., o:o + RW_GATE_LORA]
    w = -jax.nn.softplus(-(w0.astype(f32) + jnp.tanh(xw) @ w2.astype(f32))) - 0.5
    decay = jnp.exp(-jnp.exp(w))
    a = jax.nn.sigmoid(a0.astype(f32) + xa @ a2.astype(f32))
    g = jax.nn.sigmoid(xg) @ g2.astype(f32)
    kk = (k * k_k.astype(f32)).reshape(bsz, seq, N_HEADS_RW, HEAD_DIM)
    kk = kk / jnp.maximum(jnp.sqrt(jnp.sum(kk * kk, axis=-1, keepdims=True)), L2_EPS)
    k = k * (1.0 + (a - 1.0) * k_a.astype(f32))
    shp = (bsz, seq, N_HEADS_RW, HEAD_DIM)
    r_h, k_h, v_h, a_h, d_h = r.reshape(shp), k.reshape(shp), v.reshape(shp), a.reshape(shp), decay.reshape(shp)

    def step(state, inp):
        r_t, d_t, k_t, v_t, kk_t, a_t = inp
        sa = jnp.einsum('bhvk,bhk->bhv', state, -kk_t)
        state = (state * d_t[:, :, None, :]
                 + sa[..., None] * (kk_t * a_t)[:, :, None, :]
                 + v_t[..., None] * k_t[:, :, None, :])
        return state, jnp.einsum('bhvk,bhk->bhv', state, r_t)

    xs = tuple(jnp.swapaxes(t, 0, 1) for t in (r_h, d_h, k_h, v_h, kk, a_h))
    state0 = jnp.zeros((bsz, N_HEADS_RW, HEAD_DIM, HEAD_DIM), f32)
    _, y = lax.scan(step, state0, xs)
    y = jnp.swapaxes(y, 0, 1)
    mean = jnp.mean(y, axis=-1, keepdims=True)
    var = jnp.mean(jnp.square(y - mean), axis=-1, keepdims=True)
    y = ((y - mean) * lax.rsqrt(var + GN_EPS)).reshape(bsz, seq, W_RW)
    y = y * gn_w.astype(f32) + gn_b.astype(f32)
    bonus = (jnp.sum(r_h * k_h * r_k.astype(f32), axis=-1, keepdims=True) * v_h).reshape(bsz, seq, W_RW)
    return (y + bonus) * g


def routed_experts(hf, expert_idx, gates, w_gate, w_up, w_down):
    n_tok, d = hf.shape
    n_assign = n_tok * TOP_K
    flat_e = expert_idx.reshape(n_assign)
    order = jnp.argsort(flat_e)
    sorted_e = flat_e[order]
    counts = jnp.bincount(flat_e, length=N_EXPERTS)
    padded = (counts + MOE_BLOCK - 1) // MOE_BLOCK * MOE_BLOCK
    pad_end = jnp.cumsum(padded)
    pad_start = pad_end - padded
    seg_start = jnp.cumsum(counts) - counts
    slot = pad_start[sorted_e] + jnp.arange(n_assign) - seg_start[sorted_e]
    n_blocks = -(-n_assign // MOE_BLOCK) + N_EXPERTS
    n_slots = n_blocks * MOE_BLOCK
    slot_token = jnp.full((n_slots,), n_tok, dtype=jnp.int32).at[slot].set((order // TOP_K).astype(jnp.int32))
    block_expert = jnp.minimum(
        jnp.searchsorted(pad_end, jnp.arange(n_blocks) * MOE_BLOCK, side='right'), N_EXPERTS - 1)
    h_pad = jnp.concatenate([hf, jnp.zeros((1, d), hf.dtype)], axis=0)
    xb = h_pad[slot_token].reshape(n_blocks, MOE_BLOCK, d)

    def expert_block(args):
        xe, e = args
        return (jax.nn.silu(xe @ w_gate[e]) * (xe @ w_up[e])) @ w_down[e]

    yb = lax.map(expert_block, (xb, block_expert)).reshape(n_slots, d)
    slot_of_assign = jnp.zeros((n_assign,), slot.dtype).at[order].set(slot)
    y_assign = yb[slot_of_assign].reshape(n_tok, TOP_K, d)
    return jnp.einsum('nkd,nk->nd', y_assign, gates.astype(yb.dtype))


def hierarchical_moe(h, wg, bg, we, be, w_gate, w_up, w_down):
    bsz, seq, d = h.shape
    n_tok = bsz * seq
    hf = h.reshape(n_tok, d)
    rows = jnp.arange(n_tok)
    group_logits = (hf @ wg + bg).astype(jnp.float32)
    group_prob = jax.nn.softmax(group_logits, axis=-1)
    g_sel = jnp.argmax(group_logits, axis=-1)
    g_gate = group_prob[rows, g_sel]
    expert_logits = (hf @ we + be).astype(jnp.float32).reshape(n_tok, N_EXPERT_GROUPS, EXPERTS_PER_GROUP)
    in_group = expert_logits[rows, g_sel]
    top_logits, top_local = lax.top_k(in_group, TOP_K)
    gates = jax.nn.softmax(top_logits, axis=-1) * g_gate[:, None]
    expert_idx = g_sel[:, None] * EXPERTS_PER_GROUP + top_local
    y = routed_experts(hf, expert_idx, gates, w_gate, w_up, w_down)
    return y.reshape(bsz, seq, d).astype(h.dtype)


def setup_inputs(seed: int = 0) -> dict:
    key = jax.random.key(seed)
    ks = jax.random.split(key, 32)
    f32 = jnp.float32

    def nrm(k, shape, scale):
        return jax.random.normal(k, shape, f32) * scale

    resid_scale = (2 * DEPTH) ** -0.5
    return {
        'x': nrm(ks[0], (BATCH, SEQ, D_MODEL), 1.0),
        'norm1_g': 1.0 + nrm(ks[1], (DEPTH, D_MODEL), 0.02),
        'w_in': nrm(ks[2], (DEPTH, D_MODEL, D_IN_PROJ), D_MODEL ** -0.5),
        'gm_w_s': nrm(ks[3], (DEPTH, N_HEADS_GM, CHUNK, CHUNK), CHUNK ** -0.5),
        'gm_b': nrm(ks[4], (DEPTH, N_HEADS_GM, CHUNK), 0.02),
        'rw_mu': jax.random.uniform(ks[5], (DEPTH, RW_COLS), f32),
        'rw_w0': nrm(ks[6], (DEPTH, W_RW), 0.5),
        'rw_w2': nrm(ks[7], (DEPTH, RW_DECAY_LORA, W_RW), 0.5 * RW_DECAY_LORA ** -0.5),
        'rw_a0': nrm(ks[8], (DEPTH, W_RW), 0.1),
        'rw_a2': nrm(ks[9], (DEPTH, RW_AAA_LORA, W_RW), 0.5 * RW_AAA_LORA ** -0.5),
        'rw_g2': nrm(ks[10], (DEPTH, RW_GATE_LORA, W_RW), RW_GATE_LORA ** -0.5),
        'rw_k_k': 0.85 + nrm(ks[11], (DEPTH, W_RW), 0.02),
        'rw_k_a': 1.0 + nrm(ks[12], (DEPTH, W_RW), 0.02),
        'rw_r_k': nrm(ks[13], (DEPTH, N_HEADS_RW, HEAD_DIM), 0.1),
        'rw_gn_w': 1.0 + nrm(ks[14], (DEPTH, W_RW), 0.02),
        'rw_gn_b': nrm(ks[15], (DEPTH, W_RW), 0.02),
        'fx_b_f': nrm(ks[16], (DEPTH, N_HEADS_FX), 0.1),
        'w_out': nrm(ks[17], (DEPTH, D_MIX, D_MODEL), D_MIX ** -0.5 * resid_scale),
        'norm2_g': 1.0 + nrm(ks[18], (DEPTH, D_MODEL), 0.02),
        'router_group_w': nrm(ks[19], (DEPTH, D_MODEL, N_EXPERT_GROUPS), D_MODEL ** -0.5),
        'router_group_b': nrm(ks[20], (DEPTH, N_EXPERT_GROUPS), 0.01),
        'router_expert_w': nrm(ks[21], (DEPTH, D_MODEL, N_EXPERTS), D_MODEL ** -0.5),
        'router_expert_b': nrm(ks[22], (DEPTH, N_EXPERTS), 0.01),
        'exp_w_gate': nrm(ks[23], (DEPTH, N_EXPERTS, D_MODEL, EXPERT_HIDDEN), D_MODEL ** -0.5),
        'exp_w_up': nrm(ks[24], (DEPTH, N_EXPERTS, D_MODEL, EXPERT_HIDDEN), D_MODEL ** -0.5),
        'exp_w_down': nrm(ks[25], (DEPTH, N_EXPERTS, EXPERT_HIDDEN, D_MODEL), EXPERT_HIDDEN ** -0.5 * resid_scale),
        'final_norm_g': 1.0 + nrm(ks[26], (D_MODEL,), 0.02),
    }


def reference(x, norm1_g, w_in, gm_w_s, gm_b, rw_mu, rw_w0, rw_w2, rw_a0, rw_a2, rw_g2,
              rw_k_k, rw_k_a, rw_r_k, rw_gn_w, rw_gn_b, fx_b_f, w_out, norm2_g,
              router_group_w, router_group_b, router_expert_w, router_expert_b,
              exp_w_gate, exp_w_up, exp_w_down, final_norm_g):
    splits = [SB_COLS, SB_COLS + GM_COLS, SB_COLS + GM_COLS + RW_COLS]
    for layer in range(DEPTH):
        h = rms_norm(x, norm1_g[layer])
        proj = h @ w_in[layer]
        p_sb, p_gm, p_rw, p_fx = jnp.split(proj, splits, axis=-1)

        q, k, v = qkv_heads(p_sb, N_HEADS_SB, W_SB)
        y_sb = merge_heads(stick_breaking_attention(q, k, v))

        y_gm = chunked_spatial_gating(p_gm, gm_w_s[layer], gm_b[layer])

        y_rw = rwkv7_time_mix(p_rw, rw_mu[layer], rw_w0[layer], rw_w2[layer], rw_a0[layer],
                              rw_a2[layer], rw_g2[layer], rw_k_k[layer], rw_k_a[layer],
                              rw_r_k[layer], rw_gn_w[layer], rw_gn_b[layer]).astype(x.dtype)

        q, k, v = qkv_heads(p_fx, N_HEADS_FX, W_FX)
        log_f = jax.nn.log_sigmoid(p_fx[..., 3 * W_FX:].astype(jnp.float32)
                                   + fx_b_f[layer].astype(jnp.float32))
        y_fx = merge_heads(forgetting_attention(q, k, v, jnp.transpose(log_f, (0, 2, 1))))

        mix = jnp.concatenate([y_sb, y_gm, y_rw, y_fx], axis=-1)
        x = x + mix @ w_out[layer]

        h2 = rms_norm(x, norm2_g[layer])
        x = x + hierarchical_moe(h2, router_group_w[layer], router_group_b[layer],
                                 router_expert_w[layer], router_expert_b[layer],
                                 exp_w_gate[layer], exp_w_up[layer], exp_w_down[layer])
    return rms_norm(x, final_norm_g)
```

```cpp
#include <hip/hip_runtime.h>
#include <cstdio>
#include <cstdint>

#define DI __device__ __forceinline__
#define LAS __attribute__((address_space(3)))
#define GAS __attribute__((address_space(1)))
typedef unsigned short bf16_t;
typedef short bf16x8 __attribute__((ext_vector_type(8)));
typedef short s16x4 __attribute__((ext_vector_type(4)));
typedef float f32x2 __attribute__((ext_vector_type(2)));
typedef float f32x4 __attribute__((ext_vector_type(4)));
typedef float f32x16 __attribute__((ext_vector_type(16)));
typedef unsigned u32x2 __attribute__((ext_vector_type(2)));
typedef unsigned u32x4 __attribute__((ext_vector_type(4)));
typedef __bf16 bf16x2_t __attribute__((ext_vector_type(2)));
typedef GAS unsigned gu32;

constexpr int NT = 32768, SEQ = 2048, NB = 16, D = 1024, DEPTH = 4, NH = 4;
constexpr int PP = 3072;
constexpr int NIN = 3328;
constexpr int C_SBQ = 0, C_SBK = 256, C_SBV = 512, C_GMU = 768, C_GMV = 1024, C_RWR = 1280, C_RWK = 1536, C_RWV = 1792, C_RWX = 2048, C_FXQ = 2304, C_FXK = 2560, C_FXV = 2816;
constexpr int NE = 32, EH = 512;
constexpr float LOG2E = 1.4426950408889634f, LN2 = 0.6931471805599453f;
constexpr float QSCALE2 = 0.125f * LOG2E;

constexpr size_t MiB = 1u << 20;
constexpr size_t WS_CTL = 0, CTL_BYTES = 1 * MiB;
constexpr size_t WS_BIN = 1 * MiB;
constexpr size_t WS_BOUT = 28 * MiB;
constexpr size_t WS_BGU = 36 * MiB;
constexpr size_t WS_BDN = 292 * MiB;
constexpr size_t WS_WCAT = 420 * MiB;
constexpr size_t WS_RTW = 421 * MiB;
constexpr size_t WS_SS1 = 422 * MiB;
constexpr size_t WS_RSTD2 = 424 * MiB;
constexpr size_t WS_LF = 425 * MiB;
constexpr size_t WS_SCAL = 426 * MiB;
constexpr size_t WS_LIST = 428 * MiB;
constexpr size_t WS_GLIST = 436 * MiB;
constexpr size_t WS_GBUF = 444 * MiB;
constexpr size_t WS_YBUF = 460 * MiB;
constexpr size_t WS_MIX = 492 * MiB;
constexpr size_t WS_P = 556 * MiB;
constexpr size_t WS_XB = 748 * MiB;
constexpr size_t WS_HB = 812 * MiB;
constexpr size_t WS_REC = 748 * MiB;
constexpr size_t WS_CHMT = 748 * MiB;
constexpr size_t WS_CHN = 780 * MiB;
constexpr size_t WS_CHFR = 812 * MiB;
constexpr size_t WS_CHRY = 877 * MiB;
constexpr size_t WS_CHY0 = 893 * MiB;
constexpr size_t WS_BONV = 909 * MiB;
constexpr size_t WS_PLIST = 940 * MiB;
constexpr size_t WS_END = 968 * MiB;

constexpr int CW_BAR = 4096;
constexpr int CW_CNT = 16384;
constexpr int CW_R1D = 40960;
constexpr int CW_SD = 28672;
constexpr int CW_WQ = 24576;
constexpr int CW_KMAX = 20480;

constexpr int LDS_BYTES = 163840;
constexpr int LDS_AUX = 131072;
constexpr int LDS_MISC = 163840 - 256;

DI float bf2f(unsigned b) { return __uint_as_float(b << 16); }
DI unsigned pk2(float lo, float hi) { f32x2 v = {lo, hi}; bf16x2_t b = __builtin_convertvector(v, bf16x2_t); return __builtin_bit_cast(unsigned, b); }
DI unsigned f2bf(float f) { return pk2(f, 0.f) & 0xffffu; }
DI float ex2(float x) { return __builtin_amdgcn_exp2f(x); }
DI float lg2(float x) { return __builtin_amdgcn_logf(x); }
DI float rcpf_(float x) { return __builtin_amdgcn_rcpf(x); }
DI float sigmoidf_(float x) { return rcpf_(1.f + ex2(-x * LOG2E)); }
DI float tanhf_(float x) { return 1.f - 2.f * rcpf_(1.f + ex2(2.f * LOG2E * x)); }
DI float geluf_(float x) { const float u = 0.7978845608028654f * (x + 0.044715f * x * x * x); return x * rcpf_(1.f + ex2(-2.f * LOG2E * u)); }
DI float softplusf_(float x) { return fmaxf(x, 0.f) + LN2 * lg2(1.f + ex2(-fabsf(x) * LOG2E)); }
template <int CTRL, int RMASK, bool BC> DI float dppf(float x) { return __builtin_bit_cast(float, __builtin_amdgcn_update_dpp(0, __builtin_bit_cast(int, x), CTRL, RMASK, 0xf, BC)); }
DI float wave_sum(float v) {
    v += dppf<0xB1, 0xf, true>(v); v += dppf<0x4E, 0xf, true>(v); v += dppf<0x141, 0xf, true>(v); v += dppf<0x140, 0xf, true>(v);
    v += dppf<0x142, 0xa, false>(v); v += dppf<0x143, 0xc, false>(v);
    return __builtin_bit_cast(float, __builtin_amdgcn_readlane(__builtin_bit_cast(int, v), 63));
}
DI float swap32(float v) { return __shfl_xor(v, 32); }
#define MFMA32(a, b, c) __builtin_amdgcn_mfma_f32_32x32x16_bf16((a), (b), (c), 0, 0, 0)
DI int crow(int r, int h) { return (r & 3) + 8 * (r >> 2) + 4 * h; }

#define XB_TMO      128
#define XB_XCNT(j)  (256  + 64 * (j))
#define XB_XSUB(j)  (1280 + 64 * (j))
#define XB_XGEN(j)  (2304 + 64 * (j))
#define XB_TOP      3328
#define XB_TOPGEN   3392
#define XCD_BAR_WORDS 3456
#define XB_SPIN_CAP (1u << 18)
DI unsigned xb_ld(unsigned* p)              { return __hip_atomic_load(p, __ATOMIC_RELAXED, __HIP_MEMORY_SCOPE_AGENT); }
DI unsigned xb_add(unsigned* p, unsigned v) { return __hip_atomic_fetch_add(p, v, __ATOMIC_RELAXED, __HIP_MEMORY_SCOPE_AGENT); }
DI unsigned xb_xcc_id() { return (unsigned)__builtin_amdgcn_s_getreg((3 << 11) | 20) & 0xFu; }
#define XB_SPIN(cond, bar) do { unsigned _sp = 0; while (cond) { __builtin_amdgcn_s_sleep(1); \
    if ((++_sp & 255u) == 0u) { if (xb_ld(&(bar)[XB_TMO])) break; if (_sp > XB_SPIN_CAP) { atomicAdd(&(bar)[XB_TMO], 1u); break; } } } } while (0)
struct XcdBarrier { unsigned* bar; unsigned x; volatile LAS unsigned* st; };
DI XcdBarrier xcd_barrier_post(unsigned* bar, volatile LAS unsigned* st) {
    XcdBarrier b; b.bar = bar; b.x = xb_xcc_id(); b.st = st;
    if (threadIdx.x == 0) (void)xb_add(&bar[XB_XCNT(b.x)], 1u);
    return b;
}
DI void xcd_barrier_complete(unsigned* bar, unsigned x, unsigned& nloc, unsigned& nx) {
    const unsigned G = gridDim.x * gridDim.y * gridDim.z;
    unsigned sum, cnt, mine, sp = 0u;
    for (;;) {
        sum = 0u; cnt = 0u; mine = 0u;
#pragma unroll
        for (unsigned j = 0; j < 16; ++j) { const unsigned c = xb_ld(&bar[XB_XCNT(j)]); sum += c; cnt += (c > 0u) ? 1u : 0u; mine = (j == x) ? c : mine; }
        if (sum == G) break;
        __builtin_amdgcn_s_sleep(1);
        if ((++sp & 255u) == 0u) { if (xb_ld(&bar[XB_TMO])) break; if (sp > XB_SPIN_CAP) { atomicAdd(&bar[XB_TMO], 1u); break; } }
    }
    nloc = mine > 0u ? mine : 1u; nx = cnt > 0u ? cnt : 1u;
}
DI void xcd_barrier(const XcdBarrier& b) {
    asm volatile("s_waitcnt vmcnt(0)" ::: "memory");
    __syncthreads();
    if (threadIdx.x == 0) {
        unsigned* bar = b.bar;
        __builtin_amdgcn_s_waitcnt(0);
        unsigned nloc = b.st[0], nx = b.st[1];
        if (nloc == 0u) { xcd_barrier_complete(bar, b.x, nloc, nx); b.st[0] = nloc; b.st[1] = nx; }
        const unsigned old = xb_add(&bar[XB_XSUB(b.x)], 1u);
        const unsigned gen = old / nloc;
        if (old + 1u == (gen + 1u) * nloc) {
            __builtin_amdgcn_fence(__ATOMIC_RELEASE, "agent");
            asm volatile("s_waitcnt vmcnt(0)" ::: "memory");
            const unsigned og = xb_add(&bar[XB_TOP], 1u);
            const unsigned tg = og / nx;
            if (og + 1u == (tg + 1u) * nx) xb_add(&bar[XB_TOPGEN], 1u);
            else XB_SPIN(xb_ld(&bar[XB_TOPGEN]) == tg, bar);
            __builtin_amdgcn_fence(__ATOMIC_ACQUIRE, "agent");
            xb_add(&bar[XB_XGEN(b.x)], 1u);
            asm volatile("s_waitcnt vmcnt(0)" ::: "memory");
        } else {
            XB_SPIN(xb_ld(&bar[XB_XGEN(b.x)]) == gen, bar);
            __builtin_amdgcn_fence(__ATOMIC_ACQUIRE, "agent");
            asm volatile("s_waitcnt vmcnt(0)" ::: "memory");
        }
    }
    __syncthreads();
}

DI void xcd_arrive(const XcdBarrier& b, unsigned* w) {
    asm volatile("s_waitcnt vmcnt(0)" ::: "memory");
    __syncthreads();
    if (threadIdx.x == 0) {
        const unsigned nloc = b.st[0];
        const unsigned old = xb_add(&w[64 * b.x], 1u);
        if (old + 1u == nloc) { __builtin_amdgcn_fence(__ATOMIC_RELEASE, "agent"); asm volatile("s_waitcnt vmcnt(0)" ::: "memory"); (void)xb_add(&w[64 * 16], 1u); }
    }
}
DI void xcd_wait_all(const XcdBarrier& b, unsigned* w) {
    if (threadIdx.x == 0) { const unsigned nx = b.st[1]; unsigned sp = 0; while (xb_ld(&w[64 * 16]) < nx) { __builtin_amdgcn_s_sleep(1); if (++sp > (1u << 22)) break; }
        __builtin_amdgcn_fence(__ATOMIC_ACQUIRE, "agent"); asm volatile("s_waitcnt vmcnt(0)" ::: "memory"); }
    __syncthreads();
}

typedef const float* cfp_t;
struct Args { const float* in[27]; float* out; unsigned char* ws; int ph_lo, ph_hi, li, pad; };
struct Frame {
    LAS unsigned char* lds;
    int tid, lane, wave, G, bid;
    const __attribute__((address_space(4))) cfp_t* in;
    float* out; unsigned char* ws;
};
#define WSP(T, off) ((T*)(F.ws + (off)))

namespace pg8 {
constexpr int BM = 256, BK = 64, HALF = 128, HTB = HALF * BK * 2, STAGE_BYTES = 8 * HTB, NXCD = 8, WGM = 8;
DI int lds_byte(int r, int c) { const int st = (r >> 4) * 2 + (c >> 5), rr = r & 15, cc = c & 31, ob = rr * 64 + cc * 2; return st * 1024 + (ob ^ (((ob >> 9) & 1) << 5)); }
DI void stage_rc(int b, int& R, int& C) { const int st = b / 1024, sb = b % 1024, swz = sb ^ (((sb >> 9) & 1) << 5); R = (st >> 1) * 16 + swz / 64; C = (st & 1) * 32 + (swz % 64) / 2; }
DI int perm32(int rho) { const int n = rho >> 4, i = rho & 15; return 8 * (i >> 2) + 4 * n + (i & 3); }
struct Unit { int pm, pn, e, cnt, base, aux; };
DI bool static_next(int nM, int nN, int G, int c, int i, Unit& u) {
    const int nwg = nM * nN; const long L = (long)i * G + c; if (L >= nwg) return false;
    int wgid = (int)L; { const int q = nwg / NXCD, r = nwg % NXCD, xcd = wgid % NXCD, off = wgid / NXCD; wgid = (xcd < r ? xcd * (q + 1) : r * (q + 1) + (xcd - r) * q) + off; }
    const int nig = WGM * nN, gid = wgid / nig, fm = gid * WGM, gsz = (nM - fm) < WGM ? (nM - fm) : WGM;
    u.pm = fm + ((wgid % nig) % gsz); u.pn = (wgid % nig) / gsz; u.e = 0; u.cnt = 0; u.base = 0; u.aux = 0; return true;
}

template <class Prob, bool ALIGN_EPI>
DI void gemm_phase(LAS unsigned char* lds, const Prob& P, const int tid) {
    const int wid = __builtin_amdgcn_readfirstlane(tid >> 6), lane = tid & 63, wr = wid >> 2, wc = wid & 3, fr = lane & 15, fq = lane >> 4;
    const int K = P.K, nt = K / BK;
    constexpr bool GA = Prob::GATHER;
    unsigned voffB[2], voffA[2];
#pragma unroll
    for (int i = 0; i < 2; ++i) { int R, C; stage_rc(tid * 16 + i * 8192, R, C); const int Rb = Prob::PERM ? ((R & ~31) + perm32(R & 31)) : R; voffB[i] = (unsigned)(Rb * K + C) * 2u; voffA[i] = (unsigned)(R * K + C) * 2u; }
    const size_t kstep = (size_t)(BK * 2);
    const size_t hstepB = (size_t)HALF * K * 2;
    const unsigned ldsw = (unsigned)wid * 1024u;
    const int aoffL = lds_byte(wr * 64 + fr, fq * 8), boffL = lds_byte(wc * 32 + fr, fq * 8);
    const char* Abase = (const char*)P.A;
#define PG8_SA(b, h) (((b) * 2 + (h)) * HTB)
#define PG8_SB(b, h) ((4 + (b) * 2 + (h)) * HTB)
#define PG8_STG_B(bufoff, gbase) do { _Pragma("unroll") for (int _i = 0; _i < 2; ++_i) \
        __builtin_amdgcn_global_load_lds((const unsigned*)((const char*)(gbase) + voffB[_i]), (LAS unsigned*)(lds + (bufoff) + ldsw + _i * 8192), 16, 0, 0); } while (0)
#define PG8_STG_A(bufoff, h, kbyte) do { _Pragma("unroll") for (int _i = 0; _i < 2; ++_i) { \
        const char* _p; if constexpr (GA) _p = Abase + (size_t)(kbyte) + aoff[h][_i]; else _p = cA + (size_t)(h) * hstepB + (size_t)(kbyte) + voffA[_i]; \
        __builtin_amdgcn_global_load_lds((const unsigned*)_p, (LAS unsigned*)(lds + (bufoff) + ldsw + _i * 8192), 16, 0, 0); } } while (0)
#define PG8_LDA(dst, b, h) do { _Pragma("unroll") for (int m = 0; m < 4; ++m) _Pragma("unroll") for (int k = 0; k < 2; ++k) dst[m][k] = *(const LAS bf16x8*)(lds + PG8_SA(b, h) + aoffL + m * 2048 + k * 1024); } while (0)
#define PG8_LDB(dst, b, h) do { _Pragma("unroll") for (int n = 0; n < 2; ++n) _Pragma("unroll") for (int k = 0; k < 2; ++k) dst[n][k] = *(const LAS bf16x8*)(lds + PG8_SB(b, h) + boffL + n * 2048 + k * 1024); } while (0)
#define PG8_MMA(ai, bj, At, Bt) do { __builtin_amdgcn_s_setprio(1); _Pragma("unroll") for (int m = 0; m < 4; ++m) _Pragma("unroll") for (int n = 0; n < 2; ++n) _Pragma("unroll") for (int k = 0; k < 2; ++k) \
        acc[ai][bj][m][n] = __builtin_amdgcn_mfma_f32_16x16x32_bf16(Bt[n][k], At[m][k], acc[ai][bj][m][n], 0, 0, 0); __builtin_amdgcn_s_setprio(0); } while (0)
#define PG8_WAIT_V(n) asm volatile("s_waitcnt vmcnt(" #n ")" ::: "memory")
#define PG8_WAIT_L(n) asm volatile("s_waitcnt lgkmcnt(" #n ")" ::: "memory")
#define PG8_BAR __builtin_amdgcn_s_barrier()
#define PG8_SCHED __builtin_amdgcn_sched_barrier(0)
    Unit cur, nxt; int ui = 0;
    if (!P.next(0, cur)) return;
    f32x4 acc[2][2][4][2];
#pragma unroll
    for (int a = 0; a < 2; ++a)
#pragma unroll
        for (int b = 0; b < 2; ++b)
#pragma unroll
            for (int m = 0; m < 4; ++m)
#pragma unroll
                for (int n = 0; n < 2; ++n) acc[a][b][m][n] = (f32x4){0.f, 0.f, 0.f, 0.f};
    bf16x8 At[4][2], B0[2][2], B1[2][2];
    unsigned aoff[2][2] = {{0u, 0u}, {0u, 0u}}, noff[2][2] = {{0u, 0u}, {0u, 0u}};
    const char* cA = Abase; const char* nA = Abase;
    if constexpr (GA) P.aoffs(cur, tid, aoff); else cA = Abase + (size_t)P.arow0(cur) * K * 2;
    const char* cB = P.bbase(cur);
    PG8_STG_B(PG8_SB(0, 0), cB); PG8_STG_B(PG8_SB(0, 1), cB + hstepB); PG8_STG_A(PG8_SA(0, 0), 0, 0); PG8_STG_A(PG8_SA(0, 1), 1, 0);
    if (wr == 1) PG8_BAR;
    PG8_WAIT_V(2); PG8_BAR;
    PG8_STG_B(PG8_SB(1, 0), cB + kstep); PG8_STG_A(PG8_SA(1, 0), 0, kstep); PG8_STG_B(PG8_SB(1, 1), cB + hstepB + kstep);
    PG8_WAIT_V(6); PG8_BAR;
    for (;;) {
        const bool has_next = P.next(ui + 1, nxt);
        const char* nB = cB; nA = cA;
        if (has_next) { nB = P.bbase(nxt); if constexpr (GA) P.aoffs(nxt, tid, noff); else nA = Abase + (size_t)P.arow0(nxt) * K * 2; }
        else if constexpr (GA) { noff[0][0] = aoff[0][0]; noff[0][1] = aoff[0][1]; noff[1][0] = aoff[1][0]; noff[1][1] = aoff[1][1]; }
        if constexpr (GA) { *(LAS u32x4*)(lds + LDS_AUX + 2048 + tid * 16) = (u32x4){noff[0][0], noff[0][1], noff[1][0], noff[1][1]}; }
        for (int t = 0; t < nt; t += 2) {
            const bool last = (t == nt - 2);
            const size_t k1 = (size_t)(t + 1) * kstep;
            const size_t k2 = last ? (size_t)0 : (size_t)(t + 2) * kstep, k3 = k2 + kstep;
            const char* b2 = last ? nB : cB + (size_t)(t + 2) * kstep; const char* b3 = b2 + kstep;
            PG8_LDB(B0, 0, 0); PG8_LDB(B1, 0, 1); PG8_SCHED; PG8_LDA(At, 0, 0); PG8_STG_A(PG8_SA(1, 1), 1, k1);
            PG8_WAIT_V(8); PG8_WAIT_L(0); PG8_BAR; PG8_MMA(0, 0, At, B0); PG8_MMA(0, 1, At, B1); PG8_BAR; PG8_SCHED;
            if (last) { if constexpr (GA) { const u32x4 nq = *(const LAS u32x4*)(lds + LDS_AUX + 2048 + tid * 16); aoff[0][0] = nq[0]; aoff[0][1] = nq[1]; aoff[1][0] = nq[2]; aoff[1][1] = nq[3]; } else cA = nA; }
            PG8_LDA(At, 0, 1); PG8_STG_B(PG8_SB(0, 0), b2); PG8_STG_B(PG8_SB(0, 1), b2 + hstepB); PG8_STG_A(PG8_SA(0, 0), 0, k2);
            PG8_WAIT_V(8); PG8_WAIT_L(0); PG8_BAR; PG8_MMA(1, 0, At, B0); PG8_MMA(1, 1, At, B1); PG8_BAR; PG8_SCHED;
            PG8_LDB(B0, 1, 0); PG8_LDB(B1, 1, 1); PG8_SCHED; PG8_LDA(At, 1, 0); PG8_STG_A(PG8_SA(0, 1), 1, k2);
            PG8_WAIT_V(8); PG8_WAIT_L(0); PG8_BAR; PG8_MMA(0, 0, At, B0); PG8_MMA(0, 1, At, B1); PG8_BAR; PG8_SCHED;
            PG8_LDA(At, 1, 1); PG8_STG_B(PG8_SB(1, 0), b3); PG8_STG_B(PG8_SB(1, 1), b3 + hstepB); PG8_STG_A(PG8_SA(1, 0), 0, k3);
            PG8_WAIT_V(8); PG8_WAIT_L(0); PG8_BAR; PG8_MMA(1, 0, At, B0); PG8_MMA(1, 1, At, B1); PG8_BAR; PG8_SCHED;
        }
        if constexpr (ALIGN_EPI) { if (wr == 0) PG8_BAR; }
        P.epi(acc, cur, wr, wc, fr, fq);
        if (!has_next) break;
#pragma unroll
        for (int a = 0; a < 2; ++a)
#pragma unroll
            for (int b = 0; b < 2; ++b)
#pragma unroll
                for (int m = 0; m < 4; ++m)
#pragma unroll
                    for (int n = 0; n < 2; ++n) acc[a][b][m][n] = (f32x4){0.f, 0.f, 0.f, 0.f};
        cur = nxt; cB = nB; ++ui;
        if constexpr (ALIGN_EPI) { if (wr == 1) PG8_BAR; }
    }
    PG8_WAIT_V(0);
    if constexpr (!ALIGN_EPI) { if (wr == 0) PG8_BAR; }
    PG8_BAR;
#undef PG8_SA
#undef PG8_SB
#undef PG8_STG_A
#undef PG8_STG_B
#undef PG8_LDA
#undef PG8_LDB
#undef PG8_MMA
#undef PG8_WAIT_V
#undef PG8_WAIT_L
#undef PG8_BAR
#undef PG8_SCHED
}

template <class Prob>
DI void gemm_phase_pair(LAS unsigned char* lds, const Prob& P, const int tid) {
    const int wid = __builtin_amdgcn_readfirstlane(tid >> 6), lane = tid & 63, wr = wid >> 2, wc = wid & 3, fr = lane & 15, fq = lane >> 4;
    constexpr int KP = 512, nt = 16;
    unsigned voffB[2];
#pragma unroll
    for (int i = 0; i < 2; ++i) { int R, C; stage_rc(tid * 16 + i * 8192, R, C); const int Rb = Prob::PERM ? ((R & ~31) + perm32(R & 31)) : R; voffB[i] = (unsigned)(Rb * KP + C) * 2u; }
    const size_t kstep = (size_t)(BK * 2);
    const size_t hstepB = (size_t)HALF * KP * 2;
    const unsigned ldsw = (unsigned)wid * 1024u;
    const int aoffL = lds_byte(wr * 64 + fr, fq * 8), boffL = lds_byte(wc * 32 + fr, fq * 8);
    const char* Abase = (const char*)P.A;
    LAS unsigned char* park = lds + LDS_AUX + 2048 + tid * 48;
#define PG8_SA(b, h) (((b) * 2 + (h)) * HTB)
#define PG8_SB(b, h) ((4 + (b) * 2 + (h)) * HTB)
#define PG8_STG_B(bufoff, gbase) do { _Pragma("unroll") for (int _i = 0; _i < 2; ++_i) \
        __builtin_amdgcn_global_load_lds((const unsigned*)((const char*)(gbase) + voffB[_i]), (LAS unsigned*)(lds + (bufoff) + ldsw + _i * 8192), 16, 0, 0); } while (0)
#define PG8_STG_A(bufoff, h, kbyte) do { _Pragma("unroll") for (int _i = 0; _i < 2; ++_i) \
        __builtin_amdgcn_global_load_lds((const unsigned*)(Abase + (size_t)(kbyte) + aoff[h][_i]), (LAS unsigned*)(lds + (bufoff) + ldsw + _i * 8192), 16, 0, 0); } while (0)
#define PG8_LDA(dst, b, h) do { _Pragma("unroll") for (int m = 0; m < 4; ++m) _Pragma("unroll") for (int k = 0; k < 2; ++k) dst[m][k] = *(const LAS bf16x8*)(lds + PG8_SA(b, h) + aoffL + m * 2048 + k * 1024); } while (0)
#define PG8_LDB(dst, b, h) do { _Pragma("unroll") for (int n = 0; n < 2; ++n) _Pragma("unroll") for (int k = 0; k < 2; ++k) dst[n][k] = *(const LAS bf16x8*)(lds + PG8_SB(b, h) + boffL + n * 2048 + k * 1024); } while (0)
#define PG8_MMA(ai, bj, At, Bt) do { __builtin_amdgcn_s_setprio(1); _Pragma("unroll") for (int m = 0; m < 4; ++m) _Pragma("unroll") for (int n = 0; n < 2; ++n) _Pragma("unroll") for (int k = 0; k < 2; ++k) \
        acc[ai][bj][m][n] = __builtin_amdgcn_mfma_f32_16x16x32_bf16(Bt[n][k], At[m][k], acc[ai][bj][m][n], 0, 0, 0); __builtin_amdgcn_s_setprio(0); } while (0)
#define PG8_WAIT_V(n) asm volatile("s_waitcnt vmcnt(" #n ")" ::: "memory")
#define PG8_WAIT_L(n) asm volatile("s_waitcnt lgkmcnt(" #n ")" ::: "memory")
#define PG8_BAR __builtin_amdgcn_s_barrier()
#define PG8_SCHED __builtin_amdgcn_sched_barrier(0)
#define PG8_PARK(slot, v) (*(LAS u32x4*)(park + 16 * (slot)) = (u32x4){v[0][0], v[0][1], v[1][0], v[1][1]})
#define PG8_UNPARK(slot) do { const u32x4 _q = *(const LAS u32x4*)(park + 16 * (slot)); aoff[0][0] = _q[0]; aoff[0][1] = _q[1]; aoff[1][0] = _q[2]; aoff[1][1] = _q[3]; } while (0)
    Unit cur, nxt; int ui = 0;
    if (!P.next(0, cur)) return;
    f32x4 acc[2][2][4][2];
#pragma unroll
    for (int a = 0; a < 2; ++a)
#pragma unroll
        for (int b = 0; b < 2; ++b)
#pragma unroll
            for (int m = 0; m < 4; ++m)
#pragma unroll
                for (int n = 0; n < 2; ++n) acc[a][b][m][n] = (f32x4){0.f, 0.f, 0.f, 0.f};
    bf16x8 At[4][2], B0[2][2], B1[2][2];
    unsigned aoff[2][2];
    { unsigned tb[2][2]; P.aoffs2(cur, tid, aoff, tb); PG8_PARK(0, tb); }
    const char* cBa = P.bbase_a(cur); const char* cBb = P.bbase_b(cur);
    PG8_STG_B(PG8_SB(0, 0), cBa); PG8_STG_B(PG8_SB(0, 1), cBa + hstepB); PG8_STG_A(PG8_SA(0, 0), 0, 0); PG8_STG_A(PG8_SA(0, 1), 1, 0);
    if (wr == 1) PG8_BAR;
    PG8_WAIT_V(2); PG8_BAR;
    PG8_STG_B(PG8_SB(1, 0), cBa + kstep); PG8_STG_A(PG8_SA(1, 0), 0, kstep); PG8_STG_B(PG8_SB(1, 1), cBa + hstepB + kstep);
    PG8_WAIT_V(6); PG8_BAR;
    for (;;) {
        const bool has_next = P.next(ui + 1, nxt);
        const char* nBa = cBa; const char* nBb = cBb;
        {
            unsigned ta[2][2], tb[2][2];
            if (has_next) { P.aoffs2(nxt, tid, ta, tb); nBa = P.bbase_a(nxt); nBb = P.bbase_b(nxt); } else P.aoffs2(cur, tid, ta, tb);
            PG8_PARK(2, ta); PG8_PARK((ui + 1) & 1, tb);
        }
        const bool hu = (cur.cnt - cur.pm * 256) <= 128;
        for (int t = 0; t < nt; t += 2) {
            const bool last = (t == nt - 2);
            const size_t k1 = (size_t)((t + 1) & 7) * kstep;
            const int t2 = last ? 0 : t + 2;
            const size_t k2 = (size_t)(t2 & 7) * kstep, k3 = k2 + kstep;
            const char* b2 = last ? nBa : ((t2 < 8 ? cBa : cBb) + k2); const char* b3 = b2 + kstep;
            PG8_LDB(B0, 0, 0); PG8_LDB(B1, 0, 1); PG8_SCHED; PG8_LDA(At, 0, 0); PG8_STG_A(PG8_SA(1, 1), 1, k1);
            PG8_WAIT_V(8); PG8_WAIT_L(0); PG8_BAR; PG8_MMA(0, 0, At, B0); PG8_MMA(0, 1, At, B1); PG8_BAR; PG8_SCHED;
            if (t == 6) PG8_UNPARK(ui & 1);
            if (last) PG8_UNPARK(2);
            PG8_LDA(At, 0, 1); PG8_STG_B(PG8_SB(0, 0), b2); PG8_STG_B(PG8_SB(0, 1), b2 + hstepB); PG8_STG_A(PG8_SA(0, 0), 0, k2);
            PG8_WAIT_V(8); PG8_WAIT_L(0); PG8_BAR; if (!hu) { PG8_MMA(1, 0, At, B0); PG8_MMA(1, 1, At, B1); } PG8_BAR; PG8_SCHED;
            PG8_LDB(B0, 1, 0); PG8_LDB(B1, 1, 1); PG8_SCHED; PG8_LDA(At, 1, 0); PG8_STG_A(PG8_SA(0, 1), 1, k2);
            PG8_WAIT_V(8); PG8_WAIT_L(0); PG8_BAR; PG8_MMA(0, 0, At, B0); PG8_MMA(0, 1, At, B1); PG8_BAR; PG8_SCHED;
            PG8_LDA(At, 1, 1); PG8_STG_B(PG8_SB(1, 0), b3); PG8_STG_B(PG8_SB(1, 1), b3 + hstepB); PG8_STG_A(PG8_SA(1, 0), 0, k3);
            PG8_WAIT_V(8); PG8_WAIT_L(0); PG8_BAR; if (!hu) { PG8_MMA(1, 0, At, B0); PG8_MMA(1, 1, At, B1); } PG8_BAR; PG8_SCHED;
        }
        if (wr == 0) PG8_BAR;
        P.epi(acc, cur, wr, wc, fr, fq);
        if (!has_next) break;
#pragma unroll
        for (int a = 0; a < 2; ++a)
#pragma unroll
            for (int b = 0; b < 2; ++b)
#pragma unroll
                for (int m = 0; m < 4; ++m)
#pragma unroll
                    for (int n = 0; n < 2; ++n) acc[a][b][m][n] = (f32x4){0.f, 0.f, 0.f, 0.f};
        cur = nxt; cBa = nBa; cBb = nBb; ++ui;
        if (wr == 1) PG8_BAR;
    }
    PG8_WAIT_V(0);
    PG8_BAR;
#undef PG8_SA
#undef PG8_SB
#undef PG8_STG_A
#undef PG8_STG_B
#undef PG8_LDA
#undef PG8_LDB
#undef PG8_MMA
#undef PG8_WAIT_V
#undef PG8_WAIT_L
#undef PG8_BAR
#undef PG8_SCHED
#undef PG8_PARK
#undef PG8_UNPARK
}
}
using pg8::Unit;


struct MoeTab { int ce[32], sb[32], tpg[33], cp[112], tpf[113], tph[113]; };
constexpr int LCAP = 32768;
DI int pair_lo(int p) { int i = 0; _Pragma("unroll") for (int k = 1; k < 7; ++k) if (p >= k * (15 - k) / 2) i = k; return i; }
DI int pair_hi(int p, int i) { return p - i * (15 - i) / 2 + i + 1; }

struct ProbIn {
    static constexpr bool PERM = true, GATHER = false;
    int K; const bf16_t* A; const bf16_t* Bt; int G, c;
    bf16_t* Pout; const float* ss1; float* lf; const float* bfx; unsigned* kmax;
    DI bool next(int i, Unit& u) const { return pg8::static_next(128, 12, G, c, i, u); }
    DI int arow0(const Unit& u) const { return u.pm * 256; }
    DI const char* bbase(const Unit& u) const { return (const char*)Bt + (size_t)u.pn * 256 * K * 2; }
    DI void epi(const f32x4 (&acc)[2][2][4][2], const Unit& u, int wr, int wc, int fr, int fq) const {
        float km0 = 0.f, km1 = 0.f;
        float rs[8];
#pragma unroll
        for (int hb_ = 0; hb_ < 4; ++hb_) {
            f32x4 sv[2][4];
#pragma unroll
            for (int m = 0; m < 2; ++m) { const int g = hb_ * 2 + m; const f32x4* sp = (const f32x4*)(ss1 + (size_t)(u.pm * 256 + (g >> 2) * 128 + wr * 64 + (g & 3) * 16 + fr) * 16);
#pragma unroll
                for (int k = 0; k < 4; ++k) sv[m][k] = sp[k]; }
#pragma unroll
            for (int m = 0; m < 2; ++m) { float ss = 0.f;
#pragma unroll
                for (int k = 0; k < 4; ++k) ss += (sv[m][k][0] + sv[m][k][1]) + (sv[m][k][2] + sv[m][k][3]);
                rs[hb_ * 2 + m] = __builtin_amdgcn_rsqf(ss * (1.f / 1024.f) + 1e-6f); }
            asm volatile("" : "+v"(rs[hb_ * 2]), "+v"(rs[hb_ * 2 + 1]));
        }
#pragma unroll
        for (int ai = 0; ai < 2; ++ai)
#pragma unroll
            for (int m = 0; m < 4; ++m) {
                const int row = u.pm * 256 + ai * 128 + wr * 64 + m * 16 + fr;
                const float rstd = rs[ai * 4 + m];
                {
                    bf16_t* rowp = Pout + (size_t)row * PP + u.pn * 256 + wc * 32 + 8 * fq;
#pragma unroll
                    for (int bj = 0; bj < 2; ++bj) { const f32x4 v0 = acc[ai][bj][m][0] * rstd, v1 = acc[ai][bj][m][1] * rstd;
                        u32x4 w; w.x = pk2(v0[0], v0[1]); w.y = pk2(v0[2], v0[3]); w.z = pk2(v1[0], v1[1]); w.w = pk2(v1[2], v1[3]);
                        *(u32x4*)(rowp + bj * 128) = w; }
                    if (u.pn == 10) {
#pragma unroll
                        for (int bj = 0; bj < 2; ++bj) { const f32x4 v0 = acc[ai][bj][m][0] * rstd, v1 = acc[ai][bj][m][1] * rstd;
                            float p = ((v0[0] * v0[0] + v0[1] * v0[1]) + (v0[2] * v0[2] + v0[3] * v0[3])) + ((v1[0] * v1[0] + v1[1] * v1[1]) + (v1[2] * v1[2] + v1[3] * v1[3]));
                            p += __shfl_xor(p, 16); p += __shfl_xor(p, 32);
                            if (bj == 0) km0 = fmaxf(km0, p); else km1 = fmaxf(km1, p); }
                    }
                }
            }
        if (u.pn == 10) {
#pragma unroll
            for (int o = 1; o < 16; o <<= 1) { km0 = fmaxf(km0, __shfl_xor(km0, o)); km1 = fmaxf(km1, __shfl_xor(km1, o)); }
            if (fr == 0 && fq == 0) { const int b = (u.pm * 256) >> 11;
                __hip_atomic_fetch_max(kmax + ((b * 4 + 0 + (wc >> 1)) * 2 + (wc & 1)), __float_as_uint(km0), __ATOMIC_RELAXED, __HIP_MEMORY_SCOPE_AGENT);
                __hip_atomic_fetch_max(kmax + ((b * 4 + 2 + (wc >> 1)) * 2 + (wc & 1)), __float_as_uint(km1), __ATOMIC_RELAXED, __HIP_MEMORY_SCOPE_AGENT); }
        }
    }
};

struct ProbOut {
    static constexpr bool PERM = false, GATHER = false;
    int K; const bf16_t* A; const bf16_t* Bt; int G, c;
    const float* base; float* out; float ascale;
    DI bool next(int i, Unit& u) const { return pg8::static_next(128, 4, G, c, i, u); }
    DI int arow0(const Unit& u) const { return u.pm * 256; }
    DI const char* bbase(const Unit& u) const { return (const char*)Bt + (size_t)u.pn * 256 * K * 2; }
    DI void epi(const f32x4 (&acc)[2][2][4][2], const Unit& u, int wr, int wc, int fr, int fq) const {
#pragma unroll
        for (int ai = 0; ai < 2; ++ai)
#pragma unroll
            for (int mp = 0; mp < 2; ++mp) {
                f32x4 bv[2][2][2]; size_t offs[2];
#pragma unroll
                for (int mm = 0; mm < 2; ++mm) { const int m = 2 * mp + mm; offs[mm] = (size_t)(u.pm * 256 + ai * 128 + wr * 64 + m * 16 + fr) * D + u.pn * 256 + wc * 32 + 4 * fq;
#pragma unroll
                    for (int bj = 0; bj < 2; ++bj)
#pragma unroll
                        for (int n = 0; n < 2; ++n) bv[mm][bj][n] = *(const f32x4*)(base + offs[mm] + bj * 128 + n * 16); }
#pragma unroll
                for (int mm = 0; mm < 2; ++mm) { const int m = 2 * mp + mm;
#pragma unroll
                    for (int bj = 0; bj < 2; ++bj)
#pragma unroll
                        for (int n = 0; n < 2; ++n) *(f32x4*)(out + offs[mm] + bj * 128 + n * 16) = bv[mm][bj][n] + acc[ai][bj][m][n] * ascale; }
                asm volatile("" ::: "memory");
            }
    }
};

DI int moe_L(int i, int G, int c) {
    if ((G & 31) != 0) return i * G + c;
    const int x = c & 7, j = c >> 3, per = G >> 5;
    return ((i * (G >> 2) + x * per + (j >> 2)) << 2) + (j & 3);
}
template <int NL> DI bool moe_unit(const LAS int* tp, int L, Unit& u) {
    const int tt = L >> 2; if (tt >= tp[NL]) return false;
    int e = 0;
#pragma unroll 1
    while (tp[e + 1] <= tt) ++e;
    u.e = e; u.pm = tt - tp[e]; u.pn = L & 3; return true;
}

struct ProbGU {
    static constexpr bool PERM = true, GATHER = true;
    int K; const bf16_t* A; const bf16_t* Bt; int G, c;
    const LAS MoeTab* T; const int* elist; const float* egate; const float* rstd2; bf16_t* HB;
    DI bool next(int i, Unit& u) const {
        if (!moe_unit<32>(T->tpg, moe_L(i, G, c), u)) return false;
        u.cnt = T->ce[u.e]; u.base = T->sb[u.e]; return true;
    }
    DI int tok_of(const Unit& u, int r) const { return (r < u.cnt) ? elist[(size_t)u.e * LCAP + r] : 0; }
    DI void aoffs(const Unit& u, int tid, unsigned (&o)[2][2]) const {
        int Rr[2], Cc[2]; pg8::stage_rc(tid * 16, Rr[0], Cc[0]); pg8::stage_rc(tid * 16 + 8192, Rr[1], Cc[1]);
#pragma unroll
        for (int h = 0; h < 2; ++h)
#pragma unroll
            for (int i = 0; i < 2; ++i) { const int tok = tok_of(u, u.pm * 256 + h * 128 + Rr[i]); o[h][i] = (unsigned)((tok * K + Cc[i]) * 2); }
    }
    DI const char* bbase(const Unit& u) const { return (const char*)Bt + ((size_t)u.e * 1024 + u.pn * 256) * K * 2; }
    DI void epi(const f32x4 (&acc)[2][2][4][2], const Unit& u, int wr, int wc, int fr, int fq) const {
        int tk[8]; float rsv[8], gv[8];
#pragma unroll
        for (int g = 0; g < 8; ++g) { const int r = u.pm * 256 + (g >> 2) * 128 + wr * 64 + (g & 3) * 16 + fr; tk[g] = tok_of(u, r); gv[g] = (r < u.cnt) ? egate[(size_t)u.e * LCAP + r] : 0.f; }
#pragma unroll
        for (int g = 0; g < 8; ++g) rsv[g] = rstd2[tk[g]];
#pragma unroll
        for (int ai = 0; ai < 2; ++ai)
#pragma unroll
            for (int m = 0; m < 4; ++m) {
                const int r = u.pm * 256 + ai * 128 + wr * 64 + m * 16 + fr;
                if (r < u.cnt) {
                    const float rs = rsv[ai * 4 + m], gt = gv[ai * 4 + m];
                    float hv[8];
#pragma unroll
                    for (int n = 0; n < 2; ++n)
#pragma unroll
                        for (int j = 0; j < 4; ++j) { const float g = acc[ai][0][m][n][j] * rs, uu = acc[ai][1][m][n][j] * rs; hv[n * 4 + j] = g * sigmoidf_(g) * uu * gt; }
                    u32x4 w; w.x = pk2(hv[0], hv[1]); w.y = pk2(hv[2], hv[3]); w.z = pk2(hv[4], hv[5]); w.w = pk2(hv[6], hv[7]);
                    *(u32x4*)(HB + (size_t)(u.base + r) * EH + u.pn * 128 + wc * 32 + 8 * fq) = w;
                }
            }
    }
};

struct ProbDP {
    static constexpr bool PERM = false;
    const bf16_t* A; const bf16_t* Bt; int G, c;
    const LAS MoeTab* T; const u32x2* plist; float* x; bf16_t* xb; float* ss1;
    DI bool next(int i, Unit& u) const {
        const int L = moe_L(i, G, c), tt = L >> 2, nf = T->tpf[112];
        if (tt < nf) { if (!moe_unit<112>(T->tpf, L, u)) return false; }
        else { if (!moe_unit<112>(T->tph, L - 4 * nf, u)) return false; u.pm = (T->cp[u.e] - 1) >> 8; }
        u.cnt = T->cp[u.e]; const int g = u.e / 28, p = u.e - g * 28, lo = pair_lo(p); u.base = g * 8 + lo; u.aux = g * 8 + pair_hi(p, lo); return true;
    }
    DI void aoffs2(const Unit& u, int tid, unsigned (&oa)[2][2], unsigned (&ob)[2][2]) const {
        int Rr[2], Cc[2]; pg8::stage_rc(tid * 16, Rr[0], Cc[0]); pg8::stage_rc(tid * 16 + 8192, Rr[1], Cc[1]);
        const int sba = T->sb[u.base], sbb = T->sb[u.aux];
#pragma unroll
        for (int h = 0; h < 2; ++h)
#pragma unroll
            for (int i = 0; i < 2; ++i) { const int r = u.pm * 256 + h * 128 + Rr[i]; unsigned pos = 0u; if (r < u.cnt) pos = plist[(size_t)u.e * LCAP + r].y;
                const int ra = (r < u.cnt) ? sba + (int)(pos & 0xffffu) : 0, rb = (r < u.cnt) ? sbb + (int)(pos >> 16) : 0;
                oa[h][i] = (unsigned)((ra * EH + Cc[i]) * 2); ob[h][i] = (unsigned)((rb * EH + Cc[i]) * 2); }
    }
    DI const char* bbase_a(const Unit& u) const { return (const char*)Bt + ((size_t)u.base * 1024 + u.pn * 256) * EH * 2; }
    DI const char* bbase_b(const Unit& u) const { return (const char*)Bt + ((size_t)u.aux * 1024 + u.pn * 256) * EH * 2; }
    DI void epi(const f32x4 (&acc)[2][2][4][2], const Unit& u, int wr, int wc, int fr, int fq) const {
        int tk[8];
#pragma unroll
        for (int g = 0; g < 8; ++g) { const int r = u.pm * 256 + (g >> 2) * 128 + wr * 64 + (g & 3) * 16 + fr; tk[g] = (r < u.cnt) ? (int)plist[(size_t)u.e * LCAP + r].x : 0; }
#pragma unroll
        for (int ai = 0; ai < 2; ++ai)
#pragma unroll
            for (int m = 0; m < 4; ++m) {
                const int r = u.pm * 256 + ai * 128 + wr * 64 + m * 16 + fr; const bool val = r < u.cnt;
                const size_t off = (size_t)tk[ai * 4 + m] * D + u.pn * 256 + wc * 32 + 4 * fq;
                f32x4 xv[2][2];
#pragma unroll
                for (int bj = 0; bj < 2; ++bj)
#pragma unroll
                    for (int n = 0; n < 2; ++n) xv[bj][n] = *(const f32x4*)(x + off + bj * 128 + n * 16);
                float ssp = 0.f;
#pragma unroll
                for (int bj = 0; bj < 2; ++bj)
#pragma unroll
                    for (int n = 0; n < 2; ++n) { const size_t o = off + bj * 128 + n * 16; const f32x4 v = xv[bj][n] + acc[ai][bj][m][n];
                        if (val) { *(f32x4*)(x + o) = v; u32x2 w; w.x = pk2(v[0], v[1]); w.y = pk2(v[2], v[3]); *(u32x2*)(xb + o) = w; }
                        ssp += (v[0] * v[0] + v[1] * v[1]) + (v[2] * v[2] + v[3] * v[3]); }
                ssp += __shfl_xor(ssp, 16); ssp += __shfl_xor(ssp, 32);
                if (val && fq == 0) ss1[(size_t)tk[ai * 4 + m] * 16 + u.pn * 4 + wc] = ssp;
                asm volatile("" ::: "memory");
            }
    }
};


DI void fgate_item(Frame& F, int layer, int item) {
    const int lane = F.lane, m16 = lane & 15, q4 = lane >> 4, r0 = 16 * item;
    const bf16_t* ap = WSP(bf16_t, WS_XB) + (size_t)(r0 + m16) * D + 8 * q4;
    const bf16_t* bp = WSP(bf16_t, WS_BIN) + (size_t)layer * NIN * D + (size_t)(3072 + (m16 & 3)) * D + 8 * q4;
    f32x4 acc = {0.f, 0.f, 0.f, 0.f};
#pragma unroll 16
    for (int ks = 0; ks < 32; ++ks) {
        const bf16x8 a = *(const bf16x8*)(ap + 32 * ks); bf16x8 b = *(const bf16x8*)(bp + 32 * ks);
        if (m16 >= 4) b = (bf16x8){0, 0, 0, 0, 0, 0, 0, 0};
        acc = __builtin_amdgcn_mfma_f32_16x16x32_bf16(a, b, acc, 0, 0, 0);
    }
    if (m16 < 4) {
        const float bfv = F.in[16][layer * 4 + m16];
#pragma unroll
        for (int r = 0; r < 4; ++r) { const int row = r0 + 4 * q4 + r;
            const f32x4* sp = (const f32x4*)(WSP(float, WS_SS1) + (size_t)row * 16);
            const f32x4 s0 = sp[0], s1 = sp[1], s2 = sp[2], s3 = sp[3];
            const float ss = ((s0[0] + s0[1]) + (s0[2] + s0[3])) + ((s1[0] + s1[1]) + (s1[2] + s1[3])) + ((s2[0] + s2[1]) + (s2[2] + s2[3])) + ((s3[0] + s3[1]) + (s3[2] + s3[3]));
            const float rstd = __builtin_amdgcn_rsqf(ss * (1.f / 1024.f) + 1e-6f);
            WSP(float, WS_LF)[(size_t)((row >> 11) * 4 + m16) * SEQ + (row & 2047)] = -softplusf_(-(acc[r] * rstd + bfv)); }
    }
}
DI void p0_transpose64(const float* W, int K, int N, int ldn, const float* gs, bf16_t* WT, int mode, LAS unsigned* T, int kb, int nb, int lane) {
    const int k0 = 64 * kb, n0 = 64 * nb, nq = lane & 15, kr = lane >> 4;
    const bool nv = (n0 + 4 * nq) < N;
    f32x4 a[8], b[8];
#pragma unroll
    for (int i = 0; i < 8; ++i) { const int k = k0 + 8 * i + 2 * kr;
        a[i] = nv ? *(const f32x4*)(W + (size_t)k * ldn + n0 + 4 * nq) : (f32x4){0.f, 0.f, 0.f, 0.f};
        b[i] = nv ? *(const f32x4*)(W + (size_t)(k + 1) * ldn + n0 + 4 * nq) : (f32x4){0.f, 0.f, 0.f, 0.f}; }
#pragma unroll
    for (int i = 0; i < 8; ++i) { const int k = k0 + 8 * i + 2 * kr; float g0 = 1.f, g1 = 1.f; if (gs) { g0 = gs[k]; g1 = gs[k + 1]; }
#pragma unroll
        for (int jj = 0; jj < 4; ++jj) T[(4 * nq + jj) * 36 + 4 * i + kr] = pk2(a[i][jj] * g0, b[i][jj] * g1); }
    asm volatile("s_waitcnt lgkmcnt(0)" ::: "memory");
    const int c = lane & 7;
#pragma unroll
    for (int p = 0; p < 8; ++p) { const int nl = 8 * p + (lane >> 3), n = n0 + nl;
        const u32x4 o = *(const LAS u32x4*)(T + nl * 36 + 4 * c);
        const int drow = (mode == 0) ? n : (((n >> 7) << 8) + (n & 127) + (mode == 2 ? 128 : 0));
        *(u32x4*)(WT + (size_t)drow * K + k0 + 8 * c) = o; }
    asm volatile("s_waitcnt lgkmcnt(0)" ::: "memory");
}
DI void p0_prologue(Frame& F) {
    LAS unsigned* scr = (LAS unsigned*)(F.lds + F.wave * 16384);
    const int gw = F.bid * 8 + F.wave, NGW = F.G * 8;
    constexpr int I_IN = 16 * 52, I_OUT = 16 * 16, I_GU = 16 * 8, I_DN = 8 * 16;
    constexpr int S0 = DEPTH * I_IN, S1 = S0 + DEPTH * I_OUT, S2 = S1 + DEPTH * NE * I_GU, S3 = S2 + DEPTH * NE * I_GU, S4 = S3 + DEPTH * NE * I_DN;
    for (int it = gw; it < S4; it += NGW) {
        if (it < S0) { const int l = it / I_IN, r = it % I_IN;
            p0_transpose64(F.in[2] + (size_t)l * D * 3076, D, 3076, 3076, F.in[1] + l * D, WSP(bf16_t, WS_BIN) + (size_t)l * NIN * D, 0, scr, r / 52, r % 52, F.lane);
        } else if (it < S1) { const int q = it - S0, l = q / I_OUT, r = q % I_OUT;
            p0_transpose64(F.in[17] + (size_t)l * D * D, D, D, D, nullptr, WSP(bf16_t, WS_BOUT) + (size_t)l * D * D, 0, scr, r / 16, r % 16, F.lane);
        } else if (it < S3) { const int up = it >= S2, q = it - (up ? S2 : S1), le = q / I_GU, r = q % I_GU;
            p0_transpose64(F.in[up ? 24 : 23] + (size_t)le * D * EH, D, EH, EH, F.in[18] + (le / NE) * D, WSP(bf16_t, WS_BGU) + (size_t)le * 1024 * D, up ? 2 : 1, scr, r / 8, r % 8, F.lane);
        } else { const int q = it - S3, le = q / I_DN, r = q % I_DN;
            p0_transpose64(F.in[25] + (size_t)le * EH * D, EH, D, D, nullptr, WSP(bf16_t, WS_BDN) + (size_t)le * D * EH, 0, scr, r / 16, r % 16, F.lane);
        }
    }
    const int gt = F.bid * 512 + F.tid, NGT = F.G * 512;
    for (int i = gt; i < DEPTH * 256 * 256; i += NGT) { const int l = i >> 16, c = (i >> 8) & 255, k = i & 255;
        const float v = k < 64 ? F.in[7][((size_t)l * 64 + k) * 256 + c] : (k < 128 ? F.in[9][((size_t)l * 64 + (k - 64)) * 256 + c] : F.in[10][((size_t)l * 128 + (k - 128)) * 256 + c]);
        WSP(bf16_t, WS_WCAT)[i] = (bf16_t)f2bf(v); }
    for (int i = gt; i < DEPTH * 36 * 1024; i += NGT) { const int l = i / (36 * 1024), j = (i / 1024) % 36, k = i & 1023;
        const float g = F.in[18][l * D + k];
        const float w = j < 4 ? F.in[19][((size_t)l * D + k) * 4 + j] : F.in[21][((size_t)l * D + k) * 32 + (j - 4)];
        WSP(float, WS_RTW)[i] = g * w; }
    for (int m0 = gw * 4; m0 < NT; m0 += NGW * 4) {
        f32x4 v[4][4];
#pragma unroll
        for (int r = 0; r < 4; ++r) { const f32x4* xr = (const f32x4*)(F.in[0] + (size_t)(m0 + r) * D) + F.lane;
#pragma unroll
            for (int j = 0; j < 4; ++j) v[r][j] = xr[64 * j]; }
#pragma unroll
        for (int r = 0; r < 4; ++r) { float s = 0.f; u32x2* o8 = (u32x2*)(WSP(bf16_t, WS_XB) + (size_t)(m0 + r) * D) + F.lane;
#pragma unroll
            for (int j = 0; j < 4; ++j) { const f32x4 q = v[r][j]; s += (q[0] * q[0] + q[1] * q[1]) + (q[2] * q[2] + q[3] * q[3]); u32x2 w; w.x = pk2(q[0], q[1]); w.y = pk2(q[2], q[3]); o8[64 * j] = w; }
            s = wave_sum(s);
            if (F.lane < 16) WSP(float, WS_SS1)[(size_t)(m0 + r) * 16 + F.lane] = (F.lane == 0) ? s : 0.f; }
    }
}

constexpr int AT_KOFF = 0, AT_VOFF = 18432, AT_CUM = 36864, AT_MISC = 45056, AT_ROWB = 144, AT_BUFB = 64 * 144;
DI void at_load_tile(const bf16_t* Pb, int colK, int colV, int jt, int tid, u32x4& kreg, u32x4& vreg) {
    const int row = tid >> 3, ch = tid & 7; const bf16_t* p = Pb + (size_t)(64 * jt + row) * PP + ch * 8;
    kreg = *(const u32x4*)(p + colK); vreg = *(const u32x4*)(p + colV);
}
DI void at_store_tile(LAS unsigned char* lds, int buf, int tid, const u32x4& kreg, const u32x4& vreg) {
    const int row = tid >> 3, ch = tid & 7;
    *(LAS u32x4*)(lds + AT_KOFF + buf * AT_BUFB + row * AT_ROWB + ch * 16) = kreg;
    *(LAS u32x4*)(lds + AT_VOFF + buf * AT_BUFB + row * AT_ROWB + ch * 16) = vreg;
}
DI void at_qk(const LAS unsigned char* kb, const bf16x8 (&qf)[4], int r32, int h2, f32x16& s0, f32x16& s1) {
    const LAS unsigned char* p = kb + r32 * AT_ROWB + h2 * 16;
#pragma unroll
    for (int d0 = 0; d0 < 4; ++d0) {
        const bf16x8 a0 = *(const LAS bf16x8*)(p + d0 * 32), a1 = *(const LAS bf16x8*)(p + 32 * AT_ROWB + d0 * 32);
        s0 = MFMA32(a0, qf[d0], s0); s1 = MFMA32(a1, qf[d0], s1);
    }
}
DI bf16x8 pack8(const f32x16& x, int s) {
    u32x4 p; p.x = pk2(x[8 * s], x[8 * s + 1]); p.y = pk2(x[8 * s + 2], x[8 * s + 3]); p.z = pk2(x[8 * s + 4], x[8 * s + 5]); p.w = pk2(x[8 * s + 6], x[8 * s + 7]);
    return __builtin_bit_cast(bf16x8, p);
}
DI s16x4 tr_read(const LAS unsigned char* p) { return __builtin_bit_cast(s16x4, __builtin_amdgcn_ds_read_tr16_b64_v4i16((LAS s16x4*)p)); }
DI void at_pv(const LAS unsigned char* vb, const bf16x8 (&pb)[4], int lane, f32x16& o0, f32x16& o1) {
    const int h2 = lane >> 5;
    const LAS unsigned char* base = vb + (4 * h2 + ((lane & 15) >> 2)) * AT_ROWB + (16 * ((lane >> 4) & 1) + 4 * (lane & 3)) * 2;
#pragma unroll
    for (int s = 0; s < 4; ++s) {
        const LAS unsigned char* p = base + 16 * s * AT_ROWB;
        const s16x4 l0 = tr_read(p), h0 = tr_read(p + 8 * AT_ROWB), l1 = tr_read(p + 64), h1 = tr_read(p + 8 * AT_ROWB + 64);
        const bf16x8 a0 = __builtin_shufflevector(l0, h0, 0, 1, 2, 3, 4, 5, 6, 7), a1 = __builtin_shufflevector(l1, h1, 0, 1, 2, 3, 4, 5, 6, 7);
        o0 = MFMA32(a0, pb[s], o0); o1 = MFMA32(a1, pb[s], o1);
    }
}
DI void at_store_out(bf16_t* dst  , const f32x16& o0, const f32x16& o1, float scale, int h2) {
#pragma unroll
    for (int g = 0; g < 4; ++g) {
        u32x2 w0, w1; w0.x = pk2(o0[4 * g] * scale, o0[4 * g + 1] * scale); w0.y = pk2(o0[4 * g + 2] * scale, o0[4 * g + 3] * scale);
        w1.x = pk2(o1[4 * g] * scale, o1[4 * g + 1] * scale); w1.y = pk2(o1[4 * g + 2] * scale, o1[4 * g + 3] * scale);
        *(u32x2*)(dst + 8 * g + 4 * h2) = w0; *(u32x2*)(dst + 32 + 8 * g + 4 * h2) = w1;
    }
}
DI void block_cumsum(const float* src, int n, LAS float* cum, LAS float* wtot, int tid, int lane, int wave) {
    f32x4 v = (f32x4){0.f, 0.f, 0.f, 0.f};
    if (4 * tid < n) v = *(const f32x4*)(src + 4 * tid);
    v[1] += v[0]; v[2] += v[1]; v[3] += v[2];
    float t = v[3];
#pragma unroll
    for (int o = 1; o < 64; o <<= 1) { const float u = __shfl_up(t, o); if (lane >= o) t += u; }
    if (lane == 63) wtot[wave] = t;
    __syncthreads();
    float pre = t - v[3];
    for (int w = 0; w < wave; ++w) pre += wtot[w];
    if (4 * tid < n) { v[0] += pre; v[1] += pre; v[2] += pre; v[3] += pre; *(LAS f32x4*)(cum + 4 * tid) = v; }
    __syncthreads();
}

DI void fx_unit(Frame& F, int layer, int b, int h, int qb) {
    LAS unsigned char* L = F.lds; const int tid = F.tid, lane = F.lane, wid = F.wave, r32 = lane & 31, h2 = lane >> 5;
    const bf16_t* Pb = WSP(bf16_t, WS_P) + (size_t)b * SEQ * PP;
    LAS float* cum = (LAS float*)(L + AT_CUM);
    const int kend = 256 * qb + 256;
    __syncthreads();
    block_cumsum(WSP(float, WS_LF) + (size_t)(b * 4 + h) * SEQ, kend, cum, (LAS float*)(L + AT_MISC), tid, lane, wid);
    const int tw0 = 256 * qb + 32 * wid, tq = tw0 + r32;
    bf16x8 qf[4];
#pragma unroll
    for (int d0 = 0; d0 < 4; ++d0) qf[d0] = *(const bf16x8*)(Pb + (size_t)tq * PP + C_FXQ + h * 64 + 16 * d0 + 8 * h2);
    const float ct2 = cum[tq] * LOG2E;
    float qb2;
    { float qn = 0.f;
#pragma unroll
      for (int d0 = 0; d0 < 4; ++d0) { const u32x4 qq = __builtin_bit_cast(u32x4, qf[d0]);
#pragma unroll
        for (int j = 0; j < 4; ++j) { const float a = bf2f(qq[j] & 0xffffu), c = bf2f(qq[j] >> 16); qn += a * a + c * c; } }
      qn += swap32(qn);
      const unsigned* km = (const unsigned*)(F.ws + WS_CTL) + CW_KMAX + layer * 128 + (b * 4 + h) * 2;
      const float kk2 = __uint_as_float(xb_ld((unsigned*)km)) + __uint_as_float(xb_ld((unsigned*)km + 1));
      qb2 = sqrtf(qn * kk2) * QSCALE2 * 1.01f + 1e-3f; }
    float mrun = -1e30f, lrun = 0.f; f32x16 o0 = {}, o1 = {};
    const int jtop = 4 * qb + 3;
    u32x4 kreg, vreg;
    at_load_tile(Pb, C_FXK + h * 64, C_FXV + h * 64, jtop, tid, kreg, vreg);
    at_store_tile(L, 0, tid, kreg, vreg);
    __syncthreads();
    int buf = 0; bool wskip = false;
    for (int jt = jtop; jt >= 0; --jt) {
        if (jt > 0) at_load_tile(Pb, C_FXK + h * 64, C_FXV + h * 64, jt - 1, tid, kreg, vreg);
        if (64 * jt <= tw0 + 31 && !wskip) {
            f32x16 s0 = {}, s1 = {};
            at_qk(L + AT_KOFF + buf * AT_BUFB, qf, r32, h2, s0, s1);
            const bool needmask = (64 * jt + 63 > tw0);
            float mx = -1e30f;
#pragma unroll
            for (int g = 0; g < 4; ++g) {
                const f32x4 c0 = *(const LAS f32x4*)(cum + 64 * jt + 8 * g + 4 * h2), c1 = *(const LAS f32x4*)(cum + 64 * jt + 32 + 8 * g + 4 * h2);
#pragma unroll
                for (int j = 0; j < 4; ++j) {
                    const int r = 4 * g + j, kv = 64 * jt + 8 * g + 4 * h2 + j;
                    float v0 = s0[r] * QSCALE2 + (ct2 - c0[j] * LOG2E), v1 = s1[r] * QSCALE2 + (ct2 - c1[j] * LOG2E);
                    if (needmask) { if (kv > tq) v0 = -1e30f; if (kv + 32 > tq) v1 = -1e30f; }
                    s0[r] = v0; s1[r] = v1; mx = fmaxf(mx, fmaxf(v0, v1));
                }
            }
            mx = fmaxf(mx, swap32(mx));
            const float mnew = fmaxf(mrun, mx), alpha = ex2(mrun - mnew);
            mrun = mnew;
            float ps = 0.f;
#pragma unroll
            for (int r = 0; r < 16; ++r) { s0[r] = ex2(s0[r] - mnew); s1[r] = ex2(s1[r] - mnew); ps += s0[r] + s1[r]; }
            lrun = lrun * alpha + ps;
#pragma unroll
            for (int r = 0; r < 16; ++r) { o0[r] *= alpha; o1[r] *= alpha; }
            bf16x8 pb[4]; pb[0] = pack8(s0, 0); pb[1] = pack8(s0, 1); pb[2] = pack8(s1, 0); pb[3] = pack8(s1, 1);
            at_pv(L + AT_VOFF + buf * AT_BUFB, pb, lane, o0, o1);
        }
        if (jt > 0) at_store_tile(L, buf ^ 1, tid, kreg, vreg);
        { int wdone = 0; if (jt > 0) wdone = __all(qb2 + (ct2 - cum[64 * jt - 1] * LOG2E) - mrun < -150.f) ? 1 : 0; wskip = wdone != 0; if (lane == 0) *(LAS int*)(L + AT_MISC + 64 + 32 * (jt & 1) + 4 * wid) = wdone; }
        __syncthreads();
        buf ^= 1;
        { const LAS int* fl = (const LAS int*)(L + AT_MISC + 64 + 32 * (jt & 1)); const int alld = fl[0] & fl[1] & fl[2] & fl[3] & fl[4] & fl[5] & fl[6] & fl[7]; if (alld) break; }
    }
    const float ltot = lrun + swap32(lrun);
    at_store_out(WSP(bf16_t, WS_MIX) + (size_t)(b * SEQ + tq) * D + 768 + h * 64, o0, o1, rcpf_(ltot), h2);
}

DI void sb_unit(Frame& F, int b, int h, int qb) {
    LAS unsigned char* L = F.lds; const int tid = F.tid, lane = F.lane, wid = F.wave, r32 = lane & 31, h2 = lane >> 5;
    const bf16_t* Pb = WSP(bf16_t, WS_P) + (size_t)b * SEQ * PP;
    const int tw0 = 256 * qb + 32 * wid, tq = tw0 + r32;
    bf16x8 qf[4];
#pragma unroll
    for (int d0 = 0; d0 < 4; ++d0) qf[d0] = *(const bf16x8*)(Pb + (size_t)tq * PP + C_SBQ + h * 64 + 16 * d0 + 8 * h2);
    bf16x8 uf[2], onesf;
#pragma unroll
    for (int s = 0; s < 2; ++s)
#pragma unroll
        for (int j = 0; j < 8; ++j) uf[s][j] = ((16 * s + 8 * (j >> 2) + 4 * h2 + (j & 3)) > r32) ? (short)0x3F80 : (short)0;
#pragma unroll
    for (int j = 0; j < 8; ++j) onesf[j] = (short)0x3F80;
    float R2 = 0.f; f32x16 o0 = {}, o1 = {};
    const int jtop = 4 * qb + 3;
    u32x4 kreg, vreg;
    __syncthreads();
    at_load_tile(Pb, C_SBK + h * 64, C_SBV + h * 64, jtop, tid, kreg, vreg);
    at_store_tile(L, 0, tid, kreg, vreg);
    __syncthreads();
    int buf = 0; bool wskip = false;
    for (int jt = jtop; jt >= 0; --jt) {
        if (jt > 0) at_load_tile(Pb, C_SBK + h * 64, C_SBV + h * 64, jt - 1, tid, kreg, vreg);
        if (64 * jt <= tw0 + 31 && !wskip) {
            f32x16 s0 = {}, s1 = {};
            at_qk(L + AT_KOFF + buf * AT_BUFB, qf, r32, h2, s0, s1);
            const bool needmask = (64 * jt + 63 >= tw0);
            f32x16 l0, l1;
            float cs = 0.f;
#pragma unroll
            for (int r = 0; r < 16; ++r) {
                const int kv = 64 * jt + crow(r, h2);
                const float z0 = s0[r] * QSCALE2, z1 = s1[r] * QSCALE2;
                const float sp0 = fmaxf(z0, 0.f) + lg2(1.f + ex2(-fabsf(z0))), sp1 = fmaxf(z1, 0.f) + lg2(1.f + ex2(-fabsf(z1)));
                float a0 = -sp0, a1 = -sp1, b0 = z0 - sp0, b1 = z1 - sp1;
                if (needmask) { if (kv >= tq) { a0 = 0.f; b0 = -1e30f; } if (kv + 32 >= tq) { a1 = 0.f; b1 = -1e30f; } }
                l0[r] = a0; l1[r] = a1; s0[r] = b0; s1[r] = b1; cs += a0 + a1;
            }
            f32x16 t0 = {}, t1 = {};
#pragma unroll
            for (int s = 0; s < 2; ++s) {
                const bf16x8 h0 = pack8(l0, s), h1 = pack8(l1, s);
                f32x16 d0_, d1_;
#pragma unroll
                for (int j = 0; j < 8; ++j) { d0_[j] = l0[8 * s + j] - bf2f((unsigned short)h0[j]); d1_[j] = l1[8 * s + j] - bf2f((unsigned short)h1[j]); }
                u32x4 q0, q1; q0.x = pk2(d0_[0], d0_[1]); q0.y = pk2(d0_[2], d0_[3]); q0.z = pk2(d0_[4], d0_[5]); q0.w = pk2(d0_[6], d0_[7]);
                q1.x = pk2(d1_[0], d1_[1]); q1.y = pk2(d1_[2], d1_[3]); q1.z = pk2(d1_[4], d1_[5]); q1.w = pk2(d1_[6], d1_[7]);
                const bf16x8 e0 = __builtin_bit_cast(bf16x8, q0), e1 = __builtin_bit_cast(bf16x8, q1);
                t0 = MFMA32(uf[s], h0, t0); t0 = MFMA32(uf[s], e0, t0); t0 = MFMA32(onesf, h1, t0); t0 = MFMA32(onesf, e1, t0);
                t1 = MFMA32(uf[s], h1, t1); t1 = MFMA32(uf[s], e1, t1);
            }
#pragma unroll
            for (int r = 0; r < 16; ++r) { s0[r] = ex2(s0[r] + R2 + t0[r]); s1[r] = ex2(s1[r] + R2 + t1[r]); }
            R2 += cs + swap32(cs);
            bf16x8 pb[4]; pb[0] = pack8(s0, 0); pb[1] = pack8(s0, 1); pb[2] = pack8(s1, 0); pb[3] = pack8(s1, 1);
            at_pv(L + AT_VOFF + buf * AT_BUFB, pb, lane, o0, o1);
        }
        if (jt > 0) at_store_tile(L, buf ^ 1, tid, kreg, vreg);
        { const int wdone = __all(R2 < -150.f) ? 1 : 0; wskip = wdone != 0; if (lane == 0) *(LAS int*)(L + AT_MISC + 64 + 32 * (jt & 1) + 4 * wid) = wdone; }
        __syncthreads();
        buf ^= 1;
        { const LAS int* fl = (const LAS int*)(L + AT_MISC + 64 + 32 * (jt & 1)); const int alld = fl[0] & fl[1] & fl[2] & fl[3] & fl[4] & fl[5] & fl[6] & fl[7]; if (alld) break; }
    }
    at_store_out(WSP(bf16_t, WS_MIX) + (size_t)(b * SEQ + tq) * D + 0 + h * 64, o0, o1, 1.f, h2);
}
DI void attn_rank_to_unit(int r, int& bh, int& qb) { if (r < 256) { qb = 7 - (r >> 6); bh = r & 63; } else { const int p = r - 256; qb = p >> 6; bh = p & 63; } }

DI void gm_unit(Frame& F, int layer, int b, int c, int g) {
    LAS unsigned char* L = F.lds; const int lane = F.lane, wid = F.wave, r32 = lane & 31, h2 = lane >> 5;
    constexpr int VSTR = 272;
    const bf16_t* Pb = WSP(bf16_t, WS_P) + (size_t)(b * SEQ + c * 128) * PP;
    __syncthreads();
    { bf16_t xr[16];
#pragma unroll
      for (int i = 0; i < 16; ++i) xr[i] = Pb[(size_t)(16 * wid + i) * PP + C_GMV + g * 64 + lane];
#pragma unroll
      for (int i = 0; i < 16; ++i) {
        const int s = 16 * wid + i;
        const float ge = geluf_(bf2f(xr[i])), mean = wave_sum(ge) * (1.f / 64.f), dv = ge - mean, var = wave_sum(dv * dv) * (1.f / 64.f);
        *(LAS bf16_t*)(L + lane * VSTR + s * 2) = (bf16_t)f2bf(dv * __builtin_amdgcn_rsqf(var + 1e-5f));
      } }
    __syncthreads();
    const int tb = wid >> 1, db = wid & 1, t = 32 * tb + r32;
    const float* Wrow = F.in[3] + ((size_t)(layer * 4 + g) * 128 + t) * 128;
    f32x16 acc = {};
    f32x4 wq[8][2];
#pragma unroll
    for (int ks = 0; ks < 8; ++ks) if (ks <= 2 * tb + 1) { const int s0 = 16 * ks + 8 * h2; wq[ks][0] = *(const f32x4*)(Wrow + s0); wq[ks][1] = *(const f32x4*)(Wrow + s0 + 4); }
#pragma unroll
    for (int ks = 0; ks < 8; ++ks) if (ks <= 2 * tb + 1) {
        const int s0 = 16 * ks + 8 * h2;
        float wv[8] = {wq[ks][0][0], wq[ks][0][1], wq[ks][0][2], wq[ks][0][3], wq[ks][1][0], wq[ks][1][1], wq[ks][1][2], wq[ks][1][3]};
#pragma unroll
        for (int j = 0; j < 8; ++j) if (s0 + j > t) wv[j] = 0.f;
        u32x4 aw; aw.x = pk2(wv[0], wv[1]); aw.y = pk2(wv[2], wv[3]); aw.z = pk2(wv[4], wv[5]); aw.w = pk2(wv[6], wv[7]);
        const bf16x8 bv = *(const LAS bf16x8*)(L + (32 * db + r32) * VSTR + s0 * 2);
        acc = MFMA32(__builtin_bit_cast(bf16x8, aw), bv, acc);
    }
    const int d = 32 * db + r32;
    const float* gb = F.in[4] + (size_t)(layer * 4 + g) * 128;
    bf16_t* mo = WSP(bf16_t, WS_MIX) + (size_t)(b * SEQ + c * 128) * D + 256 + g * 64 + d;
#pragma unroll
    for (int r = 0; r < 16; ++r) { const int tt = 32 * tb + crow(r, h2);
        const float u = geluf_(bf2f(Pb[(size_t)tt * PP + C_GMU + g * 64 + d]));
        mo[(size_t)tt * D] = (bf16_t)f2bf(u * (acc[r] + gb[tt])); }
}

DI void rw_load_shift8(const bf16_t* Pt, bool hasprev, int col, const float* mu, float (&o)[8]) {
    const u32x4 cu = *(const u32x4*)(Pt + col); u32x4 pr = (u32x4){0u, 0u, 0u, 0u}; if (hasprev) pr = *(const u32x4*)(Pt - PP + col);
    const f32x4 m0 = *(const f32x4*)(mu), m1 = *(const f32x4*)(mu + 4);
    const float mm[8] = {m0[0], m0[1], m0[2], m0[3], m1[0], m1[1], m1[2], m1[3]};
#pragma unroll
    for (int j = 0; j < 4; ++j) { const float c0 = bf2f(cu[j] & 0xffffu), c1 = bf2f(cu[j] >> 16), p0 = bf2f(pr[j] & 0xffffu), p1 = bf2f(pr[j] >> 16);
        o[2 * j] = c0 + (p0 - c0) * mm[2 * j]; o[2 * j + 1] = c1 + (p1 - c1) * mm[2 * j + 1]; }
}
DI void rw_load_shift4(const bf16_t* Pt, bool hasprev, int col, const float* mu, float (&o)[4]) {
    const u32x2 cu = *(const u32x2*)(Pt + col); u32x2 pr = (u32x2){0u, 0u}; if (hasprev) pr = *(const u32x2*)(Pt - PP + col);
    const f32x4 m0 = *(const f32x4*)(mu);
#pragma unroll
    for (int j = 0; j < 2; ++j) { const float c0 = bf2f(cu[j] & 0xffffu), c1 = bf2f(cu[j] >> 16), p0 = bf2f(pr[j] & 0xffffu), p1 = bf2f(pr[j] >> 16);
        o[2 * j] = c0 + (p0 - c0) * m0[2 * j]; o[2 * j + 1] = c1 + (p1 - c1) * m0[2 * j + 1]; }
}
DI bf16x8 rw_act_frag(const bf16_t* Pt, bool hasprev, const float* mu, int ks, int h2, int mode) {
    float v[8]; rw_load_shift8(Pt, hasprev, C_RWX + 16 * ks + 8 * h2, mu + 768 + 16 * ks + 8 * h2, v);
    if (mode == 1) {
#pragma unroll
        for (int j = 0; j < 8; ++j) v[j] = tanhf_(v[j]);
    } else if (mode == 2) {
#pragma unroll
        for (int j = 0; j < 8; ++j) v[j] = sigmoidf_(v[j]);
    }
    u32x4 pb; pb.x = pk2(v[0], v[1]); pb.y = pk2(v[2], v[3]); pb.z = pk2(v[4], v[5]); pb.w = pk2(v[6], v[7]);
    return __builtin_bit_cast(bf16x8, pb);
}

constexpr int RC_V = 0, RC_KB = 4608, RC_BB = 9216, RC_KT = 13824, RC_CF = 13824, RC_PC = 18432, RC_WAVE = 18688, RC_ROWB = 144;
DI float scan32(float x) {
    x += dppf<0x111, 0xf, true>(x); x += dppf<0x112, 0xf, true>(x); x += dppf<0x114, 0xf, true>(x); x += dppf<0x118, 0xf, true>(x);
    x += dppf<0x142, 0xa, false>(x);
    return x;
}
DI bf16x8 pk8f(const float (&v)[8]) { u32x4 p; p.x = pk2(v[0], v[1]); p.y = pk2(v[2], v[3]); p.z = pk2(v[4], v[5]); p.w = pk2(v[6], v[7]); return __builtin_bit_cast(bf16x8, p); }
DI bf16x8 rc_trfrag(const LAS unsigned char* tile, int lane, int s, int colblk) {
    const int h2 = lane >> 5;
    const LAS unsigned char* p = tile + (16 * s + 4 * h2 + ((lane & 15) >> 2)) * RC_ROWB + (32 * colblk + 16 * ((lane >> 4) & 1) + 4 * (lane & 3)) * 2;
    const s16x4 lo = tr_read(p), hi = tr_read(p + 8 * RC_ROWB);
    return __builtin_shufflevector(lo, hi, 0, 1, 2, 3, 4, 5, 6, 7);
}
DI void rw_chunk_item(Frame& F, int layer, int bh, int ch) {
    asm volatile("" : "+s"(F.in)); asm volatile("" : "+s"(F.ws)); asm volatile("" : "+v"(F.lane));
    const int lane = F.lane, r32 = lane & 31, h2 = lane >> 5, hd = bh & 3, bb = bh >> 2;
    LAS unsigned char* W = F.lds + F.wave * RC_WAVE;
    const int tl = 32 * ch + r32, tok = bb * SEQ + tl; const bool hasprev = tl > 0;
    const bf16_t* Pt0 = WSP(bf16_t, WS_P) + (size_t)tok * PP;
    const float* mu = F.in[5] + (size_t)layer * 1024;
    const bf16_t* wc = WSP(bf16_t, WS_WCAT) + (size_t)layer * 65536 + (size_t)(64 * hd + r32) * 256 + 8 * h2;
    const int chunk = bh * 64 + ch;
    float n2 = 0.f;
    const float* kkw = F.in[11] + layer * 256 + 64 * hd;
#pragma unroll
    for (int blk = 0; blk < 2; ++blk)
#pragma unroll
        for (int g = 0; g < 4; ++g) { const int cl = 32 * blk + 8 * g + 4 * h2; float kv[4]; rw_load_shift4(Pt0, hasprev, C_RWK + 64 * hd + cl, mu + 256 + 64 * hd + cl, kv);
            const f32x4 kw = *(const f32x4*)(kkw + cl);
#pragma unroll
            for (int j = 0; j < 4; ++j) { const float q = kv[j] * kw[j]; n2 += q * q; } }
    n2 += swap32(n2);
    const float inv = 1.f / fmaxf(sqrtf(n2), 1e-12f);
    const float *w0 = F.in[6] + layer * 256 + 64 * hd, *a0 = F.in[8] + layer * 256 + 64 * hd, *kaw = F.in[12] + layer * 256 + 64 * hd, *rk = F.in[13] + layer * 256 + 64 * hd;
    u32x4* FR = WSP(u32x4, WS_CHFR) + (size_t)chunk * 16 * 64 + lane;
    float bon = 0.f;
#pragma unroll
    for (int blk = 0; blk < 2; ++blk) {
        const bf16_t* wb = wc + (size_t)blk * 32 * 256;
        f32x16 aW = {}, aA = {};
#pragma unroll
        for (int ks = 0; ks < 4; ++ks) { const bf16x8 bfr = rw_act_frag(Pt0, hasprev, mu, ks, h2, 1); aW = MFMA32(*(const bf16x8*)(wb + 16 * ks), bfr, aW); }
#pragma unroll
        for (int ks = 4; ks < 8; ++ks) { const bf16x8 bfr = rw_act_frag(Pt0, hasprev, mu, ks, h2, 0); aA = MFMA32(*(const bf16x8*)(wb + 16 * ks), bfr, aA); }
#pragma unroll
        for (int s = 0; s < 2; ++s) {
            float e_kat[8], e_rt[8], e_kt[8], e_bt[8], e_kb[8], e_bb[8];
#pragma unroll
            for (int q = 0; q < 2; ++q) { const int g = 2 * s + q, cl = 32 * blk + 8 * g + 4 * h2;
                const bf16_t* Pt = Pt0;
                float rv[4], vv[4], kv[4]; rw_load_shift4(Pt, hasprev, C_RWR + 64 * hd + cl, mu + 64 * hd + cl, rv); rw_load_shift4(Pt, hasprev, C_RWV + 64 * hd + cl, mu + 512 + 64 * hd + cl, vv);
                rw_load_shift4(Pt, hasprev, C_RWK + 64 * hd + cl, mu + 256 + 64 * hd + cl, kv);
                const f32x4 w0v = *(const f32x4*)(w0 + cl), a0v = *(const f32x4*)(a0 + cl), kav = *(const f32x4*)(kaw + cl), rkv = *(const f32x4*)(rk + cl), kwv = *(const f32x4*)(kkw + cl);
#pragma unroll
                for (int j = 0; j < 4; ++j) { const int r = 4 * g + j, jj = 4 * q + j;
                    const float w = -softplusf_(-(w0v[j] + aW[r])) - 0.5f;
                    const float l2d = -LOG2E * ex2(w * LOG2E);
                    const float a = sigmoidf_(a0v[j] + aA[r]);
                    const float kkv = kv[j] * kwv[j] * inv, bev = kkv * a, kpv = kv[j] * (1.f + (a - 1.f) * kav[j]);
                    bon += rv[j] * kpv * rkv[j];
                    const float Li = scan32(l2d), Lex = Li - l2d, LC = __shfl(Li, 31 + 32 * h2);
                    const float pin = ex2(Li), pex = ex2(Lex), pinv = ex2(-Li), pc = ex2(LC - Li);
                    e_kat[jj] = kkv * pex; e_rt[jj] = rv[j] * pin; e_kt[jj] = kpv * pinv; e_bt[jj] = bev * pinv; e_kb[jj] = kpv * pc; e_bb[jj] = bev * pc;
                    if (r32 == 31) *(LAS float*)(W + RC_PC + (cl + j) * 4) = ex2(LC); }
                u32x2 vq; vq.x = pk2(vv[0], vv[1]); vq.y = pk2(vv[2], vv[3]);
                *(LAS u32x2*)(W + RC_V + r32 * RC_ROWB + cl * 2) = vq;
                *(LAS u32x2*)(W + RC_KB + r32 * RC_ROWB + cl * 2) = (u32x2){pk2(e_kb[4 * q], e_kb[4 * q + 1]), pk2(e_kb[4 * q + 2], e_kb[4 * q + 3])};
                *(LAS u32x2*)(W + RC_BB + r32 * RC_ROWB + cl * 2) = (u32x2){pk2(e_bb[4 * q], e_bb[4 * q + 1]), pk2(e_bb[4 * q + 2], e_bb[4 * q + 3])};
                *(LAS u32x2*)(W + RC_KT + r32 * RC_ROWB + cl * 2) = (u32x2){pk2(e_kat[4 * q], e_kat[4 * q + 1]), pk2(e_kat[4 * q + 2], e_kat[4 * q + 3])};
            }
            { const int ks = 2 * blk + s; FR[(ks * 4 + 0) * 64] = __builtin_bit_cast(u32x4, pk8f(e_kat)); FR[(ks * 4 + 1) * 64] = __builtin_bit_cast(u32x4, pk8f(e_rt)); FR[(ks * 4 + 2) * 64] = __builtin_bit_cast(u32x4, pk8f(e_kt)); FR[(ks * 4 + 3) * 64] = __builtin_bit_cast(u32x4, pk8f(e_bt)); }
        }
        f32x16 aG = {};
#pragma unroll 4
        for (int ks = 8; ks < 16; ++ks) { const bf16x8 bfr = rw_act_frag(Pt0, hasprev, mu, ks, h2, 2); aG = MFMA32(*(const bf16x8*)(wb + 16 * ks), bfr, aG); }
#pragma unroll
        for (int g = 0; g < 4; ++g) { const int cl = 32 * blk + 8 * g + 4 * h2; u32x2 gq;
            gq.x = pk2(aG[4 * g], aG[4 * g + 1]); gq.y = pk2(aG[4 * g + 2], aG[4 * g + 3]);
            *(u32x2*)(WSP(bf16_t, WS_GBUF) + (size_t)tok * 256 + 64 * hd + cl) = gq; }
    }
    bon += swap32(bon);
    asm volatile("s_waitcnt vmcnt(0)" ::: "memory");
    asm volatile("" ::: "memory");
#pragma unroll
    for (int blk = 0; blk < 2; ++blk)
#pragma unroll
        for (int g = 0; g < 4; ++g) { const int cl = 32 * blk + 8 * g + 4 * h2; const u32x2 vq = *(const LAS u32x2*)(W + RC_V + r32 * RC_ROWB + cl * 2); u32x2 q;
            q.x = pk2(bon * bf2f(vq.x & 0xffffu), bon * bf2f(vq.x >> 16)); q.y = pk2(bon * bf2f(vq.y & 0xffffu), bon * bf2f(vq.y >> 16));
            *(u32x2*)(WSP(bf16_t, WS_BONV) + (size_t)tok * 256 + 64 * hd + cl) = q; }
    const float pc_lo = *(const LAS float*)(W + RC_PC + r32 * 4), pc_hi = *(const LAS float*)(W + RC_PC + (32 + r32) * 4);
    bf16x8 akkf[2], arkf[2], arbf[2];
    f32x16 Tt;
    {
        f32x16 skk = {}, skb = {}, sl = {};
#pragma unroll
        for (int ks = 0; ks < 4; ++ks) { const bf16x8 katf = __builtin_bit_cast(bf16x8, FR[(ks * 4 + 0) * 64]), ktf = __builtin_bit_cast(bf16x8, FR[(ks * 4 + 2) * 64]), btf = __builtin_bit_cast(bf16x8, FR[(ks * 4 + 3) * 64]);
            skk = MFMA32(ktf, katf, skk); skb = MFMA32(btf, katf, skb); sl = MFMA32(katf, btf, sl); }
#pragma unroll
        for (int r = 0; r < 16; ++r) { const int i = crow(r, h2); if (i >= r32) { skk[r] = 0.f; skb[r] = 0.f; } if (i <= r32) sl[r] = 0.f; }
#pragma unroll
        for (int s = 0; s < 2; ++s) akkf[s] = pack8(skk, s);
        bf16x8 fx[2], fxt[2];
#pragma unroll
        for (int s = 0; s < 2; ++s) { fx[s] = pack8(sl, s); fxt[s] = pack8(skb, s); }
#pragma unroll
        for (int r = 0; r < 16; ++r) Tt[r] = ((crow(r, h2) == r32) ? 1.f : 0.f) - skb[r];
#pragma unroll
        for (int lvl = 0; lvl < 4; ++lvl) {
            f32x16 p = {}, pt = {};
#pragma unroll
            for (int s = 0; s < 2; ++s) { p = MFMA32(fxt[s], fx[s], p); if (lvl < 3) pt = MFMA32(fx[s], fxt[s], pt); }
#pragma unroll
            for (int s = 0; s < 2; ++s) fx[s] = pack8(p, s);
            const bf16x8 t0 = pack8(Tt, 0), t1 = pack8(Tt, 1);
            Tt = MFMA32(fx[0], t0, Tt); Tt = MFMA32(fx[1], t1, Tt);
            if (lvl < 3) {
#pragma unroll
                for (int s = 0; s < 2; ++s) fxt[s] = pack8(pt, s); }
        }
    }
    {
        f32x16 srk = {}, srb = {};
#pragma unroll
        for (int ks = 0; ks < 4; ++ks) { const bf16x8 rtf = __builtin_bit_cast(bf16x8, FR[(ks * 4 + 1) * 64]), ktf = __builtin_bit_cast(bf16x8, FR[(ks * 4 + 2) * 64]), btf = __builtin_bit_cast(bf16x8, FR[(ks * 4 + 3) * 64]);
            srk = MFMA32(ktf, rtf, srk); srb = MFMA32(btf, rtf, srb); }
#pragma unroll
        for (int r = 0; r < 16; ++r) if (crow(r, h2) > r32) { srk[r] = 0.f; srb[r] = 0.f; }
#pragma unroll
        for (int s = 0; s < 2; ++s) { arkf[s] = pack8(srk, s); arbf[s] = pack8(srb, s); }
    }
    asm volatile("" ::: "memory");
    bf16x8 ng1f[2][2], ng2f[2][2];
    {
        const bf16x8 tf0 = pack8(Tt, 0), tf1 = pack8(Tt, 1);
#pragma unroll
        for (int cb = 0; cb < 2; ++cb) {
            f32x16 g = {};
            g = MFMA32(tf0, rc_trfrag(W + RC_KT, lane, 0, cb), g); g = MFMA32(tf1, rc_trfrag(W + RC_KT, lane, 1, cb), g);
#pragma unroll
            for (int r = 0; r < 16; ++r) g[r] = -g[r];
            ng1f[cb][0] = pack8(g, 0); ng1f[cb][1] = pack8(g, 1);
        }
#pragma unroll
        for (int vb = 0; vb < 2; ++vb) {
            f32x16 x1 = {};
#pragma unroll
            for (int s = 0; s < 2; ++s) x1 = MFMA32(akkf[s], rc_trfrag(W + RC_V, lane, s, vb), x1);
            f32x16 g = {};
            g = MFMA32(tf0, pack8(x1, 0), g); g = MFMA32(tf1, pack8(x1, 1), g);
#pragma unroll
            for (int r = 0; r < 16; ++r) g[r] = -g[r];
            ng2f[vb][0] = pack8(g, 0); ng2f[vb][1] = pack8(g, 1);
        }
    }
    asm volatile("" ::: "memory");
    u32x4* mt = WSP(u32x4, WS_CHMT) + (size_t)chunk * 8 * 64 + lane;
#pragma unroll
    for (int bip = 0; bip < 2; ++bip)
#pragma unroll
        for (int bi = 0; bi < 2; ++bi) {
            f32x16 m = {};
#pragma unroll
            for (int s = 0; s < 2; ++s) m = MFMA32(ng1f[bi][s], rc_trfrag(W + RC_BB, lane, s, bip), m);
            if (bi == bip) {
#pragma unroll
                for (int r = 0; r < 16; ++r) if (crow(r, h2) == r32) m[r] += (bi ? pc_hi : pc_lo); }
#pragma unroll
            for (int s = 0; s < 2; ++s) mt[(bip * 4 + bi * 2 + s) * 64] = __builtin_bit_cast(u32x4, pack8(m, s));
        }
    asm volatile("" ::: "memory");
    u32x4* nb_ = WSP(u32x4, WS_CHN) + (size_t)chunk * 8 * 64 + lane;
#pragma unroll
    for (int vb = 0; vb < 2; ++vb)
#pragma unroll
        for (int bip = 0; bip < 2; ++bip) {
            f32x16 n = {};
#pragma unroll
            for (int s = 0; s < 2; ++s) { n = MFMA32(rc_trfrag(W + RC_KB, lane, s, bip), rc_trfrag(W + RC_V, lane, s, vb), n); n = MFMA32(rc_trfrag(W + RC_BB, lane, s, bip), ng2f[vb][s], n); }
#pragma unroll
            for (int s = 0; s < 2; ++s) nb_[((vb * 2 + bip) * 2 + s) * 64] = __builtin_bit_cast(u32x4, pack8(n, s));
        }
    asm volatile("" ::: "memory");
    u32x4* ry = WSP(u32x4, WS_CHRY) + (size_t)chunk * 4 * 64 + lane;
#pragma unroll
    for (int bi = 0; bi < 2; ++bi) {
        f32x16 q = {};
#pragma unroll
        for (int s = 0; s < 2; ++s) q = MFMA32(ng1f[bi][s], arbf[s], q);
#pragma unroll
        for (int s = 0; s < 2; ++s) { const u32x4 rq = FR[((2 * bi + s) * 4 + 1) * 64]; float o[8];
#pragma unroll
            for (int j = 0; j < 4; ++j) { o[2 * j] = q[8 * s + 2 * j] + bf2f(rq[j] & 0xffffu); o[2 * j + 1] = q[8 * s + 2 * j + 1] + bf2f(rq[j] >> 16); }
            ry[(bi * 2 + s) * 64] = __builtin_bit_cast(u32x4, pk8f(o)); }
    }
    asm volatile("" ::: "memory");
    u32x4* y0 = WSP(u32x4, WS_CHY0) + (size_t)chunk * 4 * 64 + lane;
#pragma unroll
    for (int vb = 0; vb < 2; ++vb) {
        f32x16 yy = {};
#pragma unroll
        for (int s = 0; s < 2; ++s) { yy = MFMA32(arkf[s], rc_trfrag(W + RC_V, lane, s, vb), yy); yy = MFMA32(arbf[s], ng2f[vb][s], yy); }
#pragma unroll
        for (int s = 0; s < 2; ++s) y0[(vb * 2 + s) * 64] = __builtin_bit_cast(u32x4, pack8(yy, s));
    }
    asm volatile("s_waitcnt lgkmcnt(0)" ::: "memory");
}
DI void unpack16(const u32x4& a, const u32x4& b, f32x16& o) {
#pragma unroll
    for (int j = 0; j < 4; ++j) { o[2 * j] = bf2f(a[j] & 0xffffu); o[2 * j + 1] = bf2f(a[j] >> 16); o[8 + 2 * j] = bf2f(b[j] & 0xffffu); o[8 + 2 * j + 1] = bf2f(b[j] >> 16); }
}
constexpr int SQ_BH = 24576, SQ_STAGE = 2 * SQ_BH;
DI void rw_seq_wg(Frame& F, int item, unsigned* sd) {
    LAS unsigned char* L = F.lds; const int lane = F.lane, wid = F.wave, r32 = lane & 31, h2 = lane >> 5;
    __syncthreads();
    if (wid >= 4) {
        const int slot = (wid - 4) >> 1, half = (wid - 4) & 1, bh = 2 * item + slot;
        const u32x4* mtb = WSP(u32x4, WS_CHMT) + (size_t)bh * 64 * 8 * 64 + lane;
        const u32x4* nbb = WSP(u32x4, WS_CHN) + (size_t)bh * 64 * 8 * 64 + lane;
        const u32x4* ryb = WSP(u32x4, WS_CHRY) + (size_t)bh * 64 * 4 * 64 + lane;
        const u32x4* y0b = WSP(u32x4, WS_CHY0) + (size_t)bh * 64 * 4 * 64 + lane;
#define SQ_ISSUE(CH) do { const int ch_ = (CH); LAS unsigned char* st_ = L + (ch_ % 3) * SQ_STAGE + slot * SQ_BH; \
            if (half == 0) { _Pragma("unroll") for (int i = 0; i < 8; ++i) __builtin_amdgcn_global_load_lds((const unsigned*)(mtb + (size_t)ch_ * 512 + i * 64), (LAS unsigned*)(st_ + i * 1024), 16, 0, 0); \
                             _Pragma("unroll") for (int i = 0; i < 4; ++i) __builtin_amdgcn_global_load_lds((const unsigned*)(ryb + (size_t)ch_ * 256 + i * 64), (LAS unsigned*)(st_ + (8 + i) * 1024), 16, 0, 0); } \
            else { _Pragma("unroll") for (int i = 0; i < 8; ++i) __builtin_amdgcn_global_load_lds((const unsigned*)(nbb + (size_t)ch_ * 512 + i * 64), (LAS unsigned*)(st_ + (12 + i) * 1024), 16, 0, 0); \
                   _Pragma("unroll") for (int i = 0; i < 4; ++i) __builtin_amdgcn_global_load_lds((const unsigned*)(y0b + (size_t)ch_ * 256 + i * 64), (LAS unsigned*)(st_ + (20 + i) * 1024), 16, 0, 0); } } while (0)
        SQ_ISSUE(0); SQ_ISSUE(1);
        asm volatile("s_waitcnt vmcnt(12)" ::: "memory");
        __builtin_amdgcn_s_barrier();
#pragma unroll 1
        for (int ch = 0; ch < 64; ++ch) {
            if (ch + 2 < 64) { SQ_ISSUE(ch + 2); asm volatile("s_waitcnt vmcnt(12)" ::: "memory"); }
            else asm volatile("s_waitcnt vmcnt(0)" ::: "memory");
            __builtin_amdgcn_s_barrier();
        }
#undef SQ_ISSUE
    } else {
        const int slot = wid >> 1, vb = wid & 1, bh = 2 * item + slot;
        f32x16 H0 = {}, H1 = {};
        float* yb = WSP(float, WS_YBUF) + (size_t)(bh >> 2) * SEQ * 256 + (bh & 3) * 64 + 32 * vb + r32;
        __builtin_amdgcn_s_barrier();
#pragma unroll 1
        for (int ch = 0; ch < 64; ++ch) {
            const LAS unsigned char* st = L + (ch % 3) * SQ_STAGE + slot * SQ_BH + lane * 16;
            u32x4 cmt[8], cry[4], cnn[4], cy0[2];
#pragma unroll
            for (int i = 0; i < 8; ++i) cmt[i] = *(const LAS u32x4*)(st + i * 1024);
#pragma unroll
            for (int i = 0; i < 4; ++i) { cry[i] = *(const LAS u32x4*)(st + (8 + i) * 1024); cnn[i] = *(const LAS u32x4*)(st + (12 + 4 * vb + i) * 1024); }
            cy0[0] = *(const LAS u32x4*)(st + (20 + 2 * vb) * 1024); cy0[1] = *(const LAS u32x4*)(st + (21 + 2 * vb) * 1024);
            bf16x8 hb[4]; hb[0] = pack8(H0, 0); hb[1] = pack8(H0, 1); hb[2] = pack8(H1, 0); hb[3] = pack8(H1, 1);
            f32x16 y, n0, n1;
            unpack16(cy0[0], cy0[1], y); unpack16(cnn[0], cnn[1], n0); unpack16(cnn[2], cnn[3], n1);
            asm volatile("s_waitcnt lgkmcnt(0)" ::: "memory");
#pragma unroll
            for (int ks = 0; ks < 4; ++ks) { n0 = MFMA32(__builtin_bit_cast(bf16x8, cmt[ks]), hb[ks], n0); n1 = MFMA32(__builtin_bit_cast(bf16x8, cmt[4 + ks]), hb[ks], n1); y = MFMA32(__builtin_bit_cast(bf16x8, cry[ks]), hb[ks], y); }
            H0 = n0; H1 = n1;
#pragma unroll
            for (int r = 0; r < 16; ++r) yb[(size_t)(32 * ch + crow(r, h2)) * 256] = y[r];
            __builtin_amdgcn_s_barrier();
        }
        asm volatile("s_waitcnt vmcnt(0)" ::: "memory");
    }
    __syncthreads();
    if (F.tid == 0) {
        __builtin_amdgcn_fence(__ATOMIC_RELEASE, "agent");
        asm volatile("s_waitcnt vmcnt(0)" ::: "memory");
        (void)xb_add(sd, 1u);
    }
}
template <int NB> DI void rw_post_batch(Frame& F, int layer, int w0, int ws) {
    const int lane = F.lane;
    float y[NB], bv[NB], g[NB]; int tokv[NB], cv[NB];
#pragma unroll
    for (int i = 0; i < NB; ++i) { const int w = w0 + i * ws; tokv[i] = w >> 2; cv[i] = 64 * (w & 3) + lane;
        y[i] = WSP(float, WS_YBUF)[(size_t)tokv[i] * 256 + cv[i]];
        bv[i] = bf2f(WSP(bf16_t, WS_BONV)[(size_t)tokv[i] * 256 + cv[i]]); g[i] = bf2f(WSP(bf16_t, WS_GBUF)[(size_t)tokv[i] * 256 + cv[i]]); }
#pragma unroll
    for (int i = 0; i < NB; ++i) {
        const float mean = wave_sum(y[i]) * (1.f / 64.f), dv = y[i] - mean, var = wave_sum(dv * dv) * (1.f / 64.f);
        const float yn = dv * __builtin_amdgcn_rsqf(var + 64e-5f) * F.in[14][layer * 256 + cv[i]] + F.in[15][layer * 256 + cv[i]];
        WSP(bf16_t, WS_MIX)[(size_t)tokv[i] * D + 512 + cv[i]] = (bf16_t)f2bf((yn + bv[i]) * g[i]);
    }
}

constexpr int RT_WSTR = 1028;
DI void p4_router(Frame& F, int layer, bool dry) {
    LAS unsigned char* L = F.lds; const int tid = F.tid, lane = F.lane, wid = F.wave, m16 = lane & 15, q4 = lane >> 4;
    LAS float* W = (LAS float*)L;
    LAS float* wlog = (LAS float*)L + wid * (16 * 49);
    LAS int* ent = (LAS int*)(L + 148032);
    LAS float* entg = (LAS float*)(L + 148032 + 4096);
    LAS int* lcnt = (LAS int*)(L + 148032 + 5120);
    LAS int* lbase = lcnt + 144;
    const float* x = F.out; bf16_t* xb = WSP(bf16_t, WS_XB);
    const float *bg = F.in[20] + layer * 4, *be = F.in[22] + layer * 32;
    unsigned* cnt = (unsigned*)(F.ws + WS_CTL) + CW_CNT + layer * 256;
    int* elist = WSP(int, WS_LIST); float* egate = WSP(float, WS_GLIST); u32x2* plist = WSP(u32x2, WS_PLIST);
    for (int blk = F.bid; blk < NT / 128; blk += F.G) {
        __syncthreads();
        { const f32x4* src = (const f32x4*)(WSP(float, WS_RTW) + (size_t)layer * 36 * 1024);
          for (int i = tid; i < 36 * 256; i += 512) *(LAS f32x4*)(W + (i >> 8) * RT_WSTR + 4 * (i & 255)) = src[i]; }
        if (tid < 144) lcnt[tid] = 0;
        __syncthreads();
        const int row0 = blk * 128 + wid * 16;
        const float* xr = x + (size_t)(row0 + m16) * D + 4 * q4; bf16_t* xbr = xb + (size_t)(row0 + m16) * D + 4 * q4;
        f32x4 a0 = {}, a1 = {}, a2 = {}; float ssq = 0.f;
        const LAS float* w0p = W + (size_t)m16 * RT_WSTR + 4 * q4; const LAS float* w1p = w0p + 16 * RT_WSTR; const LAS float* w2p = W + (size_t)(32 + (m16 & 3)) * RT_WSTR + 4 * q4;
        const bool v2 = m16 < 4;
#pragma unroll 16
        for (int j = 0; j < 64; ++j) {
            const f32x4 xv = *(const f32x4*)(xr + 16 * j);
            const f32x4 wa = *(const LAS f32x4*)(w0p + 16 * j), wb = *(const LAS f32x4*)(w1p + 16 * j); f32x4 wc_ = *(const LAS f32x4*)(w2p + 16 * j);
            if (!v2) wc_ = (f32x4){0.f, 0.f, 0.f, 0.f};
            ssq += (xv[0] * xv[0] + xv[1] * xv[1]) + (xv[2] * xv[2] + xv[3] * xv[3]);
            u32x2 w; w.x = pk2(xv[0], xv[1]); w.y = pk2(xv[2], xv[3]); *(u32x2*)(xbr + 16 * j) = w;
#pragma unroll
            for (int i = 0; i < 4; ++i) { a0 = __builtin_amdgcn_mfma_f32_16x16x4f32(xv[i], wa[i], a0, 0, 0, 0); a1 = __builtin_amdgcn_mfma_f32_16x16x4f32(xv[i], wb[i], a1, 0, 0, 0); a2 = __builtin_amdgcn_mfma_f32_16x16x4f32(xv[i], wc_[i], a2, 0, 0, 0); }
        }
        ssq += __shfl_xor(ssq, 16); ssq += __shfl_xor(ssq, 32);
        __syncthreads();
#pragma unroll
        for (int jj = 0; jj < 4; ++jj) { wlog[(4 * q4 + jj) * 49 + m16] = a0[jj]; wlog[(4 * q4 + jj) * 49 + 16 + m16] = a1[jj]; wlog[(4 * q4 + jj) * 49 + 32 + m16] = a2[jj]; }
        asm volatile("s_waitcnt lgkmcnt(0)" ::: "memory");
        if (lane < 16) {
            const int r = lane, row = row0 + r;
            const float rstd = __builtin_amdgcn_rsqf(ssq * (1.f / 1024.f) + 1e-6f);
            WSP(float, WS_RSTD2)[row] = rstd;
            float gl[4]; int gs = 0; float gmax;
#pragma unroll
            for (int j = 0; j < 4; ++j) gl[j] = wlog[r * 49 + j] * rstd + bg[j];
            gmax = gl[0];
#pragma unroll
            for (int j = 1; j < 4; ++j) if (gl[j] > gmax) { gmax = gl[j]; gs = j; }
            float gsum = 0.f;
#pragma unroll
            for (int j = 0; j < 4; ++j) gsum += ex2((gl[j] - gmax) * LOG2E);
            const float ggate = 1.f / gsum;
            float el[8];
#pragma unroll
            for (int j = 0; j < 8; ++j) el[j] = wlog[r * 49 + 4 + gs * 8 + j] * rstd + be[gs * 8 + j];
            int i0 = 0; float m0 = el[0];
#pragma unroll
            for (int j = 1; j < 8; ++j) if (el[j] > m0) { m0 = el[j]; i0 = j; }
            int i1 = -1; float m1 = -3.0e38f;
#pragma unroll
            for (int j = 0; j < 8; ++j) if (j != i0 && (i1 < 0 || el[j] > m1)) { m1 = el[j]; i1 = j; }
            const float e1 = ex2((m1 - m0) * LOG2E), g0 = ggate / (1.f + e1), g1 = ggate * e1 / (1.f + e1);
            const int la = i0 < i1 ? i0 : i1, lb = i0 < i1 ? i1 : i0; const float ga = i0 < i1 ? g0 : g1, gb = i0 < i1 ? g1 : g0;
            const int ea = gs * 8 + la, eb = gs * 8 + lb, pid = gs * 28 + la * (15 - la) / 2 + (lb - la - 1);
            const int ra = atomicAdd((int*)&lcnt[ea], 1), rb = atomicAdd((int*)&lcnt[eb], 1), rp = atomicAdd((int*)&lcnt[32 + pid], 1);
            const int li = wid * 16 + r;
            ent[li * 8 + 0] = ea; ent[li * 8 + 1] = eb; ent[li * 8 + 2] = pid; ent[li * 8 + 3] = ra; ent[li * 8 + 4] = rb; ent[li * 8 + 5] = rp; entg[li * 2] = ga; entg[li * 2 + 1] = gb;
        }
        __syncthreads();
        if (tid < 144) { const int n = lcnt[tid]; lbase[tid] = (n && !dry) ? (int)xb_add(cnt + tid, (unsigned)n) : 0; }
        __syncthreads();
        if (tid < 128 && !dry) { const int row = blk * 128 + tid; const int ea = ent[tid * 8], eb = ent[tid * 8 + 1], pid = ent[tid * 8 + 2];
            const int pa = lbase[ea] + ent[tid * 8 + 3], pb = lbase[eb] + ent[tid * 8 + 4], pp = lbase[32 + pid] + ent[tid * 8 + 5];
            elist[(size_t)ea * LCAP + pa] = row; egate[(size_t)ea * LCAP + pa] = entg[tid * 2];
            elist[(size_t)eb * LCAP + pb] = row; egate[(size_t)eb * LCAP + pb] = entg[tid * 2 + 1];
            plist[(size_t)pid * LCAP + pp] = (u32x2){(unsigned)row, (unsigned)pa | ((unsigned)pb << 16)}; }
    }
    __syncthreads();
}
DI void moe_tables(Frame& F, int layer) {
    LAS MoeTab* T = (LAS MoeTab*)(F.lds + LDS_AUX);
    unsigned* cnt = (unsigned*)(F.ws + WS_CTL) + CW_CNT + layer * 256;
    __syncthreads();
    if (F.tid < 32) T->ce[F.tid] = (int)xb_ld(cnt + F.tid); else if (F.tid < 144) T->cp[F.tid - 32] = (int)xb_ld(cnt + F.tid);
    __syncthreads();
    if (F.tid == 0) { int sb = 0, tg = 0;
        for (int e = 0; e < 32; ++e) { const int a = T->ce[e]; T->sb[e] = sb; T->tpg[e] = tg; sb += a; tg += (a + 255) >> 8; }
        T->tpg[32] = tg; }
    if (F.tid == 64) { int tf = 0, th = 0;
        for (int p = 0; p < 112; ++p) { const int n = T->cp[p], nt_ = (n + 255) >> 8, half = (nt_ > 0 && n - 256 * (nt_ - 1) <= 128) ? 1 : 0; T->tpf[p] = tf; T->tph[p] = th; tf += nt_ - half; th += half; }
        T->tpf[112] = tf; T->tph[112] = th; }
    __syncthreads();
}
DI void p_final(Frame& F) {
    const int gw = F.bid * 8 + F.wave, NGW = F.G * 8; const f32x4* gq = (const f32x4*)F.in[26] + F.lane;
    f32x4 gv[4];
#pragma unroll
    for (int j = 0; j < 4; ++j) gv[j] = gq[64 * j];
    for (int m0 = gw * 4; m0 < NT; m0 += NGW * 4) {
        f32x4 v[4][4];
#pragma unroll
        for (int r = 0; r < 4; ++r) { const f32x4* xr = (const f32x4*)(F.out + (size_t)(m0 + r) * D) + F.lane;
#pragma unroll
            for (int j = 0; j < 4; ++j) v[r][j] = xr[64 * j]; }
#pragma unroll
        for (int r = 0; r < 4; ++r) { float s = 0.f; f32x4* xw = (f32x4*)(F.out + (size_t)(m0 + r) * D) + F.lane;
#pragma unroll
            for (int j = 0; j < 4; ++j) s += (v[r][j][0] * v[r][j][0] + v[r][j][1] * v[r][j][1]) + (v[r][j][2] * v[r][j][2] + v[r][j][3] * v[r][j][3]);
            const float rstd = __builtin_amdgcn_rsqf(wave_sum(s) * (1.f / 1024.f) + 1e-6f);
#pragma unroll
            for (int j = 0; j < 4; ++j) xw[64 * j] = v[r][j] * rstd * gv[j]; }
    }
}


#ifndef DUP_PH
#define DUP_PH -1
#endif
#define NREP(n) ((DUP_PH == (n)) ? 2 : 1)
constexpr int PH_PER_LAYER = 6, N_PHASES = 1 + DEPTH * PH_PER_LAYER + 1;
__global__ void __launch_bounds__(512, 2) mk_fwd(Args args) {
    extern __shared__ __attribute__((aligned(16))) unsigned char lds_raw[];
    Frame F;
    F.lds = (LAS unsigned char*)lds_raw; F.tid = threadIdx.x; F.lane = F.tid & 63; F.wave = __builtin_amdgcn_readfirstlane(F.tid >> 6);
    F.G = gridDim.x; F.bid = blockIdx.x; F.in = (const __attribute__((address_space(4))) cfp_t*)__builtin_amdgcn_kernarg_segment_ptr(); F.out = args.out; F.ws = args.ws;
    volatile LAS unsigned* MISC = (volatile LAS unsigned*)(F.lds + LDS_MISC);
    if (F.tid < 64) MISC[F.tid] = 0u;
    __syncthreads();
    unsigned* ctl = (unsigned*)(F.ws + WS_CTL);
    const int lo = args.ph_lo, hi = args.ph_hi;
    const bool multi = (hi - lo) > 1;
    XcdBarrier bar; bar.bar = ctl + CW_BAR; bar.x = 0; bar.st = nullptr;
    if (multi) bar = xcd_barrier_post(ctl + CW_BAR, MISC + 8);
#ifndef PHSEL
#define PHSEL -1
#endif
#ifndef PHMASK
#define PHMASK 0xFFFF
#endif
#define PS(n) ((PHSEL < 0 || PHSEL == (n)) && ((PHMASK >> (n)) & 1))
#define LAUNDER() do { asm volatile("" : "+s"(F.in)); asm volatile("" : "+s"(F.ws)); asm volatile("" : "+s"(F.out)); asm volatile("" : "+v"(F.tid)); asm volatile("" : "+v"(F.lane)); asm volatile("" : "+s"(F.bid)); asm volatile("" : "+s"(F.G)); } while (0)
#define IN(k) (lo <= (k) && (k) < hi)
#define SEAM(k) do { if (IN(k) && IN((k) + 1)) { xcd_barrier(bar); if (DUP_PH == 99) xcd_barrier(bar); } LAUNDER(); } while (0)
    LAUNDER();
    if (PS(0) && IN(0)) { _Pragma("unroll 1") for (int rep = 0; rep < NREP(0); ++rep) p0_prologue(F); }
    SEAM(0);
#pragma unroll 1
    for (int layer = 0; layer < DEPTH; ++layer) {
        const int pb = 1 + layer * PH_PER_LAYER;
        LAUNDER();
        if (PS(1) && IN(pb + 0)) _Pragma("unroll 1") for (int rep = 0; rep < NREP(1); ++rep) {
            ProbIn P; P.K = D; P.A = WSP(bf16_t, WS_XB); P.Bt = WSP(bf16_t, WS_BIN) + (size_t)layer * NIN * D; P.G = F.G; P.c = F.bid;
            P.Pout = WSP(bf16_t, WS_P); P.ss1 = WSP(float, WS_SS1); P.lf = WSP(float, WS_LF); P.bfx = F.in[16] + layer * 4; P.kmax = (unsigned*)(F.ws + WS_CTL) + CW_KMAX + layer * 128;
            pg8::gemm_phase<ProbIn, true>(F.lds, P, F.tid);
            LAUNDER();
            for (int it = F.bid * 8 + F.wave; it < NT / 16; it += F.G * 8) fgate_item(F, layer, it);
        }
        SEAM(pb + 0);
        if (IN(pb + 1)) _Pragma("unroll 1") for (int rep = 0; rep < NREP(2); ++rep) {
            if (PS(4)) { __syncthreads(); _Pragma("unroll 1") for (int rep2 = 0; rep2 < NREP(22); ++rep2) for (int i = F.bid; i < 512; i += F.G) { const int w = i * 8 + F.wave; rw_chunk_item(F, layer, w >> 6, w & 63); } __syncthreads(); }
        }
        if (IN(pb + 1)) {
            unsigned* r1d = (unsigned*)(F.ws + WS_CTL) + CW_R1D + layer * 2048;
            xcd_arrive(bar, r1d);
            unsigned* sdw = (unsigned*)(F.ws + WS_CTL) + CW_SD + layer * 64;
            if (PS(5)) { if (F.G >= 64) { if (F.bid < 32) { xcd_wait_all(bar, r1d); rw_seq_wg(F, F.bid, sdw); } } else { xcd_wait_all(bar, r1d); for (int i = F.bid; i < 32; i += F.G) rw_seq_wg(F, i, sdw); } }
            unsigned* wq = (unsigned*)(F.ws + WS_CTL) + CW_WQ + layer * 64;
            volatile LAS int* qslot = (volatile LAS int*)(F.lds + LDS_MISC + 64);
            __syncthreads();
            if (F.tid == 0) qslot[0] = (int)xb_add(wq, 1u);
            __syncthreads();
            int q = qslot[0];
#pragma unroll 1
            for (;;) {
                if (q >= 1024 + 256 + 256) break;
                unsigned nq = 0u; if (F.tid == 0) nq = xb_add(wq, 1u);
                LAUNDER();
                if (q < 512) { if (PS(6)) sb_unit(F, (q & 63) >> 2, q & 3, 7 - (q >> 6)); }
                else if (q < 1024) { const int r = q - 512; if (PS(2)) fx_unit(F, layer, (r & 63) >> 2, r & 3, 7 - (r >> 6)); }
                else if (q < 1280) { if (PS(3)) _Pragma("unroll 1") for (int k = 0; k < 4; ++k) { const int i = 4 * (q - 1024) + k; gm_unit(F, layer, i >> 6, (i >> 2) & 15, i & 3); } }
                else if (PS(7)) {
                    if (F.tid == 0) { unsigned sp = 0; while (xb_ld(sdw) < 32u) { __builtin_amdgcn_s_sleep(2); if (++sp > (1u << 22)) break; }
                        __builtin_amdgcn_fence(__ATOMIC_ACQUIRE, "agent"); asm volatile("s_waitcnt vmcnt(0)" ::: "memory"); }
                    __syncthreads();
                    const int w0 = (q - 1280) * 512 + F.wave;
                    _Pragma("unroll 1") for (int k = 0; k < 8; ++k) rw_post_batch<8>(F, layer, w0 + 64 * k, 8);
                }
                __syncthreads();
                if (F.tid == 0) qslot[0] = (int)nq;
                __syncthreads();
                q = qslot[0];
            }
        }
        SEAM(pb + 1);
        if (PS(8) && IN(pb + 2)) {
            ProbOut P; P.K = D; P.A = WSP(bf16_t, WS_MIX); P.Bt = WSP(bf16_t, WS_BOUT) + (size_t)layer * D * D; P.G = F.G; P.c = F.bid;
            P.base = (layer == 0) ? F.in[0] : F.out; P.out = F.out;
            if (DUP_PH == 8) { P.ascale = 0.f; P.base = F.out; pg8::gemm_phase<ProbOut, true>(F.lds, P, F.tid); P.base = (layer == 0) ? F.in[0] : F.out; }
            P.ascale = 1.f; pg8::gemm_phase<ProbOut, true>(F.lds, P, F.tid);
        }
        SEAM(pb + 2);
        if (PS(9) && IN(pb + 3)) { if (DUP_PH == 9) p4_router(F, layer, true); p4_router(F, layer, false); }
        SEAM(pb + 3);
        if (PS(10) && IN(pb + 4)) {
            moe_tables(F, layer);
            ProbGU P; P.K = D; P.A = WSP(bf16_t, WS_XB); P.Bt = WSP(bf16_t, WS_BGU) + (size_t)layer * NE * 1024 * D; P.G = F.G; P.c = F.bid;
            P.T = (const LAS MoeTab*)(F.lds + LDS_AUX); P.elist = WSP(int, WS_LIST); P.egate = WSP(float, WS_GLIST); P.rstd2 = WSP(float, WS_RSTD2); P.HB = WSP(bf16_t, WS_HB);
            pg8::gemm_phase<ProbGU, true>(F.lds, P, F.tid);
        }
        SEAM(pb + 4);
        if (PS(11) && IN(pb + 5)) {
            moe_tables(F, layer);
            ProbDP P; P.A = WSP(bf16_t, WS_HB); P.Bt = WSP(bf16_t, WS_BDN) + (size_t)layer * NE * D * EH; P.G = F.G; P.c = F.bid;
            P.T = (const LAS MoeTab*)(F.lds + LDS_AUX); P.plist = WSP(u32x2, WS_PLIST); P.x = F.out; P.xb = WSP(bf16_t, WS_XB); P.ss1 = WSP(float, WS_SS1);
            pg8::gemm_phase_pair<ProbDP>(F.lds, P, F.tid);
        }
        SEAM(pb + 5);
    }
    if (PS(13) && IN(N_PHASES - 1)) p_final(F);
#undef IN
#undef SEAM
}

#ifndef MK_ONE_LAUNCH
#define MK_ONE_LAUNCH 1
#endif
extern "C" void kernel_launch(void* const* d_in, const int* in_sizes, int n_in, void* d_out, int out_size, void* d_ws, size_t ws_size, hipStream_t stream) {
    static int grid = 0;
    if (grid == 0) {
        if (n_in != 27 || out_size != NT * D || ws_size < WS_END) { fprintf(stderr, "kernel_launch: unexpected shapes (n_in %d out %d ws %zu)\n", n_in, out_size, ws_size); grid = -1; return; }
        int dev = 0, cus = 0;
        if (hipGetDevice(&dev) != hipSuccess || hipDeviceGetAttribute(&cus, hipDeviceAttributeMultiprocessorCount, dev) != hipSuccess) { grid = -1; return; }
        if (hipFuncSetAttribute((const void*)mk_fwd, hipFuncAttributeMaxDynamicSharedMemorySize, LDS_BYTES) != hipSuccess) { fprintf(stderr, "kernel_launch: hipFuncSetAttribute failed\n"); grid = -1; return; }
        (void)hipGetLastError();
        grid = cus;
    }
    if (grid < 0) return;
    (void)hipMemsetAsync((char*)d_ws + WS_CTL, 0, CTL_BYTES, stream);
    Args a{};
    for (int i = 0; i < 27; ++i) a.in[i] = (const float*)d_in[i];
    a.out = (float*)d_out; a.ws = (unsigned char*)d_ws; a.li = 0; a.pad = 0;
#if MK_ONE_LAUNCH
    a.ph_lo = 0; a.ph_hi = N_PHASES;
    hipLaunchKernelGGL(mk_fwd, dim3(grid), dim3(512), LDS_BYTES, stream, a);
#else
    for (int p = 0; p < N_PHASES; ++p) { a.ph_lo = p; a.ph_hi = p + 1; hipLaunchKernelGGL(mk_fwd, dim3(grid), dim3(512), LDS_BYTES, stream, a); }
#endif
}
```

```cpp
#include <hip/hip_runtime.h>
#include <cstdio>
#include <cstdint>

#define DI __device__ __forceinline__
#define LAS __attribute__((address_space(3)))
#define GAS __attribute__((address_space(1)))
typedef unsigned short bf16_t;
typedef short bf16x8 __attribute__((ext_vector_type(8)));
typedef short s16x4 __attribute__((ext_vector_type(4)));
typedef float f32x2 __attribute__((ext_vector_type(2)));
typedef float f32x4 __attribute__((ext_vector_type(4)));
typedef float f32x16 __attribute__((ext_vector_type(16)));
typedef unsigned u32x2 __attribute__((ext_vector_type(2)));
typedef unsigned u32x4 __attribute__((ext_vector_type(4)));
typedef __bf16 bf16x2_t __attribute__((ext_vector_type(2)));
typedef GAS unsigned gu32;

constexpr int NT = 32768, SEQ = 2048, NB = 16, D = 1024, DEPTH = 4, NH = 4;
constexpr int PP = 3072;
constexpr int NIN = 3328;
constexpr int C_SBQ = 0, C_SBK = 256, C_SBV = 512, C_GMU = 768, C_GMV = 1024, C_RWR = 1280, C_RWK = 1536, C_RWV = 1792, C_RWX = 2048, C_FXQ = 2304, C_FXK = 2560, C_FXV = 2816;
constexpr int NE = 32, EH = 512;
constexpr float LOG2E = 1.4426950408889634f, LN2 = 0.6931471805599453f;
constexpr float QSCALE2 = 0.125f * LOG2E;

constexpr size_t MiB = 1u << 20;
constexpr size_t WS_CTL = 0, CTL_BYTES = 1 * MiB;
constexpr size_t WS_BIN = 1 * MiB;
constexpr size_t WS_BOUT = 28 * MiB;
constexpr size_t WS_BGU = 36 * MiB;
constexpr size_t WS_BDN = 292 * MiB;
constexpr size_t WS_WCAT = 420 * MiB;
constexpr size_t WS_RTW = 421 * MiB;
constexpr size_t WS_SS1 = 422 * MiB;
constexpr size_t WS_RSTD2 = 424 * MiB;
constexpr size_t WS_LF = 425 * MiB;
constexpr size_t WS_SCAL = 426 * MiB;
constexpr size_t WS_LIST = 428 * MiB;
constexpr size_t WS_GLIST = 436 * MiB;
constexpr size_t WS_GBUF = 444 * MiB;
constexpr size_t WS_YBUF = 460 * MiB;
constexpr size_t WS_MIX = 492 * MiB;
constexpr size_t WS_P = 556 * MiB;
constexpr size_t WS_XB = 748 * MiB;
constexpr size_t WS_HB = 812 * MiB;
constexpr size_t WS_REC = 748 * MiB;
constexpr size_t WS_CHMT = 748 * MiB;
constexpr size_t WS_CHN = 780 * MiB;
constexpr size_t WS_CHFR = 812 * MiB;
constexpr size_t WS_CHRY = 877 * MiB;
constexpr size_t WS_CHY0 = 893 * MiB;
constexpr size_t WS_BONV = 909 * MiB;
constexpr size_t WS_PLIST = 940 * MiB;
constexpr size_t WS_END = 968 * MiB;

constexpr int CW_BAR = 4096;
constexpr int CW_CNT = 16384;
constexpr int CW_R1D = 40960;
constexpr int CW_SD = 28672;
constexpr int CW_WQ = 24576;
constexpr int CW_KMAX = 20480;

constexpr int LDS_BYTES = 163840;
constexpr int LDS_AUX = 131072;
constexpr int LDS_MISC = 163840 - 256;

DI float bf2f(unsigned b) { return __uint_as_float(b << 16); }
DI unsigned pk2(float lo, float hi) { f32x2 v = {lo, hi}; bf16x2_t b = __builtin_convertvector(v, bf16x2_t); return __builtin_bit_cast(unsigned, b); }
DI unsigned f2bf(float f) { return pk2(f, 0.f) & 0xffffu; }
DI float ex2(float x) { return __builtin_amdgcn_exp2f(x); }
DI float lg2(float x) { return __builtin_amdgcn_logf(x); }
DI float rcpf_(float x) { return __builtin_amdgcn_rcpf(x); }
DI float sigmoidf_(float x) { return rcpf_(1.f + ex2(-x * LOG2E)); }
DI float tanhf_(float x) { return 1.f - 2.f * rcpf_(1.f + ex2(2.f * LOG2E * x)); }
DI float geluf_(float x) { const float u = 0.7978845608028654f * (x + 0.044715f * x * x * x); return x * rcpf_(1.f + ex2(-2.f * LOG2E * u)); }
DI float softplusf_(float x) { return fmaxf(x, 0.f) + LN2 * lg2(1.f + ex2(-fabsf(x) * LOG2E)); }
template <int CTRL, int RMASK, bool BC> DI float dppf(float x) { return __builtin_bit_cast(float, __builtin_amdgcn_update_dpp(0, __builtin_bit_cast(int, x), CTRL, RMASK, 0xf, BC)); }
DI float wave_sum(float v) {
    v += dppf<0xB1, 0xf, true>(v); v += dppf<0x4E, 0xf, true>(v); v += dppf<0x141, 0xf, true>(v); v += dppf<0x140, 0xf, true>(v);
    v += dppf<0x142, 0xa, false>(v); v += dppf<0x143, 0xc, false>(v);
    return __builtin_bit_cast(float, __builtin_amdgcn_readlane(__builtin_bit_cast(int, v), 63));
}
DI float swap32(float v) { return __shfl_xor(v, 32); }
#define MFMA32(a, b, c) __builtin_amdgcn_mfma_f32_32x32x16_bf16((a), (b), (c), 0, 0, 0)
DI int crow(int r, int h) { return (r & 3) + 8 * (r >> 2) + 4 * h; }

#define XB_TMO      128
#define XB_XCNT(j)  (256  + 64 * (j))
#define XB_XSUB(j)  (1280 + 64 * (j))
#define XB_XGEN(j)  (2304 + 64 * (j))
#define XB_TOP      3328
#define XB_TOPGEN   3392
#define XCD_BAR_WORDS 3456
#define XB_SPIN_CAP (1u << 18)
DI unsigned xb_ld(unsigned* p)              { return __hip_atomic_load(p, __ATOMIC_RELAXED, __HIP_MEMORY_SCOPE_AGENT); }
DI unsigned xb_add(unsigned* p, unsigned v) { return __hip_atomic_fetch_add(p, v, __ATOMIC_RELAXED, __HIP_MEMORY_SCOPE_AGENT); }
DI unsigned xb_xcc_id() { return (unsigned)__builtin_amdgcn_s_getreg((3 << 11) | 20) & 0xFu; }
#define XB_SPIN(cond, bar) do { unsigned _sp = 0; while (cond) { __builtin_amdgcn_s_sleep(1); \
    if ((++_sp & 255u) == 0u) { if (xb_ld(&(bar)[XB_TMO])) break; if (_sp > XB_SPIN_CAP) { atomicAdd(&(bar)[XB_TMO], 1u); break; } } } } while (0)
struct XcdBarrier { unsigned* bar; unsigned x; volatile LAS unsigned* st; };
DI XcdBarrier xcd_barrier_post(unsigned* bar, volatile LAS unsigned* st) {
    XcdBarrier b; b.bar = bar; b.x = xb_xcc_id(); b.st = st;
    if (threadIdx.x == 0) (void)xb_add(&bar[XB_XCNT(b.x)], 1u);
    return b;
}
DI void xcd_barrier_complete(unsigned* bar, unsigned x, unsigned& nloc, unsigned& nx) {
    const unsigned G = gridDim.x * gridDim.y * gridDim.z;
    unsigned sum, cnt, mine, sp = 0u;
    for (;;) {
        sum = 0u; cnt = 0u; mine = 0u;
#pragma unroll
        for (unsigned j = 0; j < 16; ++j) { const unsigned c = xb_ld(&bar[XB_XCNT(j)]); sum += c; cnt += (c > 0u) ? 1u : 0u; mine = (j == x) ? c : mine; }
        if (sum == G) break;
        __builtin_amdgcn_s_sleep(1);
        if ((++sp & 255u) == 0u) { if (xb_ld(&bar[XB_TMO])) break; if (sp > XB_SPIN_CAP) { atomicAdd(&bar[XB_TMO], 1u); break; } }
    }
    nloc = mine > 0u ? mine : 1u; nx = cnt > 0u ? cnt : 1u;
}
DI void xcd_barrier(const XcdBarrier& b) {
    asm volatile("s_waitcnt vmcnt(0)" ::: "memory");
    __syncthreads();
    if (threadIdx.x == 0) {
        unsigned* bar = b.bar;
        __builtin_amdgcn_s_waitcnt(0);
        unsigned nloc = b.st[0], nx = b.st[1];
        if (nloc == 0u) { xcd_barrier_complete(bar, b.x, nloc, nx); b.st[0] = nloc; b.st[1] = nx; }
        const unsigned old = xb_add(&bar[XB_XSUB(b.x)], 1u);
        const unsigned gen = old / nloc;
        if (old + 1u == (gen + 1u) * nloc) {
            __builtin_amdgcn_fence(__ATOMIC_RELEASE, "agent");
            asm volatile("s_waitcnt vmcnt(0)" ::: "memory");
            const unsigned og = xb_add(&bar[XB_TOP], 1u);
            const unsigned tg = og / nx;
            if (og + 1u == (tg + 1u) * nx) xb_add(&bar[XB_TOPGEN], 1u);
            else XB_SPIN(xb_ld(&bar[XB_TOPGEN]) == tg, bar);
            __builtin_amdgcn_fence(__ATOMIC_ACQUIRE, "agent");
            xb_add(&bar[XB_XGEN(b.x)], 1u);
            asm volatile("s_waitcnt vmcnt(0)" ::: "memory");
        } else {
            XB_SPIN(xb_ld(&bar[XB_XGEN(b.x)]) == gen, bar);
            __builtin_amdgcn_fence(__ATOMIC_ACQUIRE, "agent");
            asm volatile("s_waitcnt vmcnt(0)" ::: "memory");
        }
    }
    __syncthreads();
}

DI void xcd_arrive(const XcdBarrier& b, unsigned* w) {
    asm volatile("s_waitcnt vmcnt(0)" ::: "memory");
    __syncthreads();
    if (threadIdx.x == 0) {
        const unsigned nloc = b.st[0];
        const unsigned old = xb_add(&w[64 * b.x], 1u);
        if (old + 1u == nloc) { __builtin_amdgcn_fence(__ATOMIC_RELEASE, "agent"); asm volatile("s_waitcnt vmcnt(0)" ::: "memory"); (void)xb_add(&w[64 * 16], 1u); }
    }
}
DI void xcd_wait_all(const XcdBarrier& b, unsigned* w) {
    if (threadIdx.x == 0) { const unsigned nx = b.st[1]; unsigned sp = 0; while (xb_ld(&w[64 * 16]) < nx) { __builtin_amdgcn_s_sleep(1); if (++sp > (1u << 22)) break; }
        __builtin_amdgcn_fence(__ATOMIC_ACQUIRE, "agent"); asm volatile("s_waitcnt vmcnt(0)" ::: "memory"); }
    __syncthreads();
}

typedef const float* cfp_t;
struct Args { const float* in[27]; float* out; unsigned char* ws; int ph_lo, ph_hi, li, pad; };
struct Frame {
    LAS unsigned char* lds;
    int tid, lane, wave, G, bid;
    const __attribute__((address_space(4))) cfp_t* in;
    float* out; unsigned char* ws;
};
#define WSP(T, off) ((T*)(F.ws + (off)))

namespace pg8 {
constexpr int BM = 256, BK = 64, HALF = 128, HTB = HALF * BK * 2, STAGE_BYTES = 8 * HTB, NXCD = 8, WGM = 8;
DI int lds_byte(int r, int c) { const int st = (r >> 4) * 2 + (c >> 5), rr = r & 15, cc = c & 31, ob = rr * 64 + cc * 2; return st * 1024 + (ob ^ (((ob >> 9) & 1) << 5)); }
DI void stage_rc(int b, int& R, int& C) { const int st = b / 1024, sb = b % 1024, swz = sb ^ (((sb >> 9) & 1) << 5); R = (st >> 1) * 16 + swz / 64; C = (st & 1) * 32 + (swz % 64) / 2; }
DI int perm32(int rho) { const int n = rho >> 4, i = rho & 15; return 8 * (i >> 2) + 4 * n + (i & 3); }
struct Unit { int pm, pn, e, cnt, base, aux; };
DI bool static_next(int nM, int nN, int G, int c, int i, Unit& u) {
    const int nwg = nM * nN; const long L = (long)i * G + c; if (L >= nwg) return false;
    int wgid = (int)L; { const int q = nwg / NXCD, r = nwg % NXCD, xcd = wgid % NXCD, off = wgid / NXCD; wgid = (xcd < r ? xcd * (q + 1) : r * (q + 1) + (xcd - r) * q) + off; }
    const int nig = WGM * nN, gid = wgid / nig, fm = gid * WGM, gsz = (nM - fm) < WGM ? (nM - fm) : WGM;
    u.pm = fm + ((wgid % nig) % gsz); u.pn = (wgid % nig) / gsz; u.e = 0; u.cnt = 0; u.base = 0; u.aux = 0; return true;
}

template <class Prob, bool ALIGN_EPI>
DI void gemm_phase(LAS unsigned char* lds, const Prob& P, const int tid) {
    const int wid = __builtin_amdgcn_readfirstlane(tid >> 6), lane = tid & 63, wr = wid >> 2, wc = wid & 3, fr = lane & 15, fq = lane >> 4;
    const int K = P.K, nt = K / BK;
    constexpr bool GA = Prob::GATHER;
    unsigned voffB[2], voffA[2];
#pragma unroll
    for (int i = 0; i < 2; ++i) { int R, C; stage_rc(tid * 16 + i * 8192, R, C); const int Rb = Prob::PERM ? ((R & ~31) + perm32(R & 31)) : R; voffB[i] = (unsigned)(Rb * K + C) * 2u; voffA[i] = (unsigned)(R * K + C) * 2u; }
    const size_t kstep = (size_t)(BK * 2);
    const size_t hstepB = (size_t)HALF * K * 2;
    const unsigned ldsw = (unsigned)wid * 1024u;
    const int aoffL = lds_byte(wr * 64 + fr, fq * 8), boffL = lds_byte(wc * 32 + fr, fq * 8);
    const char* Abase = (const char*)P.A;
#define PG8_SA(b, h) (((b) * 2 + (h)) * HTB)
#define PG8_SB(b, h) ((4 + (b) * 2 + (h)) * HTB)
#define PG8_STG_B(bufoff, gbase) do { _Pragma("unroll") for (int _i = 0; _i < 2; ++_i) \
        __builtin_amdgcn_global_load_lds((const unsigned*)((const char*)(gbase) + voffB[_i]), (LAS unsigned*)(lds + (bufoff) + ldsw + _i * 8192), 16, 0, 0); } while (0)
#define PG8_STG_A(bufoff, h, kbyte) do { _Pragma("unroll") for (int _i = 0; _i < 2; ++_i) { \
        const char* _p; if constexpr (GA) _p = Abase + (size_t)(kbyte) + aoff[h][_i]; else _p = cA + (size_t)(h) * hstepB + (size_t)(kbyte) + voffA[_i]; \
        __builtin_amdgcn_global_load_lds((const unsigned*)_p, (LAS unsigned*)(lds + (bufoff) + ldsw + _i * 8192), 16, 0, 0); } } while (0)
#define PG8_LDA(dst, b, h) do { _Pragma("unroll") for (int m = 0; m < 4; ++m) _Pragma("unroll") for (int k = 0; k < 2; ++k) dst[m][k] = *(const LAS bf16x8*)(lds + PG8_SA(b, h) + aoffL + m * 2048 + k * 1024); } while (0)
#define PG8_LDB(dst, b, h) do { _Pragma("unroll") for (int n = 0; n < 2; ++n) _Pragma("unroll") for (int k = 0; k < 2; ++k) dst[n][k] = *(const LAS bf16x8*)(lds + PG8_SB(b, h) + boffL + n * 2048 + k * 1024); } while (0)
#define PG8_MMA(ai, bj, At, Bt) do { __builtin_amdgcn_s_setprio(1); _Pragma("unroll") for (int m = 0; m < 4; ++m) _Pragma("unroll") for (int n = 0; n < 2; ++n) _Pragma("unroll") for (int k = 0; k < 2; ++k) \
        acc[ai][bj][m][n] = __builtin_amdgcn_mfma_f32_16x16x32_bf16(Bt[n][k], At[m][k], acc[ai][bj][m][n], 0, 0, 0); __builtin_amdgcn_s_setprio(0); } while (0)
#define PG8_WAIT_V(n) asm volatile("s_waitcnt vmcnt(" #n ")" ::: "memory")
#define PG8_WAIT_L(n) asm volatile("s_waitcnt lgkmcnt(" #n ")" ::: "memory")
#define PG8_BAR __builtin_amdgcn_s_barrier()
#define PG8_SCHED __builtin_amdgcn_sched_barrier(0)
    Unit cur, nxt; int ui = 0;
    if (!P.next(0, cur)) return;
    f32x4 acc[2][2][4][2];
#pragma unroll
    for (int a = 0; a < 2; ++a)
#pragma unroll
        for (int b = 0; b < 2; ++b)
#pragma unroll
            for (int m = 0; m < 4; ++m)
#pragma unroll
                for (int n = 0; n < 2; ++n) acc[a][b][m][n] = (f32x4){0.f, 0.f, 0.f, 0.f};
    bf16x8 At[4][2], B0[2][2], B1[2][2];
    unsigned aoff[2][2] = {{0u, 0u}, {0u, 0u}}, noff[2][2] = {{0u, 0u}, {0u, 0u}};
    const char* cA = Abase; const char* nA = Abase;
    if constexpr (GA) P.aoffs(cur, tid, aoff); else cA = Abase + (size_t)P.arow0(cur) * K * 2;
    const char* cB = P.bbase(cur);
    PG8_STG_B(PG8_SB(0, 0), cB); PG8_STG_B(PG8_SB(0, 1), cB + hstepB); PG8_STG_A(PG8_SA(0, 0), 0, 0); PG8_STG_A(PG8_SA(0, 1), 1, 0);
    if (wr == 1) PG8_BAR;
    PG8_WAIT_V(2); PG8_BAR;
    PG8_STG_B(PG8_SB(1, 0), cB + kstep); PG8_STG_A(PG8_SA(1, 0), 0, kstep); PG8_STG_B(PG8_SB(1, 1), cB + hstepB + kstep);
    PG8_WAIT_V(6); PG8_BAR;
    for (;;) {
        const bool has_next = P.next(ui + 1, nxt);
        const char* nB = cB; nA = cA;
        if (has_next) { nB = P.bbase(nxt); if constexpr (GA) P.aoffs(nxt, tid, noff); else nA = Abase + (size_t)P.arow0(nxt) * K * 2; }
        else if constexpr (GA) { noff[0][0] = aoff[0][0]; noff[0][1] = aoff[0][1]; noff[1][0] = aoff[1][0]; noff[1][1] = aoff[1][1]; }
        if constexpr (GA) { *(LAS u32x4*)(lds + LDS_AUX + 2048 + tid * 16) = (u32x4){noff[0][0], noff[0][1], noff[1][0], noff[1][1]}; }
        for (int t = 0; t < nt; t += 2) {
            const bool last = (t == nt - 2);
            const size_t k1 = (size_t)(t + 1) * kstep;
            const size_t k2 = last ? (size_t)0 : (size_t)(t + 2) * kstep, k3 = k2 + kstep;
            const char* b2 = last ? nB : cB + (size_t)(t + 2) * kstep; const char* b3 = b2 + kstep;
            PG8_LDB(B0, 0, 0); PG8_LDB(B1, 0, 1); PG8_SCHED; PG8_LDA(At, 0, 0); PG8_STG_A(PG8_SA(1, 1), 1, k1);
            PG8_WAIT_V(8); PG8_WAIT_L(0); PG8_BAR; PG8_MMA(0, 0, At, B0); PG8_MMA(0, 1, At, B1); PG8_BAR; PG8_SCHED;
            if (last) { if constexpr (GA) { const u32x4 nq = *(const LAS u32x4*)(lds + LDS_AUX + 2048 + tid * 16); aoff[0][0] = nq[0]; aoff[0][1] = nq[1]; aoff[1][0] = nq[2]; aoff[1][1] = nq[3]; } else cA = nA; }
            PG8_LDA(At, 0, 1); PG8_STG_B(PG8_SB(0, 0), b2); PG8_STG_B(PG8_SB(0, 1), b2 + hstepB); PG8_STG_A(PG8_SA(0, 0), 0, k2);
            PG8_WAIT_V(8); PG8_WAIT_L(0); PG8_BAR; PG8_MMA(1, 0, At, B0); PG8_MMA(1, 1, At, B1); PG8_BAR; PG8_SCHED;
            PG8_LDB(B0, 1, 0); PG8_LDB(B1, 1, 1); PG8_SCHED; PG8_LDA(At, 1, 0); PG8_STG_A(PG8_SA(0, 1), 1, k2);
            PG8_WAIT_V(8); PG8_WAIT_L(0); PG8_BAR; PG8_MMA(0, 0, At, B0); PG8_MMA(0, 1, At, B1); PG8_BAR; PG8_SCHED;
            PG8_LDA(At, 1, 1); PG8_STG_B(PG8_SB(1, 0), b3); PG8_STG_B(PG8_SB(1, 1), b3 + hstepB); PG8_STG_A(PG8_SA(1, 0), 0, k3);
            PG8_WAIT_V(8); PG8_WAIT_L(0); PG8_BAR; PG8_MMA(1, 0, At, B0); PG8_MMA(1, 1, At, B1); PG8_BAR; PG8_SCHED;
        }
        if constexpr (ALIGN_EPI) { if (wr == 0) PG8_BAR; }
        P.epi(acc, cur, wr, wc, fr, fq);
        if (!has_next) break;
#pragma unroll
        for (int a = 0; a < 2; ++a)
#pragma unroll
            for (int b = 0; b < 2; ++b)
#pragma unroll
                for (int m = 0; m < 4; ++m)
#pragma unroll
                    for (int n = 0; n < 2; ++n) acc[a][b][m][n] = (f32x4){0.f, 0.f, 0.f, 0.f};
        cur = nxt; cB = nB; ++ui;
        if constexpr (ALIGN_EPI) { if (wr == 1) PG8_BAR; }
    }
    PG8_WAIT_V(0);
    if constexpr (!ALIGN_EPI) { if (wr == 0) PG8_BAR; }
    PG8_BAR;
#undef PG8_SA
#undef PG8_SB
#undef PG8_STG_A
#undef PG8_STG_B
#undef PG8_LDA
#undef PG8_LDB
#undef PG8_MMA
#undef PG8_WAIT_V
#undef PG8_WAIT_L
#undef PG8_BAR
#undef PG8_SCHED
}

template <class Prob>
DI void gemm_phase_pair(LAS unsigned char* lds, const Prob& P, const int tid) {
    const int wid = __builtin_amdgcn_readfirstlane(tid >> 6), lane = tid & 63, wr = wid >> 2, wc = wid & 3, fr = lane & 15, fq = lane >> 4;
    constexpr int KP = 512, nt = 16;
    unsigned voffB[2];
#pragma unroll
    for (int i = 0; i < 2; ++i) { int R, C; stage_rc(tid * 16 + i * 8192, R, C); const int Rb = Prob::PERM ? ((R & ~31) + perm32(R & 31)) : R; voffB[i] = (unsigned)(Rb * KP + C) * 2u; }
    const size_t kstep = (size_t)(BK * 2);
    const size_t hstepB = (size_t)HALF * KP * 2;
    const unsigned ldsw = (unsigned)wid * 1024u;
    const int aoffL = lds_byte(wr * 64 + fr, fq * 8), boffL = lds_byte(wc * 32 + fr, fq * 8);
    const char* Abase = (const char*)P.A;
    LAS unsigned char* park = lds + LDS_AUX + 2048 + tid * 48;
#define PG8_SA(b, h) (((b) * 2 + (h)) * HTB)
#define PG8_SB(b, h) ((4 + (b) * 2 + (h)) * HTB)
#define PG8_STG_B(bufoff, gbase) do { _Pragma("unroll") for (int _i = 0; _i < 2; ++_i) \
        __builtin_amdgcn_global_load_lds((const unsigned*)((const char*)(gbase) + voffB[_i]), (LAS unsigned*)(lds + (bufoff) + ldsw + _i * 8192), 16, 0, 0); } while (0)
#define PG8_STG_A(bufoff, h, kbyte) do { _Pragma("unroll") for (int _i = 0; _i < 2; ++_i) \
        __builtin_amdgcn_global_load_lds((const unsigned*)(Abase + (size_t)(kbyte) + aoff[h][_i]), (LAS unsigned*)(lds + (bufoff) + ldsw + _i * 8192), 16, 0, 0); } while (0)
#define PG8_LDA(dst, b, h) do { _Pragma("unroll") for (int m = 0; m < 4; ++m) _Pragma("unroll") for (int k = 0; k < 2; ++k) dst[m][k] = *(const LAS bf16x8*)(lds + PG8_SA(b, h) + aoffL + m * 2048 + k * 1024); } while (0)
#define PG8_LDB(dst, b, h) do { _Pragma("unroll") for (int n = 0; n < 2; ++n) _Pragma("unroll") for (int k = 0; k < 2; ++k) dst[n][k] = *(const LAS bf16x8*)(lds + PG8_SB(b, h) + boffL + n * 2048 + k * 1024); } while (0)
#define PG8_MMA(ai, bj, At, Bt) do { __builtin_amdgcn_s_setprio(1); _Pragma("unroll") for (int m = 0; m < 4; ++m) _Pragma("unroll") for (int n = 0; n < 2; ++n) _Pragma("unroll") for (int k = 0; k < 2; ++k) \
        acc[ai][bj][m][n] = __builtin_amdgcn_mfma_f32_16x16x32_bf16(Bt[n][k], At[m][k], acc[ai][bj][m][n], 0, 0, 0); __builtin_amdgcn_s_setprio(0); } while (0)
#define PG8_WAIT_V(n) asm volatile("s_waitcnt vmcnt(" #n ")" ::: "memory")
#define PG8_WAIT_L(n) asm volatile("s_waitcnt lgkmcnt(" #n ")" ::: "memory")
#define PG8_BAR __builtin_amdgcn_s_barrier()
#define PG8_SCHED __builtin_amdgcn_sched_barrier(0)
#define PG8_PARK(slot, v) (*(LAS u32x4*)(park + 16 * (slot)) = (u32x4){v[0][0], v[0][1], v[1][0], v[1][1]})
#define PG8_UNPARK(slot) do { const u32x4 _q = *(const LAS u32x4*)(park + 16 * (slot)); aoff[0][0] = _q[0]; aoff[0][1] = _q[1]; aoff[1][0] = _q[2]; aoff[1][1] = _q[3]; } while (0)
    Unit cur, nxt; int ui = 0;
    if (!P.next(0, cur)) return;
    f32x4 acc[2][2][4][2];
#pragma unroll
    for (int a = 0; a < 2; ++a)
#pragma unroll
        for (int b = 0; b < 2; ++b)
#pragma unroll
            for (int m = 0; m < 4; ++m)
#pragma unroll
                for (int n = 0; n < 2; ++n) acc[a][b][m][n] = (f32x4){0.f, 0.f, 0.f, 0.f};
    bf16x8 At[4][2], B0[2][2], B1[2][2];
    unsigned aoff[2][2];
    { unsigned tb[2][2]; P.aoffs2(cur, tid, aoff, tb); PG8_PARK(0, tb); }
    const char* cBa = P.bbase_a(cur); const char* cBb = P.bbase_b(cur);
    PG8_STG_B(PG8_SB(0, 0), cBa); PG8_STG_B(PG8_SB(0, 1), cBa + hstepB); PG8_STG_A(PG8_SA(0, 0), 0, 0); PG8_STG_A(PG8_SA(0, 1), 1, 0);
    if (wr == 1) PG8_BAR;
    PG8_WAIT_V(2); PG8_BAR;
    PG8_STG_B(PG8_SB(1, 0), cBa + kstep); PG8_STG_A(PG8_SA(1, 0), 0, kstep); PG8_STG_B(PG8_SB(1, 1), cBa + hstepB + kstep);
    PG8_WAIT_V(6); PG8_BAR;
    for (;;) {
        const bool has_next = P.next(ui + 1, nxt);
        const char* nBa = cBa; const char* nBb = cBb;
        {
            unsigned ta[2][2], tb[2][2];
            if (has_next) { P.aoffs2(nxt, tid, ta, tb); nBa = P.bbase_a(nxt); nBb = P.bbase_b(nxt); } else P.aoffs2(cur, tid, ta, tb);
            PG8_PARK(2, ta); PG8_PARK((ui + 1) & 1, tb);
        }
        const bool hu = (cur.cnt - cur.pm * 256) <= 128;
        for (int t = 0; t < nt; t += 2) {
            const bool last = (t == nt - 2);
            const size_t k1 = (size_t)((t + 1) & 7) * kstep;
            const int t2 = last ? 0 : t + 2;
            const size_t k2 = (size_t)(t2 & 7) * kstep, k3 = k2 + kstep;
            const char* b2 = last ? nBa : ((t2 < 8 ? cBa : cBb) + k2); const char* b3 = b2 + kstep;
            PG8_LDB(B0, 0, 0); PG8_LDB(B1, 0, 1); PG8_SCHED; PG8_LDA(At, 0, 0); PG8_STG_A(PG8_SA(1, 1), 1, k1);
            PG8_WAIT_V(8); PG8_WAIT_L(0); PG8_BAR; PG8_MMA(0, 0, At, B0); PG8_MMA(0, 1, At, B1); PG8_BAR; PG8_SCHED;
            if (t == 6) PG8_UNPARK(ui & 1);
            if (last) PG8_UNPARK(2);
            PG8_LDA(At, 0, 1); PG8_STG_B(PG8_SB(0, 0), b2); PG8_STG_B(PG8_SB(0, 1), b2 + hstepB); PG8_STG_A(PG8_SA(0, 0), 0, k2);
            PG8_WAIT_V(8); PG8_WAIT_L(0); PG8_BAR; if (!hu) { PG8_MMA(1, 0, At, B0); PG8_MMA(1, 1, At, B1); } PG8_BAR; PG8_SCHED;
            PG8_LDB(B0, 1, 0); PG8_LDB(B1, 1, 1); PG8_SCHED; PG8_LDA(At, 1, 0); PG8_STG_A(PG8_SA(0, 1), 1, k2);
            PG8_WAIT_V(8); PG8_WAIT_L(0); PG8_BAR; PG8_MMA(0, 0, At, B0); PG8_MMA(0, 1, At, B1); PG8_BAR; PG8_SCHED;
            PG8_LDA(At, 1, 1); PG8_STG_B(PG8_SB(1, 0), b3); PG8_STG_B(PG8_SB(1, 1), b3 + hstepB); PG8_STG_A(PG8_SA(1, 0), 0, k3);
            PG8_WAIT_V(8); PG8_WAIT_L(0); PG8_BAR; if (!hu) { PG8_MMA(1, 0, At, B0); PG8_MMA(1, 1, At, B1); } PG8_BAR; PG8_SCHED;
        }
        if (wr == 0) PG8_BAR;
        P.epi(acc, cur, wr, wc, fr, fq);
        if (!has_next) break;
#pragma unroll
        for (int a = 0; a < 2; ++a)
#pragma unroll
            for (int b = 0; b < 2; ++b)
#pragma unroll
                for (int m = 0; m < 4; ++m)
#pragma unroll
                    for (int n = 0; n < 2; ++n) acc[a][b][m][n] = (f32x4){0.f, 0.f, 0.f, 0.f};
        cur = nxt; cBa = nBa; cBb = nBb; ++ui;
        if (wr == 1) PG8_BAR;
    }
    PG8_WAIT_V(0);
    PG8_BAR;
#undef PG8_SA
#undef PG8_SB
#undef PG8_STG_A
#undef PG8_STG_B
#undef PG8_LDA
#undef PG8_LDB
#undef PG8_MMA
#undef PG8_WAIT_V
#undef PG8_WAIT_L
#undef PG8_BAR
#undef PG8_SCHED
#undef PG8_PARK
#undef PG8_UNPARK
}
}
using pg8::Unit;


struct MoeTab { int ce[32], sb[32], tpg[33], cp[112], tpf[113], tph[113]; };
constexpr int LCAP = 32768;
DI int pair_lo(int p) { int i = 0; _Pragma("unroll") for (int k = 1; k < 7; ++k) if (p >= k * (15 - k) / 2) i = k; return i; }
DI int pair_hi(int p, int i) { return p - i * (15 - i) / 2 + i + 1; }

struct ProbIn {
    static constexpr bool PERM = true, GATHER = false;
    int K; const bf16_t* A; const bf16_t* Bt; int G, c;
    bf16_t* Pout; const float* ss1; float* lf; const float* bfx; unsigned* kmax;
    DI bool next(int i, Unit& u) const { return pg8::static_next(128, 12, G, c, i, u); }
    DI int arow0(const Unit& u) const { return u.pm * 256; }
    DI const char* bbase(const Unit& u) const { return (const char*)Bt + (size_t)u.pn * 256 * K * 2; }
    DI void epi(const f32x4 (&acc)[2][2][4][2], const Unit& u, int wr, int wc, int fr, int fq) const {
        float km0 = 0.f, km1 = 0.f;
        float rs[8];
#pragma unroll
        for (int hb_ = 0; hb_ < 4; ++hb_) {
            f32x4 sv[2][4];
#pragma unroll
            for (int m = 0; m < 2; ++m) { const int g = hb_ * 2 + m; const f32x4* sp = (const f32x4*)(ss1 + (size_t)(u.pm * 256 + (g >> 2) * 128 + wr * 64 + (g & 3) * 16 + fr) * 16);
#pragma unroll
                for (int k = 0; k < 4; ++k) sv[m][k] = sp[k]; }
#pragma unroll
            for (int m = 0; m < 2; ++m) { float ss = 0.f;
#pragma unroll
                for (int k = 0; k < 4; ++k) ss += (sv[m][k][0] + sv[m][k][1]) + (sv[m][k][2] + sv[m][k][3]);
                rs[hb_ * 2 + m] = __builtin_amdgcn_rsqf(ss * (1.f / 1024.f) + 1e-6f); }
            asm volatile("" : "+v"(rs[hb_ * 2]), "+v"(rs[hb_ * 2 + 1]));
        }
#pragma unroll
        for (int ai = 0; ai < 2; ++ai)
#pragma unroll
            for (int m = 0; m < 4; ++m) {
                const int row = u.pm * 256 + ai * 128 + wr * 64 + m * 16 + fr;
                const float rstd = rs[ai * 4 + m];
                {
                    bf16_t* rowp = Pout + (size_t)row * PP + u.pn * 256 + wc * 32 + 8 * fq;
#pragma unroll
                    for (int bj = 0; bj < 2; ++bj) { const f32x4 v0 = acc[ai][bj][m][0] * rstd, v1 = acc[ai][bj][m][1] * rstd;
                        u32x4 w; w.x = pk2(v0[0], v0[1]); w.y = pk2(v0[2], v0[3]); w.z = pk2(v1[0], v1[1]); w.w = pk2(v1[2], v1[3]);
                        *(u32x4*)(rowp + bj * 128) = w; }
                    if (u.pn == 10) {
#pragma unroll
                        for (int bj = 0; bj < 2; ++bj) { const f32x4 v0 = acc[ai][bj][m][0] * rstd, v1 = acc[ai][bj][m][1] * rstd;
                            float p = ((v0[0] * v0[0] + v0[1] * v0[1]) + (v0[2] * v0[2] + v0[3] * v0[3])) + ((v1[0] * v1[0] + v1[1] * v1[1]) + (v1[2] * v1[2] + v1[3] * v1[3]));
                            p += __shfl_xor(p, 16); p += __shfl_xor(p, 32);
                            if (bj == 0) km0 = fmaxf(km0, p); else km1 = fmaxf(km1, p); }
                    }
                }
            }
        if (u.pn == 10) {
#pragma unroll
            for (int o = 1; o < 16; o <<= 1) { km0 = fmaxf(km0, __shfl_xor(km0, o)); km1 = fmaxf(km1, __shfl_xor(km1, o)); }
            if (fr == 0 && fq == 0) { const int b = (u.pm * 256) >> 11;
                __hip_atomic_fetch_max(kmax + ((b * 4 + 0 + (wc >> 1)) * 2 + (wc & 1)), __float_as_uint(km0), __ATOMIC_RELAXED, __HIP_MEMORY_SCOPE_AGENT);
                __hip_atomic_fetch_max(kmax + ((b * 4 + 2 + (wc >> 1)) * 2 + (wc & 1)), __float_as_uint(km1), __ATOMIC_RELAXED, __HIP_MEMORY_SCOPE_AGENT); }
        }
    }
};

struct ProbOut {
    static constexpr bool PERM = false, GATHER = false;
    int K; const bf16_t* A; const bf16_t* Bt; int G, c;
    const float* base; float* out; float ascale;
    DI bool next(int i, Unit& u) const { return pg8::static_next(128, 4, G, c, i, u); }
    DI int arow0(const Unit& u) const { return u.pm * 256; }
    DI const char* bbase(const Unit& u) const { return (const char*)Bt + (size_t)u.pn * 256 * K * 2; }
    DI void epi(const f32x4 (&acc)[2][2][4][2], const Unit& u, int wr, int wc, int fr, int fq) const {
#pragma unroll
        for (int ai = 0; ai < 2; ++ai)
#pragma unroll
            for (int mp = 0; mp < 2; ++mp) {
                f32x4 bv[2][2][2]; size_t offs[2];
#pragma unroll
                for (int mm = 0; mm < 2; ++mm) { const int m = 2 * mp + mm; offs[mm] = (size_t)(u.pm * 256 + ai * 128 + wr * 64 + m * 16 + fr) * D + u.pn * 256 + wc * 32 + 4 * fq;
#pragma unroll
                    for (int bj = 0; bj < 2; ++bj)
#pragma unroll
                        for (int n = 0; n < 2; ++n) bv[mm][bj][n] = *(const f32x4*)(base + offs[mm] + bj * 128 + n * 16); }
#pragma unroll
                for (int mm = 0; mm < 2; ++mm) { const int m = 2 * mp + mm;
#pragma unroll
                    for (int bj = 0; bj < 2; ++bj)
#pragma unroll
                        for (int n = 0; n < 2; ++n) *(f32x4*)(out + offs[mm] + bj * 128 + n * 16) = bv[mm][bj][n] + acc[ai][bj][m][n] * ascale; }
                asm volatile("" ::: "memory");
            }
    }
};

DI int moe_L(int i, int G, int c) {
    if ((G & 31) != 0) return i * G + c;
    const int x = c & 7, j = c >> 3, per = G >> 5;
    return ((i * (G >> 2) + x * per + (j >> 2)) << 2) + (j & 3);
}
template <int NL> DI bool moe_unit(const LAS int* tp, int L, Unit& u) {
    const int tt = L >> 2; if (tt >= tp[NL]) return false;
    int e = 0;
#pragma unroll 1
    while (tp[e + 1] <= tt) ++e;
    u.e = e; u.pm = tt - tp[e]; u.pn = L & 3; return true;
}

struct ProbGU {
    static constexpr bool PERM = true, GATHER = true;
    int K; const bf16_t* A; const bf16_t* Bt; int G, c;
    const LAS MoeTab* T; const int* elist; const float* egate; const float* rstd2; bf16_t* HB;
    DI bool next(int i, Unit& u) const {
        if (!moe_unit<32>(T->tpg, moe_L(i, G, c), u)) return false;
        u.cnt = T->ce[u.e]; u.base = T->sb[u.e]; return true;
    }
    DI int tok_of(const Unit& u, int r) const { return (r < u.cnt) ? elist[(size_t)u.e * LCAP + r] : 0; }
    DI void aoffs(const Unit& u, int tid, unsigned (&o)[2][2]) const {
        int Rr[2], Cc[2]; pg8::stage_rc(tid * 16, Rr[0], Cc[0]); pg8::stage_rc(tid * 16 + 8192, Rr[1], Cc[1]);
#pragma unroll
        for (int h = 0; h < 2; ++h)
#pragma unroll
            for (int i = 0; i < 2; ++i) { const int tok = tok_of(u, u.pm * 256 + h * 128 + Rr[i]); o[h][i] = (unsigned)((tok * K + Cc[i]) * 2); }
    }
    DI const char* bbase(const Unit& u) const { return (const char*)Bt + ((size_t)u.e * 1024 + u.pn * 256) * K * 2; }
    DI void epi(const f32x4 (&acc)[2][2][4][2], const Unit& u, int wr, int wc, int fr, int fq) const {
        int tk[8]; float rsv[8], gv[8];
#pragma unroll
        for (int g = 0; g < 8; ++g) { const int r = u.pm * 256 + (g >> 2) * 128 + wr * 64 + (g & 3) * 16 + fr; tk[g] = tok_of(u, r); gv[g] = (r < u.cnt) ? egate[(size_t)u.e * LCAP + r] : 0.f; }
#pragma unroll
        for (int g = 0; g < 8; ++g) rsv[g] = rstd2[tk[g]];
#pragma unroll
        for (int ai = 0; ai < 2; ++ai)
#pragma unroll
            for (int m = 0; m < 4; ++m) {
                const int r = u.pm * 256 + ai * 128 + wr * 64 + m * 16 + fr;
                if (r < u.cnt) {
                    const float rs = rsv[ai * 4 + m], gt = gv[ai * 4 + m];
                    float hv[8];
#pragma unroll
                    for (int n = 0; n < 2; ++n)
#pragma unroll
                        for (int j = 0; j < 4; ++j) { const float g = acc[ai][0][m][n][j] * rs, uu = acc[ai][1][m][n][j] * rs; hv[n * 4 + j] = g * sigmoidf_(g) * uu * gt; }
                    u32x4 w; w.x = pk2(hv[0], hv[1]); w.y = pk2(hv[2], hv[3]); w.z = pk2(hv[4], hv[5]); w.w = pk2(hv[6], hv[7]);
                    *(u32x4*)(HB + (size_t)(u.base + r) * EH + u.pn * 128 + wc * 32 + 8 * fq) = w;
                }
            }
    }
};

struct ProbDP {
    static constexpr bool PERM = false;
    const bf16_t* A; const bf16_t* Bt; int G, c;
    const LAS MoeTab* T; const u32x2* plist; float* x; bf16_t* xb; float* ss1;
    DI bool next(int i, Unit& u) const {
        const int L = moe_L(i, G, c), tt = L >> 2, nf = T->tpf[112];
        if (tt < nf) { if (!moe_unit<112>(T->tpf, L, u)) return false; }
        else { if (!moe_unit<112>(T->tph, L - 4 * nf, u)) return false; u.pm = (T->cp[u.e] - 1) >> 8; }
        u.cnt = T->cp[u.e]; const int g = u.e / 28, p = u.e - g * 28, lo = pair_lo(p); u.base = g * 8 + lo; u.aux = g * 8 + pair_hi(p, lo); return true;
    }
    DI void aoffs2(const Unit& u, int tid, unsigned (&oa)[2][2], unsigned (&ob)[2][2]) const {
        int Rr[2], Cc[2]; pg8::stage_rc(tid * 16, Rr[0], Cc[0]); pg8::stage_rc(tid * 16 + 8192, Rr[1], Cc[1]);
        const int sba = T->sb[u.base], sbb = T->sb[u.aux];
#pragma unroll
        for (int h = 0; h < 2; ++h)
#pragma unroll
            for (int i = 0; i < 2; ++i) { const int r = u.pm * 256 + h * 128 + Rr[i]; unsigned pos = 0u; if (r < u.cnt) pos = plist[(size_t)u.e * LCAP + r].y;
                const int ra = (r < u.cnt) ? sba + (int)(pos & 0xffffu) : 0, rb = (r < u.cnt) ? sbb + (int)(pos >> 16) : 0;
                oa[h][i] = (unsigned)((ra * EH + Cc[i]) * 2); ob[h][i] = (unsigned)((rb * EH + Cc[i]) * 2); }
    }
    DI const char* bbase_a(const Unit& u) const { return (const char*)Bt + ((size_t)u.base * 1024 + u.pn * 256) * EH * 2; }
    DI const char* bbase_b(const Unit& u) const { return (const char*)Bt + ((size_t)u.aux * 1024 + u.pn * 256) * EH * 2; }
    DI void epi(const f32x4 (&acc)[2][2][4][2], const Unit& u, int wr, int wc, int fr, int fq) const {
        int tk[8];
#pragma unroll
        for (int g = 0; g < 8; ++g) { const int r = u.pm * 256 + (g >> 2) * 128 + wr * 64 + (g & 3) * 16 + fr; tk[g] = (r < u.cnt) ? (int)plist[(size_t)u.e * LCAP + r].x : 0; }
#pragma unroll
        for (int ai = 0; ai < 2; ++ai)
#pragma unroll
            for (int m = 0; m < 4; ++m) {
                const int r = u.pm * 256 + ai * 128 + wr * 64 + m * 16 + fr; const bool val = r < u.cnt;
                const size_t off = (size_t)tk[ai * 4 + m] * D + u.pn * 256 + wc * 32 + 4 * fq;
                f32x4 xv[2][2];
#pragma unroll
                for (int bj = 0; bj < 2; ++bj)
#pragma unroll
                    for (int n = 0; n < 2; ++n) xv[bj][n] = *(const f32x4*)(x + off + bj * 128 + n * 16);
                float ssp = 0.f;
#pragma unroll
                for (int bj = 0; bj < 2; ++bj)
#pragma unroll
                    for (int n = 0; n < 2; ++n) { const size_t o = off + bj * 128 + n * 16; const f32x4 v = xv[bj][n] + acc[ai][bj][m][n];
                        if (val) { *(f32x4*)(x + o) = v; u32x2 w; w.x = pk2(v[0], v[1]); w.y = pk2(v[2], v[3]); *(u32x2*)(xb + o) = w; }
                        ssp += (v[0] * v[0] + v[1] * v[1]) + (v[2] * v[2] + v[3] * v[3]); }
                ssp += __shfl_xor(ssp, 16); ssp += __shfl_xor(ssp, 32);
                if (val && fq == 0) ss1[(size_t)tk[ai * 4 + m] * 16 + u.pn * 4 + wc] = ssp;
                asm volatile("" ::: "memory");
            }
    }
};


DI void fgate_item(Frame& F, int layer, int item) {
    const int lane = F.lane, m16 = lane & 15, q4 = lane >> 4, r0 = 16 * item;
    const bf16_t* ap = WSP(bf16_t, WS_XB) + (size_t)(r0 + m16) * D + 8 * q4;
    const bf16_t* bp = WSP(bf16_t, WS_BIN) + (size_t)layer * NIN * D + (size_t)(3072 + (m16 & 3)) * D + 8 * q4;
    f32x4 acc = {0.f, 0.f, 0.f, 0.f};
#pragma unroll 16
    for (int ks = 0; ks < 32; ++ks) {
        const bf16x8 a = *(const bf16x8*)(ap + 32 * ks); bf16x8 b = *(const bf16x8*)(bp + 32 * ks);
        if (m16 >= 4) b = (bf16x8){0, 0, 0, 0, 0, 0, 0, 0};
        acc = __builtin_amdgcn_mfma_f32_16x16x32_bf16(a, b, acc, 0, 0, 0);
    }
    if (m16 < 4) {
        const float bfv = F.in[16][layer * 4 + m16];
#pragma unroll
        for (int r = 0; r < 4; ++r) { const int row = r0 + 4 * q4 + r;
            const f32x4* sp = (const f32x4*)(WSP(float, WS_SS1) + (size_t)row * 16);
            const f32x4 s0 = sp[0], s1 = sp[1], s2 = sp[2], s3 = sp[3];
            const float ss = ((s0[0] + s0[1]) + (s0[2] + s0[3])) + ((s1[0] + s1[1]) + (s1[2] + s1[3])) + ((s2[0] + s2[1]) + (s2[2] + s2[3])) + ((s3[0] + s3[1]) + (s3[2] + s3[3]));
            const float rstd = __builtin_amdgcn_rsqf(ss * (1.f / 1024.f) + 1e-6f);
            WSP(float, WS_LF)[(size_t)((row >> 11) * 4 + m16) * SEQ + (row & 2047)] = -softplusf_(-(acc[r] * rstd + bfv)); }
    }
}
DI void p0_transpose64(const float* W, int K, int N, int ldn, const float* gs, bf16_t* WT, int mode, LAS unsigned* T, int kb, int nb, int lane) {
    const int k0 = 64 * kb, n0 = 64 * nb, nq = lane & 15, kr = lane >> 4;
    const bool nv = (n0 + 4 * nq) < N;
    f32x4 a[8], b[8];
#pragma unroll
    for (int i = 0; i < 8; ++i) { const int k = k0 + 8 * i + 2 * kr;
        a[i] = nv ? *(const f32x4*)(W + (size_t)k * ldn + n0 + 4 * nq) : (f32x4){0.f, 0.f, 0.f, 0.f};
        b[i] = nv ? *(const f32x4*)(W + (size_t)(k + 1) * ldn + n0 + 4 * nq) : (f32x4){0.f, 0.f, 0.f, 0.f}; }
#pragma unroll
    for (int i = 0; i < 8; ++i) { const int k = k0 + 8 * i + 2 * kr; float g0 = 1.f, g1 = 1.f; if (gs) { g0 = gs[k]; g1 = gs[k + 1]; }
#pragma unroll
        for (int jj = 0; jj < 4; ++jj) T[(4 * nq + jj) * 36 + 4 * i + kr] = pk2(a[i][jj] * g0, b[i][jj] * g1); }
    asm volatile("s_waitcnt lgkmcnt(0)" ::: "memory");
    const int c = lane & 7;
#pragma unroll
    for (int p = 0; p < 8; ++p) { const int nl = 8 * p + (lane >> 3), n = n0 + nl;
        const u32x4 o = *(const LAS u32x4*)(T + nl * 36 + 4 * c);
        const int drow = (mode == 0) ? n : (((n >> 7) << 8) + (n & 127) + (mode == 2 ? 128 : 0));
        *(u32x4*)(WT + (size_t)drow * K + k0 + 8 * c) = o; }
    asm volatile("s_waitcnt lgkmcnt(0)" ::: "memory");
}
DI void p0_prologue(Frame& F) {
    LAS unsigned* scr = (LAS unsigned*)(F.lds + F.wave * 16384);
    const int gw = F.bid * 8 + F.wave, NGW = F.G * 8;
    constexpr int I_IN = 16 * 52, I_OUT = 16 * 16, I_GU = 16 * 8, I_DN = 8 * 16;
    constexpr int S0 = DEPTH * I_IN, S1 = S0 + DEPTH * I_OUT, S2 = S1 + DEPTH * NE * I_GU, S3 = S2 + DEPTH * NE * I_GU, S4 = S3 + DEPTH * NE * I_DN;
    for (int it = gw; it < S4; it += NGW) {
        if (it < S0) { const int l = it / I_IN, r = it % I_IN;
            p0_transpose64(F.in[2] + (size_t)l * D * 3076, D, 3076, 3076, F.in[1] + l * D, WSP(bf16_t, WS_BIN) + (size_t)l * NIN * D, 0, scr, r / 52, r % 52, F.lane);
        } else if (it < S1) { const int q = it - S0, l = q / I_OUT, r = q % I_OUT;
            p0_transpose64(F.in[17] + (size_t)l * D * D, D, D, D, nullptr, WSP(bf16_t, WS_BOUT) + (size_t)l * D * D, 0, scr, r / 16, r % 16, F.lane);
        } else if (it < S3) { const int up = it >= S2, q = it - (up ? S2 : S1), le = q / I_GU, r = q % I_GU;
            p0_transpose64(F.in[up ? 24 : 23] + (size_t)le * D * EH, D, EH, EH, F.in[18] + (le / NE) * D, WSP(bf16_t, WS_BGU) + (size_t)le * 1024 * D, up ? 2 : 1, scr, r / 8, r % 8, F.lane);
        } else { const int q = it - S3, le = q / I_DN, r = q % I_DN;
            p0_transpose64(F.in[25] + (size_t)le * EH * D, EH, D, D, nullptr, WSP(bf16_t, WS_BDN) + (size_t)le * D * EH, 0, scr, r / 16, r % 16, F.lane);
        }
    }
    const int gt = F.bid * 512 + F.tid, NGT = F.G * 512;
    for (int i = gt; i < DEPTH * 256 * 256; i += NGT) { const int l = i >> 16, c = (i >> 8) & 255, k = i & 255;
        const float v = k < 64 ? F.in[7][((size_t)l * 64 + k) * 256 + c] : (k < 128 ? F.in[9][((size_t)l * 64 + (k - 64)) * 256 + c] : F.in[10][((size_t)l * 128 + (k - 128)) * 256 + c]);
        WSP(bf16_t, WS_WCAT)[i] = (bf16_t)f2bf(v); }
    for (int i = gt; i < DEPTH * 36 * 1024; i += NGT) { const int l = i / (36 * 1024), j = (i / 1024) % 36, k = i & 1023;
        const float g = F.in[18][l * D + k];
        const float w = j < 4 ? F.in[19][((size_t)l * D + k) * 4 + j] : F.in[21][((size_t)l * D + k) * 32 + (j - 4)];
        WSP(float, WS_RTW)[i] = g * w; }
    for (int m0 = gw * 4; m0 < NT; m0 += NGW * 4) {
        f32x4 v[4][4];
#pragma unroll
        for (int r = 0; r < 4; ++r) { const f32x4* xr = (const f32x4*)(F.in[0] + (size_t)(m0 + r) * D) + F.lane;
#pragma unroll
            for (int j = 0; j < 4; ++j) v[r][j] = xr[64 * j]; }
#pragma unroll
        for (int r = 0; r < 4; ++r) { float s = 0.f; u32x2* o8 = (u32x2*)(WSP(bf16_t, WS_XB) + (size_t)(m0 + r) * D) + F.lane;
#pragma unroll
            for (int j = 0; j < 4; ++j) { const f32x4 q = v[r][j]; s += (q[0] * q[0] + q[1] * q[1]) + (q[2] * q[2] + q[3] * q[3]); u32x2 w; w.x = pk2(q[0], q[1]); w.y = pk2(q[2], q[3]); o8[64 * j] = w; }
            s = wave_sum(s);
            if (F.lane < 16) WSP(float, WS_SS1)[(size_t)(m0 + r) * 16 + F.lane] = (F.lane == 0) ? s : 0.f; }
    }
}

constexpr int AT_KOFF = 0, AT_VOFF = 18432, AT_CUM = 36864, AT_MISC = 45056, AT_ROWB = 144, AT_BUFB = 64 * 144;
DI void at_load_tile(const bf16_t* Pb, int colK, int colV, int jt, int tid, u32x4& kreg, u32x4& vreg) {
    const int row = tid >> 3, ch = tid & 7; const bf16_t* p = Pb + (size_t)(64 * jt + row) * PP + ch * 8;
    kreg = *(const u32x4*)(p + colK); vreg = *(const u32x4*)(p + colV);
}
DI void at_store_tile(LAS unsigned char* lds, int buf, int tid, const u32x4& kreg, const u32x4& vreg) {
    const int row = tid >> 3, ch = tid & 7;
    *(LAS u32x4*)(lds + AT_KOFF + buf * AT_BUFB + row * AT_ROWB + ch * 16) = kreg;
    *(LAS u32x4*)(lds + AT_VOFF + buf * AT_BUFB + row * AT_ROWB + ch * 16) = vreg;
}
DI void at_qk(const LAS unsigned char* kb, const bf16x8 (&qf)[4], int r32, int h2, f32x16& s0, f32x16& s1) {
    const LAS unsigned char* p = kb + r32 * AT_ROWB + h2 * 16;
#pragma unroll
    for (int d0 = 0; d0 < 4; ++d0) {
        const bf16x8 a0 = *(const LAS bf16x8*)(p + d0 * 32), a1 = *(const LAS bf16x8*)(p + 32 * AT_ROWB + d0 * 32);
        s0 = MFMA32(a0, qf[d0], s0); s1 = MFMA32(a1, qf[d0], s1);
    }
}
DI bf16x8 pack8(const f32x16& x, int s) {
    u32x4 p; p.x = pk2(x[8 * s], x[8 * s + 1]); p.y = pk2(x[8 * s + 2], x[8 * s + 3]); p.z = pk2(x[8 * s + 4], x[8 * s + 5]); p.w = pk2(x[8 * s + 6], x[8 * s + 7]);
    return __builtin_bit_cast(bf16x8, p);
}
DI s16x4 tr_read(const LAS unsigned char* p) { return __builtin_bit_cast(s16x4, __builtin_amdgcn_ds_read_tr16_b64_v4i16((LAS s16x4*)p)); }
DI void at_pv(const LAS unsigned char* vb, const bf16x8 (&pb)[4], int lane, f32x16& o0, f32x16& o1) {
    const int h2 = lane >> 5;
    const LAS unsigned char* base = vb + (4 * h2 + ((lane & 15) >> 2)) * AT_ROWB + (16 * ((lane >> 4) & 1) + 4 * (lane & 3)) * 2;
#pragma unroll
    for (int s = 0; s < 4; ++s) {
        const LAS unsigned char* p = base + 16 * s * AT_ROWB;
        const s16x4 l0 = tr_read(p), h0 = tr_read(p + 8 * AT_ROWB), l1 = tr_read(p + 64), h1 = tr_read(p + 8 * AT_ROWB + 64);
        const bf16x8 a0 = __builtin_shufflevector(l0, h0, 0, 1, 2, 3, 4, 5, 6, 7), a1 = __builtin_shufflevector(l1, h1, 0, 1, 2, 3, 4, 5, 6, 7);
        o0 = MFMA32(a0, pb[s], o0); o1 = MFMA32(a1, pb[s], o1);
    }
}
DI void at_store_out(bf16_t* dst  , const f32x16& o0, const f32x16& o1, float scale, int h2) {
#pragma unroll
    for (int g = 0; g < 4; ++g) {
        u32x2 w0, w1; w0.x = pk2(o0[4 * g] * scale, o0[4 * g + 1] * scale); w0.y = pk2(o0[4 * g + 2] * scale, o0[4 * g + 3] * scale);
        w1.x = pk2(o1[4 * g] * scale, o1[4 * g + 1] * scale); w1.y = pk2(o1[4 * g + 2] * scale, o1[4 * g + 3] * scale);
        *(u32x2*)(dst + 8 * g + 4 * h2) = w0; *(u32x2*)(dst + 32 + 8 * g + 4 * h2) = w1;
    }
}
DI void block_cumsum(const float* src, int n, LAS float* cum, LAS float* wtot, int tid, int lane, int wave) {
    f32x4 v = (f32x4){0.f, 0.f, 0.f, 0.f};
    if (4 * tid < n) v = *(const f32x4*)(src + 4 * tid);
    v[1] += v[0]; v[2] += v[1]; v[3] += v[2];
    float t = v[3];
#pragma unroll
    for (int o = 1; o < 64; o <<= 1) { const float u = __shfl_up(t, o); if (lane >= o) t += u; }
    if (lane == 63) wtot[wave] = t;
    __syncthreads();
    float pre = t - v[3];
    for (int w = 0; w < wave; ++w) pre += wtot[w];
    if (4 * tid < n) { v[0] += pre; v[1] += pre; v[2] += pre; v[3] += pre; *(LAS f32x4*)(cum + 4 * tid) = v; }
    __syncthreads();
}

DI void fx_unit(Frame& F, int layer, int b, int h, int qb) {
    LAS unsigned char* L = F.lds; const int tid = F.tid, lane = F.lane, wid = F.wave, r32 = lane & 31, h2 = lane >> 5;
    const bf16_t* Pb = WSP(bf16_t, WS_P) + (size_t)b * SEQ * PP;
    LAS float* cum = (LAS float*)(L + AT_CUM);
    const int kend = 256 * qb + 256;
    __syncthreads();
    block_cumsum(WSP(float, WS_LF) + (size_t)(b * 4 + h) * SEQ, kend, cum, (LAS float*)(L + AT_MISC), tid, lane, wid);
    const int tw0 = 256 * qb + 32 * wid, tq = tw0 + r32;
    bf16x8 qf[4];
#pragma unroll
    for (int d0 = 0; d0 < 4; ++d0) qf[d0] = *(const bf16x8*)(Pb + (size_t)tq * PP + C_FXQ + h * 64 + 16 * d0 + 8 * h2);
    const float ct2 = cum[tq] * LOG2E;
    float qb2;
    { float qn = 0.f;
#pragma unroll
      for (int d0 = 0; d0 < 4; ++d0) { const u32x4 qq = __builtin_bit_cast(u32x4, qf[d0]);
#pragma unroll
        for (int j = 0; j < 4; ++j) { const float a = bf2f(qq[j] & 0xffffu), c = bf2f(qq[j] >> 16); qn += a * a + c * c; } }
      qn += swap32(qn);
      const unsigned* km = (const unsigned*)(F.ws + WS_CTL) + CW_KMAX + layer * 128 + (b * 4 + h) * 2;
      const float kk2 = __uint_as_float(xb_ld((unsigned*)km)) + __uint_as_float(xb_ld((unsigned*)km + 1));
      qb2 = sqrtf(qn * kk2) * QSCALE2 * 1.01f + 1e-3f; }
    float mrun = -1e30f, lrun = 0.f; f32x16 o0 = {}, o1 = {};
    const int jtop = 4 * qb + 3;
    u32x4 kreg, vreg;
    at_load_tile(Pb, C_FXK + h * 64, C_FXV + h * 64, jtop, tid, kreg, vreg);
    at_store_tile(L, 0, tid, kreg, vreg);
    __syncthreads();
    int buf = 0; bool wskip = false;
    for (int jt = jtop; jt >= 0; --jt) {
        if (jt > 0) at_load_tile(Pb, C_FXK + h * 64, C_FXV + h * 64, jt - 1, tid, kreg, vreg);
        if (64 * jt <= tw0 + 31 && !wskip) {
            f32x16 s0 = {}, s1 = {};
            at_qk(L + AT_KOFF + buf * AT_BUFB, qf, r32, h2, s0, s1);
            const bool needmask = (64 * jt + 63 > tw0);
            float mx = -1e30f;
#pragma unroll
            for (int g = 0; g < 4; ++g) {
                const f32x4 c0 = *(const LAS f32x4*)(cum + 64 * jt + 8 * g + 4 * h2), c1 = *(const LAS f32x4*)(cum + 64 * jt + 32 + 8 * g + 4 * h2);
#pragma unroll
                for (int j = 0; j < 4; ++j) {
                    const int r = 4 * g + j, kv = 64 * jt + 8 * g + 4 * h2 + j;
                    float v0 = s0[r] * QSCALE2 + (ct2 - c0[j] * LOG2E), v1 = s1[r] * QSCALE2 + (ct2 - c1[j] * LOG2E);
                    if (needmask) { if (kv > tq) v0 = -1e30f; if (kv + 32 > tq) v1 = -1e30f; }
                    s0[r] = v0; s1[r] = v1; mx = fmaxf(mx, fmaxf(v0, v1));
                }
            }
            mx = fmaxf(mx, swap32(mx));
            const float mnew = fmaxf(mrun, mx), alpha = ex2(mrun - mnew);
            mrun = mnew;
            float ps = 0.f;
#pragma unroll
            for (int r = 0; r < 16; ++r) { s0[r] = ex2(s0[r] - mnew); s1[r] = ex2(s1[r] - mnew); ps += s0[r] + s1[r]; }
            lrun = lrun * alpha + ps;
#pragma unroll
            for (int r = 0; r < 16; ++r) { o0[r] *= alpha; o1[r] *= alpha; }
            bf16x8 pb[4]; pb[0] = pack8(s0, 0); pb[1] = pack8(s0, 1); pb[2] = pack8(s1, 0); pb[3] = pack8(s1, 1);
            at_pv(L + AT_VOFF + buf * AT_BUFB, pb, lane, o0, o1);
        }
        if (jt > 0) at_store_tile(L, buf ^ 1, tid, kreg, vreg);
        { int wdone = 0; if (jt > 0) wdone = __all(qb2 + (ct2 - cum[64 * jt - 1] * LOG2E) - mrun < -150.f) ? 1 : 0; wskip = wdone != 0; if (lane == 0) *(LAS int*)(L + AT_MISC + 64 + 32 * (jt & 1) + 4 * wid) = wdone; }
        __syncthreads();
        buf ^= 1;
        { const LAS int* fl = (const LAS int*)(L + AT_MISC + 64 + 32 * (jt & 1)); const int alld = fl[0] & fl[1] & fl[2] & fl[3] & fl[4] & fl[5] & fl[6] & fl[7]; if (alld) break; }
    }
    const float ltot = lrun + swap32(lrun);
    at_store_out(WSP(bf16_t, WS_MIX) + (size_t)(b * SEQ + tq) * D + 768 + h * 64, o0, o1, rcpf_(ltot), h2);
}

DI void sb_unit(Frame& F, int b, int h, int qb) {
    LAS unsigned char* L = F.lds; const int tid = F.tid, lane = F.lane, wid = F.wave, r32 = lane & 31, h2 = lane >> 5;
    const bf16_t* Pb = WSP(bf16_t, WS_P) + (size_t)b * SEQ * PP;
    const int tw0 = 256 * qb + 32 * wid, tq = tw0 + r32;
    bf16x8 qf[4];
#pragma unroll
    for (int d0 = 0; d0 < 4; ++d0) qf[d0] = *(const bf16x8*)(Pb + (size_t)tq * PP + C_SBQ + h * 64 + 16 * d0 + 8 * h2);
    bf16x8 uf[2], onesf;
#pragma unroll
    for (int s = 0; s < 2; ++s)
#pragma unroll
        for (int j = 0; j < 8; ++j) uf[s][j] = ((16 * s + 8 * (j >> 2) + 4 * h2 + (j & 3)) > r32) ? (short)0x3F80 : (short)0;
#pragma unroll
    for (int j = 0; j < 8; ++j) onesf[j] = (short)0x3F80;
    float R2 = 0.f; f32x16 o0 = {}, o1 = {};
    const int jtop = 4 * qb + 3;
    u32x4 kreg, vreg;
    __syncthreads();
    at_load_tile(Pb, C_SBK + h * 64, C_SBV + h * 64, jtop, tid, kreg, vreg);
    at_store_tile(L, 0, tid, kreg, vreg);
    __syncthreads();
    int buf = 0; bool wskip = false;
    for (int jt = jtop; jt >= 0; --jt) {
        if (jt > 0) at_load_tile(Pb, C_SBK + h * 64, C_SBV + h * 64, jt - 1, tid, kreg, vreg);
        if (64 * jt <= tw0 + 31 && !wskip) {
            f32x16 s0 = {}, s1 = {};
            at_qk(L + AT_KOFF + buf * AT_BUFB, qf, r32, h2, s0, s1);
            const bool needmask = (64 * jt + 63 >= tw0);
            f32x16 l0, l1;
            float cs = 0.f;
#pragma unroll
            for (int r = 0; r < 16; ++r) {
                const int kv = 64 * jt + crow(r, h2);
                const float z0 = s0[r] * QSCALE2, z1 = s1[r] * QSCALE2;
                const float sp0 = fmaxf(z0, 0.f) + lg2(1.f + ex2(-fabsf(z0))), sp1 = fmaxf(z1, 0.f) + lg2(1.f + ex2(-fabsf(z1)));
                float a0 = -sp0, a1 = -sp1, b0 = z0 - sp0, b1 = z1 - sp1;
                if (needmask) { if (kv >= tq) { a0 = 0.f; b0 = -1e30f; } if (kv + 32 >= tq) { a1 = 0.f; b1 = -1e30f; } }
                l0[r] = a0; l1[r] = a1; s0[r] = b0; s1[r] = b1; cs += a0 + a1;
            }
            f32x16 t0 = {}, t1 = {};
#pragma unroll
            for (int s = 0; s < 2; ++s) {
                const bf16x8 h0 = pack8(l0, s), h1 = pack8(l1, s);
                f32x16 d0_, d1_;
#pragma unroll
                for (int j = 0; j < 8; ++j) { d0_[j] = l0[8 * s + j] - bf2f((unsigned short)h0[j]); d1_[j] = l1[8 * s + j] - bf2f((unsigned short)h1[j]); }
                u32x4 q0, q1; q0.x = pk2(d0_[0], d0_[1]); q0.y = pk2(d0_[2], d0_[3]); q0.z = pk2(d0_[4], d0_[5]); q0.w = pk2(d0_[6], d0_[7]);
                q1.x = pk2(d1_[0], d1_[1]); q1.y = pk2(d1_[2], d1_[3]); q1.z = pk2(d1_[4], d1_[5]); q1.w = pk2(d1_[6], d1_[7]);
                const bf16x8 e0 = __builtin_bit_cast(bf16x8, q0), e1 = __builtin_bit_cast(bf16x8, q1);
                t0 = MFMA32(uf[s], h0, t0); t0 = MFMA32(uf[s], e0, t0); t0 = MFMA32(onesf, h1, t0); t0 = MFMA32(onesf, e1, t0);
                t1 = MFMA32(uf[s], h1, t1); t1 = MFMA32(uf[s], e1, t1);
            }
#pragma unroll
            for (int r = 0; r < 16; ++r) { s0[r] = ex2(s0[r] + R2 + t0[r]); s1[r] = ex2(s1[r] + R2 + t1[r]); }
            R2 += cs + swap32(cs);
            bf16x8 pb[4]; pb[0] = pack8(s0, 0); pb[1] = pack8(s0, 1); pb[2] = pack8(s1, 0); pb[3] = pack8(s1, 1);
            at_pv(L + AT_VOFF + buf * AT_BUFB, pb, lane, o0, o1);
        }
        if (jt > 0) at_store_tile(L, buf ^ 1, tid, kreg, vreg);
        { const int wdone = __all(R2 < -150.f) ? 1 : 0; wskip = wdone != 0; if (lane == 0) *(LAS int*)(L + AT_MISC + 64 + 32 * (jt & 1) + 4 * wid) = wdone; }
        __syncthreads();
        buf ^= 1;
        { const LAS int* fl = (const LAS int*)(L + AT_MISC + 64 + 32 * (jt & 1)); const int alld = fl[0] & fl[1] & fl[2] & fl[3] & fl[4] & fl[5] & fl[6] & fl[7]; if (alld) break; }
    }
    at_store_out(WSP(bf16_t, WS_MIX) + (size_t)(b * SEQ + tq) * D + 0 + h * 64, o0, o1, 1.f, h2);
}
DI void attn_rank_to_unit(int r, int& bh, int& qb) { if (r < 256) { qb = 7 - (r >> 6); bh = r & 63; } else { const int p = r - 256; qb = p >> 6; bh = p & 63; } }

DI void gm_unit(Frame& F, int layer, int b, int c, int g) {
    LAS unsigned char* L = F.lds; const int lane = F.lane, wid = F.wave, r32 = lane & 31, h2 = lane >> 5;
    constexpr int VSTR = 272;
    const bf16_t* Pb = WSP(bf16_t, WS_P) + (size_t)(b * SEQ + c * 128) * PP;
    __syncthreads();
    { bf16_t xr[16];
#pragma unroll
      for (int i = 0; i < 16; ++i) xr[i] = Pb[(size_t)(16 * wid + i) * PP + C_GMV + g * 64 + lane];
#pragma unroll
      for (int i = 0; i < 16; ++i) {
        const int s = 16 * wid + i;
        const float ge = geluf_(bf2f(xr[i])), mean = wave_sum(ge) * (1.f / 64.f), dv = ge - mean, var = wave_sum(dv * dv) * (1.f / 64.f);
        *(LAS bf16_t*)(L + lane * VSTR + s * 2) = (bf16_t)f2bf(dv * __builtin_amdgcn_rsqf(var + 1e-5f));
      } }
    __syncthreads();
    const int tb = wid >> 1, db = wid & 1, t = 32 * tb + r32;
    const float* Wrow = F.in[3] + ((size_t)(layer * 4 + g) * 128 + t) * 128;
    f32x16 acc = {};
    f32x4 wq[8][2];
#pragma unroll
    for (int ks = 0; ks < 8; ++ks) if (ks <= 2 * tb + 1) { const int s0 = 16 * ks + 8 * h2; wq[ks][0] = *(const f32x4*)(Wrow + s0); wq[ks][1] = *(const f32x4*)(Wrow + s0 + 4); }
#pragma unroll
    for (int ks = 0; ks < 8; ++ks) if (ks <= 2 * tb + 1) {
        const int s0 = 16 * ks + 8 * h2;
        float wv[8] = {wq[ks][0][0], wq[ks][0][1], wq[ks][0][2], wq[ks][0][3], wq[ks][1][0], wq[ks][1][1], wq[ks][1][2], wq[ks][1][3]};
#pragma unroll
        for (int j = 0; j < 8; ++j) if (s0 + j > t) wv[j] = 0.f;
        u32x4 aw; aw.x = pk2(wv[0], wv[1]); aw.y = pk2(wv[2], wv[3]); aw.z = pk2(wv[4], wv[5]); aw.w = pk2(wv[6], wv[7]);
        const bf16x8 bv = *(const LAS bf16x8*)(L + (32 * db + r32) * VSTR + s0 * 2);
        acc = MFMA32(__builtin_bit_cast(bf16x8, aw), bv, acc);
    }
    const int d = 32 * db + r32;
    const float* gb = F.in[4] + (size_t)(layer * 4 + g) * 128;
    bf16_t* mo = WSP(bf16_t, WS_MIX) + (size_t)(b * SEQ + c * 128) * D + 256 + g * 64 + d;
#pragma unroll
    for (int r = 0; r < 16; ++r) { const int tt = 32 * tb + crow(r, h2);
        const float u = geluf_(bf2f(Pb[(size_t)tt * PP + C_GMU + g * 64 + d]));
        mo[(size_t)tt * D] = (bf16_t)f2bf(u * (acc[r] + gb[tt])); }
}

DI void rw_load_shift8(const bf16_t* Pt, bool hasprev, int col, const float* mu, float (&o)[8]) {
    const u32x4 cu = *(const u32x4*)(Pt + col); u32x4 pr = (u32x4){0u, 0u, 0u, 0u}; if (hasprev) pr = *(const u32x4*)(Pt - PP + col);
    const f32x4 m0 = *(const f32x4*)(mu), m1 = *(const f32x4*)(mu + 4);
    const float mm[8] = {m0[0], m0[1], m0[2], m0[3], m1[0], m1[1], m1[2], m1[3]};
#pragma unroll
    for (int j = 0; j < 4; ++j) { const float c0 = bf2f(cu[j] & 0xffffu), c1 = bf2f(cu[j] >> 16), p0 = bf2f(pr[j] & 0xffffu), p1 = bf2f(pr[j] >> 16);
        o[2 * j] = c0 + (p0 - c0) * mm[2 * j]; o[2 * j + 1] = c1 + (p1 - c1) * mm[2 * j + 1]; }
}
DI void rw_load_shift4(const bf16_t* Pt, bool hasprev, int col, const float* mu, float (&o)[4]) {
    const u32x2 cu = *(const u32x2*)(Pt + col); u32x2 pr = (u32x2){0u, 0u}; if (hasprev) pr = *(const u32x2*)(Pt - PP + col);
    const f32x4 m0 = *(const f32x4*)(mu);
#pragma unroll
    for (int j = 0; j < 2; ++j) { const float c0 = bf2f(cu[j] & 0xffffu), c1 = bf2f(cu[j] >> 16), p0 = bf2f(pr[j] & 0xffffu), p1 = bf2f(pr[j] >> 16);
        o[2 * j] = c0 + (p0 - c0) * m0[2 * j]; o[2 * j + 1] = c1 + (p1 - c1) * m0[2 * j + 1]; }
}
DI bf16x8 rw_act_frag(const bf16_t* Pt, bool hasprev, const float* mu, int ks, int h2, int mode) {
    float v[8]; rw_load_shift8(Pt, hasprev, C_RWX + 16 * ks + 8 * h2, mu + 768 + 16 * ks + 8 * h2, v);
    if (mode == 1) {
#pragma unroll
        for (int j = 0; j < 8; ++j) v[j] = tanhf_(v[j]);
    } else if (mode == 2) {
#pragma unroll
        for (int j = 0; j < 8; ++j) v[j] = sigmoidf_(v[j]);
    }
    u32x4 pb; pb.x = pk2(v[0], v[1]); pb.y = pk2(v[2], v[3]); pb.z = pk2(v[4], v[5]); pb.w = pk2(v[6], v[7]);
    return __builtin_bit_cast(bf16x8, pb);
}

constexpr int RC_V = 0, RC_KB = 4608, RC_BB = 9216, RC_KT = 13824, RC_CF = 13824, RC_PC = 18432, RC_WAVE = 18688, RC_ROWB = 144;
DI float scan32(float x) {
    x += dppf<0x111, 0xf, true>(x); x += dppf<0x112, 0xf, true>(x); x += dppf<0x114, 0xf, true>(x); x += dppf<0x118, 0xf, true>(x);
    x += dppf<0x142, 0xa, false>(x);
    return x;
}
DI bf16x8 pk8f(const float (&v)[8]) { u32x4 p; p.x = pk2(v[0], v[1]); p.y = pk2(v[2], v[3]); p.z = pk2(v[4], v[5]); p.w = pk2(v[6], v[7]); return __builtin_bit_cast(bf16x8, p); }
DI bf16x8 rc_trfrag(const LAS unsigned char* tile, int lane, int s, int colblk) {
    const int h2 = lane >> 5;
    const LAS unsigned char* p = tile + (16 * s + 4 * h2 + ((lane & 15) >> 2)) * RC_ROWB + (32 * colblk + 16 * ((lane >> 4) & 1) + 4 * (lane & 3)) * 2;
    const s16x4 lo = tr_read(p), hi = tr_read(p + 8 * RC_ROWB);
    return __builtin_shufflevector(lo, hi, 0, 1, 2, 3, 4, 5, 6, 7);
}
DI void rw_chunk_item(Frame& F, int layer, int bh, int ch) {
    asm volatile("" : "+s"(F.in)); asm volatile("" : "+s"(F.ws)); asm volatile("" : "+v"(F.lane));
    const int lane = F.lane, r32 = lane & 31, h2 = lane >> 5, hd = bh & 3, bb = bh >> 2;
    LAS unsigned char* W = F.lds + F.wave * RC_WAVE;
    const int tl = 32 * ch + r32, tok = bb * SEQ + tl; const bool hasprev = tl > 0;
    const bf16_t* Pt0 = WSP(bf16_t, WS_P) + (size_t)tok * PP;
    const float* mu = F.in[5] + (size_t)layer * 1024;
    const bf16_t* wc = WSP(bf16_t, WS_WCAT) + (size_t)layer * 65536 + (size_t)(64 * hd + r32) * 256 + 8 * h2;
    const int chunk = bh * 64 + ch;
    float n2 = 0.f;
    const float* kkw = F.in[11] + layer * 256 + 64 * hd;
#pragma unroll
    for (int blk = 0; blk < 2; ++blk)
#pragma unroll
        for (int g = 0; g < 4; ++g) { const int cl = 32 * blk + 8 * g + 4 * h2; float kv[4]; rw_load_shift4(Pt0, hasprev, C_RWK + 64 * hd + cl, mu + 256 + 64 * hd + cl, kv);
            const f32x4 kw = *(const f32x4*)(kkw + cl);
#pragma unroll
            for (int j = 0; j < 4; ++j) { const float q = kv[j] * kw[j]; n2 += q * q; } }
    n2 += swap32(n2);
    const float inv = 1.f / fmaxf(sqrtf(n2), 1e-12f);
    const float *w0 = F.in[6] + layer * 256 + 64 * hd, *a0 = F.in[8] + layer * 256 + 64 * hd, *kaw = F.in[12] + layer * 256 + 64 * hd, *rk = F.in[13] + layer * 256 + 64 * hd;
    u32x4* FR = WSP(u32x4, WS_CHFR) + (size_t)chunk * 16 * 64 + lane;
    float bon = 0.f;
#pragma unroll
    for (int blk = 0; blk < 2; ++blk) {
        const bf16_t* wb = wc + (size_t)blk * 32 * 256;
        f32x16 aW = {}, aA = {};
#pragma unroll
        for (int ks = 0; ks < 4; ++ks) { const bf16x8 bfr = rw_act_frag(Pt0, hasprev, mu, ks, h2, 1); aW = MFMA32(*(const bf16x8*)(wb + 16 * ks), bfr, aW); }
#pragma unroll
        for (int ks = 4; ks < 8; ++ks) { const bf16x8 bfr = rw_act_frag(Pt0, hasprev, mu, ks, h2, 0); aA = MFMA32(*(const bf16x8*)(wb + 16 * ks), bfr, aA); }
#pragma unroll
        for (int s = 0; s < 2; ++s) {
            float e_kat[8], e_rt[8], e_kt[8], e_bt[8], e_kb[8], e_bb[8];
#pragma unroll
            for (int q = 0; q < 2; ++q) { const int g = 2 * s + q, cl = 32 * blk + 8 * g + 4 * h2;
                const bf16_t* Pt = Pt0;
                float rv[4], vv[4], kv[4]; rw_load_shift4(Pt, hasprev, C_RWR + 64 * hd + cl, mu + 64 * hd + cl, rv); rw_load_shift4(Pt, hasprev, C_RWV + 64 * hd + cl, mu + 512 + 64 * hd + cl, vv);
                rw_load_shift4(Pt, hasprev, C_RWK + 64 * hd + cl, mu + 256 + 64 * hd + cl, kv);
                const f32x4 w0v = *(const f32x4*)(w0 + cl), a0v = *(const f32x4*)(a0 + cl), kav = *(const f32x4*)(kaw + cl), rkv = *(const f32x4*)(rk + cl), kwv = *(const f32x4*)(kkw + cl);
#pragma unroll
                for (int j = 0; j < 4; ++j) { const int r = 4 * g + j, jj = 4 * q + j;
                    const float w = -softplusf_(-(w0v[j] + aW[r])) - 0.5f;
                    const float l2d = -LOG2E * ex2(w * LOG2E);
                    const float a = sigmoidf_(a0v[j] + aA[r]);
                    const float kkv = kv[j] * kwv[j] * inv, bev = kkv * a, kpv = kv[j] * (1.f + (a - 1.f) * kav[j]);
                    bon += rv[j] * kpv * rkv[j];
                    const float Li = scan32(l2d), Lex = Li - l2d, LC = __shfl(Li, 31 + 32 * h2);
                    const float pin = ex2(Li), pex = ex2(Lex), pinv = ex2(-Li), pc = ex2(LC - Li);
                    e_kat[jj] = kkv * pex; e_rt[jj] = rv[j] * pin; e_kt[jj] = kpv * pinv; e_bt[jj] = bev * pinv; e_kb[jj] = kpv * pc; e_bb[jj] = bev * pc;
                    if (r32 == 31) *(LAS float*)(W + RC_PC + (cl + j) * 4) = ex2(LC); }
                u32x2 vq; vq.x = pk2(vv[0], vv[1]); vq.y = pk2(vv[2], vv[3]);
                *(LAS u32x2*)(W + RC_V + r32 * RC_ROWB + cl * 2) = vq;
                *(LAS u32x2*)(W + RC_KB + r32 * RC_ROWB + cl * 2) = (u32x2){pk2(e_kb[4 * q], e_kb[4 * q + 1]), pk2(e_kb[4 * q + 2], e_kb[4 * q + 3])};
                *(LAS u32x2*)(W + RC_BB + r32 * RC_ROWB + cl * 2) = (u32x2){pk2(e_bb[4 * q], e_bb[4 * q + 1]), pk2(e_bb[4 * q + 2], e_bb[4 * q + 3])};
                *(LAS u32x2*)(W + RC_KT + r32 * RC_ROWB + cl * 2) = (u32x2){pk2(e_kat[4 * q], e_kat[4 * q + 1]), pk2(e_kat[4 * q + 2], e_kat[4 * q + 3])};
            }
            { const int ks = 2 * blk + s; FR[(ks * 4 + 0) * 64] = __builtin_bit_cast(u32x4, pk8f(e_kat)); FR[(ks * 4 + 1) * 64] = __builtin_bit_cast(u32x4, pk8f(e_rt)); FR[(ks * 4 + 2) * 64] = __builtin_bit_cast(u32x4, pk8f(e_kt)); FR[(ks * 4 + 3) * 64] = __builtin_bit_cast(u32x4, pk8f(e_bt)); }
        }
        f32x16 aG = {};
#pragma unroll 4
        for (int ks = 8; ks < 16; ++ks) { const bf16x8 bfr = rw_act_frag(Pt0, hasprev, mu, ks, h2, 2); aG = MFMA32(*(const bf16x8*)(wb + 16 * ks), bfr, aG); }
#pragma unroll
        for (int g = 0; g < 4; ++g) { const int cl = 32 * blk + 8 * g + 4 * h2; u32x2 gq;
            gq.x = pk2(aG[4 * g], aG[4 * g + 1]); gq.y = pk2(aG[4 * g + 2], aG[4 * g + 3]);
            *(u32x2*)(WSP(bf16_t, WS_GBUF) + (size_t)tok * 256 + 64 * hd + cl) = gq; }
    }
    bon += swap32(bon);
    asm volatile("s_waitcnt vmcnt(0)" ::: "memory");
    asm volatile("" ::: "memory");
#pragma unroll
    for (int blk = 0; blk < 2; ++blk)
#pragma unroll
        for (int g = 0; g < 4; ++g) { const int cl = 32 * blk + 8 * g + 4 * h2; const u32x2 vq = *(const LAS u32x2*)(W + RC_V + r32 * RC_ROWB + cl * 2); u32x2 q;
            q.x = pk2(bon * bf2f(vq.x & 0xffffu), bon * bf2f(vq.x >> 16)); q.y = pk2(bon * bf2f(vq.y & 0xffffu), bon * bf2f(vq.y >> 16));
            *(u32x2*)(WSP(bf16_t, WS_BONV) + (size_t)tok * 256 + 64 * hd + cl) = q; }
    const float pc_lo = *(const LAS float*)(W + RC_PC + r32 * 4), pc_hi = *(const LAS float*)(W + RC_PC + (32 + r32) * 4);
    bf16x8 akkf[2], arkf[2], arbf[2];
    f32x16 Tt;
    {
        f32x16 skk = {}, skb = {}, sl = {};
#pragma unroll
        for (int ks = 0; ks < 4; ++ks) { const bf16x8 katf = __builtin_bit_cast(bf16x8, FR[(ks * 4 + 0) * 64]), ktf = __builtin_bit_cast(bf16x8, FR[(ks * 4 + 2) * 64]), btf = __builtin_bit_cast(bf16x8, FR[(ks * 4 + 3) * 64]);
            skk = MFMA32(ktf, katf, skk); skb = MFMA32(btf, katf, skb); sl = MFMA32(katf, btf, sl); }
#pragma unroll
        for (int r = 0; r < 16; ++r) { const int i = crow(r, h2); if (i >= r32) { skk[r] = 0.f; skb[r] = 0.f; } if (i <= r32) sl[r] = 0.f; }
#pragma unroll
        for (int s = 0; s < 2; ++s) akkf[s] = pack8(skk, s);
        bf16x8 fx[2], fxt[2];
#pragma unroll
        for (int s = 0; s < 2; ++s) { fx[s] = pack8(sl, s); fxt[s] = pack8(skb, s); }
#pragma unroll
        for (int r = 0; r < 16; ++r) Tt[r] = ((crow(r, h2) == r32) ? 1.f : 0.f) - skb[r];
#pragma unroll
        for (int lvl = 0; lvl < 4; ++lvl) {
            f32x16 p = {}, pt = {};
#pragma unroll
            for (int s = 0; s < 2; ++s) { p = MFMA32(fxt[s], fx[s], p); if (lvl < 3) pt = MFMA32(fx[s], fxt[s], pt); }
#pragma unroll
            for (int s = 0; s < 2; ++s) fx[s] = pack8(p, s);
            const bf16x8 t0 = pack8(Tt, 0), t1 = pack8(Tt, 1);
            Tt = MFMA32(fx[0], t0, Tt); Tt = MFMA32(fx[1], t1, Tt);
            if (lvl < 3) {
#pragma unroll
                for (int s = 0; s < 2; ++s) fxt[s] = pack8(pt, s); }
        }
    }
    {
        f32x16 srk = {}, srb = {};
#pragma unroll
        for (int ks = 0; ks < 4; ++ks) { const bf16x8 rtf = __builtin_bit_cast(bf16x8, FR[(ks * 4 + 1) * 64]), ktf = __builtin_bit_cast(bf16x8, FR[(ks * 4 + 2) * 64]), btf = __builtin_bit_cast(bf16x8, FR[(ks * 4 + 3) * 64]);
            srk = MFMA32(ktf, rtf, srk); srb = MFMA32(btf, rtf, srb); }
#pragma unroll
        for (int r = 0; r < 16; ++r) if (crow(r, h2) > r32) { srk[r] = 0.f; srb[r] = 0.f; }
#pragma unroll
        for (int s = 0; s < 2; ++s) { arkf[s] = pack8(srk, s); arbf[s] = pack8(srb, s); }
    }
    asm volatile("" ::: "memory");
    bf16x8 ng1f[2][2], ng2f[2][2];
    {
        const bf16x8 tf0 = pack8(Tt, 0), tf1 = pack8(Tt, 1);
#pragma unroll
        for (int cb = 0; cb < 2; ++cb) {
            f32x16 g = {};
            g = MFMA32(tf0, rc_trfrag(W + RC_KT, lane, 0, cb), g); g = MFMA32(tf1, rc_trfrag(W + RC_KT, lane, 1, cb), g);
#pragma unroll
            for (int r = 0; r < 16; ++r) g[r] = -g[r];
            ng1f[cb][0] = pack8(g, 0); ng1f[cb][1] = pack8(g, 1);
        }
#pragma unroll
        for (int vb = 0; vb < 2; ++vb) {
            f32x16 x1 = {};
#pragma unroll
            for (int s = 0; s < 2; ++s) x1 = MFMA32(akkf[s], rc_trfrag(W + RC_V, lane, s, vb), x1);
            f32x16 g = {};
            g = MFMA32(tf0, pack8(x1, 0), g); g = MFMA32(tf1, pack8(x1, 1), g);
#pragma unroll
            for (int r = 0; r < 16; ++r) g[r] = -g[r];
            ng2f[vb][0] = pack8(g, 0); ng2f[vb][1] = pack8(g, 1);
        }
    }
    asm volatile("" ::: "memory");
    u32x4* mt = WSP(u32x4, WS_CHMT) + (size_t)chunk * 8 * 64 + lane;
#pragma unroll
    for (int bip = 0; bip < 2; ++bip)
#pragma unroll
        for (int bi = 0; bi < 2; ++bi) {
            f32x16 m = {};
#pragma unroll
            for (int s = 0; s < 2; ++s) m = MFMA32(ng1f[bi][s], rc_trfrag(W + RC_BB, lane, s, bip), m);
            if (bi == bip) {
#pragma unroll
                for (int r = 0; r < 16; ++r) if (crow(r, h2) == r32) m[r] += (bi ? pc_hi : pc_lo); }
#pragma unroll
            for (int s = 0; s < 2; ++s) mt[(bip * 4 + bi * 2 + s) * 64] = __builtin_bit_cast(u32x4, pack8(m, s));
        }
    asm volatile("" ::: "memory");
    u32x4* nb_ = WSP(u32x4, WS_CHN) + (size_t)chunk * 8 * 64 + lane;
#pragma unroll
    for (int vb = 0; vb < 2; ++vb)
#pragma unroll
        for (int bip = 0; bip < 2; ++bip) {
            f32x16 n = {};
#pragma unroll
            for (int s = 0; s < 2; ++s) { n = MFMA32(rc_trfrag(W + RC_KB, lane, s, bip), rc_trfrag(W + RC_V, lane, s, vb), n); n = MFMA32(rc_trfrag(W + RC_BB, lane, s, bip), ng2f[vb][s], n); }
#pragma unroll
            for (int s = 0; s < 2; ++s) nb_[((vb * 2 + bip) * 2 + s) * 64] = __builtin_bit_cast(u32x4, pack8(n, s));
        }
    asm volatile("" ::: "memory");
    u32x4* ry = WSP(u32x4, WS_CHRY) + (size_t)chunk * 4 * 64 + lane;
#pragma unroll
    for (int bi = 0; bi < 2; ++bi) {
        f32x16 q = {};
#pragma unroll
        for (int s = 0; s < 2; ++s) q = MFMA32(ng1f[bi][s], arbf[s], q);
#pragma unroll
        for (int s = 0; s < 2; ++s) { const u32x4 rq = FR[((2 * bi + s) * 4 + 1) * 64]; float o[8];
#pragma unroll
            for (int j = 0; j < 4; ++j) { o[2 * j] = q[8 * s + 2 * j] + bf2f(rq[j] & 0xffffu); o[2 * j + 1] = q[8 * s + 2 * j + 1] + bf2f(rq[j] >> 16); }
            ry[(bi * 2 + s) * 64] = __builtin_bit_cast(u32x4, pk8f(o)); }
    }
    asm volatile("" ::: "memory");
    u32x4* y0 = WSP(u32x4, WS_CHY0) + (size_t)chunk * 4 * 64 + lane;
#pragma unroll
    for (int vb = 0; vb < 2; ++vb) {
        f32x16 yy = {};
#pragma unroll
        for (int s = 0; s < 2; ++s) { yy = MFMA32(arkf[s], rc_trfrag(W + RC_V, lane, s, vb), yy); yy = MFMA32(arbf[s], ng2f[vb][s], yy); }
#pragma unroll
        for (int s = 0; s < 2; ++s) y0[(vb * 2 + s) * 64] = __builtin_bit_cast(u32x4, pack8(yy, s));
    }
    asm volatile("s_waitcnt lgkmcnt(0)" ::: "memory");
}
constexpr int RG_ACT = 4 * RC_WAVE, RG_RKV = RG_ACT + 16384, RG_PAR = RG_RKV + 12 * 4608, RG_END = RG_PAR + 5120;
static_assert(RG_END <= LDS_MISC, "chunk-pass LDS map");
DI void rw_group_loader(Frame& F, int layer, int tg) {
    asm volatile("" : "+s"(F.in)); asm volatile("" : "+s"(F.ws)); asm volatile("" : "+v"(F.lane));
    const int lane = F.lane, r32 = lane & 31, h2 = lane >> 5, lw = F.wave - 4, bb = tg >> 6, ch = tg & 63;
    LAS unsigned char* L = F.lds;
    const int tl = 32 * ch + r32, tok = bb * SEQ + tl; const bool hasprev = tl > 0;
    const bf16_t* Pt0 = WSP(bf16_t, WS_P) + (size_t)tok * PP;
    const float* mu = F.in[5] + (size_t)layer * 1024;
#pragma unroll
    for (int j = 0; j < 4; ++j) { const int ks = 4 * lw + j; const bf16x8 fr = rw_act_frag(Pt0, hasprev, mu, ks, h2, lw == 0 ? 1 : (lw == 1 ? 0 : 2));
        *(LAS bf16x8*)(L + RG_ACT + ks * 1024 + lane * 16) = fr; }
#pragma unroll
    for (int arr = 0; arr < 3; ++arr) { const int cb = (arr == 0 ? C_RWR : (arr == 1 ? C_RWK : C_RWV)) + 64 * lw, mo = 256 * arr + 64 * lw;
#pragma unroll
        for (int g8 = 0; g8 < 4; ++g8) { const int c0 = 32 * h2 + 8 * g8; float o[8]; rw_load_shift8(Pt0, hasprev, cb + c0, mu + mo + c0, o);
            *(LAS bf16x8*)(L + RG_RKV + (lw * 3 + arr) * 4608 + r32 * RC_ROWB + c0 * 2) = pk8f(o); } }
    asm volatile("s_waitcnt lgkmcnt(0)" ::: "memory");
    asm volatile("" ::: "memory"); __builtin_amdgcn_s_barrier(); asm volatile("" ::: "memory");
    {
        const bf16_t* wp = WSP(bf16_t, WS_BIN) + (size_t)layer * NIN * D + (size_t)3072 * D + 4 * lane;
        u32x2 wv[4][4];
#pragma unroll
        for (int c = 0; c < 4; ++c)
#pragma unroll
            for (int j = 0; j < 4; ++j) wv[c][j] = *(const u32x2*)(wp + (size_t)c * D + 256 * j);
        const float* xsrc = (layer == 0) ? F.in[0] : F.out;
        const int t0 = bb * SEQ + 32 * ch + 8 * lw;
#pragma unroll
        for (int ib = 0; ib < 2; ++ib) {
            f32x4 xr[4][4]; float sp[4];
#pragma unroll
            for (int i = 0; i < 4; ++i) { const f32x4* xp = (const f32x4*)(xsrc + (size_t)(t0 + 4 * ib + i) * D) + lane;
#pragma unroll
                for (int j = 0; j < 4; ++j) xr[i][j] = xp[64 * j];
                sp[i] = (lane < 16) ? WSP(float, WS_SS1)[(size_t)(t0 + 4 * ib + i) * 16 + lane] : 0.f; }
#pragma unroll
            for (int i = 0; i < 4; ++i) {
                const float ss = wave_sum(sp[i]); const float rstd = __builtin_amdgcn_rsqf(ss * (1.f / 1024.f) + 1e-6f);
                float res = 0.f;
#pragma unroll
                for (int c = 0; c < 4; ++c) { float a = 0.f;
#pragma unroll
                    for (int j = 0; j < 4; ++j) { const f32x4 x4 = xr[i][j]; const u32x2 wq = wv[c][j];
                        a += (x4[0] * bf2f(wq.x & 0xffffu) + x4[1] * bf2f(wq.x >> 16)) + (x4[2] * bf2f(wq.y & 0xffffu) + x4[3] * bf2f(wq.y >> 16)); }
                    a = wave_sum(a); if (lane == c) res = a; }
                if (lane < 4) { const int row = t0 + 4 * ib + i; WSP(float, WS_LF)[(size_t)((row >> 11) * 4 + lane) * SEQ + (row & 2047)] = -softplusf_(-(res * rstd + F.in[16][layer * 4 + lane])); }
            }
        }
    }
    asm volatile("" ::: "memory"); __builtin_amdgcn_s_barrier(); asm volatile("" ::: "memory");
}
DI void rw_group_compute(Frame& F, int layer, int tg) {
    asm volatile("" : "+s"(F.in)); asm volatile("" : "+s"(F.ws)); asm volatile("" : "+v"(F.lane));
    const int lane = F.lane, r32 = lane & 31, h2 = lane >> 5, hd = F.wave, bb = tg >> 6, ch = tg & 63, bh = bb * 4 + hd;
    LAS unsigned char* L = F.lds;
    LAS unsigned char* W = L + F.wave * RC_WAVE;
    const int tl = 32 * ch + r32, tok = bb * SEQ + tl;
    const bf16_t* wc = WSP(bf16_t, WS_WCAT) + (size_t)layer * 65536 + (size_t)(64 * hd + r32) * 256 + 8 * h2;
    const int chunk = bh * 64 + ch;
    const LAS float* PAR = (const LAS float*)(L + RG_PAR) + 64 * hd;
    const LAS unsigned char* TR = L + RG_RKV + (hd * 3 + 0) * 4608 + r32 * RC_ROWB;
    const LAS unsigned char* TK = TR + 4608; const LAS unsigned char* TV = TR + 2 * 4608;
    u32x4* FR = WSP(u32x4, WS_CHFR) + (size_t)chunk * 16 * 64 + lane;
    asm volatile("" ::: "memory"); __builtin_amdgcn_s_barrier(); asm volatile("" ::: "memory");
    float n2 = 0.f;
#pragma unroll
    for (int g8 = 0; g8 < 4; ++g8) { const u32x4 kq = *(const LAS u32x4*)(TK + 64 * h2 + 16 * g8); const f32x4 k0 = *(const LAS f32x4*)(PAR + 1024 + 32 * h2 + 8 * g8), k1 = *(const LAS f32x4*)(PAR + 1024 + 32 * h2 + 8 * g8 + 4);
#pragma unroll
        for (int j = 0; j < 4; ++j) { const float a = bf2f(kq[j] & 0xffffu) * (j < 2 ? k0[2 * j] : k1[2 * j - 4]), c = bf2f(kq[j] >> 16) * (j < 2 ? k0[2 * j + 1] : k1[2 * j - 3]); n2 += a * a + c * c; } }
    n2 += swap32(n2);
    const float inv = 1.f / fmaxf(sqrtf(n2), 1e-12f);
    float bon = 0.f;
#pragma unroll
    for (int blk = 0; blk < 2; ++blk) {
        const bf16_t* wb = wc + (size_t)blk * 32 * 256;
        f32x16 aW = {}, aA = {};
#pragma unroll
        for (int ks = 0; ks < 4; ++ks) aW = MFMA32(*(const bf16x8*)(wb + 16 * ks), *(const LAS bf16x8*)(L + RG_ACT + ks * 1024 + lane * 16), aW);
#pragma unroll
        for (int ks = 4; ks < 8; ++ks) aA = MFMA32(*(const bf16x8*)(wb + 16 * ks), *(const LAS bf16x8*)(L + RG_ACT + ks * 1024 + lane * 16), aA);
#pragma unroll
        for (int s = 0; s < 2; ++s) {
            float e_kat[8], e_rt[8], e_kt[8], e_bt[8], e_kb[8], e_bb[8];
#pragma unroll
            for (int q = 0; q < 2; ++q) { const int g = 2 * s + q, cl = 32 * blk + 8 * g + 4 * h2;
                const u32x2 rq = *(const LAS u32x2*)(TR + cl * 2), kq = *(const LAS u32x2*)(TK + cl * 2), vq = *(const LAS u32x2*)(TV + cl * 2);
                const float rv[4] = {bf2f(rq.x & 0xffffu), bf2f(rq.x >> 16), bf2f(rq.y & 0xffffu), bf2f(rq.y >> 16)}, kv[4] = {bf2f(kq.x & 0xffffu), bf2f(kq.x >> 16), bf2f(kq.y & 0xffffu), bf2f(kq.y >> 16)};
                const f32x4 w0v = *(const LAS f32x4*)(PAR + cl), a0v = *(const LAS f32x4*)(PAR + 256 + cl), kav = *(const LAS f32x4*)(PAR + 512 + cl), rkv = *(const LAS f32x4*)(PAR + 768 + cl), kwv = *(const LAS f32x4*)(PAR + 1024 + cl);
#pragma unroll
                for (int j = 0; j < 4; ++j) { const int r = 4 * g + j, jj = 4 * q + j;
                    const float w = -softplusf_(-(w0v[j] + aW[r])) - 0.5f;
                    const float l2d = -LOG2E * ex2(w * LOG2E);
                    const float a = sigmoidf_(a0v[j] + aA[r]);
                    const float kkv = kv[j] * kwv[j] * inv, bev = kkv * a, kpv = kv[j] * (1.f + (a - 1.f) * kav[j]);
                    bon += rv[j] * kpv * rkv[j];
                    const float Li = scan32(l2d), Lex = Li - l2d, LC = __shfl(Li, 31 + 32 * h2);
                    const float pin = ex2(Li), pex = ex2(Lex), pinv = ex2(-Li), pc = ex2(LC - Li);
                    e_kat[jj] = kkv * pex; e_rt[jj] = rv[j] * pin; e_kt[jj] = kpv * pinv; e_bt[jj] = bev * pinv; e_kb[jj] = kpv * pc; e_bb[jj] = bev * pc;
                    if (r32 == 31) *(LAS float*)(W + RC_PC + (cl + j) * 4) = ex2(LC); }
                *(LAS u32x2*)(W + RC_V + r32 * RC_ROWB + cl * 2) = vq;
                *(LAS u32x2*)(W + RC_KB + r32 * RC_ROWB + cl * 2) = (u32x2){pk2(e_kb[4 * q], e_kb[4 * q + 1]), pk2(e_kb[4 * q + 2], e_kb[4 * q + 3])};
                *(LAS u32x2*)(W + RC_BB + r32 * RC_ROWB + cl * 2) = (u32x2){pk2(e_bb[4 * q], e_bb[4 * q + 1]), pk2(e_bb[4 * q + 2], e_bb[4 * q + 3])};
                *(LAS u32x2*)(W + RC_KT + r32 * RC_ROWB + cl * 2) = (u32x2){pk2(e_kat[4 * q], e_kat[4 * q + 1]), pk2(e_kat[4 * q + 2], e_kat[4 * q + 3])};
            }
            { const int ks = 2 * blk + s; FR[(ks * 4 + 0) * 64] = __builtin_bit_cast(u32x4, pk8f(e_kat)); FR[(ks * 4 + 1) * 64] = __builtin_bit_cast(u32x4, pk8f(e_rt)); FR[(ks * 4 + 2) * 64] = __builtin_bit_cast(u32x4, pk8f(e_kt)); FR[(ks * 4 + 3) * 64] = __builtin_bit_cast(u32x4, pk8f(e_bt)); }
        }
        f32x16 aG = {};
#pragma unroll
        for (int ks = 8; ks < 16; ++ks) aG = MFMA32(*(const bf16x8*)(wb + 16 * ks), *(const LAS bf16x8*)(L + RG_ACT + ks * 1024 + lane * 16), aG);
#pragma unroll
        for (int g = 0; g < 4; ++g) { const int cl = 32 * blk + 8 * g + 4 * h2; u32x2 gq;
            gq.x = pk2(aG[4 * g], aG[4 * g + 1]); gq.y = pk2(aG[4 * g + 2], aG[4 * g + 3]);
            *(u32x2*)(WSP(bf16_t, WS_GBUF) + (size_t)tok * 256 + 64 * hd + cl) = gq; }
    }
    asm volatile("s_waitcnt lgkmcnt(0)" ::: "memory");
    asm volatile("" ::: "memory"); __builtin_amdgcn_s_barrier(); asm volatile("" ::: "memory");
    bon += swap32(bon);
    asm volatile("s_waitcnt vmcnt(0)" ::: "memory");
    asm volatile("" ::: "memory");
#pragma unroll
    for (int blk = 0; blk < 2; ++blk)
#pragma unroll
        for (int g = 0; g < 4; ++g) { const int cl = 32 * blk + 8 * g + 4 * h2; const u32x2 vq = *(const LAS u32x2*)(W + RC_V + r32 * RC_ROWB + cl * 2); u32x2 q;
            q.x = pk2(bon * bf2f(vq.x & 0xffffu), bon * bf2f(vq.x >> 16)); q.y = pk2(bon * bf2f(vq.y & 0xffffu), bon * bf2f(vq.y >> 16));
            *(u32x2*)(WSP(bf16_t, WS_BONV) + (size_t)tok * 256 + 64 * hd + cl) = q; }
    const float pc_lo = *(const LAS float*)(W + RC_PC + r32 * 4), pc_hi = *(const LAS float*)(W + RC_PC + (32 + r32) * 4);
    bf16x8 akkf[2], arkf[2], arbf[2];
    f32x16 Tt;
    {
        f32x16 skk = {}, skb = {}, sl = {};
#pragma unroll
        for (int ks = 0; ks < 4; ++ks) { const bf16x8 katf = __builtin_bit_cast(bf16x8, FR[(ks * 4 + 0) * 64]), ktf = __builtin_bit_cast(bf16x8, FR[(ks * 4 + 2) * 64]), btf = __builtin_bit_cast(bf16x8, FR[(ks * 4 + 3) * 64]);
            skk = MFMA32(ktf, katf, skk); skb = MFMA32(btf, katf, skb); sl = MFMA32(katf, btf, sl); }
#pragma unroll
        for (int r = 0; r < 16; ++r) { const int i = crow(r, h2); if (i >= r32) { skk[r] = 0.f; skb[r] = 0.f; } if (i <= r32) sl[r] = 0.f; }
#pragma unroll
        for (int s = 0; s < 2; ++s) akkf[s] = pack8(skk, s);
        bf16x8 fx[2], fxt[2];
#pragma unroll
        for (int s = 0; s < 2; ++s) { fx[s] = pack8(sl, s); fxt[s] = pack8(skb, s); }
#pragma unroll
        for (int r = 0; r < 16; ++r) Tt[r] = ((crow(r, h2) == r32) ? 1.f : 0.f) - skb[r];
#pragma unroll
        for (int lvl = 0; lvl < 4; ++lvl) {
            f32x16 p = {}, pt = {};
#pragma unroll
            for (int s = 0; s < 2; ++s) { p = MFMA32(fxt[s], fx[s], p); if (lvl < 3) pt = MFMA32(fx[s], fxt[s], pt); }
#pragma unroll
            for (int s = 0; s < 2; ++s) fx[s] = pack8(p, s);
            const bf16x8 t0 = pack8(Tt, 0), t1 = pack8(Tt, 1);
            Tt = MFMA32(fx[0], t0, Tt); Tt = MFMA32(fx[1], t1, Tt);
            if (lvl < 3) {
#pragma unroll
                for (int s = 0; s < 2; ++s) fxt[s] = pack8(pt, s); }
        }
    }
    {
        f32x16 srk = {}, srb = {};
#pragma unroll
        for (int ks = 0; ks < 4; ++ks) { const bf16x8 rtf = __builtin_bit_cast(bf16x8, FR[(ks * 4 + 1) * 64]), ktf = __builtin_bit_cast(bf16x8, FR[(ks * 4 + 2) * 64]), btf = __builtin_bit_cast(bf16x8, FR[(ks * 4 + 3) * 64]);
            srk = MFMA32(ktf, rtf, srk); srb = MFMA32(btf, rtf, srb); }
#pragma unroll
        for (int r = 0; r < 16; ++r) if (crow(r, h2) > r32) { srk[r] = 0.f; srb[r] = 0.f; }
#pragma unroll
        for (int s = 0; s < 2; ++s) { arkf[s] = pack8(srk, s); arbf[s] = pack8(srb, s); }
    }
    asm volatile("" ::: "memory");
    bf16x8 ng1f[2][2], ng2f[2][2];
    {
        const bf16x8 tf0 = pack8(Tt, 0), tf1 = pack8(Tt, 1);
#pragma unroll
        for (int cb = 0; cb < 2; ++cb) {
            f32x16 g = {};
            g = MFMA32(tf0, rc_trfrag(W + RC_KT, lane, 0, cb), g); g = MFMA32(tf1, rc_trfrag(W + RC_KT, lane, 1, cb), g);
#pragma unroll
            for (int r = 0; r < 16; ++r) g[r] = -g[r];
            ng1f[cb][0] = pack8(g, 0); ng1f[cb][1] = pack8(g, 1);
        }
#pragma unroll
        for (int vb = 0; vb < 2; ++vb) {
            f32x16 x1 = {};
#pragma unroll
            for (int s = 0; s < 2; ++s) x1 = MFMA32(akkf[s], rc_trfrag(W + RC_V, lane, s, vb), x1);
            f32x16 g = {};
            g = MFMA32(tf0, pack8(x1, 0), g); g = MFMA32(tf1, pack8(x1, 1), g);
#pragma unroll
            for (int r = 0; r < 16; ++r) g[r] = -g[r];
            ng2f[vb][0] = pack8(g, 0); ng2f[vb][1] = pack8(g, 1);
        }
    }
    asm volatile("" ::: "memory");
    u32x4* mt = WSP(u32x4, WS_CHMT) + (size_t)chunk * 8 * 64 + lane;
#pragma unroll
    for (int bip = 0; bip < 2; ++bip)
#pragma unroll
        for (int bi = 0; bi < 2; ++bi) {
            f32x16 m = {};
#pragma unroll
            for (int s = 0; s < 2; ++s) m = MFMA32(ng1f[bi][s], rc_trfrag(W + RC_BB, lane, s, bip), m);
            if (bi == bip) {
#pragma unroll
                for (int r = 0; r < 16; ++r) if (crow(r, h2) == r32) m[r] += (bi ? pc_hi : pc_lo); }
#pragma unroll
            for (int s = 0; s < 2; ++s) mt[(bip * 4 + bi * 2 + s) * 64] = __builtin_bit_cast(u32x4, pack8(m, s));
        }
    asm volatile("" ::: "memory");
    u32x4* nb_ = WSP(u32x4, WS_CHN) + (size_t)chunk * 8 * 64 + lane;
#pragma unroll
    for (int vb = 0; vb < 2; ++vb)
#pragma unroll
        for (int bip = 0; bip < 2; ++bip) {
            f32x16 n = {};
#pragma unroll
            for (int s = 0; s < 2; ++s) { n = MFMA32(rc_trfrag(W + RC_KB, lane, s, bip), rc_trfrag(W + RC_V, lane, s, vb), n); n = MFMA32(rc_trfrag(W + RC_BB, lane, s, bip), ng2f[vb][s], n); }
#pragma unroll
            for (int s = 0; s < 2; ++s) nb_[((vb * 2 + bip) * 2 + s) * 64] = __builtin_bit_cast(u32x4, pack8(n, s));
        }
    asm volatile("" ::: "memory");
    u32x4* ry = WSP(u32x4, WS_CHRY) + (size_t)chunk * 4 * 64 + lane;
#pragma unroll
    for (int bi = 0; bi < 2; ++bi) {
        f32x16 q = {};
#pragma unroll
        for (int s = 0; s < 2; ++s) q = MFMA32(ng1f[bi][s], arbf[s], q);
#pragma unroll
        for (int s = 0; s < 2; ++s) { const u32x4 rq = FR[((2 * bi + s) * 4 + 1) * 64]; float o[8];
#pragma unroll
            for (int j = 0; j < 4; ++j) { o[2 * j] = q[8 * s + 2 * j] + bf2f(rq[j] & 0xffffu); o[2 * j + 1] = q[8 * s + 2 * j + 1] + bf2f(rq[j] >> 16); }
            ry[(bi * 2 + s) * 64] = __builtin_bit_cast(u32x4, pk8f(o)); }
    }
    asm volatile("" ::: "memory");
    u32x4* y0 = WSP(u32x4, WS_CHY0) + (size_t)chunk * 4 * 64 + lane;
#pragma unroll
    for (int vb = 0; vb < 2; ++vb) {
        f32x16 yy = {};
#pragma unroll
        for (int s = 0; s < 2; ++s) { yy = MFMA32(arkf[s], rc_trfrag(W + RC_V, lane, s, vb), yy); yy = MFMA32(arbf[s], ng2f[vb][s], yy); }
#pragma unroll
        for (int s = 0; s < 2; ++s) y0[(vb * 2 + s) * 64] = __builtin_bit_cast(u32x4, pack8(yy, s));
    }
    asm volatile("s_waitcnt lgkmcnt(0)" ::: "memory");
}
DI void unpack16(const u32x4& a, const u32x4& b, f32x16& o) {
#pragma unroll
    for (int j = 0; j < 4; ++j) { o[2 * j] = bf2f(a[j] & 0xffffu); o[2 * j + 1] = bf2f(a[j] >> 16); o[8 + 2 * j] = bf2f(b[j] & 0xffffu); o[8 + 2 * j + 1] = bf2f(b[j] >> 16); }
}
constexpr int SQ_BH = 24576, SQ_STAGE = 2 * SQ_BH;
DI void rw_seq_wg(Frame& F, int item, unsigned* sd) {
    LAS unsigned char* L = F.lds; const int lane = F.lane, wid = F.wave, r32 = lane & 31, h2 = lane >> 5;
    __syncthreads();
    if (wid >= 4) {
        const int slot = (wid - 4) >> 1, half = (wid - 4) & 1, bh = 2 * item + slot;
        const u32x4* mtb = WSP(u32x4, WS_CHMT) + (size_t)bh * 64 * 8 * 64 + lane;
        const u32x4* nbb = WSP(u32x4, WS_CHN) + (size_t)bh * 64 * 8 * 64 + lane;
        const u32x4* ryb = WSP(u32x4, WS_CHRY) + (size_t)bh * 64 * 4 * 64 + lane;
        const u32x4* y0b = WSP(u32x4, WS_CHY0) + (size_t)bh * 64 * 4 * 64 + lane;
#define SQ_ISSUE(CH) do { const int ch_ = (CH); LAS unsigned char* st_ = L + (ch_ % 3) * SQ_STAGE + slot * SQ_BH; \
            if (half == 0) { _Pragma("unroll") for (int i = 0; i < 8; ++i) __builtin_amdgcn_global_load_lds((const unsigned*)(mtb + (size_t)ch_ * 512 + i * 64), (LAS unsigned*)(st_ + i * 1024), 16, 0, 0); \
                             _Pragma("unroll") for (int i = 0; i < 4; ++i) __builtin_amdgcn_global_load_lds((const unsigned*)(ryb + (size_t)ch_ * 256 + i * 64), (LAS unsigned*)(st_ + (8 + i) * 1024), 16, 0, 0); } \
            else { _Pragma("unroll") for (int i = 0; i < 8; ++i) __builtin_amdgcn_global_load_lds((const unsigned*)(nbb + (size_t)ch_ * 512 + i * 64), (LAS unsigned*)(st_ + (12 + i) * 1024), 16, 0, 0); \
                   _Pragma("unroll") for (int i = 0; i < 4; ++i) __builtin_amdgcn_global_load_lds((const unsigned*)(y0b + (size_t)ch_ * 256 + i * 64), (LAS unsigned*)(st_ + (20 + i) * 1024), 16, 0, 0); } } while (0)
        SQ_ISSUE(0); SQ_ISSUE(1);
        asm volatile("s_waitcnt vmcnt(12)" ::: "memory");
        __builtin_amdgcn_s_barrier();
#pragma unroll 1
        for (int ch = 0; ch < 64; ++ch) {
            if (ch + 2 < 64) { SQ_ISSUE(ch + 2); asm volatile("s_waitcnt vmcnt(12)" ::: "memory"); }
            else asm volatile("s_waitcnt vmcnt(0)" ::: "memory");
            __builtin_amdgcn_s_barrier();
        }
#undef SQ_ISSUE
    } else {
        const int slot = wid >> 1, vb = wid & 1, bh = 2 * item + slot;
        f32x16 H0 = {}, H1 = {};
        float* yb = WSP(float, WS_YBUF) + (size_t)(bh >> 2) * SEQ * 256 + (bh & 3) * 64 + 32 * vb + r32;
        __builtin_amdgcn_s_barrier();
#pragma unroll 1
        for (int ch = 0; ch < 64; ++ch) {
            const LAS unsigned char* st = L + (ch % 3) * SQ_STAGE + slot * SQ_BH + lane * 16;
            u32x4 cmt[8], cry[4], cnn[4], cy0[2];
#pragma unroll
            for (int i = 0; i < 8; ++i) cmt[i] = *(const LAS u32x4*)(st + i * 1024);
#pragma unroll
            for (int i = 0; i < 4; ++i) { cry[i] = *(const LAS u32x4*)(st + (8 + i) * 1024); cnn[i] = *(const LAS u32x4*)(st + (12 + 4 * vb + i) * 1024); }
            cy0[0] = *(const LAS u32x4*)(st + (20 + 2 * vb) * 1024); cy0[1] = *(const LAS u32x4*)(st + (21 + 2 * vb) * 1024);
            bf16x8 hb[4]; hb[0] = pack8(H0, 0); hb[1] = pack8(H0, 1); hb[2] = pack8(H1, 0); hb[3] = pack8(H1, 1);
            f32x16 y, n0, n1;
            unpack16(cy0[0], cy0[1], y); unpack16(cnn[0], cnn[1], n0); unpack16(cnn[2], cnn[3], n1);
            asm volatile("s_waitcnt lgkmcnt(0)" ::: "memory");
#pragma unroll
            for (int ks = 0; ks < 4; ++ks) { n0 = MFMA32(__builtin_bit_cast(bf16x8, cmt[ks]), hb[ks], n0); n1 = MFMA32(__builtin_bit_cast(bf16x8, cmt[4 + ks]), hb[ks], n1); y = MFMA32(__builtin_bit_cast(bf16x8, cry[ks]), hb[ks], y); }
            H0 = n0; H1 = n1;
#pragma unroll
            for (int r = 0; r < 16; ++r) yb[(size_t)(32 * ch + crow(r, h2)) * 256] = y[r];
            __builtin_amdgcn_s_barrier();
        }
        asm volatile("s_waitcnt vmcnt(0)" ::: "memory");
    }
    __syncthreads();
    if (F.tid == 0) {
        __builtin_amdgcn_fence(__ATOMIC_RELEASE, "agent");
        asm volatile("s_waitcnt vmcnt(0)" ::: "memory");
        (void)xb_add(sd, 1u);
    }
}
template <int NB> DI void rw_post_batch(Frame& F, int layer, int w0, int ws) {
    const int lane = F.lane;
    float y[NB], bv[NB], g[NB]; int tokv[NB], cv[NB];
#pragma unroll
    for (int i = 0; i < NB; ++i) { const int w = w0 + i * ws; tokv[i] = w >> 2; cv[i] = 64 * (w & 3) + lane;
        y[i] = WSP(float, WS_YBUF)[(size_t)tokv[i] * 256 + cv[i]];
        bv[i] = bf2f(WSP(bf16_t, WS_BONV)[(size_t)tokv[i] * 256 + cv[i]]); g[i] = bf2f(WSP(bf16_t, WS_GBUF)[(size_t)tokv[i] * 256 + cv[i]]); }
#pragma unroll
    for (int i = 0; i < NB; ++i) {
        const float mean = wave_sum(y[i]) * (1.f / 64.f), dv = y[i] - mean, var = wave_sum(dv * dv) * (1.f / 64.f);
        const float yn = dv * __builtin_amdgcn_rsqf(var + 64e-5f) * F.in[14][layer * 256 + cv[i]] + F.in[15][layer * 256 + cv[i]];
        WSP(bf16_t, WS_MIX)[(size_t)tokv[i] * D + 512 + cv[i]] = (bf16_t)f2bf((yn + bv[i]) * g[i]);
    }
}

constexpr int RT_WSTR = 1028;
DI void p4_router(Frame& F, int layer, bool dry) {
    LAS unsigned char* L = F.lds; const int tid = F.tid, lane = F.lane, wid = F.wave, m16 = lane & 15, q4 = lane >> 4;
    LAS float* W = (LAS float*)L;
    LAS float* wlog = (LAS float*)L + wid * (16 * 49);
    LAS int* ent = (LAS int*)(L + 148032);
    LAS float* entg = (LAS float*)(L + 148032 + 4096);
    LAS int* lcnt = (LAS int*)(L + 148032 + 5120);
    LAS int* lbase = lcnt + 144;
    const float* x = F.out; bf16_t* xb = WSP(bf16_t, WS_XB);
    const float *bg = F.in[20] + layer * 4, *be = F.in[22] + layer * 32;
    unsigned* cnt = (unsigned*)(F.ws + WS_CTL) + CW_CNT + layer * 256;
    int* elist = WSP(int, WS_LIST); float* egate = WSP(float, WS_GLIST); u32x2* plist = WSP(u32x2, WS_PLIST);
    for (int blk = F.bid; blk < NT / 128; blk += F.G) {
        __syncthreads();
        { const f32x4* src = (const f32x4*)(WSP(float, WS_RTW) + (size_t)layer * 36 * 1024);
          for (int i = tid; i < 36 * 256; i += 512) *(LAS f32x4*)(W + (i >> 8) * RT_WSTR + 4 * (i & 255)) = src[i]; }
        if (tid < 144) lcnt[tid] = 0;
        __syncthreads();
        const int row0 = blk * 128 + wid * 16;
        const float* xr = x + (size_t)(row0 + m16) * D + 4 * q4; bf16_t* xbr = xb + (size_t)(row0 + m16) * D + 4 * q4;
        f32x4 a0 = {}, a1 = {}, a2 = {}; float ssq = 0.f;
        const LAS float* w0p = W + (size_t)m16 * RT_WSTR + 4 * q4; const LAS float* w1p = w0p + 16 * RT_WSTR; const LAS float* w2p = W + (size_t)(32 + (m16 & 3)) * RT_WSTR + 4 * q4;
        const bool v2 = m16 < 4;
#pragma unroll 16
        for (int j = 0; j < 64; ++j) {
            const f32x4 xv = *(const f32x4*)(xr + 16 * j);
            const f32x4 wa = *(const LAS f32x4*)(w0p + 16 * j), wb = *(const LAS f32x4*)(w1p + 16 * j); f32x4 wc_ = *(const LAS f32x4*)(w2p + 16 * j);
            if (!v2) wc_ = (f32x4){0.f, 0.f, 0.f, 0.f};
            ssq += (xv[0] * xv[0] + xv[1] * xv[1]) + (xv[2] * xv[2] + xv[3] * xv[3]);
            u32x2 w; w.x = pk2(xv[0], xv[1]); w.y = pk2(xv[2], xv[3]); *(u32x2*)(xbr + 16 * j) = w;
#pragma unroll
            for (int i = 0; i < 4; ++i) { a0 = __builtin_amdgcn_mfma_f32_16x16x4f32(xv[i], wa[i], a0, 0, 0, 0); a1 = __builtin_amdgcn_mfma_f32_16x16x4f32(xv[i], wb[i], a1, 0, 0, 0); a2 = __builtin_amdgcn_mfma_f32_16x16x4f32(xv[i], wc_[i], a2, 0, 0, 0); }
        }
        ssq += __shfl_xor(ssq, 16); ssq += __shfl_xor(ssq, 32);
        __syncthreads();
#pragma unroll
        for (int jj = 0; jj < 4; ++jj) { wlog[(4 * q4 + jj) * 49 + m16] = a0[jj]; wlog[(4 * q4 + jj) * 49 + 16 + m16] = a1[jj]; wlog[(4 * q4 + jj) * 49 + 32 + m16] = a2[jj]; }
        asm volatile("s_waitcnt lgkmcnt(0)" ::: "memory");
        if (lane < 16) {
            const int r = lane, row = row0 + r;
            const float rstd = __builtin_amdgcn_rsqf(ssq * (1.f / 1024.f) + 1e-6f);
            WSP(float, WS_RSTD2)[row] = rstd;
            float gl[4]; int gs = 0; float gmax;
#pragma unroll
            for (int j = 0; j < 4; ++j) gl[j] = wlog[r * 49 + j] * rstd + bg[j];
            gmax = gl[0];
#pragma unroll
            for (int j = 1; j < 4; ++j) if (gl[j] > gmax) { gmax = gl[j]; gs = j; }
            float gsum = 0.f;
#pragma unroll
            for (int j = 0; j < 4; ++j) gsum += ex2((gl[j] - gmax) * LOG2E);
            const float ggate = 1.f / gsum;
            float el[8];
#pragma unroll
            for (int j = 0; j < 8; ++j) el[j] = wlog[r * 49 + 4 + gs * 8 + j] * rstd + be[gs * 8 + j];
            int i0 = 0; float m0 = el[0];
#pragma unroll
            for (int j = 1; j < 8; ++j) if (el[j] > m0) { m0 = el[j]; i0 = j; }
            int i1 = -1; float m1 = -3.0e38f;
#pragma unroll
            for (int j = 0; j < 8; ++j) if (j != i0 && (i1 < 0 || el[j] > m1)) { m1 = el[j]; i1 = j; }
            const float e1 = ex2((m1 - m0) * LOG2E), g0 = ggate / (1.f + e1), g1 = ggate * e1 / (1.f + e1);
            const int la = i0 < i1 ? i0 : i1, lb = i0 < i1 ? i1 : i0; const float ga = i0 < i1 ? g0 : g1, gb = i0 < i1 ? g1 : g0;
            const int ea = gs * 8 + la, eb = gs * 8 + lb, pid = gs * 28 + la * (15 - la) / 2 + (lb - la - 1);
            const int ra = atomicAdd((int*)&lcnt[ea], 1), rb = atomicAdd((int*)&lcnt[eb], 1), rp = atomicAdd((int*)&lcnt[32 + pid], 1);
            const int li = wid * 16 + r;
            ent[li * 8 + 0] = ea; ent[li * 8 + 1] = eb; ent[li * 8 + 2] = pid; ent[li * 8 + 3] = ra; ent[li * 8 + 4] = rb; ent[li * 8 + 5] = rp; entg[li * 2] = ga; entg[li * 2 + 1] = gb;
        }
        __syncthreads();
        if (tid < 144) { const int n = lcnt[tid]; lbase[tid] = (n && !dry) ? (int)xb_add(cnt + tid, (unsigned)n) : 0; }
        __syncthreads();
        if (tid < 128 && !dry) { const int row = blk * 128 + tid; const int ea = ent[tid * 8], eb = ent[tid * 8 + 1], pid = ent[tid * 8 + 2];
            const int pa = lbase[ea] + ent[tid * 8 + 3], pb = lbase[eb] + ent[tid * 8 + 4], pp = lbase[32 + pid] + ent[tid * 8 + 5];
            elist[(size_t)ea * LCAP + pa] = row; egate[(size_t)ea * LCAP + pa] = entg[tid * 2];
            elist[(size_t)eb * LCAP + pb] = row; egate[(size_t)eb * LCAP + pb] = entg[tid * 2 + 1];
            plist[(size_t)pid * LCAP + pp] = (u32x2){(unsigned)row, (unsigned)pa | ((unsigned)pb << 16)}; }
    }
    __syncthreads();
}
DI void moe_tables(Frame& F, int layer) {
    LAS MoeTab* T = (LAS MoeTab*)(F.lds + LDS_AUX);
    unsigned* cnt = (unsigned*)(F.ws + WS_CTL) + CW_CNT + layer * 256;
    __syncthreads();
    if (F.tid < 32) T->ce[F.tid] = (int)xb_ld(cnt + F.tid); else if (F.tid < 144) T->cp[F.tid - 32] = (int)xb_ld(cnt + F.tid);
    __syncthreads();
    if (F.tid == 0) { int sb = 0, tg = 0;
        for (int e = 0; e < 32; ++e) { const int a = T->ce[e]; T->sb[e] = sb; T->tpg[e] = tg; sb += a; tg += (a + 255) >> 8; }
        T->tpg[32] = tg; }
    if (F.tid == 64) { int tf = 0, th = 0;
        for (int p = 0; p < 112; ++p) { const int n = T->cp[p], nt_ = (n + 255) >> 8, half = (nt_ > 0 && n - 256 * (nt_ - 1) <= 128) ? 1 : 0; T->tpf[p] = tf; T->tph[p] = th; tf += nt_ - half; th += half; }
        T->tpf[112] = tf; T->tph[112] = th; }
    __syncthreads();
}
DI void p_final(Frame& F) {
    const int gw = F.bid * 8 + F.wave, NGW = F.G * 8; const f32x4* gq = (const f32x4*)F.in[26] + F.lane;
    f32x4 gv[4];
#pragma unroll
    for (int j = 0; j < 4; ++j) gv[j] = gq[64 * j];
    for (int m0 = gw * 4; m0 < NT; m0 += NGW * 4) {
        f32x4 v[4][4];
#pragma unroll
        for (int r = 0; r < 4; ++r) { const f32x4* xr = (const f32x4*)(F.out + (size_t)(m0 + r) * D) + F.lane;
#pragma unroll
            for (int j = 0; j < 4; ++j) v[r][j] = xr[64 * j]; }
#pragma unroll
        for (int r = 0; r < 4; ++r) { float s = 0.f; f32x4* xw = (f32x4*)(F.out + (size_t)(m0 + r) * D) + F.lane;
#pragma unroll
            for (int j = 0; j < 4; ++j) s += (v[r][j][0] * v[r][j][0] + v[r][j][1] * v[r][j][1]) + (v[r][j][2] * v[r][j][2] + v[r][j][3] * v[r][j][3]);
            const float rstd = __builtin_amdgcn_rsqf(wave_sum(s) * (1.f / 1024.f) + 1e-6f);
#pragma unroll
            for (int j = 0; j < 4; ++j) xw[64 * j] = v[r][j] * rstd * gv[j]; }
    }
}


#ifndef DUP_PH
#define DUP_PH -1
#endif
#define NREP(n) ((DUP_PH == (n)) ? 2 : 1)
constexpr int PH_PER_LAYER = 6, N_PHASES = 1 + DEPTH * PH_PER_LAYER + 1;
__global__ void __launch_bounds__(512, 2) mk_fwd(Args args) {
    extern __shared__ __attribute__((aligned(16))) unsigned char lds_raw[];
    Frame F;
    F.lds = (LAS unsigned char*)lds_raw; F.tid = threadIdx.x; F.lane = F.tid & 63; F.wave = __builtin_amdgcn_readfirstlane(F.tid >> 6);
    F.G = gridDim.x; F.bid = blockIdx.x; F.in = (const __attribute__((address_space(4))) cfp_t*)__builtin_amdgcn_kernarg_segment_ptr(); F.out = args.out; F.ws = args.ws;
    volatile LAS unsigned* MISC = (volatile LAS unsigned*)(F.lds + LDS_MISC);
    if (F.tid < 64) MISC[F.tid] = 0u;
    __syncthreads();
    unsigned* ctl = (unsigned*)(F.ws + WS_CTL);
    const int lo = args.ph_lo, hi = args.ph_hi;
    const bool multi = (hi - lo) > 1;
    XcdBarrier bar; bar.bar = ctl + CW_BAR; bar.x = 0; bar.st = nullptr;
    if (multi) bar = xcd_barrier_post(ctl + CW_BAR, MISC + 8);
#ifndef PHSEL
#define PHSEL -1
#endif
#ifndef PHMASK
#define PHMASK 0xFFFF
#endif
#define PS(n) ((PHSEL < 0 || PHSEL == (n)) && ((PHMASK >> (n)) & 1))
#define LAUNDER() do { asm volatile("" : "+s"(F.in)); asm volatile("" : "+s"(F.ws)); asm volatile("" : "+s"(F.out)); asm volatile("" : "+v"(F.tid)); asm volatile("" : "+v"(F.lane)); asm volatile("" : "+s"(F.bid)); asm volatile("" : "+s"(F.G)); } while (0)
#define IN(k) (lo <= (k) && (k) < hi)
#define SEAM(k) do { if (IN(k) && IN((k) + 1)) { xcd_barrier(bar); if (DUP_PH == 99) xcd_barrier(bar); } LAUNDER(); } while (0)
    LAUNDER();
    if (PS(0) && IN(0)) { _Pragma("unroll 1") for (int rep = 0; rep < NREP(0); ++rep) p0_prologue(F); }
    SEAM(0);
#pragma unroll 1
    for (int layer = 0; layer < DEPTH; ++layer) {
        const int pb = 1 + layer * PH_PER_LAYER;
        LAUNDER();
        if (PS(1) && IN(pb + 0)) _Pragma("unroll 1") for (int rep = 0; rep < NREP(1); ++rep) {
            ProbIn P; P.K = D; P.A = WSP(bf16_t, WS_XB); P.Bt = WSP(bf16_t, WS_BIN) + (size_t)layer * NIN * D; P.G = F.G; P.c = F.bid;
            P.Pout = WSP(bf16_t, WS_P); P.ss1 = WSP(float, WS_SS1); P.lf = WSP(float, WS_LF); P.bfx = F.in[16] + layer * 4; P.kmax = (unsigned*)(F.ws + WS_CTL) + CW_KMAX + layer * 128;
            pg8::gemm_phase<ProbIn, true>(F.lds, P, F.tid);
        }
        SEAM(pb + 0);
        if (IN(pb + 1)) _Pragma("unroll 1") for (int rep = 0; rep < NREP(2); ++rep) {
            if (PS(4)) {
                __syncthreads();
                { LAS float* PARW = (LAS float*)(F.lds + RG_PAR);
                  for (int i = F.tid; i < 1280; i += 512) { const int a = i >> 8, c = i & 255; PARW[i] = F.in[a == 0 ? 6 : (a == 1 ? 8 : (a == 2 ? 12 : (a == 3 ? 13 : 11)))][layer * 256 + c]; } }
                __syncthreads();
                _Pragma("unroll 1") for (int it = F.bid; it < 1024; it += F.G) { if (F.wave < 4) rw_group_compute(F, layer, it); else rw_group_loader(F, layer, it); }
                __syncthreads();
            }
        }
        if (IN(pb + 1)) {
            unsigned* r1d = (unsigned*)(F.ws + WS_CTL) + CW_R1D + layer * 2048;
            xcd_arrive(bar, r1d);
            bool fxw = false;
            unsigned* sdw = (unsigned*)(F.ws + WS_CTL) + CW_SD + layer * 64;
            if (PS(5)) { if (F.G >= 64) { if (F.bid < 32) { xcd_wait_all(bar, r1d); rw_seq_wg(F, F.bid, sdw); } } else { xcd_wait_all(bar, r1d); for (int i = F.bid; i < 32; i += F.G) rw_seq_wg(F, i, sdw); } }
            unsigned* wq = (unsigned*)(F.ws + WS_CTL) + CW_WQ + layer * 64;
            volatile LAS int* qslot = (volatile LAS int*)(F.lds + LDS_MISC + 64);
            __syncthreads();
            if (F.tid == 0) qslot[0] = (int)xb_add(wq, 1u);
            __syncthreads();
            int q = qslot[0];
#pragma unroll 1
            for (;;) {
                if (q >= 1024 + 256 + 256) break;
                unsigned nq = 0u; if (F.tid == 0) nq = xb_add(wq, 1u);
                LAUNDER();
                if (q < 512) { if (PS(6)) sb_unit(F, (q & 63) >> 2, q & 3, 7 - (q >> 6)); }
                else if (q < 1024) { const int r = q - 512; if (!fxw) { xcd_wait_all(bar, r1d); fxw = true; } if (PS(2)) fx_unit(F, layer, (r & 63) >> 2, r & 3, 7 - (r >> 6)); }
                else if (q < 1280) { if (PS(3)) _Pragma("unroll 1") for (int k = 0; k < 4; ++k) { const int i = 4 * (q - 1024) + k; gm_unit(F, layer, i >> 6, (i >> 2) & 15, i & 3); } }
                else if (PS(7)) {
                    if (F.tid == 0) { unsigned sp = 0; while (xb_ld(sdw) < 32u) { __builtin_amdgcn_s_sleep(2); if (++sp > (1u << 22)) break; }
                        __builtin_amdgcn_fence(__ATOMIC_ACQUIRE, "agent"); asm volatile("s_waitcnt vmcnt(0)" ::: "memory"); }
                    __syncthreads();
                    const int w0 = (q - 1280) * 512 + F.wave;
                    _Pragma("unroll 1") for (int k = 0; k < 8; ++k) rw_post_batch<8>(F, layer, w0 + 64 * k, 8);
                }
                __syncthreads();
                if (F.tid == 0) qslot[0] = (int)nq;
                __syncthreads();
                q = qslot[0];
            }
        }
        SEAM(pb + 1);
        if (PS(8) && IN(pb + 2)) {
            ProbOut P; P.K = D; P.A = WSP(bf16_t, WS_MIX); P.Bt = WSP(bf16_t, WS_BOUT) + (size_t)layer * D * D; P.G = F.G; P.c = F.bid;
            P.base = (layer == 0) ? F.in[0] : F.out; P.out = F.out;
            if (DUP_PH == 8) { P.ascale = 0.f; P.base = F.out; pg8::gemm_phase<ProbOut, true>(F.lds, P, F.tid); P.base = (layer == 0) ? F.in[0] : F.out; }
            P.ascale = 1.f; pg8::gemm_phase<ProbOut, true>(F.lds, P, F.tid);
        }
        SEAM(pb + 2);
        if (PS(9) && IN(pb + 3)) { if (DUP_PH == 9) p4_router(F, layer, true); p4_router(F, layer, false); }
        SEAM(pb + 3);
        if (PS(10) && IN(pb + 4)) {
            moe_tables(F, layer);
            ProbGU P; P.K = D; P.A = WSP(bf16_t, WS_XB); P.Bt = WSP(bf16_t, WS_BGU) + (size_t)layer * NE * 1024 * D; P.G = F.G; P.c = F.bid;
            P.T = (const LAS MoeTab*)(F.lds + LDS_AUX); P.elist = WSP(int, WS_LIST); P.egate = WSP(float, WS_GLIST); P.rstd2 = WSP(float, WS_RSTD2); P.HB = WSP(bf16_t, WS_HB);
            pg8::gemm_phase<ProbGU, true>(F.lds, P, F.tid);
        }
        SEAM(pb + 4);
        if (PS(11) && IN(pb + 5)) {
            moe_tables(F, layer);
            ProbDP P; P.A = WSP(bf16_t, WS_HB); P.Bt = WSP(bf16_t, WS_BDN) + (size_t)layer * NE * D * EH; P.G = F.G; P.c = F.bid;
            P.T = (const LAS MoeTab*)(F.lds + LDS_AUX); P.plist = WSP(u32x2, WS_PLIST); P.x = F.out; P.xb = WSP(bf16_t, WS_XB); P.ss1 = WSP(float, WS_SS1);
            pg8::gemm_phase_pair<ProbDP>(F.lds, P, F.tid);
        }
        SEAM(pb + 5);
    }
    if (PS(13) && IN(N_PHASES - 1)) p_final(F);
#undef IN
#undef SEAM
}

#ifndef MK_ONE_LAUNCH
#define MK_ONE_LAUNCH 1
#endif
extern "C" void kernel_launch(void* const* d_in, const int* in_sizes, int n_in, void* d_out, int out_size, void* d_ws, size_t ws_size, hipStream_t stream) {
    static int grid = 0;
    if (grid == 0) {
        if (n_in != 27 || out_size != NT * D || ws_size < WS_END) { fprintf(stderr, "kernel_launch: unexpected shapes (n_in %d out %d ws %zu)\n", n_in, out_size, ws_size); grid = -1; return; }
        int dev = 0, cus = 0;
        if (hipGetDevice(&dev) != hipSuccess || hipDeviceGetAttribute(&cus, hipDeviceAttributeMultiprocessorCount, dev) != hipSuccess) { grid = -1; return; }
        if (hipFuncSetAttribute((const void*)mk_fwd, hipFuncAttributeMaxDynamicSharedMemorySize, LDS_BYTES) != hipSuccess) { fprintf(stderr, "kernel_launch: hipFuncSetAttribute failed\n"); grid = -1; return; }
        (void)hipGetLastError();
        grid = cus;
    }
    if (grid < 0) return;
    (void)hipMemsetAsync((char*)d_ws + WS_CTL, 0, CTL_BYTES, stream);
    Args a{};
    for (int i = 0; i < 27; ++i) a.in[i] = (const float*)d_in[i];
    a.out = (float*)d_out; a.ws = (unsigned char*)d_ws; a.li = 0; a.pad = 0;
#if MK_ONE_LAUNCH
    a.ph_lo = 0; a.ph_hi = N_PHASES;
    hipLaunchKernelGGL(mk_fwd, dim3(grid), dim3(512), LDS_BYTES, stream, a);
#else
    for (int p = 0; p < N_PHASES; ++p) { a.ph_lo = p; a.ph_hi = p + 1; hipLaunchKernelGGL(mk_fwd, dim3(grid), dim3(512), LDS_BYTES, stream, a); }
#endif
}
```

```cpp
#include <hip/hip_runtime.h>
#include <cstdio>
#include <cstdint>

#define DI __device__ __forceinline__
#define LAS __attribute__((address_space(3)))
#define GAS __attribute__((address_space(1)))
typedef unsigned short bf16_t;
typedef short bf16x8 __attribute__((ext_vector_type(8)));
typedef short s16x4 __attribute__((ext_vector_type(4)));
typedef float f32x2 __attribute__((ext_vector_type(2)));
typedef float f32x4 __attribute__((ext_vector_type(4)));
typedef float f32x16 __attribute__((ext_vector_type(16)));
typedef unsigned u32x2 __attribute__((ext_vector_type(2)));
typedef unsigned u32x4 __attribute__((ext_vector_type(4)));
typedef __bf16 bf16x2_t __attribute__((ext_vector_type(2)));
typedef GAS unsigned gu32;

constexpr int NT = 32768, SEQ = 2048, NB = 16, D = 1024, DEPTH = 4, NH = 4;
constexpr int PP = 3072;
constexpr int NIN = 3328;
constexpr int C_SBQ = 0, C_SBK = 256, C_SBV = 512, C_GMU = 768, C_GMV = 1024, C_RWR = 1280, C_RWK = 1536, C_RWV = 1792, C_RWX = 2048, C_FXQ = 2304, C_FXK = 2560, C_FXV = 2816;
constexpr int NE = 32, EH = 512;
constexpr float LOG2E = 1.4426950408889634f, LN2 = 0.6931471805599453f;
constexpr float QSCALE2 = 0.125f * LOG2E;

constexpr size_t MiB = 1u << 20;
constexpr size_t WS_CTL = 0, CTL_BYTES = 1 * MiB;
constexpr size_t WS_BIN = 1 * MiB;
constexpr size_t WS_BOUT = 28 * MiB;
constexpr size_t WS_BGU = 36 * MiB;
constexpr size_t WS_BDN = 292 * MiB;
constexpr size_t WS_WCAT = 420 * MiB;
constexpr size_t WS_RTW = 421 * MiB;
constexpr size_t WS_SS1 = 422 * MiB;
constexpr size_t WS_RSTD2 = 424 * MiB;
constexpr size_t WS_LF = 425 * MiB;
constexpr size_t WS_SCAL = 426 * MiB;
constexpr size_t WS_LIST = 428 * MiB;
constexpr size_t WS_GLIST = 436 * MiB;
constexpr size_t WS_GBUF = 444 * MiB;
constexpr size_t WS_YBUF = 460 * MiB;
constexpr size_t WS_MIX = 492 * MiB;
constexpr size_t WS_P = 556 * MiB;
constexpr size_t WS_XB = 748 * MiB;
constexpr size_t WS_HB = 812 * MiB;
constexpr size_t WS_REC = 748 * MiB;
constexpr size_t WS_CHMT = 748 * MiB;
constexpr size_t WS_CHN = 780 * MiB;
constexpr size_t WS_CHFR = 812 * MiB;
constexpr size_t WS_CHRY = 877 * MiB;
constexpr size_t WS_CHY0 = 893 * MiB;
constexpr size_t WS_BONV = 909 * MiB;
constexpr size_t WS_PLIST = 940 * MiB;
constexpr size_t WS_END = 968 * MiB;

constexpr int CW_BAR = 4096;
constexpr int CW_CNT = 16384;
constexpr int CW_R1D = 40960;
constexpr int CW_SD = 28672;
constexpr int CW_WQ = 24576;
constexpr int CW_KMAX = 20480;

constexpr int LDS_BYTES = 163840;
constexpr int LDS_AUX = 131072;
constexpr int LDS_MISC = 163840 - 256;

DI float bf2f(unsigned b) { return __uint_as_float(b << 16); }
DI unsigned pk2(float lo, float hi) { f32x2 v = {lo, hi}; bf16x2_t b = __builtin_convertvector(v, bf16x2_t); return __builtin_bit_cast(unsigned, b); }
DI unsigned f2bf(float f) { return pk2(f, 0.f) & 0xffffu; }
DI float ex2(float x) { return __builtin_amdgcn_exp2f(x); }
DI float lg2(float x) { return __builtin_amdgcn_logf(x); }
DI float rcpf_(float x) { return __builtin_amdgcn_rcpf(x); }
DI float sigmoidf_(float x) { return rcpf_(1.f + ex2(-x * LOG2E)); }
DI float tanhf_(float x) { return 1.f - 2.f * rcpf_(1.f + ex2(2.f * LOG2E * x)); }
DI float geluf_(float x) { const float u = 0.7978845608028654f * (x + 0.044715f * x * x * x); return x * rcpf_(1.f + ex2(-2.f * LOG2E * u)); }
DI float softplusf_(float x) { return fmaxf(x, 0.f) + LN2 * lg2(1.f + ex2(-fabsf(x) * LOG2E)); }
template <int CTRL, int RMASK, bool BC> DI float dppf(float x) { return __builtin_bit_cast(float, __builtin_amdgcn_update_dpp(0, __builtin_bit_cast(int, x), CTRL, RMASK, 0xf, BC)); }
DI float wave_sum(float v) {
    v += dppf<0xB1, 0xf, true>(v); v += dppf<0x4E, 0xf, true>(v); v += dppf<0x141, 0xf, true>(v); v += dppf<0x140, 0xf, true>(v);
    v += dppf<0x142, 0xa, false>(v); v += dppf<0x143, 0xc, false>(v);
    return __builtin_bit_cast(float, __builtin_amdgcn_readlane(__builtin_bit_cast(int, v), 63));
}
DI float swap32(float v) { return __shfl_xor(v, 32); }
#define MFMA32(a, b, c) __builtin_amdgcn_mfma_f32_32x32x16_bf16((a), (b), (c), 0, 0, 0)
DI int crow(int r, int h) { return (r & 3) + 8 * (r >> 2) + 4 * h; }

#define XB_TMO      128
#define XB_XCNT(j)  (256  + 64 * (j))
#define XB_XSUB(j)  (1280 + 64 * (j))
#define XB_XGEN(j)  (2304 + 64 * (j))
#define XB_TOP      3328
#define XB_TOPGEN   3392
#define XCD_BAR_WORDS 3456
#define XB_SPIN_CAP (1u << 18)
DI unsigned xb_ld(unsigned* p)              { return __hip_atomic_load(p, __ATOMIC_RELAXED, __HIP_MEMORY_SCOPE_AGENT); }
DI unsigned xb_add(unsigned* p, unsigned v) { return __hip_atomic_fetch_add(p, v, __ATOMIC_RELAXED, __HIP_MEMORY_SCOPE_AGENT); }
DI unsigned xb_xcc_id() { return (unsigned)__builtin_amdgcn_s_getreg((3 << 11) | 20) & 0xFu; }
#define XB_SPIN(cond, bar) do { unsigned _sp = 0; while (cond) { __builtin_amdgcn_s_sleep(1); \
    if ((++_sp & 255u) == 0u) { if (xb_ld(&(bar)[XB_TMO])) break; if (_sp > XB_SPIN_CAP) { atomicAdd(&(bar)[XB_TMO], 1u); break; } } } } while (0)
struct XcdBarrier { unsigned* bar; unsigned x; volatile LAS unsigned* st; };
DI XcdBarrier xcd_barrier_post(unsigned* bar, volatile LAS unsigned* st) {
    XcdBarrier b; b.bar = bar; b.x = xb_xcc_id(); b.st = st;
    if (threadIdx.x == 0) (void)xb_add(&bar[XB_XCNT(b.x)], 1u);
    return b;
}
DI void xcd_barrier_complete(unsigned* bar, unsigned x, unsigned& nloc, unsigned& nx) {
    const unsigned G = gridDim.x * gridDim.y * gridDim.z;
    unsigned sum, cnt, mine, sp = 0u;
    for (;;) {
        sum = 0u; cnt = 0u; mine = 0u;
#pragma unroll
        for (unsigned j = 0; j < 16; ++j) { const unsigned c = xb_ld(&bar[XB_XCNT(j)]); sum += c; cnt += (c > 0u) ? 1u : 0u; mine = (j == x) ? c : mine; }
        if (sum == G) break;
        __builtin_amdgcn_s_sleep(1);
        if ((++sp & 255u) == 0u) { if (xb_ld(&bar[XB_TMO])) break; if (sp > XB_SPIN_CAP) { atomicAdd(&bar[XB_TMO], 1u); break; } }
    }
    nloc = mine > 0u ? mine : 1u; nx = cnt > 0u ? cnt : 1u;
}
DI void xcd_barrier(const XcdBarrier& b) {
    asm volatile("s_waitcnt vmcnt(0)" ::: "memory");
    __syncthreads();
    if (threadIdx.x == 0) {
        unsigned* bar = b.bar;
        __builtin_amdgcn_s_waitcnt(0);
        unsigned nloc = b.st[0], nx = b.st[1];
        if (nloc == 0u) { xcd_barrier_complete(bar, b.x, nloc, nx); b.st[0] = nloc; b.st[1] = nx; }
        const unsigned old = xb_add(&bar[XB_XSUB(b.x)], 1u);
        const unsigned gen = old / nloc;
        if (old + 1u == (gen + 1u) * nloc) {
            __builtin_amdgcn_fence(__ATOMIC_RELEASE, "agent");
            asm volatile("s_waitcnt vmcnt(0)" ::: "memory");
            const unsigned og = xb_add(&bar[XB_TOP], 1u);
            const unsigned tg = og / nx;
            if (og + 1u == (tg + 1u) * nx) xb_add(&bar[XB_TOPGEN], 1u);
            else XB_SPIN(xb_ld(&bar[XB_TOPGEN]) == tg, bar);
            __builtin_amdgcn_fence(__ATOMIC_ACQUIRE, "agent");
            xb_add(&bar[XB_XGEN(b.x)], 1u);
            asm volatile("s_waitcnt vmcnt(0)" ::: "memory");
        } else {
            XB_SPIN(xb_ld(&bar[XB_XGEN(b.x)]) == gen, bar);
            __builtin_amdgcn_fence(__ATOMIC_ACQUIRE, "agent");
            asm volatile("s_waitcnt vmcnt(0)" ::: "memory");
        }
    }
    __syncthreads();
}

DI void xcd_arrive(const XcdBarrier& b, unsigned* w) {
    asm volatile("s_waitcnt vmcnt(0)" ::: "memory");
    __syncthreads();
    if (threadIdx.x == 0) {
        const unsigned nloc = b.st[0];
        const unsigned old = xb_add(&w[64 * b.x], 1u);
        if (old + 1u == nloc) { __builtin_amdgcn_fence(__ATOMIC_RELEASE, "agent"); asm volatile("s_waitcnt vmcnt(0)" ::: "memory"); (void)xb_add(&w[64 * 16], 1u); }
    }
}
DI void xcd_wait_all(const XcdBarrier& b, unsigned* w) {
    if (threadIdx.x == 0) { const unsigned nx = b.st[1]; unsigned sp = 0; while (xb_ld(&w[64 * 16]) < nx) { __builtin_amdgcn_s_sleep(1); if (++sp > (1u << 22)) break; }
        __builtin_amdgcn_fence(__ATOMIC_ACQUIRE, "agent"); asm volatile("s_waitcnt vmcnt(0)" ::: "memory"); }
    __syncthreads();
}

typedef const float* cfp_t;
struct Args { const float* in[27]; float* out; unsigned char* ws; int ph_lo, ph_hi, li, pad; };
struct Frame {
    LAS unsigned char* lds;
    int tid, lane, wave, G, bid;
    const __attribute__((address_space(4))) cfp_t* in;
    float* out; unsigned char* ws;
};
#define WSP(T, off) ((T*)(F.ws + (off)))

namespace pg8 {
constexpr int BM = 256, BK = 64, HALF = 128, HTB = HALF * BK * 2, STAGE_BYTES = 8 * HTB, NXCD = 8, WGM = 8;
DI int lds_byte(int r, int c) { const int st = (r >> 4) * 2 + (c >> 5), rr = r & 15, cc = c & 31, ob = rr * 64 + cc * 2; return st * 1024 + (ob ^ (((ob >> 9) & 1) << 5)); }
DI void stage_rc(int b, int& R, int& C) { const int st = b / 1024, sb = b % 1024, swz = sb ^ (((sb >> 9) & 1) << 5); R = (st >> 1) * 16 + swz / 64; C = (st & 1) * 32 + (swz % 64) / 2; }
DI int perm32(int rho) { const int n = rho >> 4, i = rho & 15; return 8 * (i >> 2) + 4 * n + (i & 3); }
struct Unit { int pm, pn, e, cnt, base, aux; };
DI bool static_next(int nM, int nN, int G, int c, int i, Unit& u) {
    const int nwg = nM * nN; const long L = (long)i * G + c; if (L >= nwg) return false;
    int wgid = (int)L; { const int q = nwg / NXCD, r = nwg % NXCD, xcd = wgid % NXCD, off = wgid / NXCD; wgid = (xcd < r ? xcd * (q + 1) : r * (q + 1) + (xcd - r) * q) + off; }
    const int nig = WGM * nN, gid = wgid / nig, fm = gid * WGM, gsz = (nM - fm) < WGM ? (nM - fm) : WGM;
    u.pm = fm + ((wgid % nig) % gsz); u.pn = (wgid % nig) / gsz; u.e = 0; u.cnt = 0; u.base = 0; u.aux = 0; return true;
}

template <class Prob, bool ALIGN_EPI>
DI void gemm_phase(LAS unsigned char* lds, const Prob& P, const int tid) {
    const int wid = __builtin_amdgcn_readfirstlane(tid >> 6), lane = tid & 63, wr = wid >> 2, wc = wid & 3, fr = lane & 15, fq = lane >> 4;
    const int K = P.K, nt = K / BK;
    constexpr bool GA = Prob::GATHER;
    unsigned voffB[2], voffA[2];
#pragma unroll
    for (int i = 0; i < 2; ++i) { int R, C; stage_rc(tid * 16 + i * 8192, R, C); const int Rb = Prob::PERM ? ((R & ~31) + perm32(R & 31)) : R; voffB[i] = (unsigned)(Rb * K + C) * 2u; voffA[i] = (unsigned)(R * K + C) * 2u; }
    const size_t kstep = (size_t)(BK * 2);
    const size_t hstepB = (size_t)HALF * K * 2;
    const unsigned ldsw = (unsigned)wid * 1024u;
    const int aoffL = lds_byte(wr * 64 + fr, fq * 8), boffL = lds_byte(wc * 32 + fr, fq * 8);
    const char* Abase = (const char*)P.A;
#define PG8_SA(b, h) (((b) * 2 + (h)) * HTB)
#define PG8_SB(b, h) ((4 + (b) * 2 + (h)) * HTB)
#define PG8_STG_B(bufoff, gbase) do { _Pragma("unroll") for (int _i = 0; _i < 2; ++_i) \
        __builtin_amdgcn_global_load_lds((const unsigned*)((const char*)(gbase) + voffB[_i]), (LAS unsigned*)(lds + (bufoff) + ldsw + _i * 8192), 16, 0, 0); } while (0)
#define PG8_STG_A(bufoff, h, kbyte) do { _Pragma("unroll") for (int _i = 0; _i < 2; ++_i) { \
        const char* _p; if constexpr (GA) _p = Abase + (size_t)(kbyte) + aoff[h][_i]; else _p = cA + (size_t)(h) * hstepB + (size_t)(kbyte) + voffA[_i]; \
        __builtin_amdgcn_global_load_lds((const unsigned*)_p, (LAS unsigned*)(lds + (bufoff) + ldsw + _i * 8192), 16, 0, 0); } } while (0)
#define PG8_LDA(dst, b, h) do { _Pragma("unroll") for (int m = 0; m < 4; ++m) _Pragma("unroll") for (int k = 0; k < 2; ++k) dst[m][k] = *(const LAS bf16x8*)(lds + PG8_SA(b, h) + aoffL + m * 2048 + k * 1024); } while (0)
#define PG8_LDB(dst, b, h) do { _Pragma("unroll") for (int n = 0; n < 2; ++n) _Pragma("unroll") for (int k = 0; k < 2; ++k) dst[n][k] = *(const LAS bf16x8*)(lds + PG8_SB(b, h) + boffL + n * 2048 + k * 1024); } while (0)
#define PG8_MMA(ai, bj, At, Bt) do { __builtin_amdgcn_s_setprio(1); _Pragma("unroll") for (int m = 0; m < 4; ++m) _Pragma("unroll") for (int n = 0; n < 2; ++n) _Pragma("unroll") for (int k = 0; k < 2; ++k) \
        acc[ai][bj][m][n] = __builtin_amdgcn_mfma_f32_16x16x32_bf16(Bt[n][k], At[m][k], acc[ai][bj][m][n], 0, 0, 0); __builtin_amdgcn_s_setprio(0); } while (0)
#define PG8_WAIT_V(n) asm volatile("s_waitcnt vmcnt(" #n ")" ::: "memory")
#define PG8_WAIT_L(n) asm volatile("s_waitcnt lgkmcnt(" #n ")" ::: "memory")
#define PG8_BAR __builtin_amdgcn_s_barrier()
#define PG8_SCHED __builtin_amdgcn_sched_barrier(0)
    Unit cur, nxt; int ui = 0;
    if (!P.next(0, cur)) return;
    f32x4 acc[2][2][4][2];
#pragma unroll
    for (int a = 0; a < 2; ++a)
#pragma unroll
        for (int b = 0; b < 2; ++b)
#pragma unroll
            for (int m = 0; m < 4; ++m)
#pragma unroll
                for (int n = 0; n < 2; ++n) acc[a][b][m][n] = (f32x4){0.f, 0.f, 0.f, 0.f};
    bf16x8 At[4][2], B0[2][2], B1[2][2];
    unsigned aoff[2][2] = {{0u, 0u}, {0u, 0u}}, noff[2][2] = {{0u, 0u}, {0u, 0u}};
    const char* cA = Abase; const char* nA = Abase;
    if constexpr (GA) P.aoffs(cur, tid, aoff); else cA = Abase + (size_t)P.arow0(cur) * K * 2;
    const char* cB = P.bbase(cur);
    PG8_STG_B(PG8_SB(0, 0), cB); PG8_STG_B(PG8_SB(0, 1), cB + hstepB); PG8_STG_A(PG8_SA(0, 0), 0, 0); PG8_STG_A(PG8_SA(0, 1), 1, 0);
    if (wr == 1) PG8_BAR;
    PG8_WAIT_V(2); PG8_BAR;
    PG8_STG_B(PG8_SB(1, 0), cB + kstep); PG8_STG_A(PG8_SA(1, 0), 0, kstep); PG8_STG_B(PG8_SB(1, 1), cB + hstepB + kstep);
    PG8_WAIT_V(6); PG8_BAR;
    for (;;) {
        const bool has_next = P.next(ui + 1, nxt);
        const char* nB = cB; nA = cA;
        if (has_next) { nB = P.bbase(nxt); if constexpr (GA) P.aoffs(nxt, tid, noff); else nA = Abase + (size_t)P.arow0(nxt) * K * 2; }
        else if constexpr (GA) { noff[0][0] = aoff[0][0]; noff[0][1] = aoff[0][1]; noff[1][0] = aoff[1][0]; noff[1][1] = aoff[1][1]; }
        if constexpr (GA) { *(LAS u32x4*)(lds + LDS_AUX + 2048 + tid * 16) = (u32x4){noff[0][0], noff[0][1], noff[1][0], noff[1][1]}; }
        for (int t = 0; t < nt; t += 2) {
            const bool last = (t == nt - 2);
            const size_t k1 = (size_t)(t + 1) * kstep;
            const size_t k2 = last ? (size_t)0 : (size_t)(t + 2) * kstep, k3 = k2 + kstep;
            const char* b2 = last ? nB : cB + (size_t)(t + 2) * kstep; const char* b3 = b2 + kstep;
            PG8_LDB(B0, 0, 0); PG8_LDB(B1, 0, 1); PG8_SCHED; PG8_LDA(At, 0, 0); PG8_STG_A(PG8_SA(1, 1), 1, k1);
            PG8_WAIT_V(8); PG8_WAIT_L(0); PG8_BAR; PG8_MMA(0, 0, At, B0); PG8_MMA(0, 1, At, B1); PG8_BAR; PG8_SCHED;
            if (last) { if constexpr (GA) { const u32x4 nq = *(const LAS u32x4*)(lds + LDS_AUX + 2048 + tid * 16); aoff[0][0] = nq[0]; aoff[0][1] = nq[1]; aoff[1][0] = nq[2]; aoff[1][1] = nq[3]; } else cA = nA; }
            PG8_LDA(At, 0, 1); PG8_STG_B(PG8_SB(0, 0), b2); PG8_STG_B(PG8_SB(0, 1), b2 + hstepB); PG8_STG_A(PG8_SA(0, 0), 0, k2);
            PG8_WAIT_V(8); PG8_WAIT_L(0); PG8_BAR; PG8_MMA(1, 0, At, B0); PG8_MMA(1, 1, At, B1); PG8_BAR; PG8_SCHED;
            PG8_LDB(B0, 1, 0); PG8_LDB(B1, 1, 1); PG8_SCHED; PG8_LDA(At, 1, 0); PG8_STG_A(PG8_SA(0, 1), 1, k2);
            PG8_WAIT_V(8); PG8_WAIT_L(0); PG8_BAR; PG8_MMA(0, 0, At, B0); PG8_MMA(0, 1, At, B1); PG8_BAR; PG8_SCHED;
            PG8_LDA(At, 1, 1); PG8_STG_B(PG8_SB(1, 0), b3); PG8_STG_B(PG8_SB(1, 1), b3 + hstepB); PG8_STG_A(PG8_SA(1, 0), 0, k3);
            PG8_WAIT_V(8); PG8_WAIT_L(0); PG8_BAR; PG8_MMA(1, 0, At, B0); PG8_MMA(1, 1, At, B1); PG8_BAR; PG8_SCHED;
        }
        if constexpr (ALIGN_EPI) { if (wr == 0) PG8_BAR; }
        P.epi(acc, cur, wr, wc, fr, fq);
        if (!has_next) break;
#pragma unroll
        for (int a = 0; a < 2; ++a)
#pragma unroll
            for (int b = 0; b < 2; ++b)
#pragma unroll
                for (int m = 0; m < 4; ++m)
#pragma unroll
                    for (int n = 0; n < 2; ++n) acc[a][b][m][n] = (f32x4){0.f, 0.f, 0.f, 0.f};
        cur = nxt; cB = nB; ++ui;
        if constexpr (ALIGN_EPI) { if (wr == 1) PG8_BAR; }
    }
    PG8_WAIT_V(0);
    if constexpr (!ALIGN_EPI) { if (wr == 0) PG8_BAR; }
    PG8_BAR;
#undef PG8_SA
#undef PG8_SB
#undef PG8_STG_A
#undef PG8_STG_B
#undef PG8_LDA
#undef PG8_LDB
#undef PG8_MMA
#undef PG8_WAIT_V
#undef PG8_WAIT_L
#undef PG8_BAR
#undef PG8_SCHED
}

template <class Prob>
DI void gemm_phase_pair(LAS unsigned char* lds, const Prob& P, const int tid) {
    const int wid = __builtin_amdgcn_readfirstlane(tid >> 6), lane = tid & 63, wr = wid >> 2, wc = wid & 3, fr = lane & 15, fq = lane >> 4;
    constexpr int KP = 512, nt = 16;
    unsigned voffB[2];
#pragma unroll
    for (int i = 0; i < 2; ++i) { int R, C; stage_rc(tid * 16 + i * 8192, R, C); const int Rb = Prob::PERM ? ((R & ~31) + perm32(R & 31)) : R; voffB[i] = (unsigned)(Rb * KP + C) * 2u; }
    const size_t kstep = (size_t)(BK * 2);
    const size_t hstepB = (size_t)HALF * KP * 2;
    const unsigned ldsw = (unsigned)wid * 1024u;
    const int aoffL = lds_byte(wr * 64 + fr, fq * 8), boffL = lds_byte(wc * 32 + fr, fq * 8);
    const char* Abase = (const char*)P.A;
    LAS unsigned char* park = lds + LDS_AUX + 2048 + tid * 48;
#define PG8_SA(b, h) (((b) * 2 + (h)) * HTB)
#define PG8_SB(b, h) ((4 + (b) * 2 + (h)) * HTB)
#define PG8_STG_B(bufoff, gbase) do { _Pragma("unroll") for (int _i = 0; _i < 2; ++_i) \
        __builtin_amdgcn_global_load_lds((const unsigned*)((const char*)(gbase) + voffB[_i]), (LAS unsigned*)(lds + (bufoff) + ldsw + _i * 8192), 16, 0, 0); } while (0)
#define PG8_STG_A(bufoff, h, kbyte) do { _Pragma("unroll") for (int _i = 0; _i < 2; ++_i) \
        __builtin_amdgcn_global_load_lds((const unsigned*)(Abase + (size_t)(kbyte) + aoff[h][_i]), (LAS unsigned*)(lds + (bufoff) + ldsw + _i * 8192), 16, 0, 0); } while (0)
#define PG8_LDA(dst, b, h) do { _Pragma("unroll") for (int m = 0; m < 4; ++m) _Pragma("unroll") for (int k = 0; k < 2; ++k) dst[m][k] = *(const LAS bf16x8*)(lds + PG8_SA(b, h) + aoffL + m * 2048 + k * 1024); } while (0)
#define PG8_LDB(dst, b, h) do { _Pragma("unroll") for (int n = 0; n < 2; ++n) _Pragma("unroll") for (int k = 0; k < 2; ++k) dst[n][k] = *(const LAS bf16x8*)(lds + PG8_SB(b, h) + boffL + n * 2048 + k * 1024); } while (0)
#define PG8_MMA(ai, bj, At, Bt) do { __builtin_amdgcn_s_setprio(1); _Pragma("unroll") for (int m = 0; m < 4; ++m) _Pragma("unroll") for (int n = 0; n < 2; ++n) _Pragma("unroll") for (int k = 0; k < 2; ++k) \
        acc[ai][bj][m][n] = __builtin_amdgcn_mfma_f32_16x16x32_bf16(Bt[n][k], At[m][k], acc[ai][bj][m][n], 0, 0, 0); __builtin_amdgcn_s_setprio(0); } while (0)
#define PG8_WAIT_V(n) asm volatile("s_waitcnt vmcnt(" #n ")" ::: "memory")
#define PG8_WAIT_L(n) asm volatile("s_waitcnt lgkmcnt(" #n ")" ::: "memory")
#define PG8_BAR __builtin_amdgcn_s_barrier()
#define PG8_SCHED __builtin_amdgcn_sched_barrier(0)
#define PG8_PARK(slot, v) (*(LAS u32x4*)(park + 16 * (slot)) = (u32x4){v[0][0], v[0][1], v[1][0], v[1][1]})
#define PG8_UNPARK(slot) do { const u32x4 _q = *(const LAS u32x4*)(park + 16 * (slot)); aoff[0][0] = _q[0]; aoff[0][1] = _q[1]; aoff[1][0] = _q[2]; aoff[1][1] = _q[3]; } while (0)
    Unit cur, nxt; int ui = 0;
    if (!P.next(0, cur)) return;
    f32x4 acc[2][2][4][2];
#pragma unroll
    for (int a = 0; a < 2; ++a)
#pragma unroll
        for (int b = 0; b < 2; ++b)
#pragma unroll
            for (int m = 0; m < 4; ++m)
#pragma unroll
                for (int n = 0; n < 2; ++n) acc[a][b][m][n] = (f32x4){0.f, 0.f, 0.f, 0.f};
    bf16x8 At[4][2], B0[2][2], B1[2][2];
    unsigned aoff[2][2];
    { unsigned tb[2][2]; P.aoffs2(cur, tid, aoff, tb); PG8_PARK(0, tb); }
    const char* cBa = P.bbase_a(cur); const char* cBb = P.bbase_b(cur);
    PG8_STG_B(PG8_SB(0, 0), cBa); PG8_STG_B(PG8_SB(0, 1), cBa + hstepB); PG8_STG_A(PG8_SA(0, 0), 0, 0); PG8_STG_A(PG8_SA(0, 1), 1, 0);
    if (wr == 1) PG8_BAR;
    PG8_WAIT_V(2); PG8_BAR;
    PG8_STG_B(PG8_SB(1, 0), cBa + kstep); PG8_STG_A(PG8_SA(1, 0), 0, kstep); PG8_STG_B(PG8_SB(1, 1), cBa + hstepB + kstep);
    PG8_WAIT_V(6); PG8_BAR;
    for (;;) {
        const bool has_next = P.next(ui + 1, nxt);
        const char* nBa = cBa; const char* nBb = cBb;
        {
            unsigned ta[2][2], tb[2][2];
            if (has_next) { P.aoffs2(nxt, tid, ta, tb); nBa = P.bbase_a(nxt); nBb = P.bbase_b(nxt); } else P.aoffs2(cur, tid, ta, tb);
            PG8_PARK(2, ta); PG8_PARK((ui + 1) & 1, tb);
        }
        const bool hu = (cur.cnt - cur.pm * 256) <= 128;
        for (int t = 0; t < nt; t += 2) {
            const bool last = (t == nt - 2);
            const size_t k1 = (size_t)((t + 1) & 7) * kstep;
            const int t2 = last ? 0 : t + 2;
            const size_t k2 = (size_t)(t2 & 7) * kstep, k3 = k2 + kstep;
            const char* b2 = last ? nBa : ((t2 < 8 ? cBa : cBb) + k2); const char* b3 = b2 + kstep;
            PG8_LDB(B0, 0, 0); PG8_LDB(B1, 0, 1); PG8_SCHED; PG8_LDA(At, 0, 0); PG8_STG_A(PG8_SA(1, 1), 1, k1);
            PG8_WAIT_V(8); PG8_WAIT_L(0); PG8_BAR; PG8_MMA(0, 0, At, B0); PG8_MMA(0, 1, At, B1); PG8_BAR; PG8_SCHED;
            if (t == 6) PG8_UNPARK(ui & 1);
            if (last) PG8_UNPARK(2);
            PG8_LDA(At, 0, 1); PG8_STG_B(PG8_SB(0, 0), b2); PG8_STG_B(PG8_SB(0, 1), b2 + hstepB); PG8_STG_A(PG8_SA(0, 0), 0, k2);
            PG8_WAIT_V(8); PG8_WAIT_L(0); PG8_BAR; if (!hu) { PG8_MMA(1, 0, At, B0); PG8_MMA(1, 1, At, B1); } PG8_BAR; PG8_SCHED;
            PG8_LDB(B0, 1, 0); PG8_LDB(B1, 1, 1); PG8_SCHED; PG8_LDA(At, 1, 0); PG8_STG_A(PG8_SA(0, 1), 1, k2);
            PG8_WAIT_V(8); PG8_WAIT_L(0); PG8_BAR; PG8_MMA(0, 0, At, B0); PG8_MMA(0, 1, At, B1); PG8_BAR; PG8_SCHED;
            PG8_LDA(At, 1, 1); PG8_STG_B(PG8_SB(1, 0), b3); PG8_STG_B(PG8_SB(1, 1), b3 + hstepB); PG8_STG_A(PG8_SA(1, 0), 0, k3);
            PG8_WAIT_V(8); PG8_WAIT_L(0); PG8_BAR; if (!hu) { PG8_MMA(1, 0, At, B0); PG8_MMA(1, 1, At, B1); } PG8_BAR; PG8_SCHED;
        }
        if (wr == 0) PG8_BAR;
        P.epi(acc, cur, wr, wc, fr, fq);
        if (!has_next) break;
#pragma unroll
        for (int a = 0; a < 2; ++a)
#pragma unroll
            for (int b = 0; b < 2; ++b)
#pragma unroll
                for (int m = 0; m < 4; ++m)
#pragma unroll
                    for (int n = 0; n < 2; ++n) acc[a][b][m][n] = (f32x4){0.f, 0.f, 0.f, 0.f};
        cur = nxt; cBa = nBa; cBb = nBb; ++ui;
        if (wr == 1) PG8_BAR;
    }
    PG8_WAIT_V(0);
    PG8_BAR;
#undef PG8_SA
#undef PG8_SB
#undef PG8_STG_A
#undef PG8_STG_B
#undef PG8_LDA
#undef PG8_LDB
#undef PG8_MMA
#undef PG8_WAIT_V
#undef PG8_WAIT_L
#undef PG8_BAR
#undef PG8_SCHED
#undef PG8_PARK
#undef PG8_UNPARK
}
}
using pg8::Unit;


struct MoeTab { int ce[32], sb[32], tpg[33], cp[112], tpf[113], tph[113]; };
constexpr int LCAP = 32768;
DI int pair_lo(int p) { int i = 0; _Pragma("unroll") for (int k = 1; k < 7; ++k) if (p >= k * (15 - k) / 2) i = k; return i; }
DI int pair_hi(int p, int i) { return p - i * (15 - i) / 2 + i + 1; }

struct ProbIn {
    static constexpr bool PERM = true, GATHER = false;
    int K; const bf16_t* A; const bf16_t* Bt; int G, c;
    bf16_t* Pout; const float* ss1; float* lf; const float* bfx; unsigned* kmax;
    DI bool next(int i, Unit& u) const { return pg8::static_next(128, 12, G, c, i, u); }
    DI int arow0(const Unit& u) const { return u.pm * 256; }
    DI const char* bbase(const Unit& u) const { return (const char*)Bt + (size_t)u.pn * 256 * K * 2; }
    DI void epi(const f32x4 (&acc)[2][2][4][2], const Unit& u, int wr, int wc, int fr, int fq) const {
        float km0 = 0.f, km1 = 0.f;
        float rs[8];
#pragma unroll
        for (int hb_ = 0; hb_ < 4; ++hb_) {
            f32x4 sv[2][4];
#pragma unroll
            for (int m = 0; m < 2; ++m) { const int g = hb_ * 2 + m; const f32x4* sp = (const f32x4*)(ss1 + (size_t)(u.pm * 256 + (g >> 2) * 128 + wr * 64 + (g & 3) * 16 + fr) * 16);
#pragma unroll
                for (int k = 0; k < 4; ++k) sv[m][k] = sp[k]; }
#pragma unroll
            for (int m = 0; m < 2; ++m) { float ss = 0.f;
#pragma unroll
                for (int k = 0; k < 4; ++k) ss += (sv[m][k][0] + sv[m][k][1]) + (sv[m][k][2] + sv[m][k][3]);
                rs[hb_ * 2 + m] = __builtin_amdgcn_rsqf(ss * (1.f / 1024.f) + 1e-6f); }
            asm volatile("" : "+v"(rs[hb_ * 2]), "+v"(rs[hb_ * 2 + 1]));
        }
#pragma unroll
        for (int ai = 0; ai < 2; ++ai)
#pragma unroll
            for (int m = 0; m < 4; ++m) {
                const int row = u.pm * 256 + ai * 128 + wr * 64 + m * 16 + fr;
                const float rstd = rs[ai * 4 + m];
                {
                    bf16_t* rowp = Pout + (size_t)row * PP + u.pn * 256 + wc * 32 + 8 * fq;
#pragma unroll
                    for (int bj = 0; bj < 2; ++bj) { const f32x4 v0 = acc[ai][bj][m][0] * rstd, v1 = acc[ai][bj][m][1] * rstd;
                        u32x4 w; w.x = pk2(v0[0], v0[1]); w.y = pk2(v0[2], v0[3]); w.z = pk2(v1[0], v1[1]); w.w = pk2(v1[2], v1[3]);
                        *(u32x4*)(rowp + bj * 128) = w; }
                    if (u.pn == 10) {
#pragma unroll
                        for (int bj = 0; bj < 2; ++bj) { const f32x4 v0 = acc[ai][bj][m][0] * rstd, v1 = acc[ai][bj][m][1] * rstd;
                            float p = ((v0[0] * v0[0] + v0[1] * v0[1]) + (v0[2] * v0[2] + v0[3] * v0[3])) + ((v1[0] * v1[0] + v1[1] * v1[1]) + (v1[2] * v1[2] + v1[3] * v1[3]));
                            p += __shfl_xor(p, 16); p += __shfl_xor(p, 32);
                            if (bj == 0) km0 = fmaxf(km0, p); else km1 = fmaxf(km1, p); }
                    }
                }
            }
        if (u.pn == 10) {
#pragma unroll
            for (int o = 1; o < 16; o <<= 1) { km0 = fmaxf(km0, __shfl_xor(km0, o)); km1 = fmaxf(km1, __shfl_xor(km1, o)); }
            if (fr == 0 && fq == 0) { const int b = (u.pm * 256) >> 11;
                __hip_atomic_fetch_max(kmax + ((b * 4 + 0 + (wc >> 1)) * 2 + (wc & 1)), __float_as_uint(km0), __ATOMIC_RELAXED, __HIP_MEMORY_SCOPE_AGENT);
                __hip_atomic_fetch_max(kmax + ((b * 4 + 2 + (wc >> 1)) * 2 + (wc & 1)), __float_as_uint(km1), __ATOMIC_RELAXED, __HIP_MEMORY_SCOPE_AGENT); }
        }
    }
};

struct ProbOut {
    static constexpr bool PERM = false, GATHER = false;
    int K; const bf16_t* A; const bf16_t* Bt; int G, c;
    const float* base; float* out; float ascale;
    DI bool next(int i, Unit& u) const { return pg8::static_next(128, 4, G, c, i, u); }
    DI int arow0(const Unit& u) const { return u.pm * 256; }
    DI const char* bbase(const Unit& u) const { return (const char*)Bt + (size_t)u.pn * 256 * K * 2; }
    DI void epi(const f32x4 (&acc)[2][2][4][2], const Unit& u, int wr, int wc, int fr, int fq) const {
#pragma unroll
        for (int ai = 0; ai < 2; ++ai)
#pragma unroll
            for (int mp = 0; mp < 2; ++mp) {
                f32x4 bv[2][2][2]; size_t offs[2];
#pragma unroll
                for (int mm = 0; mm < 2; ++mm) { const int m = 2 * mp + mm; offs[mm] = (size_t)(u.pm * 256 + ai * 128 + wr * 64 + m * 16 + fr) * D + u.pn * 256 + wc * 32 + 4 * fq;
#pragma unroll
                    for (int bj = 0; bj < 2; ++bj)
#pragma unroll
                        for (int n = 0; n < 2; ++n) bv[mm][bj][n] = *(const f32x4*)(base + offs[mm] + bj * 128 + n * 16); }
#pragma unroll
                for (int mm = 0; mm < 2; ++mm) { const int m = 2 * mp + mm;
#pragma unroll
                    for (int bj = 0; bj < 2; ++bj)
#pragma unroll
                        for (int n = 0; n < 2; ++n) *(f32x4*)(out + offs[mm] + bj * 128 + n * 16) = bv[mm][bj][n] + acc[ai][bj][m][n] * ascale; }
                asm volatile("" ::: "memory");
            }
    }
};

DI int moe_L(int i, int G, int c) {
    if ((G & 31) != 0) return i * G + c;
    const int x = c & 7, j = c >> 3, per = G >> 5;
    return ((i * (G >> 2) + x * per + (j >> 2)) << 2) + (j & 3);
}
template <int NL> DI bool moe_unit(const LAS int* tp, int L, Unit& u) {
    const int tt = L >> 2; if (tt >= tp[NL]) return false;
    int e = 0;
#pragma unroll 1
    while (tp[e + 1] <= tt) ++e;
    u.e = e; u.pm = tt - tp[e]; u.pn = L & 3; return true;
}

struct ProbGU {
    static constexpr bool PERM = true, GATHER = true;
    int K; const bf16_t* A; const bf16_t* Bt; int G, c;
    const LAS MoeTab* T; const int* elist; const float* egate; const float* rstd2; bf16_t* HB;
    DI bool next(int i, Unit& u) const {
        if (!moe_unit<32>(T->tpg, moe_L(i, G, c), u)) return false;
        u.cnt = T->ce[u.e]; u.base = T->sb[u.e]; return true;
    }
    DI int tok_of(const Unit& u, int r) const { return (r < u.cnt) ? elist[(size_t)u.e * LCAP + r] : 0; }
    DI void aoffs(const Unit& u, int tid, unsigned (&o)[2][2]) const {
        int Rr[2], Cc[2]; pg8::stage_rc(tid * 16, Rr[0], Cc[0]); pg8::stage_rc(tid * 16 + 8192, Rr[1], Cc[1]);
#pragma unroll
        for (int h = 0; h < 2; ++h)
#pragma unroll
            for (int i = 0; i < 2; ++i) { const int tok = tok_of(u, u.pm * 256 + h * 128 + Rr[i]); o[h][i] = (unsigned)((tok * K + Cc[i]) * 2); }
    }
    DI const char* bbase(const Unit& u) const { return (const char*)Bt + ((size_t)u.e * 1024 + u.pn * 256) * K * 2; }
    DI void epi(const f32x4 (&acc)[2][2][4][2], const Unit& u, int wr, int wc, int fr, int fq) const {
        int tk[8]; float rsv[8], gv[8];
#pragma unroll
        for (int g = 0; g < 8; ++g) { const int r = u.pm * 256 + (g >> 2) * 128 + wr * 64 + (g & 3) * 16 + fr; tk[g] = tok_of(u, r); gv[g] = (r < u.cnt) ? egate[(size_t)u.e * LCAP + r] : 0.f; }
#pragma unroll
        for (int g = 0; g < 8; ++g) rsv[g] = rstd2[tk[g]];
#pragma unroll
        for (int ai = 0; ai < 2; ++ai)
#pragma unroll
            for (int m = 0; m < 4; ++m) {
                const int r = u.pm * 256 + ai * 128 + wr * 64 + m * 16 + fr;
                if (r < u.cnt) {
                    const float rs = rsv[ai * 4 + m], gt = gv[ai * 4 + m];
                    float hv[8];
#pragma unroll
                    for (int n = 0; n < 2; ++n)
#pragma unroll
                        for (int j = 0; j < 4; ++j) { const float g = acc[ai][0][m][n][j] * rs, uu = acc[ai][1][m][n][j] * rs; hv[n * 4 + j] = g * sigmoidf_(g) * uu * gt; }
                    u32x4 w; w.x = pk2(hv[0], hv[1]); w.y = pk2(hv[2], hv[3]); w.z = pk2(hv[4], hv[5]); w.w = pk2(hv[6], hv[7]);
                    *(u32x4*)(HB + (size_t)(u.base + r) * EH + u.pn * 128 + wc * 32 + 8 * fq) = w;
                }
            }
    }
};

struct ProbDP {
    static constexpr bool PERM = false;
    const bf16_t* A; const bf16_t* Bt; int G, c;
    const LAS MoeTab* T; const u32x2* plist; float* x; bf16_t* xb; float* ss1;
    DI bool next(int i, Unit& u) const {
        const int L = moe_L(i, G, c), tt = L >> 2, nf = T->tpf[112];
        if (tt < nf) { if (!moe_unit<112>(T->tpf, L, u)) return false; }
        else { if (!moe_unit<112>(T->tph, L - 4 * nf, u)) return false; u.pm = (T->cp[u.e] - 1) >> 8; }
        u.cnt = T->cp[u.e]; const int g = u.e / 28, p = u.e - g * 28, lo = pair_lo(p); u.base = g * 8 + lo; u.aux = g * 8 + pair_hi(p, lo); return true;
    }
    DI void aoffs2(const Unit& u, int tid, unsigned (&oa)[2][2], unsigned (&ob)[2][2]) const {
        int Rr[2], Cc[2]; pg8::stage_rc(tid * 16, Rr[0], Cc[0]); pg8::stage_rc(tid * 16 + 8192, Rr[1], Cc[1]);
        const int sba = T->sb[u.base], sbb = T->sb[u.aux];
#pragma unroll
        for (int h = 0; h < 2; ++h)
#pragma unroll
            for (int i = 0; i < 2; ++i) { const int r = u.pm * 256 + h * 128 + Rr[i]; unsigned pos = 0u; if (r < u.cnt) pos = plist[(size_t)u.e * LCAP + r].y;
                const int ra = (r < u.cnt) ? sba + (int)(pos & 0xffffu) : 0, rb = (r < u.cnt) ? sbb + (int)(pos >> 16) : 0;
                oa[h][i] = (unsigned)((ra * EH + Cc[i]) * 2); ob[h][i] = (unsigned)((rb * EH + Cc[i]) * 2); }
    }
    DI const char* bbase_a(const Unit& u) const { return (const char*)Bt + ((size_t)u.base * 1024 + u.pn * 256) * EH * 2; }
    DI const char* bbase_b(const Unit& u) const { return (const char*)Bt + ((size_t)u.aux * 1024 + u.pn * 256) * EH * 2; }
    DI void epi(const f32x4 (&acc)[2][2][4][2], const Unit& u, int wr, int wc, int fr, int fq) const {
        int tk[8];
#pragma unroll
        for (int g = 0; g < 8; ++g) { const int r = u.pm * 256 + (g >> 2) * 128 + wr * 64 + (g & 3) * 16 + fr; tk[g] = (r < u.cnt) ? (int)plist[(size_t)u.e * LCAP + r].x : 0; }
#pragma unroll
        for (int ai = 0; ai < 2; ++ai)
#pragma unroll
            for (int m = 0; m < 4; ++m) {
                const int r = u.pm * 256 + ai * 128 + wr * 64 + m * 16 + fr; const bool val = r < u.cnt;
                const size_t off = (size_t)tk[ai * 4 + m] * D + u.pn * 256 + wc * 32 + 4 * fq;
                f32x4 xv[2][2];
#pragma unroll
                for (int bj = 0; bj < 2; ++bj)
#pragma unroll
                    for (int n = 0; n < 2; ++n) xv[bj][n] = *(const f32x4*)(x + off + bj * 128 + n * 16);
                float ssp = 0.f;
#pragma unroll
                for (int bj = 0; bj < 2; ++bj)
#pragma unroll
                    for (int n = 0; n < 2; ++n) { const size_t o = off + bj * 128 + n * 16; const f32x4 v = xv[bj][n] + acc[ai][bj][m][n];
                        if (val) { *(f32x4*)(x + o) = v; u32x2 w; w.x = pk2(v[0], v[1]); w.y = pk2(v[2], v[3]); *(u32x2*)(xb + o) = w; }
                        ssp += (v[0] * v[0] + v[1] * v[1]) + (v[2] * v[2] + v[3] * v[3]); }
                ssp += __shfl_xor(ssp, 16); ssp += __shfl_xor(ssp, 32);
                if (val && fq == 0) ss1[(size_t)tk[ai * 4 + m] * 16 + u.pn * 4 + wc] = ssp;
                asm volatile("" ::: "memory");
            }
    }
};


DI void fgate_item(Frame& F, int layer, int item) {
    const int lane = F.lane, m16 = lane & 15, q4 = lane >> 4, r0 = 16 * item;
    const bf16_t* ap = WSP(bf16_t, WS_XB) + (size_t)(r0 + m16) * D + 8 * q4;
    const bf16_t* bp = WSP(bf16_t, WS_BIN) + (size_t)layer * NIN * D + (size_t)(3072 + (m16 & 3)) * D + 8 * q4;
    f32x4 acc = {0.f, 0.f, 0.f, 0.f};
#pragma unroll 16
    for (int ks = 0; ks < 32; ++ks) {
        const bf16x8 a = *(const bf16x8*)(ap + 32 * ks); bf16x8 b = *(const bf16x8*)(bp + 32 * ks);
        if (m16 >= 4) b = (bf16x8){0, 0, 0, 0, 0, 0, 0, 0};
        acc = __builtin_amdgcn_mfma_f32_16x16x32_bf16(a, b, acc, 0, 0, 0);
    }
    if (m16 < 4) {
        const float bfv = F.in[16][layer * 4 + m16];
#pragma unroll
        for (int r = 0; r < 4; ++r) { const int row = r0 + 4 * q4 + r;
            const f32x4* sp = (const f32x4*)(WSP(float, WS_SS1) + (size_t)row * 16);
            const f32x4 s0 = sp[0], s1 = sp[1], s2 = sp[2], s3 = sp[3];
            const float ss = ((s0[0] + s0[1]) + (s0[2] + s0[3])) + ((s1[0] + s1[1]) + (s1[2] + s1[3])) + ((s2[0] + s2[1]) + (s2[2] + s2[3])) + ((s3[0] + s3[1]) + (s3[2] + s3[3]));
            const float rstd = __builtin_amdgcn_rsqf(ss * (1.f / 1024.f) + 1e-6f);
            WSP(float, WS_LF)[(size_t)((row >> 11) * 4 + m16) * SEQ + (row & 2047)] = -softplusf_(-(acc[r] * rstd + bfv)); }
    }
}
DI void p0_transpose64(const float* W, int K, int N, int ldn, const float* gs, bf16_t* WT, int mode, LAS unsigned* T, int kb, int nb, int lane) {
    const int k0 = 64 * kb, n0 = 64 * nb, nq = lane & 15, kr = lane >> 4;
    const bool nv = (n0 + 4 * nq) < N;
    f32x4 a[8], b[8];
#pragma unroll
    for (int i = 0; i < 8; ++i) { const int k = k0 + 8 * i + 2 * kr;
        a[i] = nv ? *(const f32x4*)(W + (size_t)k * ldn + n0 + 4 * nq) : (f32x4){0.f, 0.f, 0.f, 0.f};
        b[i] = nv ? *(const f32x4*)(W + (size_t)(k + 1) * ldn + n0 + 4 * nq) : (f32x4){0.f, 0.f, 0.f, 0.f}; }
#pragma unroll
    for (int i = 0; i < 8; ++i) { const int k = k0 + 8 * i + 2 * kr; float g0 = 1.f, g1 = 1.f; if (gs) { g0 = gs[k]; g1 = gs[k + 1]; }
#pragma unroll
        for (int jj = 0; jj < 4; ++jj) T[(4 * nq + jj) * 36 + 4 * i + kr] = pk2(a[i][jj] * g0, b[i][jj] * g1); }
    asm volatile("s_waitcnt lgkmcnt(0)" ::: "memory");
    const int c = lane & 7;
#pragma unroll
    for (int p = 0; p < 8; ++p) { const int nl = 8 * p + (lane >> 3), n = n0 + nl;
        const u32x4 o = *(const LAS u32x4*)(T + nl * 36 + 4 * c);
        const int drow = (mode == 0) ? n : (((n >> 7) << 8) + (n & 127) + (mode == 2 ? 128 : 0));
        *(u32x4*)(WT + (size_t)drow * K + k0 + 8 * c) = o; }
    asm volatile("s_waitcnt lgkmcnt(0)" ::: "memory");
}
DI void p0_prologue(Frame& F) {
    LAS unsigned* scr = (LAS unsigned*)(F.lds + F.wave * 16384);
    const int gw = F.bid * 8 + F.wave, NGW = F.G * 8;
    constexpr int I_IN = 16 * 52, I_OUT = 16 * 16, I_GU = 16 * 8, I_DN = 8 * 16;
    constexpr int S0 = DEPTH * I_IN, S1 = S0 + DEPTH * I_OUT, S2 = S1 + DEPTH * NE * I_GU, S3 = S2 + DEPTH * NE * I_GU, S4 = S3 + DEPTH * NE * I_DN;
    for (int it = gw; it < S4; it += NGW) {
        if (it < S0) { const int l = it / I_IN, r = it % I_IN;
            p0_transpose64(F.in[2] + (size_t)l * D * 3076, D, 3076, 3076, F.in[1] + l * D, WSP(bf16_t, WS_BIN) + (size_t)l * NIN * D, 0, scr, r / 52, r % 52, F.lane);
        } else if (it < S1) { const int q = it - S0, l = q / I_OUT, r = q % I_OUT;
            p0_transpose64(F.in[17] + (size_t)l * D * D, D, D, D, nullptr, WSP(bf16_t, WS_BOUT) + (size_t)l * D * D, 0, scr, r / 16, r % 16, F.lane);
        } else if (it < S3) { const int up = it >= S2, q = it - (up ? S2 : S1), le = q / I_GU, r = q % I_GU;
            p0_transpose64(F.in[up ? 24 : 23] + (size_t)le * D * EH, D, EH, EH, F.in[18] + (le / NE) * D, WSP(bf16_t, WS_BGU) + (size_t)le * 1024 * D, up ? 2 : 1, scr, r / 8, r % 8, F.lane);
        } else { const int q = it - S3, le = q / I_DN, r = q % I_DN;
            p0_transpose64(F.in[25] + (size_t)le * EH * D, EH, D, D, nullptr, WSP(bf16_t, WS_BDN) + (size_t)le * D * EH, 0, scr, r / 16, r % 16, F.lane);
        }
    }
    const int gt = F.bid * 512 + F.tid, NGT = F.G * 512;
    for (int i = gt; i < DEPTH * 256 * 256; i += NGT) { const int l = i >> 16, c = (i >> 8) & 255, k = i & 255;
        const float v = k < 64 ? F.in[7][((size_t)l * 64 + k) * 256 + c] : (k < 128 ? F.in[9][((size_t)l * 64 + (k - 64)) * 256 + c] : F.in[10][((size_t)l * 128 + (k - 128)) * 256 + c]);
        WSP(bf16_t, WS_WCAT)[i] = (bf16_t)f2bf(v); }
    for (int i = gt; i < DEPTH * 36 * 1024; i += NGT) { const int l = i / (36 * 1024), j = (i / 1024) % 36, k = i & 1023;
        const float g = F.in[18][l * D + k];
        const float w = j < 4 ? F.in[19][((size_t)l * D + k) * 4 + j] : F.in[21][((size_t)l * D + k) * 32 + (j - 4)];
        WSP(float, WS_RTW)[i] = g * w; }
    for (int m0 = gw * 4; m0 < NT; m0 += NGW * 4) {
        f32x4 v[4][4];
#pragma unroll
        for (int r = 0; r < 4; ++r) { const f32x4* xr = (const f32x4*)(F.in[0] + (size_t)(m0 + r) * D) + F.lane;
#pragma unroll
            for (int j = 0; j < 4; ++j) v[r][j] = xr[64 * j]; }
#pragma unroll
        for (int r = 0; r < 4; ++r) { float s = 0.f; u32x2* o8 = (u32x2*)(WSP(bf16_t, WS_XB) + (size_t)(m0 + r) * D) + F.lane;
#pragma unroll
            for (int j = 0; j < 4; ++j) { const f32x4 q = v[r][j]; s += (q[0] * q[0] + q[1] * q[1]) + (q[2] * q[2] + q[3] * q[3]); u32x2 w; w.x = pk2(q[0], q[1]); w.y = pk2(q[2], q[3]); o8[64 * j] = w; }
            s = wave_sum(s);
            if (F.lane < 16) WSP(float, WS_SS1)[(size_t)(m0 + r) * 16 + F.lane] = (F.lane == 0) ? s : 0.f; }
    }
}

constexpr int AT_KOFF = 0, AT_VOFF = 18432, AT_CUM = 36864, AT_MISC = 45056, AT_ROWB = 144, AT_BUFB = 64 * 144;
DI void at_load_tile(const bf16_t* Pb, int colK, int colV, int jt, int tid, u32x4& kreg, u32x4& vreg) {
    const int row = tid >> 3, ch = tid & 7; const bf16_t* p = Pb + (size_t)(64 * jt + row) * PP + ch * 8;
    kreg = *(const u32x4*)(p + colK); vreg = *(const u32x4*)(p + colV);
}
DI void at_store_tile(LAS unsigned char* lds, int buf, int tid, const u32x4& kreg, const u32x4& vreg) {
    const int row = tid >> 3, ch = tid & 7;
    *(LAS u32x4*)(lds + AT_KOFF + buf * AT_BUFB + row * AT_ROWB + ch * 16) = kreg;
    *(LAS u32x4*)(lds + AT_VOFF + buf * AT_BUFB + row * AT_ROWB + ch * 16) = vreg;
}
DI void at_qk(const LAS unsigned char* kb, const bf16x8 (&qf)[4], int r32, int h2, f32x16& s0, f32x16& s1) {
    const LAS unsigned char* p = kb + r32 * AT_ROWB + h2 * 16;
#pragma unroll
    for (int d0 = 0; d0 < 4; ++d0) {
        const bf16x8 a0 = *(const LAS bf16x8*)(p + d0 * 32), a1 = *(const LAS bf16x8*)(p + 32 * AT_ROWB + d0 * 32);
        s0 = MFMA32(a0, qf[d0], s0); s1 = MFMA32(a1, qf[d0], s1);
    }
}
DI bf16x8 pack8(const f32x16& x, int s) {
    u32x4 p; p.x = pk2(x[8 * s], x[8 * s + 1]); p.y = pk2(x[8 * s + 2], x[8 * s + 3]); p.z = pk2(x[8 * s + 4], x[8 * s + 5]); p.w = pk2(x[8 * s + 6], x[8 * s + 7]);
    return __builtin_bit_cast(bf16x8, p);
}
DI s16x4 tr_read(const LAS unsigned char* p) { return __builtin_bit_cast(s16x4, __builtin_amdgcn_ds_read_tr16_b64_v4i16((LAS s16x4*)p)); }
DI void at_pv(const LAS unsigned char* vb, const bf16x8 (&pb)[4], int lane, f32x16& o0, f32x16& o1) {
    const int h2 = lane >> 5;
    const LAS unsigned char* base = vb + (4 * h2 + ((lane & 15) >> 2)) * AT_ROWB + (16 * ((lane >> 4) & 1) + 4 * (lane & 3)) * 2;
#pragma unroll
    for (int s = 0; s < 4; ++s) {
        const LAS unsigned char* p = base + 16 * s * AT_ROWB;
        const s16x4 l0 = tr_read(p), h0 = tr_read(p + 8 * AT_ROWB), l1 = tr_read(p + 64), h1 = tr_read(p + 8 * AT_ROWB + 64);
        const bf16x8 a0 = __builtin_shufflevector(l0, h0, 0, 1, 2, 3, 4, 5, 6, 7), a1 = __builtin_shufflevector(l1, h1, 0, 1, 2, 3, 4, 5, 6, 7);
        o0 = MFMA32(a0, pb[s], o0); o1 = MFMA32(a1, pb[s], o1);
    }
}
DI void at_store_out(bf16_t* dst  , const f32x16& o0, const f32x16& o1, float scale, int h2) {
#pragma unroll
    for (int g = 0; g < 4; ++g) {
        u32x2 w0, w1; w0.x = pk2(o0[4 * g] * scale, o0[4 * g + 1] * scale); w0.y = pk2(o0[4 * g + 2] * scale, o0[4 * g + 3] * scale);
        w1.x = pk2(o1[4 * g] * scale, o1[4 * g + 1] * scale); w1.y = pk2(o1[4 * g + 2] * scale, o1[4 * g + 3] * scale);
        *(u32x2*)(dst + 8 * g + 4 * h2) = w0; *(u32x2*)(dst + 32 + 8 * g + 4 * h2) = w1;
    }
}
DI void block_cumsum(const float* src, int n, LAS float* cum, LAS float* wtot, int tid, int lane, int wave) {
    f32x4 v = (f32x4){0.f, 0.f, 0.f, 0.f};
    if (4 * tid < n) v = *(const f32x4*)(src + 4 * tid);
    v[1] += v[0]; v[2] += v[1]; v[3] += v[2];
    float t = v[3];
#pragma unroll
    for (int o = 1; o < 64; o <<= 1) { const float u = __shfl_up(t, o); if (lane >= o) t += u; }
    if (lane == 63) wtot[wave] = t;
    __syncthreads();
    float pre = t - v[3];
    for (int w = 0; w < wave; ++w) pre += wtot[w];
    if (4 * tid < n) { v[0] += pre; v[1] += pre; v[2] += pre; v[3] += pre; *(LAS f32x4*)(cum + 4 * tid) = v; }
    __syncthreads();
}

DI void fx_unit(Frame& F, int layer, int b, int h, int qb) {
    LAS unsigned char* L = F.lds; const int tid = F.tid, lane = F.lane, wid = F.wave, r32 = lane & 31, h2 = lane >> 5;
    const bf16_t* Pb = WSP(bf16_t, WS_P) + (size_t)b * SEQ * PP;
    LAS float* cum = (LAS float*)(L + AT_CUM);
    const int kend = 256 * qb + 256;
    __syncthreads();
    block_cumsum(WSP(float, WS_LF) + (size_t)(b * 4 + h) * SEQ, kend, cum, (LAS float*)(L + AT_MISC), tid, lane, wid);
    const int tw0 = 256 * qb + 32 * wid, tq = tw0 + r32;
    bf16x8 qf[4];
#pragma unroll
    for (int d0 = 0; d0 < 4; ++d0) qf[d0] = *(const bf16x8*)(Pb + (size_t)tq * PP + C_FXQ + h * 64 + 16 * d0 + 8 * h2);
    const float ct2 = cum[tq] * LOG2E;
    float qb2;
    { float qn = 0.f;
#pragma unroll
      for (int d0 = 0; d0 < 4; ++d0) { const u32x4 qq = __builtin_bit_cast(u32x4, qf[d0]);
#pragma unroll
        for (int j = 0; j < 4; ++j) { const float a = bf2f(qq[j] & 0xffffu), c = bf2f(qq[j] >> 16); qn += a * a + c * c; } }
      qn += swap32(qn);
      const unsigned* km = (const unsigned*)(F.ws + WS_CTL) + CW_KMAX + layer * 128 + (b * 4 + h) * 2;
      const float kk2 = __uint_as_float(xb_ld((unsigned*)km)) + __uint_as_float(xb_ld((unsigned*)km + 1));
      qb2 = sqrtf(qn * kk2) * QSCALE2 * 1.01f + 1e-3f; }
    float mrun = -1e30f, lrun = 0.f; f32x16 o0 = {}, o1 = {};
    const int jtop = 4 * qb + 3;
    u32x4 kreg, vreg;
    at_load_tile(Pb, C_FXK + h * 64, C_FXV + h * 64, jtop, tid, kreg, vreg);
    at_store_tile(L, 0, tid, kreg, vreg);
    __syncthreads();
    int buf = 0; bool wskip = false;
    for (int jt = jtop; jt >= 0; --jt) {
        if (jt > 0) at_load_tile(Pb, C_FXK + h * 64, C_FXV + h * 64, jt - 1, tid, kreg, vreg);
        if (64 * jt <= tw0 + 31 && !wskip) {
            f32x16 s0 = {}, s1 = {};
            at_qk(L + AT_KOFF + buf * AT_BUFB, qf, r32, h2, s0, s1);
            const bool needmask = (64 * jt + 63 > tw0);
            float mx = -1e30f;
#pragma unroll
            for (int g = 0; g < 4; ++g) {
                const f32x4 c0 = *(const LAS f32x4*)(cum + 64 * jt + 8 * g + 4 * h2), c1 = *(const LAS f32x4*)(cum + 64 * jt + 32 + 8 * g + 4 * h2);
#pragma unroll
                for (int j = 0; j < 4; ++j) {
                    const int r = 4 * g + j, kv = 64 * jt + 8 * g + 4 * h2 + j;
                    float v0 = s0[r] * QSCALE2 + (ct2 - c0[j] * LOG2E), v1 = s1[r] * QSCALE2 + (ct2 - c1[j] * LOG2E);
                    if (needmask) { if (kv > tq) v0 = -1e30f; if (kv + 32 > tq) v1 = -1e30f; }
                    s0[r] = v0; s1[r] = v1; mx = fmaxf(mx, fmaxf(v0, v1));
                }
            }
            mx = fmaxf(mx, swap32(mx));
            const float mnew = fmaxf(mrun, mx), alpha = ex2(mrun - mnew);
            mrun = mnew;
            float ps = 0.f;
#pragma unroll
            for (int r = 0; r < 16; ++r) { s0[r] = ex2(s0[r] - mnew); s1[r] = ex2(s1[r] - mnew); ps += s0[r] + s1[r]; }
            lrun = lrun * alpha + ps;
#pragma unroll
            for (int r = 0; r < 16; ++r) { o0[r] *= alpha; o1[r] *= alpha; }
            bf16x8 pb[4]; pb[0] = pack8(s0, 0); pb[1] = pack8(s0, 1); pb[2] = pack8(s1, 0); pb[3] = pack8(s1, 1);
            at_pv(L + AT_VOFF + buf * AT_BUFB, pb, lane, o0, o1);
        }
        if (jt > 0) at_store_tile(L, buf ^ 1, tid, kreg, vreg);
        { int wdone = 0; if (jt > 0) wdone = __all(qb2 + (ct2 - cum[64 * jt - 1] * LOG2E) - mrun < -150.f) ? 1 : 0; wskip = wdone != 0; if (lane == 0) *(LAS int*)(L + AT_MISC + 64 + 32 * (jt & 1) + 4 * wid) = wdone; }
        __syncthreads();
        buf ^= 1;
        { const LAS int* fl = (const LAS int*)(L + AT_MISC + 64 + 32 * (jt & 1)); const int alld = fl[0] & fl[1] & fl[2] & fl[3] & fl[4] & fl[5] & fl[6] & fl[7]; if (alld) break; }
    }
    const float ltot = lrun + swap32(lrun);
    at_store_out(WSP(bf16_t, WS_MIX) + (size_t)(b * SEQ + tq) * D + 768 + h * 64, o0, o1, rcpf_(ltot), h2);
}

DI void sb_unit(Frame& F, int b, int h, int qb) {
    LAS unsigned char* L = F.lds; const int tid = F.tid, lane = F.lane, wid = F.wave, r32 = lane & 31, h2 = lane >> 5;
    const bf16_t* Pb = WSP(bf16_t, WS_P) + (size_t)b * SEQ * PP;
    const int tw0 = 256 * qb + 32 * wid, tq = tw0 + r32;
    bf16x8 qf[4];
#pragma unroll
    for (int d0 = 0; d0 < 4; ++d0) qf[d0] = *(const bf16x8*)(Pb + (size_t)tq * PP + C_SBQ + h * 64 + 16 * d0 + 8 * h2);
    bf16x8 uf[2], onesf;
#pragma unroll
    for (int s = 0; s < 2; ++s)
#pragma unroll
        for (int j = 0; j < 8; ++j) uf[s][j] = ((16 * s + 8 * (j >> 2) + 4 * h2 + (j & 3)) > r32) ? (short)0x3F80 : (short)0;
#pragma unroll
    for (int j = 0; j < 8; ++j) onesf[j] = (short)0x3F80;
    float R2 = 0.f; f32x16 o0 = {}, o1 = {};
    const int jtop = 4 * qb + 3;
    u32x4 kreg, vreg;
    __syncthreads();
    at_load_tile(Pb, C_SBK + h * 64, C_SBV + h * 64, jtop, tid, kreg, vreg);
    at_store_tile(L, 0, tid, kreg, vreg);
    __syncthreads();
    int buf = 0; bool wskip = false;
    for (int jt = jtop; jt >= 0; --jt) {
        if (jt > 0) at_load_tile(Pb, C_SBK + h * 64, C_SBV + h * 64, jt - 1, tid, kreg, vreg);
        if (64 * jt <= tw0 + 31 && !wskip) {
            f32x16 s0 = {}, s1 = {};
            at_qk(L + AT_KOFF + buf * AT_BUFB, qf, r32, h2, s0, s1);
            const bool needmask = (64 * jt + 63 >= tw0);
            f32x16 l0, l1;
            float cs = 0.f;
#pragma unroll
            for (int r = 0; r < 16; ++r) {
                const int kv = 64 * jt + crow(r, h2);
                const float z0 = s0[r] * QSCALE2, z1 = s1[r] * QSCALE2;
                const float sp0 = fmaxf(z0, 0.f) + lg2(1.f + ex2(-fabsf(z0))), sp1 = fmaxf(z1, 0.f) + lg2(1.f + ex2(-fabsf(z1)));
                float a0 = -sp0, a1 = -sp1, b0 = z0 - sp0, b1 = z1 - sp1;
                if (needmask) { if (kv >= tq) { a0 = 0.f; b0 = -1e30f; } if (kv + 32 >= tq) { a1 = 0.f; b1 = -1e30f; } }
                l0[r] = a0; l1[r] = a1; s0[r] = b0; s1[r] = b1; cs += a0 + a1;
            }
            f32x16 t0 = {}, t1 = {};
#pragma unroll
            for (int s = 0; s < 2; ++s) {
                const bf16x8 h0 = pack8(l0, s), h1 = pack8(l1, s);
                f32x16 d0_, d1_;
#pragma unroll
                for (int j = 0; j < 8; ++j) { d0_[j] = l0[8 * s + j] - bf2f((unsigned short)h0[j]); d1_[j] = l1[8 * s + j] - bf2f((unsigned short)h1[j]); }
                u32x4 q0, q1; q0.x = pk2(d0_[0], d0_[1]); q0.y = pk2(d0_[2], d0_[3]); q0.z = pk2(d0_[4], d0_[5]); q0.w = pk2(d0_[6], d0_[7]);
                q1.x = pk2(d1_[0], d1_[1]); q1.y = pk2(d1_[2], d1_[3]); q1.z = pk2(d1_[4], d1_[5]); q1.w = pk2(d1_[6], d1_[7]);
                const bf16x8 e0 = __builtin_bit_cast(bf16x8, q0), e1 = __builtin_bit_cast(bf16x8, q1);
                t0 = MFMA32(uf[s], h0, t0); t0 = MFMA32(uf[s], e0, t0); t0 = MFMA32(onesf, h1, t0); t0 = MFMA32(onesf, e1, t0);
                t1 = MFMA32(uf[s], h1, t1); t1 = MFMA32(uf[s], e1, t1);
            }
#pragma unroll
            for (int r = 0; r < 16; ++r) { s0[r] = ex2(s0[r] + R2 + t0[r]); s1[r] = ex2(s1[r] + R2 + t1[r]); }
            R2 += cs + swap32(cs);
            bf16x8 pb[4]; pb[0] = pack8(s0, 0); pb[1] = pack8(s0, 1); pb[2] = pack8(s1, 0); pb[3] = pack8(s1, 1);
            at_pv(L + AT_VOFF + buf * AT_BUFB, pb, lane, o0, o1);
        }
        if (jt > 0) at_store_tile(L, buf ^ 1, tid, kreg, vreg);
        { const int wdone = __all(R2 < -150.f) ? 1 : 0; wskip = wdone != 0; if (lane == 0) *(LAS int*)(L + AT_MISC + 64 + 32 * (jt & 1) + 4 * wid) = wdone; }
        __syncthreads();
        buf ^= 1;
        { const LAS int* fl = (const LAS int*)(L + AT_MISC + 64 + 32 * (jt & 1)); const int alld = fl[0] & fl[1] & fl[2] & fl[3] & fl[4] & fl[5] & fl[6] & fl[7]; if (alld) break; }
    }
    at_store_out(WSP(bf16_t, WS_MIX) + (size_t)(b * SEQ + tq) * D + 0 + h * 64, o0, o1, 1.f, h2);
}
DI void attn_rank_to_unit(int r, int& bh, int& qb) { if (r < 256) { qb = 7 - (r >> 6); bh = r & 63; } else { const int p = r - 256; qb = p >> 6; bh = p & 63; } }

DI void gm_unit(Frame& F, int layer, int b, int c, int g) {
    LAS unsigned char* L = F.lds; const int lane = F.lane, wid = F.wave, r32 = lane & 31, h2 = lane >> 5;
    constexpr int VSTR = 272;
    const bf16_t* Pb = WSP(bf16_t, WS_P) + (size_t)(b * SEQ + c * 128) * PP;
    __syncthreads();
    { bf16_t xr[16];
#pragma unroll
      for (int i = 0; i < 16; ++i) xr[i] = Pb[(size_t)(16 * wid + i) * PP + C_GMV + g * 64 + lane];
#pragma unroll
      for (int i = 0; i < 16; ++i) {
        const int s = 16 * wid + i;
        const float ge = geluf_(bf2f(xr[i])), mean = wave_sum(ge) * (1.f / 64.f), dv = ge - mean, var = wave_sum(dv * dv) * (1.f / 64.f);
        *(LAS bf16_t*)(L + lane * VSTR + s * 2) = (bf16_t)f2bf(dv * __builtin_amdgcn_rsqf(var + 1e-5f));
      } }
    __syncthreads();
    const int tb = wid >> 1, db = wid & 1, t = 32 * tb + r32;
    const float* Wrow = F.in[3] + ((size_t)(layer * 4 + g) * 128 + t) * 128;
    f32x16 acc = {};
    f32x4 wq[8][2];
#pragma unroll
    for (int ks = 0; ks < 8; ++ks) if (ks <= 2 * tb + 1) { const int s0 = 16 * ks + 8 * h2; wq[ks][0] = *(const f32x4*)(Wrow + s0); wq[ks][1] = *(const f32x4*)(Wrow + s0 + 4); }
#pragma unroll
    for (int ks = 0; ks < 8; ++ks) if (ks <= 2 * tb + 1) {
        const int s0 = 16 * ks + 8 * h2;
        float wv[8] = {wq[ks][0][0], wq[ks][0][1], wq[ks][0][2], wq[ks][0][3], wq[ks][1][0], wq[ks][1][1], wq[ks][1][2], wq[ks][1][3]};
#pragma unroll
        for (int j = 0; j < 8; ++j) if (s0 + j > t) wv[j] = 0.f;
        u32x4 aw; aw.x = pk2(wv[0], wv[1]); aw.y = pk2(wv[2], wv[3]); aw.z = pk2(wv[4], wv[5]); aw.w = pk2(wv[6], wv[7]);
        const bf16x8 bv = *(const LAS bf16x8*)(L + (32 * db + r32) * VSTR + s0 * 2);
        acc = MFMA32(__builtin_bit_cast(bf16x8, aw), bv, acc);
    }
    const int d = 32 * db + r32;
    const float* gb = F.in[4] + (size_t)(layer * 4 + g) * 128;
    bf16_t* mo = WSP(bf16_t, WS_MIX) + (size_t)(b * SEQ + c * 128) * D + 256 + g * 64 + d;
#pragma unroll
    for (int r = 0; r < 16; ++r) { const int tt = 32 * tb + crow(r, h2);
        const float u = geluf_(bf2f(Pb[(size_t)tt * PP + C_GMU + g * 64 + d]));
        mo[(size_t)tt * D] = (bf16_t)f2bf(u * (acc[r] + gb[tt])); }
}

DI void rw_load_shift8(const bf16_t* Pt, bool hasprev, int col, const float* mu, float (&o)[8]) {
    const u32x4 cu = *(const u32x4*)(Pt + col); u32x4 pr = (u32x4){0u, 0u, 0u, 0u}; if (hasprev) pr = *(const u32x4*)(Pt - PP + col);
    const f32x4 m0 = *(const f32x4*)(mu), m1 = *(const f32x4*)(mu + 4);
    const float mm[8] = {m0[0], m0[1], m0[2], m0[3], m1[0], m1[1], m1[2], m1[3]};
#pragma unroll
    for (int j = 0; j < 4; ++j) { const float c0 = bf2f(cu[j] & 0xffffu), c1 = bf2f(cu[j] >> 16), p0 = bf2f(pr[j] & 0xffffu), p1 = bf2f(pr[j] >> 16);
        o[2 * j] = c0 + (p0 - c0) * mm[2 * j]; o[2 * j + 1] = c1 + (p1 - c1) * mm[2 * j + 1]; }
}
DI void rw_load_shift4(const bf16_t* Pt, bool hasprev, int col, const float* mu, float (&o)[4]) {
    const u32x2 cu = *(const u32x2*)(Pt + col); u32x2 pr = (u32x2){0u, 0u}; if (hasprev) pr = *(const u32x2*)(Pt - PP + col);
    const f32x4 m0 = *(const f32x4*)(mu);
#pragma unroll
    for (int j = 0; j < 2; ++j) { const float c0 = bf2f(cu[j] & 0xffffu), c1 = bf2f(cu[j] >> 16), p0 = bf2f(pr[j] & 0xffffu), p1 = bf2f(pr[j] >> 16);
        o[2 * j] = c0 + (p0 - c0) * m0[2 * j]; o[2 * j + 1] = c1 + (p1 - c1) * m0[2 * j + 1]; }
}
DI bf16x8 rw_act_frag(const bf16_t* Pt, bool hasprev, const float* mu, int ks, int h2, int mode) {
    float v[8]; rw_load_shift8(Pt, hasprev, C_RWX + 16 * ks + 8 * h2, mu + 768 + 16 * ks + 8 * h2, v);
    if (mode == 1) {
#pragma unroll
        for (int j = 0; j < 8; ++j) v[j] = tanhf_(v[j]);
    } else if (mode == 2) {
#pragma unroll
        for (int j = 0; j < 8; ++j) v[j] = sigmoidf_(v[j]);
    }
    u32x4 pb; pb.x = pk2(v[0], v[1]); pb.y = pk2(v[2], v[3]); pb.z = pk2(v[4], v[5]); pb.w = pk2(v[6], v[7]);
    return __builtin_bit_cast(bf16x8, pb);
}

constexpr int RC_V = 0, RC_KB = 4608, RC_BB = 9216, RC_KT = 13824, RC_CF = 13824, RC_PC = 18432, RC_WAVE = 18688, RC_ROWB = 144;
DI float scan32(float x) {
    x += dppf<0x111, 0xf, true>(x); x += dppf<0x112, 0xf, true>(x); x += dppf<0x114, 0xf, true>(x); x += dppf<0x118, 0xf, true>(x);
    x += dppf<0x142, 0xa, false>(x);
    return x;
}
DI bf16x8 pk8f(const float (&v)[8]) { u32x4 p; p.x = pk2(v[0], v[1]); p.y = pk2(v[2], v[3]); p.z = pk2(v[4], v[5]); p.w = pk2(v[6], v[7]); return __builtin_bit_cast(bf16x8, p); }
DI bf16x8 rc_trfrag(const LAS unsigned char* tile, int lane, int s, int colblk) {
    const int h2 = lane >> 5;
    const LAS unsigned char* p = tile + (16 * s + 4 * h2 + ((lane & 15) >> 2)) * RC_ROWB + (32 * colblk + 16 * ((lane >> 4) & 1) + 4 * (lane & 3)) * 2;
    const s16x4 lo = tr_read(p), hi = tr_read(p + 8 * RC_ROWB);
    return __builtin_shufflevector(lo, hi, 0, 1, 2, 3, 4, 5, 6, 7);
}
DI void rw_chunk_item(Frame& F, int layer, int bh, int ch) {
    asm volatile("" : "+s"(F.in)); asm volatile("" : "+s"(F.ws)); asm volatile("" : "+v"(F.lane));
    const int lane = F.lane, r32 = lane & 31, h2 = lane >> 5, hd = bh & 3, bb = bh >> 2;
    LAS unsigned char* W = F.lds + F.wave * RC_WAVE;
    const int tl = 32 * ch + r32, tok = bb * SEQ + tl; const bool hasprev = tl > 0;
    const bf16_t* Pt0 = WSP(bf16_t, WS_P) + (size_t)tok * PP;
    const float* mu = F.in[5] + (size_t)layer * 1024;
    const bf16_t* wc = WSP(bf16_t, WS_WCAT) + (size_t)layer * 65536 + (size_t)(64 * hd + r32) * 256 + 8 * h2;
    const int chunk = bh * 64 + ch;
    float n2 = 0.f;
    const float* kkw = F.in[11] + layer * 256 + 64 * hd;
#pragma unroll
    for (int blk = 0; blk < 2; ++blk)
#pragma unroll
        for (int g = 0; g < 4; ++g) { const int cl = 32 * blk + 8 * g + 4 * h2; float kv[4]; rw_load_shift4(Pt0, hasprev, C_RWK + 64 * hd + cl, mu + 256 + 64 * hd + cl, kv);
            const f32x4 kw = *(const f32x4*)(kkw + cl);
#pragma unroll
            for (int j = 0; j < 4; ++j) { const float q = kv[j] * kw[j]; n2 += q * q; } }
    n2 += swap32(n2);
    const float inv = 1.f / fmaxf(sqrtf(n2), 1e-12f);
    const float *w0 = F.in[6] + layer * 256 + 64 * hd, *a0 = F.in[8] + layer * 256 + 64 * hd, *kaw = F.in[12] + layer * 256 + 64 * hd, *rk = F.in[13] + layer * 256 + 64 * hd;
    u32x4* FR = WSP(u32x4, WS_CHFR) + (size_t)chunk * 16 * 64 + lane;
    float bon = 0.f;
#pragma unroll
    for (int blk = 0; blk < 2; ++blk) {
        const bf16_t* wb = wc + (size_t)blk * 32 * 256;
        f32x16 aW = {}, aA = {};
#pragma unroll
        for (int ks = 0; ks < 4; ++ks) { const bf16x8 bfr = rw_act_frag(Pt0, hasprev, mu, ks, h2, 1); aW = MFMA32(*(const bf16x8*)(wb + 16 * ks), bfr, aW); }
#pragma unroll
        for (int ks = 4; ks < 8; ++ks) { const bf16x8 bfr = rw_act_frag(Pt0, hasprev, mu, ks, h2, 0); aA = MFMA32(*(const bf16x8*)(wb + 16 * ks), bfr, aA); }
#pragma unroll
        for (int s = 0; s < 2; ++s) {
            float e_kat[8], e_rt[8], e_kt[8], e_bt[8], e_kb[8], e_bb[8];
#pragma unroll
            for (int q = 0; q < 2; ++q) { const int g = 2 * s + q, cl = 32 * blk + 8 * g + 4 * h2;
                const bf16_t* Pt = Pt0;
                float rv[4], vv[4], kv[4]; rw_load_shift4(Pt, hasprev, C_RWR + 64 * hd + cl, mu + 64 * hd + cl, rv); rw_load_shift4(Pt, hasprev, C_RWV + 64 * hd + cl, mu + 512 + 64 * hd + cl, vv);
                rw_load_shift4(Pt, hasprev, C_RWK + 64 * hd + cl, mu + 256 + 64 * hd + cl, kv);
                const f32x4 w0v = *(const f32x4*)(w0 + cl), a0v = *(const f32x4*)(a0 + cl), kav = *(const f32x4*)(kaw + cl), rkv = *(const f32x4*)(rk + cl), kwv = *(const f32x4*)(kkw + cl);
#pragma unroll
                for (int j = 0; j < 4; ++j) { const int r = 4 * g + j, jj = 4 * q + j;
                    const float w = -softplusf_(-(w0v[j] + aW[r])) - 0.5f;
                    const float l2d = -LOG2E * ex2(w * LOG2E);
                    const float a = sigmoidf_(a0v[j] + aA[r]);
                    const float kkv = kv[j] * kwv[j] * inv, bev = kkv * a, kpv = kv[j] * (1.f + (a - 1.f) * kav[j]);
                    bon += rv[j] * kpv * rkv[j];
                    const float Li = scan32(l2d), Lex = Li - l2d, LC = __shfl(Li, 31 + 32 * h2);
                    const float pin = ex2(Li), pex = ex2(Lex), pinv = ex2(-Li), pc = ex2(LC - Li);
                    e_kat[jj] = kkv * pex; e_rt[jj] = rv[j] * pin; e_kt[jj] = kpv * pinv; e_bt[jj] = bev * pinv; e_kb[jj] = kpv * pc; e_bb[jj] = bev * pc;
                    if (r32 == 31) *(LAS float*)(W + RC_PC + (cl + j) * 4) = ex2(LC); }
                u32x2 vq; vq.x = pk2(vv[0], vv[1]); vq.y = pk2(vv[2], vv[3]);
                *(LAS u32x2*)(W + RC_V + r32 * RC_ROWB + cl * 2) = vq;
                *(LAS u32x2*)(W + RC_KB + r32 * RC_ROWB + cl * 2) = (u32x2){pk2(e_kb[4 * q], e_kb[4 * q + 1]), pk2(e_kb[4 * q + 2], e_kb[4 * q + 3])};
                *(LAS u32x2*)(W + RC_BB + r32 * RC_ROWB + cl * 2) = (u32x2){pk2(e_bb[4 * q], e_bb[4 * q + 1]), pk2(e_bb[4 * q + 2], e_bb[4 * q + 3])};
                *(LAS u32x2*)(W + RC_KT + r32 * RC_ROWB + cl * 2) = (u32x2){pk2(e_kat[4 * q], e_kat[4 * q + 1]), pk2(e_kat[4 * q + 2], e_kat[4 * q + 3])};
            }
            { const int ks = 2 * blk + s; FR[(ks * 4 + 0) * 64] = __builtin_bit_cast(u32x4, pk8f(e_kat)); FR[(ks * 4 + 1) * 64] = __builtin_bit_cast(u32x4, pk8f(e_rt)); FR[(ks * 4 + 2) * 64] = __builtin_bit_cast(u32x4, pk8f(e_kt)); FR[(ks * 4 + 3) * 64] = __builtin_bit_cast(u32x4, pk8f(e_bt)); }
        }
        f32x16 aG = {};
#pragma unroll 4
        for (int ks = 8; ks < 16; ++ks) { const bf16x8 bfr = rw_act_frag(Pt0, hasprev, mu, ks, h2, 2); aG = MFMA32(*(const bf16x8*)(wb + 16 * ks), bfr, aG); }
#pragma unroll
        for (int g = 0; g < 4; ++g) { const int cl = 32 * blk + 8 * g + 4 * h2; u32x2 gq;
            gq.x = pk2(aG[4 * g], aG[4 * g + 1]); gq.y = pk2(aG[4 * g + 2], aG[4 * g + 3]);
            *(u32x2*)(WSP(bf16_t, WS_GBUF) + (size_t)tok * 256 + 64 * hd + cl) = gq; }
    }
    bon += swap32(bon);
    asm volatile("s_waitcnt vmcnt(0)" ::: "memory");
    asm volatile("" ::: "memory");
#pragma unroll
    for (int blk = 0; blk < 2; ++blk)
#pragma unroll
        for (int g = 0; g < 4; ++g) { const int cl = 32 * blk + 8 * g + 4 * h2; const u32x2 vq = *(const LAS u32x2*)(W + RC_V + r32 * RC_ROWB + cl * 2); u32x2 q;
            q.x = pk2(bon * bf2f(vq.x & 0xffffu), bon * bf2f(vq.x >> 16)); q.y = pk2(bon * bf2f(vq.y & 0xffffu), bon * bf2f(vq.y >> 16));
            *(u32x2*)(WSP(bf16_t, WS_BONV) + (size_t)tok * 256 + 64 * hd + cl) = q; }
    const float pc_lo = *(const LAS float*)(W + RC_PC + r32 * 4), pc_hi = *(const LAS float*)(W + RC_PC + (32 + r32) * 4);
    bf16x8 akkf[2], arkf[2], arbf[2];
    f32x16 Tt;
    {
        f32x16 skk = {}, skb = {}, sl = {};
#pragma unroll
        for (int ks = 0; ks < 4; ++ks) { const bf16x8 katf = __builtin_bit_cast(bf16x8, FR[(ks * 4 + 0) * 64]), ktf = __builtin_bit_cast(bf16x8, FR[(ks * 4 + 2) * 64]), btf = __builtin_bit_cast(bf16x8, FR[(ks * 4 + 3) * 64]);
            skk = MFMA32(ktf, katf, skk); skb = MFMA32(btf, katf, skb); sl = MFMA32(katf, btf, sl); }
#pragma unroll
        for (int r = 0; r < 16; ++r) { const int i = crow(r, h2); if (i >= r32) { skk[r] = 0.f; skb[r] = 0.f; } if (i <= r32) sl[r] = 0.f; }
#pragma unroll
        for (int s = 0; s < 2; ++s) akkf[s] = pack8(skk, s);
        bf16x8 fx[2], fxt[2];
#pragma unroll
        for (int s = 0; s < 2; ++s) { fx[s] = pack8(sl, s); fxt[s] = pack8(skb, s); }
#pragma unroll
        for (int r = 0; r < 16; ++r) Tt[r] = ((crow(r, h2) == r32) ? 1.f : 0.f) - skb[r];
#pragma unroll
        for (int lvl = 0; lvl < 4; ++lvl) {
            f32x16 p = {}, pt = {};
#pragma unroll
            for (int s = 0; s < 2; ++s) { p = MFMA32(fxt[s], fx[s], p); if (lvl < 3) pt = MFMA32(fx[s], fxt[s], pt); }
#pragma unroll
            for (int s = 0; s < 2; ++s) fx[s] = pack8(p, s);
            const bf16x8 t0 = pack8(Tt, 0), t1 = pack8(Tt, 1);
            Tt = MFMA32(fx[0], t0, Tt); Tt = MFMA32(fx[1], t1, Tt);
            if (lvl < 3) {
#pragma unroll
                for (int s = 0; s < 2; ++s) fxt[s] = pack8(pt, s); }
        }
    }
    {
        f32x16 srk = {}, srb = {};
#pragma unroll
        for (int ks = 0; ks < 4; ++ks) { const bf16x8 rtf = __builtin_bit_cast(bf16x8, FR[(ks * 4 + 1) * 64]), ktf = __builtin_bit_cast(bf16x8, FR[(ks * 4 + 2) * 64]), btf = __builtin_bit_cast(bf16x8, FR[(ks * 4 + 3) * 64]);
            srk = MFMA32(ktf, rtf, srk); srb = MFMA32(btf, rtf, srb); }
#pragma unroll
        for (int r = 0; r < 16; ++r) if (crow(r, h2) > r32) { srk[r] = 0.f; srb[r] = 0.f; }
#pragma unroll
        for (int s = 0; s < 2; ++s) { arkf[s] = pack8(srk, s); arbf[s] = pack8(srb, s); }
    }
    asm volatile("" ::: "memory");
    bf16x8 ng1f[2][2], ng2f[2][2];
    {
        const bf16x8 tf0 = pack8(Tt, 0), tf1 = pack8(Tt, 1);
#pragma unroll
        for (int cb = 0; cb < 2; ++cb) {
            f32x16 g = {};
            g = MFMA32(tf0, rc_trfrag(W + RC_KT, lane, 0, cb), g); g = MFMA32(tf1, rc_trfrag(W + RC_KT, lane, 1, cb), g);
#pragma unroll
            for (int r = 0; r < 16; ++r) g[r] = -g[r];
            ng1f[cb][0] = pack8(g, 0); ng1f[cb][1] = pack8(g, 1);
        }
#pragma unroll
        for (int vb = 0; vb < 2; ++vb) {
            f32x16 x1 = {};
#pragma unroll
            for (int s = 0; s < 2; ++s) x1 = MFMA32(akkf[s], rc_trfrag(W + RC_V, lane, s, vb), x1);
            f32x16 g = {};
            g = MFMA32(tf0, pack8(x1, 0), g); g = MFMA32(tf1, pack8(x1, 1), g);
#pragma unroll
            for (int r = 0; r < 16; ++r) g[r] = -g[r];
            ng2f[vb][0] = pack8(g, 0); ng2f[vb][1] = pack8(g, 1);
        }
    }
    asm volatile("" ::: "memory");
    u32x4* mt = WSP(u32x4, WS_CHMT) + (size_t)chunk * 8 * 64 + lane;
#pragma unroll
    for (int bip = 0; bip < 2; ++bip)
#pragma unroll
        for (int bi = 0; bi < 2; ++bi) {
            f32x16 m = {};
#pragma unroll
            for (int s = 0; s < 2; ++s) m = MFMA32(ng1f[bi][s], rc_trfrag(W + RC_BB, lane, s, bip), m);
            if (bi == bip) {
#pragma unroll
                for (int r = 0; r < 16; ++r) if (crow(r, h2) == r32) m[r] += (bi ? pc_hi : pc_lo); }
#pragma unroll
            for (int s = 0; s < 2; ++s) mt[(bip * 4 + bi * 2 + s) * 64] = __builtin_bit_cast(u32x4, pack8(m, s));
        }
    asm volatile("" ::: "memory");
    u32x4* nb_ = WSP(u32x4, WS_CHN) + (size_t)chunk * 8 * 64 + lane;
#pragma unroll
    for (int vb = 0; vb < 2; ++vb)
#pragma unroll
        for (int bip = 0; bip < 2; ++bip) {
            f32x16 n = {};
#pragma unroll
            for (int s = 0; s < 2; ++s) { n = MFMA32(rc_trfrag(W + RC_KB, lane, s, bip), rc_trfrag(W + RC_V, lane, s, vb), n); n = MFMA32(rc_trfrag(W + RC_BB, lane, s, bip), ng2f[vb][s], n); }
#pragma unroll
            for (int s = 0; s < 2; ++s) nb_[((vb * 2 + bip) * 2 + s) * 64] = __builtin_bit_cast(u32x4, pack8(n, s));
        }
    asm volatile("" ::: "memory");
    u32x4* ry = WSP(u32x4, WS_CHRY) + (size_t)chunk * 4 * 64 + lane;
#pragma unroll
    for (int bi = 0; bi < 2; ++bi) {
        f32x16 q = {};
#pragma unroll
        for (int s = 0; s < 2; ++s) q = MFMA32(ng1f[bi][s], arbf[s], q);
#pragma unroll
        for (int s = 0; s < 2; ++s) { const u32x4 rq = FR[((2 * bi + s) * 4 + 1) * 64]; float o[8];
#pragma unroll
            for (int j = 0; j < 4; ++j) { o[2 * j] = q[8 * s + 2 * j] + bf2f(rq[j] & 0xffffu); o[2 * j + 1] = q[8 * s + 2 * j + 1] + bf2f(rq[j] >> 16); }
            ry[(bi * 2 + s) * 64] = __builtin_bit_cast(u32x4, pk8f(o)); }
    }
    asm volatile("" ::: "memory");
    u32x4* y0 = WSP(u32x4, WS_CHY0) + (size_t)chunk * 4 * 64 + lane;
#pragma unroll
    for (int vb = 0; vb < 2; ++vb) {
        f32x16 yy = {};
#pragma unroll
        for (int s = 0; s < 2; ++s) { yy = MFMA32(arkf[s], rc_trfrag(W + RC_V, lane, s, vb), yy); yy = MFMA32(arbf[s], ng2f[vb][s], yy); }
#pragma unroll
        for (int s = 0; s < 2; ++s) y0[(vb * 2 + s) * 64] = __builtin_bit_cast(u32x4, pack8(yy, s));
    }
    asm volatile("s_waitcnt lgkmcnt(0)" ::: "memory");
}
constexpr int RG_ACT = 4 * RC_WAVE, RG_RKV = RG_ACT + 16384, RG_PAR = RG_RKV + 12 * 4608, RG_END = RG_PAR + 5120;
static_assert(RG_END <= LDS_MISC, "chunk-pass LDS map");
DI void rw_group_loader(Frame& F, int layer, int tg) {
    asm volatile("" : "+s"(F.in)); asm volatile("" : "+s"(F.ws)); asm volatile("" : "+v"(F.lane));
    const int lane = F.lane, r32 = lane & 31, h2 = lane >> 5, lw = F.wave - 4, bb = tg >> 6, ch = tg & 63;
    LAS unsigned char* L = F.lds;
    const int tl = 32 * ch + r32, tok = bb * SEQ + tl; const bool hasprev = tl > 0;
    const bf16_t* Pt0 = WSP(bf16_t, WS_P) + (size_t)tok * PP;
    const float* mu = F.in[5] + (size_t)layer * 1024;
#pragma unroll
    for (int j = 0; j < 4; ++j) { const int ks = 4 * lw + j; const bf16x8 fr = rw_act_frag(Pt0, hasprev, mu, ks, h2, lw == 0 ? 1 : (lw == 1 ? 0 : 2));
        *(LAS bf16x8*)(L + RG_ACT + ks * 1024 + lane * 16) = fr; }
#pragma unroll
    for (int arr = 0; arr < 3; ++arr) { const int cb = (arr == 0 ? C_RWR : (arr == 1 ? C_RWK : C_RWV)) + 64 * lw, mo = 256 * arr + 64 * lw;
#pragma unroll
        for (int g8 = 0; g8 < 4; ++g8) { const int c0 = 32 * h2 + 8 * g8; float o[8]; rw_load_shift8(Pt0, hasprev, cb + c0, mu + mo + c0, o);
            *(LAS bf16x8*)(L + RG_RKV + (lw * 3 + arr) * 4608 + r32 * RC_ROWB + c0 * 2) = pk8f(o); } }
    asm volatile("s_waitcnt lgkmcnt(0)" ::: "memory");
    asm volatile("" ::: "memory"); __builtin_amdgcn_s_barrier(); asm volatile("" ::: "memory");
    {
        const bf16_t* wp = WSP(bf16_t, WS_BIN) + (size_t)layer * NIN * D + (size_t)3072 * D + 4 * lane;
        u32x2 wv[4][4];
#pragma unroll
        for (int c = 0; c < 4; ++c)
#pragma unroll
            for (int j = 0; j < 4; ++j) wv[c][j] = *(const u32x2*)(wp + (size_t)c * D + 256 * j);
        const float* xsrc = (layer == 0) ? F.in[0] : F.out;
        const int t0 = bb * SEQ + 32 * ch + 8 * lw;
#pragma unroll
        for (int ib = 0; ib < 2; ++ib) {
            f32x4 xr[4][4]; float sp[4];
#pragma unroll
            for (int i = 0; i < 4; ++i) { const f32x4* xp = (const f32x4*)(xsrc + (size_t)(t0 + 4 * ib + i) * D) + lane;
#pragma unroll
                for (int j = 0; j < 4; ++j) xr[i][j] = xp[64 * j];
                sp[i] = (lane < 16) ? WSP(float, WS_SS1)[(size_t)(t0 + 4 * ib + i) * 16 + lane] : 0.f; }
#pragma unroll
            for (int i = 0; i < 4; ++i) {
                const float ss = wave_sum(sp[i]); const float rstd = __builtin_amdgcn_rsqf(ss * (1.f / 1024.f) + 1e-6f);
                float res = 0.f;
#pragma unroll
                for (int c = 0; c < 4; ++c) { float a = 0.f;
#pragma unroll
                    for (int j = 0; j < 4; ++j) { const f32x4 x4 = xr[i][j]; const u32x2 wq = wv[c][j];
                        a += (x4[0] * bf2f(wq.x & 0xffffu) + x4[1] * bf2f(wq.x >> 16)) + (x4[2] * bf2f(wq.y & 0xffffu) + x4[3] * bf2f(wq.y >> 16)); }
                    a = wave_sum(a); if (lane == c) res = a; }
                if (lane < 4) { const int row = t0 + 4 * ib + i; WSP(float, WS_LF)[(size_t)((row >> 11) * 4 + lane) * SEQ + (row & 2047)] = -softplusf_(-(res * rstd + F.in[16][layer * 4 + lane])); }
            }
        }
    }
    asm volatile("" ::: "memory"); __builtin_amdgcn_s_barrier(); asm volatile("" ::: "memory");
}
DI void rw_group_compute(Frame& F, int layer, int tg) {
    asm volatile("" : "+s"(F.in)); asm volatile("" : "+s"(F.ws)); asm volatile("" : "+v"(F.lane));
    const int lane = F.lane, r32 = lane & 31, h2 = lane >> 5, hd = F.wave, bb = tg >> 6, ch = tg & 63, bh = bb * 4 + hd;
    LAS unsigned char* L = F.lds;
    LAS unsigned char* W = L + F.wave * RC_WAVE;
    const int tl = 32 * ch + r32, tok = bb * SEQ + tl;
    const bf16_t* wc = WSP(bf16_t, WS_WCAT) + (size_t)layer * 65536 + (size_t)(64 * hd + r32) * 256 + 8 * h2;
    const int chunk = bh * 64 + ch;
    const LAS float* PAR = (const LAS float*)(L + RG_PAR) + 64 * hd;
    const LAS unsigned char* TR = L + RG_RKV + (hd * 3 + 0) * 4608 + r32 * RC_ROWB;
    const LAS unsigned char* TK = TR + 4608; const LAS unsigned char* TV = TR + 2 * 4608;
    u32x4 FRr[16];
    asm volatile("" ::: "memory"); __builtin_amdgcn_s_barrier(); asm volatile("" ::: "memory");
    float n2 = 0.f;
#pragma unroll
    for (int g8 = 0; g8 < 4; ++g8) { const u32x4 kq = *(const LAS u32x4*)(TK + 64 * h2 + 16 * g8); const f32x4 k0 = *(const LAS f32x4*)(PAR + 1024 + 32 * h2 + 8 * g8), k1 = *(const LAS f32x4*)(PAR + 1024 + 32 * h2 + 8 * g8 + 4);
#pragma unroll
        for (int j = 0; j < 4; ++j) { const float a = bf2f(kq[j] & 0xffffu) * (j < 2 ? k0[2 * j] : k1[2 * j - 4]), c = bf2f(kq[j] >> 16) * (j < 2 ? k0[2 * j + 1] : k1[2 * j - 3]); n2 += a * a + c * c; } }
    n2 += swap32(n2);
    const float inv = 1.f / fmaxf(sqrtf(n2), 1e-12f);
    float bon = 0.f;
#pragma unroll
    for (int blk = 0; blk < 2; ++blk) {
        const bf16_t* wb = wc + (size_t)blk * 32 * 256;
        f32x16 aW = {}, aA = {};
#pragma unroll
        for (int ks = 0; ks < 4; ++ks) aW = MFMA32(*(const bf16x8*)(wb + 16 * ks), *(const LAS bf16x8*)(L + RG_ACT + ks * 1024 + lane * 16), aW);
#pragma unroll
        for (int ks = 4; ks < 8; ++ks) aA = MFMA32(*(const bf16x8*)(wb + 16 * ks), *(const LAS bf16x8*)(L + RG_ACT + ks * 1024 + lane * 16), aA);
#pragma unroll
        for (int s = 0; s < 2; ++s) {
            float e_kat[8], e_rt[8], e_kt[8], e_bt[8], e_kb[8], e_bb[8];
#pragma unroll
            for (int q = 0; q < 2; ++q) { const int g = 2 * s + q, cl = 32 * blk + 8 * g + 4 * h2;
                const u32x2 rq = *(const LAS u32x2*)(TR + cl * 2), kq = *(const LAS u32x2*)(TK + cl * 2), vq = *(const LAS u32x2*)(TV + cl * 2);
                const float rv[4] = {bf2f(rq.x & 0xffffu), bf2f(rq.x >> 16), bf2f(rq.y & 0xffffu), bf2f(rq.y >> 16)}, kv[4] = {bf2f(kq.x & 0xffffu), bf2f(kq.x >> 16), bf2f(kq.y & 0xffffu), bf2f(kq.y >> 16)};
                const f32x4 w0v = *(const LAS f32x4*)(PAR + cl), a0v = *(const LAS f32x4*)(PAR + 256 + cl), kav = *(const LAS f32x4*)(PAR + 512 + cl), rkv = *(const LAS f32x4*)(PAR + 768 + cl), kwv = *(const LAS f32x4*)(PAR + 1024 + cl);
#pragma unroll
                for (int j = 0; j < 4; ++j) { const int r = 4 * g + j, jj = 4 * q + j;
                    const float w = -softplusf_(-(w0v[j] + aW[r])) - 0.5f;
                    const float l2d = -LOG2E * ex2(w * LOG2E);
                    const float a = sigmoidf_(a0v[j] + aA[r]);
                    const float kkv = kv[j] * kwv[j] * inv, bev = kkv * a, kpv = kv[j] * (1.f + (a - 1.f) * kav[j]);
                    bon += rv[j] * kpv * rkv[j];
                    const float Li = scan32(l2d), Lex = Li - l2d, LC = __shfl(Li, 31 + 32 * h2);
                    const float pin = ex2(Li), pex = ex2(Lex), pinv = ex2(-Li), pc = ex2(LC - Li);
                    e_kat[jj] = kkv * pex; e_rt[jj] = rv[j] * pin; e_kt[jj] = kpv * pinv; e_bt[jj] = bev * pinv; e_kb[jj] = kpv * pc; e_bb[jj] = bev * pc;
                    if (r32 == 31) *(LAS float*)(W + RC_PC + (cl + j) * 4) = ex2(LC); }
                *(LAS u32x2*)(W + RC_V + r32 * RC_ROWB + cl * 2) = vq;
                *(LAS u32x2*)(W + RC_KB + r32 * RC_ROWB + cl * 2) = (u32x2){pk2(e_kb[4 * q], e_kb[4 * q + 1]), pk2(e_kb[4 * q + 2], e_kb[4 * q + 3])};
                *(LAS u32x2*)(W + RC_BB + r32 * RC_ROWB + cl * 2) = (u32x2){pk2(e_bb[4 * q], e_bb[4 * q + 1]), pk2(e_bb[4 * q + 2], e_bb[4 * q + 3])};
                *(LAS u32x2*)(W + RC_KT + r32 * RC_ROWB + cl * 2) = (u32x2){pk2(e_kat[4 * q], e_kat[4 * q + 1]), pk2(e_kat[4 * q + 2], e_kat[4 * q + 3])};
            }
            { const int ks = 2 * blk + s; FRr[ks * 4 + 0] = __builtin_bit_cast(u32x4, pk8f(e_kat)); FRr[ks * 4 + 1] = __builtin_bit_cast(u32x4, pk8f(e_rt)); FRr[ks * 4 + 2] = __builtin_bit_cast(u32x4, pk8f(e_kt)); FRr[ks * 4 + 3] = __builtin_bit_cast(u32x4, pk8f(e_bt)); }
        }
        f32x16 aG = {};
#pragma unroll
        for (int ks = 8; ks < 16; ++ks) aG = MFMA32(*(const bf16x8*)(wb + 16 * ks), *(const LAS bf16x8*)(L + RG_ACT + ks * 1024 + lane * 16), aG);
#pragma unroll
        for (int g = 0; g < 4; ++g) { const int cl = 32 * blk + 8 * g + 4 * h2; u32x2 gq;
            gq.x = pk2(aG[4 * g], aG[4 * g + 1]); gq.y = pk2(aG[4 * g + 2], aG[4 * g + 3]);
            *(u32x2*)(WSP(bf16_t, WS_GBUF) + (size_t)tok * 256 + 64 * hd + cl) = gq; }
    }
    asm volatile("s_waitcnt lgkmcnt(0)" ::: "memory");
    asm volatile("" ::: "memory"); __builtin_amdgcn_s_barrier(); asm volatile("" ::: "memory");
    bon += swap32(bon);
    asm volatile("" ::: "memory");
#pragma unroll
    for (int blk = 0; blk < 2; ++blk)
#pragma unroll
        for (int g = 0; g < 4; ++g) { const int cl = 32 * blk + 8 * g + 4 * h2; const u32x2 vq = *(const LAS u32x2*)(W + RC_V + r32 * RC_ROWB + cl * 2); u32x2 q;
            q.x = pk2(bon * bf2f(vq.x & 0xffffu), bon * bf2f(vq.x >> 16)); q.y = pk2(bon * bf2f(vq.y & 0xffffu), bon * bf2f(vq.y >> 16));
            *(u32x2*)(WSP(bf16_t, WS_BONV) + (size_t)tok * 256 + 64 * hd + cl) = q; }
    const float pc_lo = *(const LAS float*)(W + RC_PC + r32 * 4), pc_hi = *(const LAS float*)(W + RC_PC + (32 + r32) * 4);
    bf16x8 akkf[2], arkf[2], arbf[2];
    f32x16 Tt;
    {
        f32x16 skk = {}, skb = {}, sl = {};
#pragma unroll
        for (int ks = 0; ks < 4; ++ks) { const bf16x8 katf = __builtin_bit_cast(bf16x8, FRr[ks * 4 + 0]), ktf = __builtin_bit_cast(bf16x8, FRr[ks * 4 + 2]), btf = __builtin_bit_cast(bf16x8, FRr[ks * 4 + 3]);
            skk = MFMA32(ktf, katf, skk); skb = MFMA32(btf, katf, skb); sl = MFMA32(katf, btf, sl); }
#pragma unroll
        for (int r = 0; r < 16; ++r) { const int i = crow(r, h2); if (i >= r32) { skk[r] = 0.f; skb[r] = 0.f; } if (i <= r32) sl[r] = 0.f; }
#pragma unroll
        for (int s = 0; s < 2; ++s) akkf[s] = pack8(skk, s);
        bf16x8 fx[2], fxt[2];
#pragma unroll
        for (int s = 0; s < 2; ++s) { fx[s] = pack8(sl, s); fxt[s] = pack8(skb, s); }
#pragma unroll
        for (int r = 0; r < 16; ++r) Tt[r] = ((crow(r, h2) == r32) ? 1.f : 0.f) - skb[r];
#pragma unroll
        for (int lvl = 0; lvl < 4; ++lvl) {
            f32x16 p = {}, pt = {};
#pragma unroll
            for (int s = 0; s < 2; ++s) { p = MFMA32(fxt[s], fx[s], p); if (lvl < 3) pt = MFMA32(fx[s], fxt[s], pt); }
#pragma unroll
            for (int s = 0; s < 2; ++s) fx[s] = pack8(p, s);
            const bf16x8 t0 = pack8(Tt, 0), t1 = pack8(Tt, 1);
            Tt = MFMA32(fx[0], t0, Tt); Tt = MFMA32(fx[1], t1, Tt);
            if (lvl < 3) {
#pragma unroll
                for (int s = 0; s < 2; ++s) fxt[s] = pack8(pt, s); }
        }
    }
    {
        f32x16 srk = {}, srb = {};
#pragma unroll
        for (int ks = 0; ks < 4; ++ks) { const bf16x8 rtf = __builtin_bit_cast(bf16x8, FRr[ks * 4 + 1]), ktf = __builtin_bit_cast(bf16x8, FRr[ks * 4 + 2]), btf = __builtin_bit_cast(bf16x8, FRr[ks * 4 + 3]);
            srk = MFMA32(ktf, rtf, srk); srb = MFMA32(btf, rtf, srb); }
#pragma unroll
        for (int r = 0; r < 16; ++r) if (crow(r, h2) > r32) { srk[r] = 0.f; srb[r] = 0.f; }
#pragma unroll
        for (int s = 0; s < 2; ++s) { arkf[s] = pack8(srk, s); arbf[s] = pack8(srb, s); }
    }
    asm volatile("" ::: "memory");
    bf16x8 ng1f[2][2], ng2f[2][2];
    {
        const bf16x8 tf0 = pack8(Tt, 0), tf1 = pack8(Tt, 1);
#pragma unroll
        for (int cb = 0; cb < 2; ++cb) {
            f32x16 g = {};
            g = MFMA32(tf0, rc_trfrag(W + RC_KT, lane, 0, cb), g); g = MFMA32(tf1, rc_trfrag(W + RC_KT, lane, 1, cb), g);
#pragma unroll
            for (int r = 0; r < 16; ++r) g[r] = -g[r];
            ng1f[cb][0] = pack8(g, 0); ng1f[cb][1] = pack8(g, 1);
        }
#pragma unroll
        for (int vb = 0; vb < 2; ++vb) {
            f32x16 x1 = {};
#pragma unroll
            for (int s = 0; s < 2; ++s) x1 = MFMA32(akkf[s], rc_trfrag(W + RC_V, lane, s, vb), x1);
            f32x16 g = {};
            g = MFMA32(tf0, pack8(x1, 0), g); g = MFMA32(tf1, pack8(x1, 1), g);
#pragma unroll
            for (int r = 0; r < 16; ++r) g[r] = -g[r];
            ng2f[vb][0] = pack8(g, 0); ng2f[vb][1] = pack8(g, 1);
        }
    }
    asm volatile("" ::: "memory");
    u32x4* mt = WSP(u32x4, WS_CHMT) + (size_t)chunk * 8 * 64 + lane;
#pragma unroll
    for (int bip = 0; bip < 2; ++bip)
#pragma unroll
        for (int bi = 0; bi < 2; ++bi) {
            f32x16 m = {};
#pragma unroll
            for (int s = 0; s < 2; ++s) m = MFMA32(ng1f[bi][s], rc_trfrag(W + RC_BB, lane, s, bip), m);
            if (bi == bip) {
#pragma unroll
                for (int r = 0; r < 16; ++r) if (crow(r, h2) == r32) m[r] += (bi ? pc_hi : pc_lo); }
#pragma unroll
            for (int s = 0; s < 2; ++s) mt[(bip * 4 + bi * 2 + s) * 64] = __builtin_bit_cast(u32x4, pack8(m, s));
        }
    asm volatile("" ::: "memory");
    u32x4* nb_ = WSP(u32x4, WS_CHN) + (size_t)chunk * 8 * 64 + lane;
#pragma unroll
    for (int vb = 0; vb < 2; ++vb)
#pragma unroll
        for (int bip = 0; bip < 2; ++bip) {
            f32x16 n = {};
#pragma unroll
            for (int s = 0; s < 2; ++s) { n = MFMA32(rc_trfrag(W + RC_KB, lane, s, bip), rc_trfrag(W + RC_V, lane, s, vb), n); n = MFMA32(rc_trfrag(W + RC_BB, lane, s, bip), ng2f[vb][s], n); }
#pragma unroll
            for (int s = 0; s < 2; ++s) nb_[((vb * 2 + bip) * 2 + s) * 64] = __builtin_bit_cast(u32x4, pack8(n, s));
        }
    asm volatile("" ::: "memory");
    u32x4* ry = WSP(u32x4, WS_CHRY) + (size_t)chunk * 4 * 64 + lane;
#pragma unroll
    for (int bi = 0; bi < 2; ++bi) {
        f32x16 q = {};
#pragma unroll
        for (int s = 0; s < 2; ++s) q = MFMA32(ng1f[bi][s], arbf[s], q);
#pragma unroll
        for (int s = 0; s < 2; ++s) { const u32x4 rq = FRr[(2 * bi + s) * 4 + 1]; float o[8];
#pragma unroll
            for (int j = 0; j < 4; ++j) { o[2 * j] = q[8 * s + 2 * j] + bf2f(rq[j] & 0xffffu); o[2 * j + 1] = q[8 * s + 2 * j + 1] + bf2f(rq[j] >> 16); }
            ry[(bi * 2 + s) * 64] = __builtin_bit_cast(u32x4, pk8f(o)); }
    }
    asm volatile("" ::: "memory");
    u32x4* y0 = WSP(u32x4, WS_CHY0) + (size_t)chunk * 4 * 64 + lane;
#pragma unroll
    for (int vb = 0; vb < 2; ++vb) {
        f32x16 yy = {};
#pragma unroll
        for (int s = 0; s < 2; ++s) { yy = MFMA32(arkf[s], rc_trfrag(W + RC_V, lane, s, vb), yy); yy = MFMA32(arbf[s], ng2f[vb][s], yy); }
#pragma unroll
        for (int s = 0; s < 2; ++s) y0[(vb * 2 + s) * 64] = __builtin_bit_cast(u32x4, pack8(yy, s));
    }
    asm volatile("s_waitcnt lgkmcnt(0)" ::: "memory");
}
DI void unpack16(const u32x4& a, const u32x4& b, f32x16& o) {
#pragma unroll
    for (int j = 0; j < 4; ++j) { o[2 * j] = bf2f(a[j] & 0xffffu); o[2 * j + 1] = bf2f(a[j] >> 16); o[8 + 2 * j] = bf2f(b[j] & 0xffffu); o[8 + 2 * j + 1] = bf2f(b[j] >> 16); }
}
constexpr int SQ_BH = 24576, SQ_STAGE = 2 * SQ_BH;
DI void rw_seq_wg(Frame& F, int item, unsigned* sd) {
    LAS unsigned char* L = F.lds; const int lane = F.lane, wid = F.wave, r32 = lane & 31, h2 = lane >> 5;
    __syncthreads();
    if (wid >= 4) {
        const int slot = (wid - 4) >> 1, half = (wid - 4) & 1, bh = 2 * item + slot;
        const u32x4* mtb = WSP(u32x4, WS_CHMT) + (size_t)bh * 64 * 8 * 64 + lane;
        const u32x4* nbb = WSP(u32x4, WS_CHN) + (size_t)bh * 64 * 8 * 64 + lane;
        const u32x4* ryb = WSP(u32x4, WS_CHRY) + (size_t)bh * 64 * 4 * 64 + lane;
        const u32x4* y0b = WSP(u32x4, WS_CHY0) + (size_t)bh * 64 * 4 * 64 + lane;
#define SQ_ISSUE(CH) do { const int ch_ = (CH); LAS unsigned char* st_ = L + (ch_ % 3) * SQ_STAGE + slot * SQ_BH; \
            if (half == 0) { _Pragma("unroll") for (int i = 0; i < 8; ++i) __builtin_amdgcn_global_load_lds((const unsigned*)(mtb + (size_t)ch_ * 512 + i * 64), (LAS unsigned*)(st_ + i * 1024), 16, 0, 0); \
                             _Pragma("unroll") for (int i = 0; i < 4; ++i) __builtin_amdgcn_global_load_lds((const unsigned*)(ryb + (size_t)ch_ * 256 + i * 64), (LAS unsigned*)(st_ + (8 + i) * 1024), 16, 0, 0); } \
            else { _Pragma("unroll") for (int i = 0; i < 8; ++i) __builtin_amdgcn_global_load_lds((const unsigned*)(nbb + (size_t)ch_ * 512 + i * 64), (LAS unsigned*)(st_ + (12 + i) * 1024), 16, 0, 0); \
                   _Pragma("unroll") for (int i = 0; i < 4; ++i) __builtin_amdgcn_global_load_lds((const unsigned*)(y0b + (size_t)ch_ * 256 + i * 64), (LAS unsigned*)(st_ + (20 + i) * 1024), 16, 0, 0); } } while (0)
        SQ_ISSUE(0); SQ_ISSUE(1);
        asm volatile("s_waitcnt vmcnt(12)" ::: "memory");
        __builtin_amdgcn_s_barrier();
#pragma unroll 1
        for (int ch = 0; ch < 64; ++ch) {
            if (ch + 2 < 64) { SQ_ISSUE(ch + 2); asm volatile("s_waitcnt vmcnt(12)" ::: "memory"); }
            else asm volatile("s_waitcnt vmcnt(0)" ::: "memory");
            __builtin_amdgcn_s_barrier();
        }
#undef SQ_ISSUE
    } else {
        const int slot = wid >> 1, vb = wid & 1, bh = 2 * item + slot;
        f32x16 H0 = {}, H1 = {};
        float* yb = WSP(float, WS_YBUF) + (size_t)(bh >> 2) * SEQ * 256 + (bh & 3) * 64 + 32 * vb + r32;
        __builtin_amdgcn_s_barrier();
#pragma unroll 1
        for (int ch = 0; ch < 64; ++ch) {
            const LAS unsigned char* st = L + (ch % 3) * SQ_STAGE + slot * SQ_BH + lane * 16;
            u32x4 cmt[8], cry[4], cnn[4], cy0[2];
#pragma unroll
            for (int i = 0; i < 8; ++i) cmt[i] = *(const LAS u32x4*)(st + i * 1024);
#pragma unroll
            for (int i = 0; i < 4; ++i) { cry[i] = *(const LAS u32x4*)(st + (8 + i) * 1024); cnn[i] = *(const LAS u32x4*)(st + (12 + 4 * vb + i) * 1024); }
            cy0[0] = *(const LAS u32x4*)(st + (20 + 2 * vb) * 1024); cy0[1] = *(const LAS u32x4*)(st + (21 + 2 * vb) * 1024);
            bf16x8 hb[4]; hb[0] = pack8(H0, 0); hb[1] = pack8(H0, 1); hb[2] = pack8(H1, 0); hb[3] = pack8(H1, 1);
            f32x16 y, n0, n1;
            unpack16(cy0[0], cy0[1], y); unpack16(cnn[0], cnn[1], n0); unpack16(cnn[2], cnn[3], n1);
            asm volatile("s_waitcnt lgkmcnt(0)" ::: "memory");
#pragma unroll
            for (int ks = 0; ks < 4; ++ks) { n0 = MFMA32(__builtin_bit_cast(bf16x8, cmt[ks]), hb[ks], n0); n1 = MFMA32(__builtin_bit_cast(bf16x8, cmt[4 + ks]), hb[ks], n1); y = MFMA32(__builtin_bit_cast(bf16x8, cry[ks]), hb[ks], y); }
            H0 = n0; H1 = n1;
#pragma unroll
            for (int r = 0; r < 16; ++r) yb[(size_t)(32 * ch + crow(r, h2)) * 256] = y[r];
            __builtin_amdgcn_s_barrier();
        }
        asm volatile("s_waitcnt vmcnt(0)" ::: "memory");
    }
    __syncthreads();
    if (F.tid == 0) {
        __builtin_amdgcn_fence(__ATOMIC_RELEASE, "agent");
        asm volatile("s_waitcnt vmcnt(0)" ::: "memory");
        (void)xb_add(sd, 1u);
    }
}
template <int NB> DI void rw_post_batch(Frame& F, int layer, int w0, int ws) {
    const int lane = F.lane;
    float y[NB], bv[NB], g[NB]; int tokv[NB], cv[NB];
#pragma unroll
    for (int i = 0; i < NB; ++i) { const int w = w0 + i * ws; tokv[i] = w >> 2; cv[i] = 64 * (w & 3) + lane;
        y[i] = WSP(float, WS_YBUF)[(size_t)tokv[i] * 256 + cv[i]];
        bv[i] = bf2f(WSP(bf16_t, WS_BONV)[(size_t)tokv[i] * 256 + cv[i]]); g[i] = bf2f(WSP(bf16_t, WS_GBUF)[(size_t)tokv[i] * 256 + cv[i]]); }
#pragma unroll
    for (int i = 0; i < NB; ++i) {
        const float mean = wave_sum(y[i]) * (1.f / 64.f), dv = y[i] - mean, var = wave_sum(dv * dv) * (1.f / 64.f);
        const float yn = dv * __builtin_amdgcn_rsqf(var + 64e-5f) * F.in[14][layer * 256 + cv[i]] + F.in[15][layer * 256 + cv[i]];
        WSP(bf16_t, WS_MIX)[(size_t)tokv[i] * D + 512 + cv[i]] = (bf16_t)f2bf((yn + bv[i]) * g[i]);
    }
}

constexpr int RT_WSTR = 1028;
DI void p4_router(Frame& F, int layer, bool dry) {
    LAS unsigned char* L = F.lds; const int tid = F.tid, lane = F.lane, wid = F.wave, m16 = lane & 15, q4 = lane >> 4;
    LAS float* W = (LAS float*)L;
    LAS float* wlog = (LAS float*)L + wid * (16 * 49);
    LAS int* ent = (LAS int*)(L + 148032);
    LAS float* entg = (LAS float*)(L + 148032 + 4096);
    LAS int* lcnt = (LAS int*)(L + 148032 + 5120);
    LAS int* lbase = lcnt + 144;
    const float* x = F.out; bf16_t* xb = WSP(bf16_t, WS_XB);
    const float *bg = F.in[20] + layer * 4, *be = F.in[22] + layer * 32;
    unsigned* cnt = (unsigned*)(F.ws + WS_CTL) + CW_CNT + layer * 256;
    int* elist = WSP(int, WS_LIST); float* egate = WSP(float, WS_GLIST); u32x2* plist = WSP(u32x2, WS_PLIST);
    for (int blk = F.bid; blk < NT / 128; blk += F.G) {
        __syncthreads();
        { const f32x4* src = (const f32x4*)(WSP(float, WS_RTW) + (size_t)layer * 36 * 1024);
          for (int i = tid; i < 36 * 256; i += 512) *(LAS f32x4*)(W + (i >> 8) * RT_WSTR + 4 * (i & 255)) = src[i]; }
        if (tid < 144) lcnt[tid] = 0;
        __syncthreads();
        const int row0 = blk * 128 + wid * 16;
        const float* xr = x + (size_t)(row0 + m16) * D + 4 * q4; bf16_t* xbr = xb + (size_t)(row0 + m16) * D + 4 * q4;
        f32x4 a0 = {}, a1 = {}, a2 = {}; float ssq = 0.f;
        const LAS float* w0p = W + (size_t)m16 * RT_WSTR + 4 * q4; const LAS float* w1p = w0p + 16 * RT_WSTR; const LAS float* w2p = W + (size_t)(32 + (m16 & 3)) * RT_WSTR + 4 * q4;
        const bool v2 = m16 < 4;
#pragma unroll 16
        for (int j = 0; j < 64; ++j) {
            const f32x4 xv = *(const f32x4*)(xr + 16 * j);
            const f32x4 wa = *(const LAS f32x4*)(w0p + 16 * j), wb = *(const LAS f32x4*)(w1p + 16 * j); f32x4 wc_ = *(const LAS f32x4*)(w2p + 16 * j);
            if (!v2) wc_ = (f32x4){0.f, 0.f, 0.f, 0.f};
            ssq += (xv[0] * xv[0] + xv[1] * xv[1]) + (xv[2] * xv[2] + xv[3] * xv[3]);
            u32x2 w; w.x = pk2(xv[0], xv[1]); w.y = pk2(xv[2], xv[3]); *(u32x2*)(xbr + 16 * j) = w;
#pragma unroll
            for (int i = 0; i < 4; ++i) { a0 = __builtin_amdgcn_mfma_f32_16x16x4f32(xv[i], wa[i], a0, 0, 0, 0); a1 = __builtin_amdgcn_mfma_f32_16x16x4f32(xv[i], wb[i], a1, 0, 0, 0); a2 = __builtin_amdgcn_mfma_f32_16x16x4f32(xv[i], wc_[i], a2, 0, 0, 0); }
        }
        ssq += __shfl_xor(ssq, 16); ssq += __shfl_xor(ssq, 32);
        __syncthreads();
#pragma unroll
        for (int jj = 0; jj < 4; ++jj) { wlog[(4 * q4 + jj) * 49 + m16] = a0[jj]; wlog[(4 * q4 + jj) * 49 + 16 + m16] = a1[jj]; wlog[(4 * q4 + jj) * 49 + 32 + m16] = a2[jj]; }
        asm volatile("s_waitcnt lgkmcnt(0)" ::: "memory");
        if (lane < 16) {
            const int r = lane, row = row0 + r;
            const float rstd = __builtin_amdgcn_rsqf(ssq * (1.f / 1024.f) + 1e-6f);
            WSP(float, WS_RSTD2)[row] = rstd;
            float gl[4]; int gs = 0; float gmax;
#pragma unroll
            for (int j = 0; j < 4; ++j) gl[j] = wlog[r * 49 + j] * rstd + bg[j];
            gmax = gl[0];
#pragma unroll
            for (int j = 1; j < 4; ++j) if (gl[j] > gmax) { gmax = gl[j]; gs = j; }
            float gsum = 0.f;
#pragma unroll
            for (int j = 0; j < 4; ++j) gsum += ex2((gl[j] - gmax) * LOG2E);
            const float ggate = 1.f / gsum;
            float el[8];
#pragma unroll
            for (int j = 0; j < 8; ++j) el[j] = wlog[r * 49 + 4 + gs * 8 + j] * rstd + be[gs * 8 + j];
            int i0 = 0; float m0 = el[0];
#pragma unroll
            for (int j = 1; j < 8; ++j) if (el[j] > m0) { m0 = el[j]; i0 = j; }
            int i1 = -1; float m1 = -3.0e38f;
#pragma unroll
            for (int j = 0; j < 8; ++j) if (j != i0 && (i1 < 0 || el[j] > m1)) { m1 = el[j]; i1 = j; }
            const float e1 = ex2((m1 - m0) * LOG2E), g0 = ggate / (1.f + e1), g1 = ggate * e1 / (1.f + e1);
            const int la = i0 < i1 ? i0 : i1, lb = i0 < i1 ? i1 : i0; const float ga = i0 < i1 ? g0 : g1, gb = i0 < i1 ? g1 : g0;
            const int ea = gs * 8 + la, eb = gs * 8 + lb, pid = gs * 28 + la * (15 - la) / 2 + (lb - la - 1);
            const int ra = atomicAdd((int*)&lcnt[ea], 1), rb = atomicAdd((int*)&lcnt[eb], 1), rp = atomicAdd((int*)&lcnt[32 + pid], 1);
            const int li = wid * 16 + r;
            ent[li * 8 + 0] = ea; ent[li * 8 + 1] = eb; ent[li * 8 + 2] = pid; ent[li * 8 + 3] = ra; ent[li * 8 + 4] = rb; ent[li * 8 + 5] = rp; entg[li * 2] = ga; entg[li * 2 + 1] = gb;
        }
        __syncthreads();
        if (tid < 144) { const int n = lcnt[tid]; lbase[tid] = (n && !dry) ? (int)xb_add(cnt + tid, (unsigned)n) : 0; }
        __syncthreads();
        if (tid < 128 && !dry) { const int row = blk * 128 + tid; const int ea = ent[tid * 8], eb = ent[tid * 8 + 1], pid = ent[tid * 8 + 2];
            const int pa = lbase[ea] + ent[tid * 8 + 3], pb = lbase[eb] + ent[tid * 8 + 4], pp = lbase[32 + pid] + ent[tid * 8 + 5];
            elist[(size_t)ea * LCAP + pa] = row; egate[(size_t)ea * LCAP + pa] = entg[tid * 2];
            elist[(size_t)eb * LCAP + pb] = row; egate[(size_t)eb * LCAP + pb] = entg[tid * 2 + 1];
            plist[(size_t)pid * LCAP + pp] = (u32x2){(unsigned)row, (unsigned)pa | ((unsigned)pb << 16)}; }
    }
    __syncthreads();
}
DI void moe_tables(Frame& F, int layer) {
    LAS MoeTab* T = (LAS MoeTab*)(F.lds + LDS_AUX);
    unsigned* cnt = (unsigned*)(F.ws + WS_CTL) + CW_CNT + layer * 256;
    __syncthreads();
    if (F.tid < 32) T->ce[F.tid] = (int)xb_ld(cnt + F.tid); else if (F.tid < 144) T->cp[F.tid - 32] = (int)xb_ld(cnt + F.tid);
    __syncthreads();
    if (F.tid == 0) { int sb = 0, tg = 0;
        for (int e = 0; e < 32; ++e) { const int a = T->ce[e]; T->sb[e] = sb; T->tpg[e] = tg; sb += a; tg += (a + 255) >> 8; }
        T->tpg[32] = tg; }
    if (F.tid == 64) { int tf = 0, th = 0;
        for (int p = 0; p < 112; ++p) { const int n = T->cp[p], nt_ = (n + 255) >> 8, half = (nt_ > 0 && n - 256 * (nt_ - 1) <= 128) ? 1 : 0; T->tpf[p] = tf; T->tph[p] = th; tf += nt_ - half; th += half; }
        T->tpf[112] = tf; T->tph[112] = th; }
    __syncthreads();
}
DI void p_final(Frame& F) {
    const int gw = F.bid * 8 + F.wave, NGW = F.G * 8; const f32x4* gq = (const f32x4*)F.in[26] + F.lane;
    f32x4 gv[4];
#pragma unroll
    for (int j = 0; j < 4; ++j) gv[j] = gq[64 * j];
    for (int m0 = gw * 4; m0 < NT; m0 += NGW * 4) {
        f32x4 v[4][4];
#pragma unroll
        for (int r = 0; r < 4; ++r) { const f32x4* xr = (const f32x4*)(F.out + (size_t)(m0 + r) * D) + F.lane;
#pragma unroll
            for (int j = 0; j < 4; ++j) v[r][j] = xr[64 * j]; }
#pragma unroll
        for (int r = 0; r < 4; ++r) { float s = 0.f; f32x4* xw = (f32x4*)(F.out + (size_t)(m0 + r) * D) + F.lane;
#pragma unroll
            for (int j = 0; j < 4; ++j) s += (v[r][j][0] * v[r][j][0] + v[r][j][1] * v[r][j][1]) + (v[r][j][2] * v[r][j][2] + v[r][j][3] * v[r][j][3]);
            const float rstd = __builtin_amdgcn_rsqf(wave_sum(s) * (1.f / 1024.f) + 1e-6f);
#pragma unroll
            for (int j = 0; j < 4; ++j) xw[64 * j] = v[r][j] * rstd * gv[j]; }
    }
}


#ifndef DUP_PH
#define DUP_PH -1
#endif
#define NREP(n) ((DUP_PH == (n)) ? 2 : 1)
constexpr int PH_PER_LAYER = 6, N_PHASES = 1 + DEPTH * PH_PER_LAYER + 1;
__global__ void __launch_bounds__(512, 2) mk_fwd(Args args) {
    extern __shared__ __attribute__((aligned(16))) unsigned char lds_raw[];
    Frame F;
    F.lds = (LAS unsigned char*)lds_raw; F.tid = threadIdx.x; F.lane = F.tid & 63; F.wave = __builtin_amdgcn_readfirstlane(F.tid >> 6);
    F.G = gridDim.x; F.bid = blockIdx.x; F.in = (const __attribute__((address_space(4))) cfp_t*)__builtin_amdgcn_kernarg_segment_ptr(); F.out = args.out; F.ws = args.ws;
    volatile LAS unsigned* MISC = (volatile LAS unsigned*)(F.lds + LDS_MISC);
    if (F.tid < 64) MISC[F.tid] = 0u;
    __syncthreads();
    unsigned* ctl = (unsigned*)(F.ws + WS_CTL);
    const int lo = args.ph_lo, hi = args.ph_hi;
    const bool multi = (hi - lo) > 1;
    XcdBarrier bar; bar.bar = ctl + CW_BAR; bar.x = 0; bar.st = nullptr;
    if (multi) bar = xcd_barrier_post(ctl + CW_BAR, MISC + 8);
#ifndef PHSEL
#define PHSEL -1
#endif
#ifndef PHMASK
#define PHMASK 0xFFFF
#endif
#define PS(n) ((PHSEL < 0 || PHSEL == (n)) && ((PHMASK >> (n)) & 1))
#define LAUNDER() do { asm volatile("" : "+s"(F.in)); asm volatile("" : "+s"(F.ws)); asm volatile("" : "+s"(F.out)); asm volatile("" : "+v"(F.tid)); asm volatile("" : "+v"(F.lane)); asm volatile("" : "+s"(F.bid)); asm volatile("" : "+s"(F.G)); } while (0)
#define IN(k) (lo <= (k) && (k) < hi)
#define SEAM(k) do { if (IN(k) && IN((k) + 1)) { xcd_barrier(bar); if (DUP_PH == 99) xcd_barrier(bar); } LAUNDER(); } while (0)
    LAUNDER();
    if (PS(0) && IN(0)) { _Pragma("unroll 1") for (int rep = 0; rep < NREP(0); ++rep) p0_prologue(F); }
    SEAM(0);
#pragma unroll 1
    for (int layer = 0; layer < DEPTH; ++layer) {
        const int pb = 1 + layer * PH_PER_LAYER;
        LAUNDER();
        if (PS(1) && IN(pb + 0)) _Pragma("unroll 1") for (int rep = 0; rep < NREP(1); ++rep) {
            ProbIn P; P.K = D; P.A = WSP(bf16_t, WS_XB); P.Bt = WSP(bf16_t, WS_BIN) + (size_t)layer * NIN * D; P.G = F.G; P.c = F.bid;
            P.Pout = WSP(bf16_t, WS_P); P.ss1 = WSP(float, WS_SS1); P.lf = WSP(float, WS_LF); P.bfx = F.in[16] + layer * 4; P.kmax = (unsigned*)(F.ws + WS_CTL) + CW_KMAX + layer * 128;
            pg8::gemm_phase<ProbIn, true>(F.lds, P, F.tid);
        }
        SEAM(pb + 0);
        if (IN(pb + 1)) _Pragma("unroll 1") for (int rep = 0; rep < NREP(2); ++rep) {
            if (PS(4)) {
                __syncthreads();
                { LAS float* PARW = (LAS float*)(F.lds + RG_PAR);
                  for (int i = F.tid; i < 1280; i += 512) { const int a = i >> 8, c = i & 255; PARW[i] = F.in[a == 0 ? 6 : (a == 1 ? 8 : (a == 2 ? 12 : (a == 3 ? 13 : 11)))][layer * 256 + c]; } }
                __syncthreads();
                _Pragma("unroll 1") for (int it = F.bid; it < 1024; it += F.G) { if (F.wave < 4) rw_group_compute(F, layer, it); else rw_group_loader(F, layer, it); }
                __syncthreads();
            }
        }
        if (IN(pb + 1)) {
            unsigned* r1d = (unsigned*)(F.ws + WS_CTL) + CW_R1D + layer * 2048;
            xcd_arrive(bar, r1d);
            bool fxw = false;
            unsigned* sdw = (unsigned*)(F.ws + WS_CTL) + CW_SD + layer * 64;
            if (PS(5)) { if (F.G >= 64) { if (F.bid < 32) { xcd_wait_all(bar, r1d); rw_seq_wg(F, F.bid, sdw); } } else { xcd_wait_all(bar, r1d); for (int i = F.bid; i < 32; i += F.G) rw_seq_wg(F, i, sdw); } }
            unsigned* wq = (unsigned*)(F.ws + WS_CTL) + CW_WQ + layer * 64;
            volatile LAS int* qslot = (volatile LAS int*)(F.lds + LDS_MISC + 64);
            __syncthreads();
            if (F.tid == 0) qslot[0] = (int)xb_add(wq, 1u);
            __syncthreads();
            int q = qslot[0];
#pragma unroll 1
            for (;;) {
                if (q >= 1024 + 256 + 256) break;
                unsigned nq = 0u; if (F.tid == 0) nq = xb_add(wq, 1u);
                LAUNDER();
                if (q < 512) { if (PS(6)) sb_unit(F, (q & 63) >> 2, q & 3, 7 - (q >> 6)); }
                else if (q < 1024) { const int r = q - 512; if (!fxw) { xcd_wait_all(bar, r1d); fxw = true; } if (PS(2)) fx_unit(F, layer, (r & 63) >> 2, r & 3, 7 - (r >> 6)); }
                else if (q < 1280) { if (PS(3)) _Pragma("unroll 1") for (int k = 0; k < 4; ++k) { const int i = 4 * (q - 1024) + k; gm_unit(F, layer, i >> 6, (i >> 2) & 15, i & 3); } }
                else if (PS(7)) {
                    if (F.tid == 0) { unsigned sp = 0; while (xb_ld(sdw) < 32u) { __builtin_amdgcn_s_sleep(2); if (++sp > (1u << 22)) break; }
                        __builtin_amdgcn_fence(__ATOMIC_ACQUIRE, "agent"); asm volatile("s_waitcnt vmcnt(0)" ::: "memory"); }
                    __syncthreads();
                    const int w0 = (q - 1280) * 512 + F.wave;
                    _Pragma("unroll 1") for (int k = 0; k < 8; ++k) rw_post_batch<8>(F, layer, w0 + 64 * k, 8);
                }
                __syncthreads();
                if (F.tid == 0) qslot[0] = (int)nq;
                __syncthreads();
                q = qslot[0];
            }
        }
        SEAM(pb + 1);
        if (PS(8) && IN(pb + 2)) {
            ProbOut P; P.K = D; P.A = WSP(bf16_t, WS_MIX); P.Bt = WSP(bf16_t, WS_BOUT) + (size_t)layer * D * D; P.G = F.G; P.c = F.bid;
            P.base = (layer == 0) ? F.in[0] : F.out; P.out = F.out;
            if (DUP_PH == 8) { P.ascale = 0.f; P.base = F.out; pg8::gemm_phase<ProbOut, true>(F.lds, P, F.tid); P.base = (layer == 0) ? F.in[0] : F.out; }
            P.ascale = 1.f; pg8::gemm_phase<ProbOut, true>(F.lds, P, F.tid);
        }
        SEAM(pb + 2);
        if (PS(9) && IN(pb + 3)) { if (DUP_PH == 9) p4_router(F, layer, true); p4_router(F, layer, false); }
        SEAM(pb + 3);
        if (PS(10) && IN(pb + 4)) {
            moe_tables(F, layer);
            ProbGU P; P.K = D; P.A = WSP(bf16_t, WS_XB); P.Bt = WSP(bf16_t, WS_BGU) + (size_t)layer * NE * 1024 * D; P.G = F.G; P.c = F.bid;
            P.T = (const LAS MoeTab*)(F.lds + LDS_AUX); P.elist = WSP(int, WS_LIST); P.egate = WSP(float, WS_GLIST); P.rstd2 = WSP(float, WS_RSTD2); P.HB = WSP(bf16_t, WS_HB);
            pg8::gemm_phase<ProbGU, true>(F.lds, P, F.tid);
        }
        SEAM(pb + 4);
        if (PS(11) && IN(pb + 5)) {
            moe_tables(F, layer);
            ProbDP P; P.A = WSP(bf16_t, WS_HB); P.Bt = WSP(bf16_t, WS_BDN) + (size_t)layer * NE * D * EH; P.G = F.G; P.c = F.bid;
            P.T = (const LAS MoeTab*)(F.lds + LDS_AUX); P.plist = WSP(u32x2, WS_PLIST); P.x = F.out; P.xb = WSP(bf16_t, WS_XB); P.ss1 = WSP(float, WS_SS1);
            pg8::gemm_phase_pair<ProbDP>(F.lds, P, F.tid);
        }
        SEAM(pb + 5);
    }
    if (PS(13) && IN(N_PHASES - 1)) p_final(F);
#undef IN
#undef SEAM
}

#ifndef MK_ONE_LAUNCH
#define MK_ONE_LAUNCH 1
#endif
extern "C" void kernel_launch(void* const* d_in, const int* in_sizes, int n_in, void* d_out, int out_size, void* d_ws, size_t ws_size, hipStream_t stream) {
    static int grid = 0;
    if (grid == 0) {
        if (n_in != 27 || out_size != NT * D || ws_size < WS_END) { fprintf(stderr, "kernel_launch: unexpected shapes (n_in %d out %d ws %zu)\n", n_in, out_size, ws_size); grid = -1; return; }
        int dev = 0, cus = 0;
        if (hipGetDevice(&dev) != hipSuccess || hipDeviceGetAttribute(&cus, hipDeviceAttributeMultiprocessorCount, dev) != hipSuccess) { grid = -1; return; }
        if (hipFuncSetAttribute((const void*)mk_fwd, hipFuncAttributeMaxDynamicSharedMemorySize, LDS_BYTES) != hipSuccess) { fprintf(stderr, "kernel_launch: hipFuncSetAttribute failed\n"); grid = -1; return; }
        (void)hipGetLastError();
        grid = cus;
    }
    if (grid < 0) return;
    (void)hipMemsetAsync((char*)d_ws + WS_CTL, 0, CTL_BYTES, stream);
    Args a{};
    for (int i = 0; i < 27; ++i) a.in[i] = (const float*)d_in[i];
    a.out = (float*)d_out; a.ws = (unsigned char*)d_ws; a.li = 0; a.pad = 0;
#if MK_ONE_LAUNCH
    a.ph_lo = 0; a.ph_hi = N_PHASES;
    hipLaunchKernelGGL(mk_fwd, dim3(grid), dim3(512), LDS_BYTES, stream, a);
#else
    for (int p = 0; p < N_PHASES; ++p) { a.ph_lo = p; a.ph_hi = p + 1; hipLaunchKernelGGL(mk_fwd, dim3(grid), dim3(512), LDS_BYTES, stream, a); }
#endif
}
```

```cpp
#include <hip/hip_runtime.h>
#include <cstdio>
#include <cstdint>

#define DI __device__ __forceinline__
#define LAS __attribute__((address_space(3)))
#define GAS __attribute__((address_space(1)))
typedef unsigned short bf16_t;
typedef short bf16x8 __attribute__((ext_vector_type(8)));
typedef short s16x4 __attribute__((ext_vector_type(4)));
typedef float f32x2 __attribute__((ext_vector_type(2)));
typedef float f32x4 __attribute__((ext_vector_type(4)));
typedef float f32x16 __attribute__((ext_vector_type(16)));
typedef unsigned u32x2 __attribute__((ext_vector_type(2)));
typedef unsigned u32x4 __attribute__((ext_vector_type(4)));
typedef __bf16 bf16x2_t __attribute__((ext_vector_type(2)));
typedef GAS unsigned gu32;

constexpr int NT = 32768, SEQ = 2048, NB = 16, D = 1024, DEPTH = 4, NH = 4;
constexpr int PP = 3072;
constexpr int NIN = 3328;
constexpr int C_SBQ = 0, C_SBK = 256, C_SBV = 512, C_GMU = 768, C_GMV = 1024, C_RWR = 1280, C_RWK = 1536, C_RWV = 1792, C_RWX = 2048, C_FXQ = 2304, C_FXK = 2560, C_FXV = 2816;
constexpr int NE = 32, EH = 512;
constexpr float LOG2E = 1.4426950408889634f, LN2 = 0.6931471805599453f;
constexpr float QSCALE2 = 0.125f * LOG2E;

constexpr size_t MiB = 1u << 20;
constexpr size_t WS_CTL = 0, CTL_BYTES = 1 * MiB;
constexpr size_t WS_BIN = 1 * MiB;
constexpr size_t WS_BOUT = 28 * MiB;
constexpr size_t WS_BGU = 36 * MiB;
constexpr size_t WS_BDN = 292 * MiB;
constexpr size_t WS_WCAT = 420 * MiB;
constexpr size_t WS_RTW = 421 * MiB;
constexpr size_t WS_SS1 = 422 * MiB;
constexpr size_t WS_RSTD2 = 424 * MiB;
constexpr size_t WS_LF = 425 * MiB;
constexpr size_t WS_SCAL = 426 * MiB;
constexpr size_t WS_LIST = 428 * MiB;
constexpr size_t WS_GLIST = 436 * MiB;
constexpr size_t WS_GBUF = 444 * MiB;
constexpr size_t WS_YBUF = 460 * MiB;
constexpr size_t WS_MIX = 492 * MiB;
constexpr size_t WS_P = 556 * MiB;
constexpr size_t WS_XB = 748 * MiB;
constexpr size_t WS_HB = 812 * MiB;
constexpr size_t WS_REC = 748 * MiB;
constexpr size_t WS_CHMT = 748 * MiB;
constexpr size_t WS_CHN = 780 * MiB;
constexpr size_t WS_CHFR = 812 * MiB;
constexpr size_t WS_CHRY = 877 * MiB;
constexpr size_t WS_CHY0 = 893 * MiB;
constexpr size_t WS_BONV = 909 * MiB;
constexpr size_t WS_PLIST = 940 * MiB;
constexpr size_t WS_END = 968 * MiB;

constexpr int CW_BAR = 4096;
constexpr int CW_CNT = 16384;
constexpr int CW_R1D = 40960;
constexpr int CW_SD = 28672;
constexpr int CW_WQ = 24576;
constexpr int CW_KMAX = 20480;

constexpr int LDS_BYTES = 163840;
constexpr int LDS_AUX = 131072;
constexpr int LDS_MISC = 163840 - 256;

DI float bf2f(unsigned b) { return __uint_as_float(b << 16); }
DI unsigned pk2(float lo, float hi) { f32x2 v = {lo, hi}; bf16x2_t b = __builtin_convertvector(v, bf16x2_t); return __builtin_bit_cast(unsigned, b); }
DI unsigned f2bf(float f) { return pk2(f, 0.f) & 0xffffu; }
DI float ex2(float x) { return __builtin_amdgcn_exp2f(x); }
DI float lg2(float x) { return __builtin_amdgcn_logf(x); }
DI float rcpf_(float x) { return __builtin_amdgcn_rcpf(x); }
DI float sigmoidf_(float x) { return rcpf_(1.f + ex2(-x * LOG2E)); }
DI float tanhf_(float x) { return 1.f - 2.f * rcpf_(1.f + ex2(2.f * LOG2E * x)); }
DI float geluf_(float x) { const float u = 0.7978845608028654f * (x + 0.044715f * x * x * x); return x * rcpf_(1.f + ex2(-2.f * LOG2E * u)); }
DI float softplusf_(float x) { return fmaxf(x, 0.f) + LN2 * lg2(1.f + ex2(-fabsf(x) * LOG2E)); }
template <int CTRL, int RMASK, bool BC> DI float dppf(float x) { return __builtin_bit_cast(float, __builtin_amdgcn_update_dpp(0, __builtin_bit_cast(int, x), CTRL, RMASK, 0xf, BC)); }
DI float wave_sum(float v) {
    v += dppf<0xB1, 0xf, true>(v); v += dppf<0x4E, 0xf, true>(v); v += dppf<0x141, 0xf, true>(v); v += dppf<0x140, 0xf, true>(v);
    v += dppf<0x142, 0xa, false>(v); v += dppf<0x143, 0xc, false>(v);
    return __builtin_bit_cast(float, __builtin_amdgcn_readlane(__builtin_bit_cast(int, v), 63));
}
DI float swap32(float v) { return __shfl_xor(v, 32); }
#define MFMA32(a, b, c) __builtin_amdgcn_mfma_f32_32x32x16_bf16((a), (b), (c), 0, 0, 0)
DI int crow(int r, int h) { return (r & 3) + 8 * (r >> 2) + 4 * h; }

#define XB_TMO      128
#define XB_XCNT(j)  (256  + 64 * (j))
#define XB_XSUB(j)  (1280 + 64 * (j))
#define XB_XGEN(j)  (2304 + 64 * (j))
#define XB_TOP      3328
#define XB_TOPGEN   3392
#define XCD_BAR_WORDS 3456
#define XB_SPIN_CAP (1u << 18)
DI unsigned xb_ld(unsigned* p)              { return __hip_atomic_load(p, __ATOMIC_RELAXED, __HIP_MEMORY_SCOPE_AGENT); }
DI unsigned xb_add(unsigned* p, unsigned v) { return __hip_atomic_fetch_add(p, v, __ATOMIC_RELAXED, __HIP_MEMORY_SCOPE_AGENT); }
DI unsigned xb_xcc_id() { return (unsigned)__builtin_amdgcn_s_getreg((3 << 11) | 20) & 0xFu; }
#define XB_SPIN(cond, bar) do { unsigned _sp = 0; while (cond) { __builtin_amdgcn_s_sleep(1); \
    if ((++_sp & 255u) == 0u) { if (xb_ld(&(bar)[XB_TMO])) break; if (_sp > XB_SPIN_CAP) { atomicAdd(&(bar)[XB_TMO], 1u); break; } } } } while (0)
struct XcdBarrier { unsigned* bar; unsigned x; volatile LAS unsigned* st; };
DI XcdBarrier xcd_barrier_post(unsigned* bar, volatile LAS unsigned* st) {
    XcdBarrier b; b.bar = bar; b.x = xb_xcc_id(); b.st = st;
    if (threadIdx.x == 0) (void)xb_add(&bar[XB_XCNT(b.x)], 1u);
    return b;
}
DI void xcd_barrier_complete(unsigned* bar, unsigned x, unsigned& nloc, unsigned& nx) {
    const unsigned G = gridDim.x * gridDim.y * gridDim.z;
    unsigned sum, cnt, mine, sp = 0u;
    for (;;) {
        sum = 0u; cnt = 0u; mine = 0u;
#pragma unroll
        for (unsigned j = 0; j < 16; ++j) { const unsigned c = xb_ld(&bar[XB_XCNT(j)]); sum += c; cnt += (c > 0u) ? 1u : 0u; mine = (j == x) ? c : mine; }
        if (sum == G) break;
        __builtin_amdgcn_s_sleep(1);
        if ((++sp & 255u) == 0u) { if (xb_ld(&bar[XB_TMO])) break; if (sp > XB_SPIN_CAP) { atomicAdd(&bar[XB_TMO], 1u); break; } }
    }
    nloc = mine > 0u ? mine : 1u; nx = cnt > 0u ? cnt : 1u;
}
DI void xcd_barrier(const XcdBarrier& b) {
    asm volatile("s_waitcnt vmcnt(0)" ::: "memory");
    __syncthreads();
    if (threadIdx.x == 0) {
        unsigned* bar = b.bar;
        __builtin_amdgcn_s_waitcnt(0);
        unsigned nloc = b.st[0], nx = b.st[1];
        if (nloc == 0u) { xcd_barrier_complete(bar, b.x, nloc, nx); b.st[0] = nloc; b.st[1] = nx; }
        const unsigned old = xb_add(&bar[XB_XSUB(b.x)], 1u);
        const unsigned gen = old / nloc;
        if (old + 1u == (gen + 1u) * nloc) {
            __builtin_amdgcn_fence(__ATOMIC_RELEASE, "agent");
            asm volatile("s_waitcnt vmcnt(0)" ::: "memory");
            const unsigned og = xb_add(&bar[XB_TOP], 1u);
            const unsigned tg = og / nx;
            if (og + 1u == (tg + 1u) * nx) xb_add(&bar[XB_TOPGEN], 1u);
            else XB_SPIN(xb_ld(&bar[XB_TOPGEN]) == tg, bar);
            __builtin_amdgcn_fence(__ATOMIC_ACQUIRE, "agent");
            xb_add(&bar[XB_XGEN(b.x)], 1u);
            asm volatile("s_waitcnt vmcnt(0)" ::: "memory");
        } else {
            XB_SPIN(xb_ld(&bar[XB_XGEN(b.x)]) == gen, bar);
            __builtin_amdgcn_fence(__ATOMIC_ACQUIRE, "agent");
            asm volatile("s_waitcnt vmcnt(0)" ::: "memory");
        }
    }
    __syncthreads();
}

DI void xcd_arrive(const XcdBarrier& b, unsigned* w) {
    asm volatile("s_waitcnt vmcnt(0)" ::: "memory");
    __syncthreads();
    if (threadIdx.x == 0) {
        const unsigned nloc = b.st[0];
        const unsigned old = xb_add(&w[64 * b.x], 1u);
        if (old + 1u == nloc) { __builtin_amdgcn_fence(__ATOMIC_RELEASE, "agent"); asm volatile("s_waitcnt vmcnt(0)" ::: "memory"); (void)xb_add(&w[64 * 16], 1u); }
    }
}
DI void xcd_wait_all(const XcdBarrier& b, unsigned* w) {
    if (threadIdx.x == 0) { const unsigned nx = b.st[1]; unsigned sp = 0; while (xb_ld(&w[64 * 16]) < nx) { __builtin_amdgcn_s_sleep(1); if (++sp > (1u << 22)) break; }
        __builtin_amdgcn_fence(__ATOMIC_ACQUIRE, "agent"); asm volatile("s_waitcnt vmcnt(0)" ::: "memory"); }
    __syncthreads();
}

typedef const float* cfp_t;
struct Args { const float* in[27]; float* out; unsigned char* ws; int ph_lo, ph_hi, li, pad; };
struct Frame {
    LAS unsigned char* lds;
    int tid, lane, wave, G, bid;
    const __attribute__((address_space(4))) cfp_t* in;
    float* out; unsigned char* ws;
};
#define WSP(T, off) ((T*)(F.ws + (off)))

namespace pg8 {
constexpr int BM = 256, BK = 64, HALF = 128, HTB = HALF * BK * 2, STAGE_BYTES = 8 * HTB, NXCD = 8, WGM = 8;
DI int lds_byte(int r, int c) { const int st = (r >> 4) * 2 + (c >> 5), rr = r & 15, cc = c & 31, ob = rr * 64 + cc * 2; return st * 1024 + (ob ^ (((ob >> 9) & 1) << 5)); }
DI void stage_rc(int b, int& R, int& C) { const int st = b / 1024, sb = b % 1024, swz = sb ^ (((sb >> 9) & 1) << 5); R = (st >> 1) * 16 + swz / 64; C = (st & 1) * 32 + (swz % 64) / 2; }
DI int perm32(int rho) { const int n = rho >> 4, i = rho & 15; return 8 * (i >> 2) + 4 * n + (i & 3); }
struct Unit { int pm, pn, e, cnt, base, aux; };
DI bool static_next(int nM, int nN, int G, int c, int i, Unit& u) {
    const int nwg = nM * nN; const long L = (long)i * G + c; if (L >= nwg) return false;
    int wgid = (int)L; { const int q = nwg / NXCD, r = nwg % NXCD, xcd = wgid % NXCD, off = wgid / NXCD; wgid = (xcd < r ? xcd * (q + 1) : r * (q + 1) + (xcd - r) * q) + off; }
    const int nig = WGM * nN, gid = wgid / nig, fm = gid * WGM, gsz = (nM - fm) < WGM ? (nM - fm) : WGM;
    u.pm = fm + ((wgid % nig) % gsz); u.pn = (wgid % nig) / gsz; u.e = 0; u.cnt = 0; u.base = 0; u.aux = 0; return true;
}

template <class Prob, bool ALIGN_EPI>
DI void gemm_phase(LAS unsigned char* lds, const Prob& P, const int tid) {
    const int wid = __builtin_amdgcn_readfirstlane(tid >> 6), lane = tid & 63, wr = wid >> 2, wc = wid & 3, fr = lane & 15, fq = lane >> 4;
    const int K = P.K, nt = K / BK;
    constexpr bool GA = Prob::GATHER;
    unsigned voffB[2], voffA[2];
#pragma unroll
    for (int i = 0; i < 2; ++i) { int R, C; stage_rc(tid * 16 + i * 8192, R, C); const int Rb = Prob::PERM ? ((R & ~31) + perm32(R & 31)) : R; voffB[i] = (unsigned)(Rb * K + C) * 2u; voffA[i] = (unsigned)(R * K + C) * 2u; }
    const size_t kstep = (size_t)(BK * 2);
    const size_t hstepB = (size_t)HALF * K * 2;
    const unsigned ldsw = (unsigned)wid * 1024u;
    const int aoffL = lds_byte(wr * 64 + fr, fq * 8), boffL = lds_byte(wc * 32 + fr, fq * 8);
    const char* Abase = (const char*)P.A;
#define PG8_SA(b, h) (((b) * 2 + (h)) * HTB)
#define PG8_SB(b, h) ((4 + (b) * 2 + (h)) * HTB)
#define PG8_STG_B(bufoff, gbase) do { _Pragma("unroll") for (int _i = 0; _i < 2; ++_i) \
        __builtin_amdgcn_global_load_lds((const unsigned*)((const char*)(gbase) + voffB[_i]), (LAS unsigned*)(lds + (bufoff) + ldsw + _i * 8192), 16, 0, 0); } while (0)
#define PG8_STG_A(bufoff, h, kbyte) do { _Pragma("unroll") for (int _i = 0; _i < 2; ++_i) { \
        const char* _p; if constexpr (GA) _p = Abase + (size_t)(kbyte) + aoff[h][_i]; else _p = cA + (size_t)(h) * hstepB + (size_t)(kbyte) + voffA[_i]; \
        __builtin_amdgcn_global_load_lds((const unsigned*)_p, (LAS unsigned*)(lds + (bufoff) + ldsw + _i * 8192), 16, 0, 0); } } while (0)
#define PG8_LDA(dst, b, h) do { _Pragma("unroll") for (int m = 0; m < 4; ++m) _Pragma("unroll") for (int k = 0; k < 2; ++k) dst[m][k] = *(const LAS bf16x8*)(lds + PG8_SA(b, h) + aoffL + m * 2048 + k * 1024); } while (0)
#define PG8_LDB(dst, b, h) do { _Pragma("unroll") for (int n = 0; n < 2; ++n) _Pragma("unroll") for (int k = 0; k < 2; ++k) dst[n][k] = *(const LAS bf16x8*)(lds + PG8_SB(b, h) + boffL + n * 2048 + k * 1024); } while (0)
#define PG8_MMA(ai, bj, At, Bt) do { __builtin_amdgcn_s_setprio(1); _Pragma("unroll") for (int m = 0; m < 4; ++m) _Pragma("unroll") for (int n = 0; n < 2; ++n) _Pragma("unroll") for (int k = 0; k < 2; ++k) \
        acc[ai][bj][m][n] = __builtin_amdgcn_mfma_f32_16x16x32_bf16(Bt[n][k], At[m][k], acc[ai][bj][m][n], 0, 0, 0); __builtin_amdgcn_s_setprio(0); } while (0)
#define PG8_WAIT_V(n) asm volatile("s_waitcnt vmcnt(" #n ")" ::: "memory")
#define PG8_WAIT_L(n) asm volatile("s_waitcnt lgkmcnt(" #n ")" ::: "memory")
#define PG8_BAR __builtin_amdgcn_s_barrier()
#define PG8_SCHED __builtin_amdgcn_sched_barrier(0)
    Unit cur, nxt; int ui = 0;
    if (!P.next(0, cur)) return;
    f32x4 acc[2][2][4][2];
#pragma unroll
    for (int a = 0; a < 2; ++a)
#pragma unroll
        for (int b = 0; b < 2; ++b)
#pragma unroll
            for (int m = 0; m < 4; ++m)
#pragma unroll
                for (int n = 0; n < 2; ++n) acc[a][b][m][n] = (f32x4){0.f, 0.f, 0.f, 0.f};
    bf16x8 At[4][2], B0[2][2], B1[2][2];
    unsigned aoff[2][2] = {{0u, 0u}, {0u, 0u}}, noff[2][2] = {{0u, 0u}, {0u, 0u}};
    const char* cA = Abase; const char* nA = Abase;
    if constexpr (GA) P.aoffs(cur, tid, aoff); else cA = Abase + (size_t)P.arow0(cur) * K * 2;
    const char* cB = P.bbase(cur);
    PG8_STG_B(PG8_SB(0, 0), cB); PG8_STG_B(PG8_SB(0, 1), cB + hstepB); PG8_STG_A(PG8_SA(0, 0), 0, 0); PG8_STG_A(PG8_SA(0, 1), 1, 0);
    if (wr == 1) PG8_BAR;
    PG8_WAIT_V(2); PG8_BAR;
    PG8_STG_B(PG8_SB(1, 0), cB + kstep); PG8_STG_A(PG8_SA(1, 0), 0, kstep); PG8_STG_B(PG8_SB(1, 1), cB + hstepB + kstep);
    PG8_WAIT_V(6); PG8_BAR;
    for (;;) {
        const bool has_next = P.next(ui + 1, nxt);
        const char* nB = cB; nA = cA;
        if (has_next) { nB = P.bbase(nxt); if constexpr (GA) P.aoffs(nxt, tid, noff); else nA = Abase + (size_t)P.arow0(nxt) * K * 2; }
        else if constexpr (GA) { noff[0][0] = aoff[0][0]; noff[0][1] = aoff[0][1]; noff[1][0] = aoff[1][0]; noff[1][1] = aoff[1][1]; }
        if constexpr (GA) { *(LAS u32x4*)(lds + LDS_AUX + 2048 + tid * 16) = (u32x4){noff[0][0], noff[0][1], noff[1][0], noff[1][1]}; }
        for (int t = 0; t < nt; t += 2) {
            const bool last = (t == nt - 2);
            const size_t k1 = (size_t)(t + 1) * kstep;
            const size_t k2 = last ? (size_t)0 : (size_t)(t + 2) * kstep, k3 = k2 + kstep;
            const char* b2 = last ? nB : cB + (size_t)(t + 2) * kstep; const char* b3 = b2 + kstep;
            PG8_LDB(B0, 0, 0); PG8_LDB(B1, 0, 1); PG8_SCHED; PG8_LDA(At, 0, 0); PG8_STG_A(PG8_SA(1, 1), 1, k1);
            PG8_WAIT_V(8); PG8_WAIT_L(0); PG8_BAR; PG8_MMA(0, 0, At, B0); PG8_MMA(0, 1, At, B1); PG8_BAR; PG8_SCHED;
            if (last) { if constexpr (GA) { const u32x4 nq = *(const LAS u32x4*)(lds + LDS_AUX + 2048 + tid * 16); aoff[0][0] = nq[0]; aoff[0][1] = nq[1]; aoff[1][0] = nq[2]; aoff[1][1] = nq[3]; } else cA = nA; }
            PG8_LDA(At, 0, 1); PG8_STG_B(PG8_SB(0, 0), b2); PG8_STG_B(PG8_SB(0, 1), b2 + hstepB); PG8_STG_A(PG8_SA(0, 0), 0, k2);
            PG8_WAIT_V(8); PG8_WAIT_L(0); PG8_BAR; PG8_MMA(1, 0, At, B0); PG8_MMA(1, 1, At, B1); PG8_BAR; PG8_SCHED;
            PG8_LDB(B0, 1, 0); PG8_LDB(B1, 1, 1); PG8_SCHED; PG8_LDA(At, 1, 0); PG8_STG_A(PG8_SA(0, 1), 1, k2);
            PG8_WAIT_V(8); PG8_WAIT_L(0); PG8_BAR; PG8_MMA(0, 0, At, B0); PG8_MMA(0, 1, At, B1); PG8_BAR; PG8_SCHED;
            PG8_LDA(At, 1, 1); PG8_STG_B(PG8_SB(1, 0), b3); PG8_STG_B(PG8_SB(1, 1), b3 + hstepB); PG8_STG_A(PG8_SA(1, 0), 0, k3);
            PG8_WAIT_V(8); PG8_WAIT_L(0); PG8_BAR; PG8_MMA(1, 0, At, B0); PG8_MMA(1, 1, At, B1); PG8_BAR; PG8_SCHED;
        }
        if constexpr (ALIGN_EPI) { if (wr == 0) PG8_BAR; }
        P.epi(acc, cur, wr, wc, fr, fq);
        if (!has_next) break;
#pragma unroll
        for (int a = 0; a < 2; ++a)
#pragma unroll
            for (int b = 0; b < 2; ++b)
#pragma unroll
                for (int m = 0; m < 4; ++m)
#pragma unroll
                    for (int n = 0; n < 2; ++n) acc[a][b][m][n] = (f32x4){0.f, 0.f, 0.f, 0.f};
        cur = nxt; cB = nB; ++ui;
        if constexpr (ALIGN_EPI) { if (wr == 1) PG8_BAR; }
    }
    PG8_WAIT_V(0);
    if constexpr (!ALIGN_EPI) { if (wr == 0) PG8_BAR; }
    PG8_BAR;
#undef PG8_SA
#undef PG8_SB
#undef PG8_STG_A
#undef PG8_STG_B
#undef PG8_LDA
#undef PG8_LDB
#undef PG8_MMA
#undef PG8_WAIT_V
#undef PG8_WAIT_L
#undef PG8_BAR
#undef PG8_SCHED
}

template <class Prob>
DI void gemm_phase_pair(LAS unsigned char* lds, const Prob& P, const int tid) {
    const int wid = __builtin_amdgcn_readfirstlane(tid >> 6), lane = tid & 63, wr = wid >> 2, wc = wid & 3, fr = lane & 15, fq = lane >> 4;
    constexpr int KP = 512, nt = 16;
    unsigned voffB[2];
#pragma unroll
    for (int i = 0; i < 2; ++i) { int R, C; stage_rc(tid * 16 + i * 8192, R, C); const int Rb = Prob::PERM ? ((R & ~31) + perm32(R & 31)) : R; voffB[i] = (unsigned)(Rb * KP + C) * 2u; }
    const size_t kstep = (size_t)(BK * 2);
    const size_t hstepB = (size_t)HALF * KP * 2;
    const unsigned ldsw = (unsigned)wid * 1024u;
    const int aoffL = lds_byte(wr * 64 + fr, fq * 8), boffL = lds_byte(wc * 32 + fr, fq * 8);
    const char* Abase = (const char*)P.A;
    LAS unsigned char* park = lds + LDS_AUX + 2048 + tid * 48;
#define PG8_SA(b, h) (((b) * 2 + (h)) * HTB)
#define PG8_SB(b, h) ((4 + (b) * 2 + (h)) * HTB)
#define PG8_STG_B(bufoff, gbase) do { _Pragma("unroll") for (int _i = 0; _i < 2; ++_i) \
        __builtin_amdgcn_global_load_lds((const unsigned*)((const char*)(gbase) + voffB[_i]), (LAS unsigned*)(lds + (bufoff) + ldsw + _i * 8192), 16, 0, 0); } while (0)
#define PG8_STG_A(bufoff, h, kbyte) do { _Pragma("unroll") for (int _i = 0; _i < 2; ++_i) \
        __builtin_amdgcn_global_load_lds((const unsigned*)(Abase + (size_t)(kbyte) + aoff[h][_i]), (LAS unsigned*)(lds + (bufoff) + ldsw + _i * 8192), 16, 0, 0); } while (0)
#define PG8_LDA(dst, b, h) do { _Pragma("unroll") for (int m = 0; m < 4; ++m) _Pragma("unroll") for (int k = 0; k < 2; ++k) dst[m][k] = *(const LAS bf16x8*)(lds + PG8_SA(b, h) + aoffL + m * 2048 + k * 1024); } while (0)
#define PG8_LDB(dst, b, h) do { _Pragma("unroll") for (int n = 0; n < 2; ++n) _Pragma("unroll") for (int k = 0; k < 2; ++k) dst[n][k] = *(const LAS bf16x8*)(lds + PG8_SB(b, h) + boffL + n * 2048 + k * 1024); } while (0)
#define PG8_MMA(ai, bj, At, Bt) do { __builtin_amdgcn_s_setprio(1); _Pragma("unroll") for (int m = 0; m < 4; ++m) _Pragma("unroll") for (int n = 0; n < 2; ++n) _Pragma("unroll") for (int k = 0; k < 2; ++k) \
        acc[ai][bj][m][n] = __builtin_amdgcn_mfma_f32_16x16x32_bf16(Bt[n][k], At[m][k], acc[ai][bj][m][n], 0, 0, 0); __builtin_amdgcn_s_setprio(0); } while (0)
#define PG8_WAIT_V(n) asm volatile("s_waitcnt vmcnt(" #n ")" ::: "memory")
#define PG8_WAIT_L(n) asm volatile("s_waitcnt lgkmcnt(" #n ")" ::: "memory")
#define PG8_BAR __builtin_amdgcn_s_barrier()
#define PG8_SCHED __builtin_amdgcn_sched_barrier(0)
#define PG8_PARK(slot, v) (*(LAS u32x4*)(park + 16 * (slot)) = (u32x4){v[0][0], v[0][1], v[1][0], v[1][1]})
#define PG8_UNPARK(slot) do { const u32x4 _q = *(const LAS u32x4*)(park + 16 * (slot)); aoff[0][0] = _q[0]; aoff[0][1] = _q[1]; aoff[1][0] = _q[2]; aoff[1][1] = _q[3]; } while (0)
    Unit cur, nxt; int ui = 0;
    if (!P.next(0, cur)) return;
    f32x4 acc[2][2][4][2];
#pragma unroll
    for (int a = 0; a < 2; ++a)
#pragma unroll
        for (int b = 0; b < 2; ++b)
#pragma unroll
            for (int m = 0; m < 4; ++m)
#pragma unroll
                for (int n = 0; n < 2; ++n) acc[a][b][m][n] = (f32x4){0.f, 0.f, 0.f, 0.f};
    bf16x8 At[4][2], B0[2][2], B1[2][2];
    unsigned aoff[2][2];
    { unsigned tb[2][2]; P.aoffs2(cur, tid, aoff, tb); PG8_PARK(0, tb); }
    const char* cBa = P.bbase_a(cur); const char* cBb = P.bbase_b(cur);
    PG8_STG_B(PG8_SB(0, 0), cBa); PG8_STG_B(PG8_SB(0, 1), cBa + hstepB); PG8_STG_A(PG8_SA(0, 0), 0, 0); PG8_STG_A(PG8_SA(0, 1), 1, 0);
    if (wr == 1) PG8_BAR;
    PG8_WAIT_V(2); PG8_BAR;
    PG8_STG_B(PG8_SB(1, 0), cBa + kstep); PG8_STG_A(PG8_SA(1, 0), 0, kstep); PG8_STG_B(PG8_SB(1, 1), cBa + hstepB + kstep);
    PG8_WAIT_V(6); PG8_BAR;
    for (;;) {
        const bool has_next = P.next(ui + 1, nxt);
        const char* nBa = cBa; const char* nBb = cBb;
        {
            unsigned ta[2][2], tb[2][2];
            if (has_next) { P.aoffs2(nxt, tid, ta, tb); nBa = P.bbase_a(nxt); nBb = P.bbase_b(nxt); } else P.aoffs2(cur, tid, ta, tb);
            PG8_PARK(2, ta); PG8_PARK((ui + 1) & 1, tb);
        }
        const bool hu = (cur.cnt - cur.pm * 256) <= 128;
        for (int t = 0; t < nt; t += 2) {
            const bool last = (t == nt - 2);
            const size_t k1 = (size_t)((t + 1) & 7) * kstep;
            const int t2 = last ? 0 : t + 2;
            const size_t k2 = (size_t)(t2 & 7) * kstep, k3 = k2 + kstep;
            const char* b2 = last ? nBa : ((t2 < 8 ? cBa : cBb) + k2); const char* b3 = b2 + kstep;
            PG8_LDB(B0, 0, 0); PG8_LDB(B1, 0, 1); PG8_SCHED; PG8_LDA(At, 0, 0); PG8_STG_A(PG8_SA(1, 1), 1, k1);
            PG8_WAIT_V(8); PG8_WAIT_L(0); PG8_BAR; PG8_MMA(0, 0, At, B0); PG8_MMA(0, 1, At, B1); PG8_BAR; PG8_SCHED;
            if (t == 6) PG8_UNPARK(ui & 1);
            if (last) PG8_UNPARK(2);
            PG8_LDA(At, 0, 1); PG8_STG_B(PG8_SB(0, 0), b2); PG8_STG_B(PG8_SB(0, 1), b2 + hstepB); PG8_STG_A(PG8_SA(0, 0), 0, k2);
            PG8_WAIT_V(8); PG8_WAIT_L(0); PG8_BAR; if (!hu) { PG8_MMA(1, 0, At, B0); PG8_MMA(1, 1, At, B1); } PG8_BAR; PG8_SCHED;
            PG8_LDB(B0, 1, 0); PG8_LDB(B1, 1, 1); PG8_SCHED; PG8_LDA(At, 1, 0); PG8_STG_A(PG8_SA(0, 1), 1, k2);
            PG8_WAIT_V(8); PG8_WAIT_L(0); PG8_BAR; PG8_MMA(0, 0, At, B0); PG8_MMA(0, 1, At, B1); PG8_BAR; PG8_SCHED;
            PG8_LDA(At, 1, 1); PG8_STG_B(PG8_SB(1, 0), b3); PG8_STG_B(PG8_SB(1, 1), b3 + hstepB); PG8_STG_A(PG8_SA(1, 0), 0, k3);
            PG8_WAIT_V(8); PG8_WAIT_L(0); PG8_BAR; if (!hu) { PG8_MMA(1, 0, At, B0); PG8_MMA(1, 1, At, B1); } PG8_BAR; PG8_SCHED;
        }
        if (wr == 0) PG8_BAR;
        P.epi(acc, cur, wr, wc, fr, fq);
        if (!has_next) break;
#pragma unroll
        for (int a = 0; a < 2; ++a)
#pragma unroll
            for (int b = 0; b < 2; ++b)
#pragma unroll
                for (int m = 0; m < 4; ++m)
#pragma unroll
                    for (int n = 0; n < 2; ++n) acc[a][b][m][n] = (f32x4){0.f, 0.f, 0.f, 0.f};
        cur = nxt; cBa = nBa; cBb = nBb; ++ui;
        if (wr == 1) PG8_BAR;
    }
    PG8_WAIT_V(0);
    PG8_BAR;
#undef PG8_SA
#undef PG8_SB
#undef PG8_STG_A
#undef PG8_STG_B
#undef PG8_LDA
#undef PG8_LDB
#undef PG8_MMA
#undef PG8_WAIT_V
#undef PG8_WAIT_L
#undef PG8_BAR
#undef PG8_SCHED
#undef PG8_PARK
#undef PG8_UNPARK
}
}
using pg8::Unit;


struct MoeTab { int ce[32], sb[32], tpg[33], cp[112], tpf[113], tph[113]; };
constexpr int LCAP = 32768;
DI int pair_lo(int p) { int i = 0; _Pragma("unroll") for (int k = 1; k < 7; ++k) if (p >= k * (15 - k) / 2) i = k; return i; }
DI int pair_hi(int p, int i) { return p - i * (15 - i) / 2 + i + 1; }

struct ProbIn {
    static constexpr bool PERM = true, GATHER = false;
    int K; const bf16_t* A; const bf16_t* Bt; int G, c;
    bf16_t* Pout; const float* ss1; float* lf; const float* bfx; unsigned* kmax;
    DI bool next(int i, Unit& u) const { return pg8::static_next(128, 12, G, c, i, u); }
    DI int arow0(const Unit& u) const { return u.pm * 256; }
    DI const char* bbase(const Unit& u) const { return (const char*)Bt + (size_t)u.pn * 256 * K * 2; }
    DI void epi(const f32x4 (&acc)[2][2][4][2], const Unit& u, int wr, int wc, int fr, int fq) const {
        float km0 = 0.f, km1 = 0.f;
        float rs[8];
#pragma unroll
        for (int hb_ = 0; hb_ < 4; ++hb_) {
            f32x4 sv[2][4];
#pragma unroll
            for (int m = 0; m < 2; ++m) { const int g = hb_ * 2 + m; const f32x4* sp = (const f32x4*)(ss1 + (size_t)(u.pm * 256 + (g >> 2) * 128 + wr * 64 + (g & 3) * 16 + fr) * 16);
#pragma unroll
                for (int k = 0; k < 4; ++k) sv[m][k] = sp[k]; }
#pragma unroll
            for (int m = 0; m < 2; ++m) { float ss = 0.f;
#pragma unroll
                for (int k = 0; k < 4; ++k) ss += (sv[m][k][0] + sv[m][k][1]) + (sv[m][k][2] + sv[m][k][3]);
                rs[hb_ * 2 + m] = __builtin_amdgcn_rsqf(ss * (1.f / 1024.f) + 1e-6f); }
            asm volatile("" : "+v"(rs[hb_ * 2]), "+v"(rs[hb_ * 2 + 1]));
        }
#pragma unroll
        for (int ai = 0; ai < 2; ++ai)
#pragma unroll
            for (int m = 0; m < 4; ++m) {
                const int row = u.pm * 256 + ai * 128 + wr * 64 + m * 16 + fr;
                const float rstd = rs[ai * 4 + m];
                {
                    bf16_t* rowp = Pout + (size_t)row * PP + u.pn * 256 + wc * 32 + 8 * fq;
#pragma unroll
                    for (int bj = 0; bj < 2; ++bj) { const f32x4 v0 = acc[ai][bj][m][0] * rstd, v1 = acc[ai][bj][m][1] * rstd;
                        u32x4 w; w.x = pk2(v0[0], v0[1]); w.y = pk2(v0[2], v0[3]); w.z = pk2(v1[0], v1[1]); w.w = pk2(v1[2], v1[3]);
                        *(u32x4*)(rowp + bj * 128) = w; }
                    if (u.pn == 10) {
#pragma unroll
                        for (int bj = 0; bj < 2; ++bj) { const f32x4 v0 = acc[ai][bj][m][0] * rstd, v1 = acc[ai][bj][m][1] * rstd;
                            float p = ((v0[0] * v0[0] + v0[1] * v0[1]) + (v0[2] * v0[2] + v0[3] * v0[3])) + ((v1[0] * v1[0] + v1[1] * v1[1]) + (v1[2] * v1[2] + v1[3] * v1[3]));
                            p += __shfl_xor(p, 16); p += __shfl_xor(p, 32);
                            if (bj == 0) km0 = fmaxf(km0, p); else km1 = fmaxf(km1, p); }
                    }
                }
            }
        if (u.pn == 10) {
#pragma unroll
            for (int o = 1; o < 16; o <<= 1) { km0 = fmaxf(km0, __shfl_xor(km0, o)); km1 = fmaxf(km1, __shfl_xor(km1, o)); }
            if (fr == 0 && fq == 0) { const int b = (u.pm * 256) >> 11;
                __hip_atomic_fetch_max(kmax + ((b * 4 + 0 + (wc >> 1)) * 2 + (wc & 1)), __float_as_uint(km0), __ATOMIC_RELAXED, __HIP_MEMORY_SCOPE_AGENT);
                __hip_atomic_fetch_max(kmax + ((b * 4 + 2 + (wc >> 1)) * 2 + (wc & 1)), __float_as_uint(km1), __ATOMIC_RELAXED, __HIP_MEMORY_SCOPE_AGENT); }
        }
    }
};

struct ProbOut {
    static constexpr bool PERM = false, GATHER = false;
    int K; const bf16_t* A; const bf16_t* Bt; int G, c;
    const float* base; float* out; float ascale;
    DI bool next(int i, Unit& u) const { return pg8::static_next(128, 4, G, c, i, u); }
    DI int arow0(const Unit& u) const { return u.pm * 256; }
    DI const char* bbase(const Unit& u) const { return (const char*)Bt + (size_t)u.pn * 256 * K * 2; }
    DI void epi(const f32x4 (&acc)[2][2][4][2], const Unit& u, int wr, int wc, int fr, int fq) const {
#pragma unroll
        for (int ai = 0; ai < 2; ++ai)
#pragma unroll
            for (int mp = 0; mp < 2; ++mp) {
                f32x4 bv[2][2][2]; size_t offs[2];
#pragma unroll
                for (int mm = 0; mm < 2; ++mm) { const int m = 2 * mp + mm; offs[mm] = (size_t)(u.pm * 256 + ai * 128 + wr * 64 + m * 16 + fr) * D + u.pn * 256 + wc * 32 + 4 * fq;
#pragma unroll
                    for (int bj = 0; bj < 2; ++bj)
#pragma unroll
                        for (int n = 0; n < 2; ++n) bv[mm][bj][n] = *(const f32x4*)(base + offs[mm] + bj * 128 + n * 16); }
#pragma unroll
                for (int mm = 0; mm < 2; ++mm) { const int m = 2 * mp + mm;
#pragma unroll
                    for (int bj = 0; bj < 2; ++bj)
#pragma unroll
                        for (int n = 0; n < 2; ++n) *(f32x4*)(out + offs[mm] + bj * 128 + n * 16) = bv[mm][bj][n] + acc[ai][bj][m][n] * ascale; }
                asm volatile("" ::: "memory");
            }
    }
};

DI int moe_L(int i, int G, int c) {
    if ((G & 31) != 0) return i * G + c;
    const int x = c & 7, j = c >> 3, per = G >> 5;
    return ((i * (G >> 2) + x * per + (j >> 2)) << 2) + (j & 3);
}
template <int NL> DI bool moe_unit(const LAS int* tp, int L, Unit& u) {
    const int tt = L >> 2; if (tt >= tp[NL]) return false;
    int e = 0;
#pragma unroll 1
    while (tp[e + 1] <= tt) ++e;
    u.e = e; u.pm = tt - tp[e]; u.pn = L & 3; return true;
}

struct ProbGU {
    static constexpr bool PERM = true, GATHER = true;
    int K; const bf16_t* A; const bf16_t* Bt; int G, c;
    const LAS MoeTab* T; const int* elist; const float* egate; const float* rstd2; bf16_t* HB;
    DI bool next(int i, Unit& u) const {
        if (!moe_unit<32>(T->tpg, moe_L(i, G, c), u)) return false;
        u.cnt = T->ce[u.e]; u.base = T->sb[u.e]; return true;
    }
    DI int tok_of(const Unit& u, int r) const { return (r < u.cnt) ? elist[(size_t)u.e * LCAP + r] : 0; }
    DI void aoffs(const Unit& u, int tid, unsigned (&o)[2][2]) const {
        int Rr[2], Cc[2]; pg8::stage_rc(tid * 16, Rr[0], Cc[0]); pg8::stage_rc(tid * 16 + 8192, Rr[1], Cc[1]);
#pragma unroll
        for (int h = 0; h < 2; ++h)
#pragma unroll
            for (int i = 0; i < 2; ++i) { const int tok = tok_of(u, u.pm * 256 + h * 128 + Rr[i]); o[h][i] = (unsigned)((tok * K + Cc[i]) * 2); }
    }
    DI const char* bbase(const Unit& u) const { return (const char*)Bt + ((size_t)u.e * 1024 + u.pn * 256) * K * 2; }
    DI void epi(const f32x4 (&acc)[2][2][4][2], const Unit& u, int wr, int wc, int fr, int fq) const {
        int tk[8]; float rsv[8], gv[8];
#pragma unroll
        for (int g = 0; g < 8; ++g) { const int r = u.pm * 256 + (g >> 2) * 128 + wr * 64 + (g & 3) * 16 + fr; tk[g] = tok_of(u, r); gv[g] = (r < u.cnt) ? egate[(size_t)u.e * LCAP + r] : 0.f; }
#pragma unroll
        for (int g = 0; g < 8; ++g) rsv[g] = rstd2[tk[g]];
#pragma unroll
        for (int ai = 0; ai < 2; ++ai)
#pragma unroll
            for (int m = 0; m < 4; ++m) {
                const int r = u.pm * 256 + ai * 128 + wr * 64 + m * 16 + fr;
                if (r < u.cnt) {
                    const float rs = rsv[ai * 4 + m], gt = gv[ai * 4 + m];
                    float hv[8];
#pragma unroll
                    for (int n = 0; n < 2; ++n)
#pragma unroll
                        for (int j = 0; j < 4; ++j) { const float g = acc[ai][0][m][n][j] * rs, uu = acc[ai][1][m][n][j] * rs; hv[n * 4 + j] = g * sigmoidf_(g) * uu * gt; }
                    u32x4 w; w.x = pk2(hv[0], hv[1]); w.y = pk2(hv[2], hv[3]); w.z = pk2(hv[4], hv[5]); w.w = pk2(hv[6], hv[7]);
                    *(u32x4*)(HB + (size_t)(u.base + r) * EH + u.pn * 128 + wc * 32 + 8 * fq) = w;
                }
            }
    }
};

struct ProbDP {
    static constexpr bool PERM = false;
    const bf16_t* A; const bf16_t* Bt; int G, c;
    const LAS MoeTab* T; const u32x2* plist; float* x; bf16_t* xb; float* ss1;
    DI bool next(int i, Unit& u) const {
        const int L = moe_L(i, G, c), tt = L >> 2, nf = T->tpf[112];
        if (tt < nf) { if (!moe_unit<112>(T->tpf, L, u)) return false; }
        else { if (!moe_unit<112>(T->tph, L - 4 * nf, u)) return false; u.pm = (T->cp[u.e] - 1) >> 8; }
        u.cnt = T->cp[u.e]; const int g = u.e / 28, p = u.e - g * 28, lo = pair_lo(p); u.base = g * 8 + lo; u.aux = g * 8 + pair_hi(p, lo); return true;
    }
    DI void aoffs2(const Unit& u, int tid, unsigned (&oa)[2][2], unsigned (&ob)[2][2]) const {
        int Rr[2], Cc[2]; pg8::stage_rc(tid * 16, Rr[0], Cc[0]); pg8::stage_rc(tid * 16 + 8192, Rr[1], Cc[1]);
        const int sba = T->sb[u.base], sbb = T->sb[u.aux];
#pragma unroll
        for (int h = 0; h < 2; ++h)
#pragma unroll
            for (int i = 0; i < 2; ++i) { const int r = u.pm * 256 + h * 128 + Rr[i]; unsigned pos = 0u; if (r < u.cnt) pos = plist[(size_t)u.e * LCAP + r].y;
                const int ra = (r < u.cnt) ? sba + (int)(pos & 0xffffu) : 0, rb = (r < u.cnt) ? sbb + (int)(pos >> 16) : 0;
                oa[h][i] = (unsigned)((ra * EH + Cc[i]) * 2); ob[h][i] = (unsigned)((rb * EH + Cc[i]) * 2); }
    }
    DI const char* bbase_a(const Unit& u) const { return (const char*)Bt + ((size_t)u.base * 1024 + u.pn * 256) * EH * 2; }
    DI const char* bbase_b(const Unit& u) const { return (const char*)Bt + ((size_t)u.aux * 1024 + u.pn * 256) * EH * 2; }
    DI void epi(const f32x4 (&acc)[2][2][4][2], const Unit& u, int wr, int wc, int fr, int fq) const {
        int tk[8];
#pragma unroll
        for (int g = 0; g < 8; ++g) { const int r = u.pm * 256 + (g >> 2) * 128 + wr * 64 + (g & 3) * 16 + fr; tk[g] = (r < u.cnt) ? (int)plist[(size_t)u.e * LCAP + r].x : 0; }
#pragma unroll
        for (int ai = 0; ai < 2; ++ai)
#pragma unroll
            for (int m = 0; m < 4; ++m) {
                const int r = u.pm * 256 + ai * 128 + wr * 64 + m * 16 + fr; const bool val = r < u.cnt;
                const size_t off = (size_t)tk[ai * 4 + m] * D + u.pn * 256 + wc * 32 + 4 * fq;
                f32x4 xv[2][2];
#pragma unroll
                for (int bj = 0; bj < 2; ++bj)
#pragma unroll
                    for (int n = 0; n < 2; ++n) xv[bj][n] = *(const f32x4*)(x + off + bj * 128 + n * 16);
                float ssp = 0.f;
#pragma unroll
                for (int bj = 0; bj < 2; ++bj)
#pragma unroll
                    for (int n = 0; n < 2; ++n) { const size_t o = off + bj * 128 + n * 16; const f32x4 v = xv[bj][n] + acc[ai][bj][m][n];
                        if (val) { *(f32x4*)(x + o) = v; u32x2 w; w.x = pk2(v[0], v[1]); w.y = pk2(v[2], v[3]); *(u32x2*)(xb + o) = w; }
                        ssp += (v[0] * v[0] + v[1] * v[1]) + (v[2] * v[2] + v[3] * v[3]); }
                ssp += __shfl_xor(ssp, 16); ssp += __shfl_xor(ssp, 32);
                if (val && fq == 0) ss1[(size_t)tk[ai * 4 + m] * 16 + u.pn * 4 + wc] = ssp;
                asm volatile("" ::: "memory");
            }
    }
};


DI void p0_transpose64(const float* W, int K, int N, int ldn, const float* gs, bf16_t* WT, int mode, LAS unsigned* T, int kb, int nb, int lane) {
    const int k0 = 64 * kb, n0 = 64 * nb, nq = lane & 15, kr = lane >> 4;
    const bool nv = (n0 + 4 * nq) < N;
    f32x4 a[8], b[8];
#pragma unroll
    for (int i = 0; i < 8; ++i) { const int k = k0 + 8 * i + 2 * kr;
        a[i] = nv ? *(const f32x4*)(W + (size_t)k * ldn + n0 + 4 * nq) : (f32x4){0.f, 0.f, 0.f, 0.f};
        b[i] = nv ? *(const f32x4*)(W + (size_t)(k + 1) * ldn + n0 + 4 * nq) : (f32x4){0.f, 0.f, 0.f, 0.f}; }
#pragma unroll
    for (int i = 0; i < 8; ++i) { const int k = k0 + 8 * i + 2 * kr; float g0 = 1.f, g1 = 1.f; if (gs) { g0 = gs[k]; g1 = gs[k + 1]; }
#pragma unroll
        for (int jj = 0; jj < 4; ++jj) T[(4 * nq + jj) * 36 + 4 * i + kr] = pk2(a[i][jj] * g0, b[i][jj] * g1); }
    asm volatile("s_waitcnt lgkmcnt(0)" ::: "memory");
    const int c = lane & 7;
#pragma unroll
    for (int p = 0; p < 8; ++p) { const int nl = 8 * p + (lane >> 3), n = n0 + nl;
        const u32x4 o = *(const LAS u32x4*)(T + nl * 36 + 4 * c);
        const int drow = (mode == 0) ? n : (((n >> 7) << 8) + (n & 127) + (mode == 2 ? 128 : 0));
        *(u32x4*)(WT + (size_t)drow * K + k0 + 8 * c) = o; }
    asm volatile("s_waitcnt lgkmcnt(0)" ::: "memory");
}
DI void p0_prologue(Frame& F) {
    LAS unsigned* scr = (LAS unsigned*)(F.lds + F.wave * 16384);
    const int gw = F.bid * 8 + F.wave, NGW = F.G * 8;
    constexpr int I_IN = 16 * 52, I_OUT = 16 * 16, I_GU = 16 * 8, I_DN = 8 * 16;
    constexpr int S0 = DEPTH * I_IN, S1 = S0 + DEPTH * I_OUT, S2 = S1 + DEPTH * NE * I_GU, S3 = S2 + DEPTH * NE * I_GU, S4 = S3 + DEPTH * NE * I_DN;
    for (int it = gw; it < S4; it += NGW) {
        if (it < S0) { const int l = it / I_IN, r = it % I_IN;
            p0_transpose64(F.in[2] + (size_t)l * D * 3076, D, 3076, 3076, F.in[1] + l * D, WSP(bf16_t, WS_BIN) + (size_t)l * NIN * D, 0, scr, r / 52, r % 52, F.lane);
        } else if (it < S1) { const int q = it - S0, l = q / I_OUT, r = q % I_OUT;
            p0_transpose64(F.in[17] + (size_t)l * D * D, D, D, D, nullptr, WSP(bf16_t, WS_BOUT) + (size_t)l * D * D, 0, scr, r / 16, r % 16, F.lane);
        } else if (it < S3) { const int up = it >= S2, q = it - (up ? S2 : S1), le = q / I_GU, r = q % I_GU;
            p0_transpose64(F.in[up ? 24 : 23] + (size_t)le * D * EH, D, EH, EH, F.in[18] + (le / NE) * D, WSP(bf16_t, WS_BGU) + (size_t)le * 1024 * D, up ? 2 : 1, scr, r / 8, r % 8, F.lane);
        } else { const int q = it - S3, le = q / I_DN, r = q % I_DN;
            p0_transpose64(F.in[25] + (size_t)le * EH * D, EH, D, D, nullptr, WSP(bf16_t, WS_BDN) + (size_t)le * D * EH, 0, scr, r / 16, r % 16, F.lane);
        }
    }
    const int gt = F.bid * 512 + F.tid, NGT = F.G * 512;
    for (int i = gt; i < DEPTH * 256 * 256; i += NGT) { const int l = i >> 16, c = (i >> 8) & 255, k = i & 255;
        const float v = k < 64 ? F.in[7][((size_t)l * 64 + k) * 256 + c] : (k < 128 ? F.in[9][((size_t)l * 64 + (k - 64)) * 256 + c] : F.in[10][((size_t)l * 128 + (k - 128)) * 256 + c]);
        WSP(bf16_t, WS_WCAT)[i] = (bf16_t)f2bf(v); }
    for (int i = gt; i < DEPTH * 36 * 1024; i += NGT) { const int l = i / (36 * 1024), j = (i / 1024) % 36, k = i & 1023;
        const float g = F.in[18][l * D + k];
        const float w = j < 4 ? F.in[19][((size_t)l * D + k) * 4 + j] : F.in[21][((size_t)l * D + k) * 32 + (j - 4)];
        WSP(float, WS_RTW)[i] = g * w; }
    for (int m0 = gw * 4; m0 < NT; m0 += NGW * 4) {
        f32x4 v[4][4];
#pragma unroll
        for (int r = 0; r < 4; ++r) { const f32x4* xr = (const f32x4*)(F.in[0] + (size_t)(m0 + r) * D) + F.lane;
#pragma unroll
            for (int j = 0; j < 4; ++j) v[r][j] = xr[64 * j]; }
#pragma unroll
        for (int r = 0; r < 4; ++r) { float s = 0.f; u32x2* o8 = (u32x2*)(WSP(bf16_t, WS_XB) + (size_t)(m0 + r) * D) + F.lane;
#pragma unroll
            for (int j = 0; j < 4; ++j) { const f32x4 q = v[r][j]; s += (q[0] * q[0] + q[1] * q[1]) + (q[2] * q[2] + q[3] * q[3]); u32x2 w; w.x = pk2(q[0], q[1]); w.y = pk2(q[2], q[3]); o8[64 * j] = w; }
            s = wave_sum(s);
            if (F.lane < 16) WSP(float, WS_SS1)[(size_t)(m0 + r) * 16 + F.lane] = (F.lane == 0) ? s : 0.f; }
    }
}

constexpr int AT_KOFF = 0, AT_VOFF = 18432, AT_CUM = 36864, AT_MISC = 45056, AT_ROWB = 144, AT_BUFB = 64 * 144;
DI void at_load_tile(const bf16_t* Pb, int colK, int colV, int jt, int tid, u32x4& kreg, u32x4& vreg) {
    const int row = tid >> 3, ch = tid & 7; const bf16_t* p = Pb + (size_t)(64 * jt + row) * PP + ch * 8;
    kreg = *(const u32x4*)(p + colK); vreg = *(const u32x4*)(p + colV);
}
DI void at_store_tile(LAS unsigned char* lds, int buf, int tid, const u32x4& kreg, const u32x4& vreg) {
    const int row = tid >> 3, ch = tid & 7;
    *(LAS u32x4*)(lds + AT_KOFF + buf * AT_BUFB + row * AT_ROWB + ch * 16) = kreg;
    *(LAS u32x4*)(lds + AT_VOFF + buf * AT_BUFB + row * AT_ROWB + ch * 16) = vreg;
}
DI void at_qk(const LAS unsigned char* kb, const bf16x8 (&qf)[4], int r32, int h2, f32x16& s0, f32x16& s1) {
    const LAS unsigned char* p = kb + r32 * AT_ROWB + h2 * 16;
#pragma unroll
    for (int d0 = 0; d0 < 4; ++d0) {
        const bf16x8 a0 = *(const LAS bf16x8*)(p + d0 * 32), a1 = *(const LAS bf16x8*)(p + 32 * AT_ROWB + d0 * 32);
        s0 = MFMA32(a0, qf[d0], s0); s1 = MFMA32(a1, qf[d0], s1);
    }
}
DI bf16x8 pack8(const f32x16& x, int s) {
    u32x4 p; p.x = pk2(x[8 * s], x[8 * s + 1]); p.y = pk2(x[8 * s + 2], x[8 * s + 3]); p.z = pk2(x[8 * s + 4], x[8 * s + 5]); p.w = pk2(x[8 * s + 6], x[8 * s + 7]);
    return __builtin_bit_cast(bf16x8, p);
}
DI s16x4 tr_read(const LAS unsigned char* p) { return __builtin_bit_cast(s16x4, __builtin_amdgcn_ds_read_tr16_b64_v4i16((LAS s16x4*)p)); }
DI void at_pv(const LAS unsigned char* vb, const bf16x8 (&pb)[4], int lane, f32x16& o0, f32x16& o1) {
    const int h2 = lane >> 5;
    const LAS unsigned char* base = vb + (4 * h2 + ((lane & 15) >> 2)) * AT_ROWB + (16 * ((lane >> 4) & 1) + 4 * (lane & 3)) * 2;
#pragma unroll
    for (int s = 0; s < 4; ++s) {
        const LAS unsigned char* p = base + 16 * s * AT_ROWB;
        const s16x4 l0 = tr_read(p), h0 = tr_read(p + 8 * AT_ROWB), l1 = tr_read(p + 64), h1 = tr_read(p + 8 * AT_ROWB + 64);
        const bf16x8 a0 = __builtin_shufflevector(l0, h0, 0, 1, 2, 3, 4, 5, 6, 7), a1 = __builtin_shufflevector(l1, h1, 0, 1, 2, 3, 4, 5, 6, 7);
        o0 = MFMA32(a0, pb[s], o0); o1 = MFMA32(a1, pb[s], o1);
    }
}
DI void at_store_out(bf16_t* dst  , const f32x16& o0, const f32x16& o1, float scale, int h2) {
#pragma unroll
    for (int g = 0; g < 4; ++g) {
        u32x2 w0, w1; w0.x = pk2(o0[4 * g] * scale, o0[4 * g + 1] * scale); w0.y = pk2(o0[4 * g + 2] * scale, o0[4 * g + 3] * scale);
        w1.x = pk2(o1[4 * g] * scale, o1[4 * g + 1] * scale); w1.y = pk2(o1[4 * g + 2] * scale, o1[4 * g + 3] * scale);
        *(u32x2*)(dst + 8 * g + 4 * h2) = w0; *(u32x2*)(dst + 32 + 8 * g + 4 * h2) = w1;
    }
}
DI void block_cumsum(const float* src, int n, LAS float* cum, LAS float* wtot, int tid, int lane, int wave) {
    f32x4 v = (f32x4){0.f, 0.f, 0.f, 0.f};
    if (4 * tid < n) v = *(const f32x4*)(src + 4 * tid);
    v[1] += v[0]; v[2] += v[1]; v[3] += v[2];
    float t = v[3];
#pragma unroll
    for (int o = 1; o < 64; o <<= 1) { const float u = __shfl_up(t, o); if (lane >= o) t += u; }
    if (lane == 63) wtot[wave] = t;
    __syncthreads();
    float pre = t - v[3];
    for (int w = 0; w < wave; ++w) pre += wtot[w];
    if (4 * tid < n) { v[0] += pre; v[1] += pre; v[2] += pre; v[3] += pre; *(LAS f32x4*)(cum + 4 * tid) = v; }
    __syncthreads();
}

DI void fx_unit(Frame& F, int layer, int b, int h, int qb) {
    LAS unsigned char* L = F.lds; const int tid = F.tid, lane = F.lane, wid = F.wave, r32 = lane & 31, h2 = lane >> 5;
    const bf16_t* Pb = WSP(bf16_t, WS_P) + (size_t)b * SEQ * PP;
    LAS float* cum = (LAS float*)(L + AT_CUM);
    const int kend = 256 * qb + 256;
    __syncthreads();
    block_cumsum(WSP(float, WS_LF) + (size_t)(b * 4 + h) * SEQ, kend, cum, (LAS float*)(L + AT_MISC), tid, lane, wid);
    const int tw0 = 256 * qb + 32 * wid, tq = tw0 + r32;
    bf16x8 qf[4];
#pragma unroll
    for (int d0 = 0; d0 < 4; ++d0) qf[d0] = *(const bf16x8*)(Pb + (size_t)tq * PP + C_FXQ + h * 64 + 16 * d0 + 8 * h2);
    const float ct2 = cum[tq] * LOG2E;
    float qb2;
    { float qn = 0.f;
#pragma unroll
      for (int d0 = 0; d0 < 4; ++d0) { const u32x4 qq = __builtin_bit_cast(u32x4, qf[d0]);
#pragma unroll
        for (int j = 0; j < 4; ++j) { const float a = bf2f(qq[j] & 0xffffu), c = bf2f(qq[j] >> 16); qn += a * a + c * c; } }
      qn += swap32(qn);
      const unsigned* km = (const unsigned*)(F.ws + WS_CTL) + CW_KMAX + layer * 128 + (b * 4 + h) * 2;
      const float kk2 = __uint_as_float(xb_ld((unsigned*)km)) + __uint_as_float(xb_ld((unsigned*)km + 1));
      qb2 = sqrtf(qn * kk2) * QSCALE2 * 1.01f + 1e-3f; }
    float mrun = -1e30f, lrun = 0.f; f32x16 o0 = {}, o1 = {};
    const int jtop = 4 * qb + 3;
    u32x4 kreg, vreg;
    at_load_tile(Pb, C_FXK + h * 64, C_FXV + h * 64, jtop, tid, kreg, vreg);
    at_store_tile(L, 0, tid, kreg, vreg);
    __syncthreads();
    int buf = 0; bool wskip = false;
    for (int jt = jtop; jt >= 0; --jt) {
        if (jt > 0) at_load_tile(Pb, C_FXK + h * 64, C_FXV + h * 64, jt - 1, tid, kreg, vreg);
        if (64 * jt <= tw0 + 31 && !wskip) {
            f32x16 s0 = {}, s1 = {};
            at_qk(L + AT_KOFF + buf * AT_BUFB, qf, r32, h2, s0, s1);
            const bool needmask = (64 * jt + 63 > tw0);
            float mx = -1e30f;
#pragma unroll
            for (int g = 0; g < 4; ++g) {
                const f32x4 c0 = *(const LAS f32x4*)(cum + 64 * jt + 8 * g + 4 * h2), c1 = *(const LAS f32x4*)(cum + 64 * jt + 32 + 8 * g + 4 * h2);
#pragma unroll
                for (int j = 0; j < 4; ++j) {
                    const int r = 4 * g + j, kv = 64 * jt + 8 * g + 4 * h2 + j;
                    float v0 = s0[r] * QSCALE2 + (ct2 - c0[j] * LOG2E), v1 = s1[r] * QSCALE2 + (ct2 - c1[j] * LOG2E);
                    if (needmask) { if (kv > tq) v0 = -1e30f; if (kv + 32 > tq) v1 = -1e30f; }
                    s0[r] = v0; s1[r] = v1; mx = fmaxf(mx, fmaxf(v0, v1));
                }
            }
            mx = fmaxf(mx, swap32(mx));
            const float mnew = fmaxf(mrun, mx), alpha = ex2(mrun - mnew);
            mrun = mnew;
            float ps = 0.f;
#pragma unroll
            for (int r = 0; r < 16; ++r) { s0[r] = ex2(s0[r] - mnew); s1[r] = ex2(s1[r] - mnew); ps += s0[r] + s1[r]; }
            lrun = lrun * alpha + ps;
#pragma unroll
            for (int r = 0; r < 16; ++r) { o0[r] *= alpha; o1[r] *= alpha; }
            bf16x8 pb[4]; pb[0] = pack8(s0, 0); pb[1] = pack8(s0, 1); pb[2] = pack8(s1, 0); pb[3] = pack8(s1, 1);
            at_pv(L + AT_VOFF + buf * AT_BUFB, pb, lane, o0, o1);
        }
        if (jt > 0) at_store_tile(L, buf ^ 1, tid, kreg, vreg);
        { int wdone = 0; if (jt > 0) wdone = __all(qb2 + (ct2 - cum[64 * jt - 1] * LOG2E) - mrun < -150.f) ? 1 : 0; wskip = wdone != 0; if (lane == 0) *(LAS int*)(L + AT_MISC + 64 + 32 * (jt & 1) + 4 * wid) = wdone; }
        __syncthreads();
        buf ^= 1;
        { const LAS int* fl = (const LAS int*)(L + AT_MISC + 64 + 32 * (jt & 1)); const int alld = fl[0] & fl[1] & fl[2] & fl[3] & fl[4] & fl[5] & fl[6] & fl[7]; if (alld) break; }
    }
    const float ltot = lrun + swap32(lrun);
    at_store_out(WSP(bf16_t, WS_MIX) + (size_t)(b * SEQ + tq) * D + 768 + h * 64, o0, o1, rcpf_(ltot), h2);
}

DI void sb_unit(Frame& F, int b, int h, int qb) {
    LAS unsigned char* L = F.lds; const int tid = F.tid, lane = F.lane, wid = F.wave, r32 = lane & 31, h2 = lane >> 5;
    const bf16_t* Pb = WSP(bf16_t, WS_P) + (size_t)b * SEQ * PP;
    const int tw0 = 256 * qb + 32 * wid, tq = tw0 + r32;
    bf16x8 qf[4];
#pragma unroll
    for (int d0 = 0; d0 < 4; ++d0) qf[d0] = *(const bf16x8*)(Pb + (size_t)tq * PP + C_SBQ + h * 64 + 16 * d0 + 8 * h2);
    bf16x8 uf[2], onesf;
#pragma unroll
    for (int s = 0; s < 2; ++s)
#pragma unroll
        for (int j = 0; j < 8; ++j) uf[s][j] = ((16 * s + 8 * (j >> 2) + 4 * h2 + (j & 3)) > r32) ? (short)0x3F80 : (short)0;
#pragma unroll
    for (int j = 0; j < 8; ++j) onesf[j] = (short)0x3F80;
    float R2 = 0.f; f32x16 o0 = {}, o1 = {};
    const int jtop = 4 * qb + 3;
    u32x4 kreg, vreg;
    __syncthreads();
    at_load_tile(Pb, C_SBK + h * 64, C_SBV + h * 64, jtop, tid, kreg, vreg);
    at_store_tile(L, 0, tid, kreg, vreg);
    __syncthreads();
    int buf = 0; bool wskip = false;
    for (int jt = jtop; jt >= 0; --jt) {
        if (jt > 0) at_load_tile(Pb, C_SBK + h * 64, C_SBV + h * 64, jt - 1, tid, kreg, vreg);
        if (64 * jt <= tw0 + 31 && !wskip) {
            f32x16 s0 = {}, s1 = {};
            at_qk(L + AT_KOFF + buf * AT_BUFB, qf, r32, h2, s0, s1);
            const bool needmask = (64 * jt + 63 >= tw0);
            f32x16 l0, l1;
            float cs = 0.f;
#pragma unroll
            for (int r = 0; r < 16; ++r) {
                const int kv = 64 * jt + crow(r, h2);
                const float z0 = s0[r] * QSCALE2, z1 = s1[r] * QSCALE2;
                const float sp0 = fmaxf(z0, 0.f) + lg2(1.f + ex2(-fabsf(z0))), sp1 = fmaxf(z1, 0.f) + lg2(1.f + ex2(-fabsf(z1)));
                float a0 = -sp0, a1 = -sp1, b0 = z0 - sp0, b1 = z1 - sp1;
                if (needmask) { if (kv >= tq) { a0 = 0.f; b0 = -1e30f; } if (kv + 32 >= tq) { a1 = 0.f; b1 = -1e30f; } }
                l0[r] = a0; l1[r] = a1; s0[r] = b0; s1[r] = b1; cs += a0 + a1;
            }
            f32x16 t0 = {}, t1 = {};
#pragma unroll
            for (int s = 0; s < 2; ++s) {
                const bf16x8 h0 = pack8(l0, s), h1 = pack8(l1, s);
                f32x16 d0_, d1_;
#pragma unroll
                for (int j = 0; j < 8; ++j) { d0_[j] = l0[8 * s + j] - bf2f((unsigned short)h0[j]); d1_[j] = l1[8 * s + j] - bf2f((unsigned short)h1[j]); }
                u32x4 q0, q1; q0.x = pk2(d0_[0], d0_[1]); q0.y = pk2(d0_[2], d0_[3]); q0.z = pk2(d0_[4], d0_[5]); q0.w = pk2(d0_[6], d0_[7]);
                q1.x = pk2(d1_[0], d1_[1]); q1.y = pk2(d1_[2], d1_[3]); q1.z = pk2(d1_[4], d1_[5]); q1.w = pk2(d1_[6], d1_[7]);
                const bf16x8 e0 = __builtin_bit_cast(bf16x8, q0), e1 = __builtin_bit_cast(bf16x8, q1);
                t0 = MFMA32(uf[s], h0, t0); t0 = MFMA32(uf[s], e0, t0); t0 = MFMA32(onesf, h1, t0); t0 = MFMA32(onesf, e1, t0);
                t1 = MFMA32(uf[s], h1, t1); t1 = MFMA32(uf[s], e1, t1);
            }
#pragma unroll
            for (int r = 0; r < 16; ++r) { s0[r] = ex2(s0[r] + R2 + t0[r]); s1[r] = ex2(s1[r] + R2 + t1[r]); }
            R2 += cs + swap32(cs);
            bf16x8 pb[4]; pb[0] = pack8(s0, 0); pb[1] = pack8(s0, 1); pb[2] = pack8(s1, 0); pb[3] = pack8(s1, 1);
            at_pv(L + AT_VOFF + buf * AT_BUFB, pb, lane, o0, o1);
        }
        if (jt > 0) at_store_tile(L, buf ^ 1, tid, kreg, vreg);
        { const int wdone = __all(R2 < -150.f) ? 1 : 0; wskip = wdone != 0; if (lane == 0) *(LAS int*)(L + AT_MISC + 64 + 32 * (jt & 1) + 4 * wid) = wdone; }
        __syncthreads();
        buf ^= 1;
        { const LAS int* fl = (const LAS int*)(L + AT_MISC + 64 + 32 * (jt & 1)); const int alld = fl[0] & fl[1] & fl[2] & fl[3] & fl[4] & fl[5] & fl[6] & fl[7]; if (alld) break; }
    }
    at_store_out(WSP(bf16_t, WS_MIX) + (size_t)(b * SEQ + tq) * D + 0 + h * 64, o0, o1, 1.f, h2);
}
DI void attn_rank_to_unit(int r, int& bh, int& qb) { if (r < 256) { qb = 7 - (r >> 6); bh = r & 63; } else { const int p = r - 256; qb = p >> 6; bh = p & 63; } }

DI void gm_unit(Frame& F, int layer, int b, int c, int g) {
    LAS unsigned char* L = F.lds; const int lane = F.lane, wid = F.wave, r32 = lane & 31, h2 = lane >> 5;
    constexpr int VSTR = 272;
    const bf16_t* Pb = WSP(bf16_t, WS_P) + (size_t)(b * SEQ + c * 128) * PP;
    __syncthreads();
    { bf16_t xr[16];
#pragma unroll
      for (int i = 0; i < 16; ++i) xr[i] = Pb[(size_t)(16 * wid + i) * PP + C_GMV + g * 64 + lane];
#pragma unroll
      for (int i = 0; i < 16; ++i) {
        const int s = 16 * wid + i;
        const float ge = geluf_(bf2f(xr[i])), mean = wave_sum(ge) * (1.f / 64.f), dv = ge - mean, var = wave_sum(dv * dv) * (1.f / 64.f);
        *(LAS bf16_t*)(L + lane * VSTR + s * 2) = (bf16_t)f2bf(dv * __builtin_amdgcn_rsqf(var + 1e-5f));
      } }
    __syncthreads();
    const int tb = wid >> 1, db = wid & 1, t = 32 * tb + r32;
    const float* Wrow = F.in[3] + ((size_t)(layer * 4 + g) * 128 + t) * 128;
    f32x16 acc = {};
    f32x4 wq[8][2];
#pragma unroll
    for (int ks = 0; ks < 8; ++ks) if (ks <= 2 * tb + 1) { const int s0 = 16 * ks + 8 * h2; wq[ks][0] = *(const f32x4*)(Wrow + s0); wq[ks][1] = *(const f32x4*)(Wrow + s0 + 4); }
#pragma unroll
    for (int ks = 0; ks < 8; ++ks) if (ks <= 2 * tb + 1) {
        const int s0 = 16 * ks + 8 * h2;
        float wv[8] = {wq[ks][0][0], wq[ks][0][1], wq[ks][0][2], wq[ks][0][3], wq[ks][1][0], wq[ks][1][1], wq[ks][1][2], wq[ks][1][3]};
#pragma unroll
        for (int j = 0; j < 8; ++j) if (s0 + j > t) wv[j] = 0.f;
        u32x4 aw; aw.x = pk2(wv[0], wv[1]); aw.y = pk2(wv[2], wv[3]); aw.z = pk2(wv[4], wv[5]); aw.w = pk2(wv[6], wv[7]);
        const bf16x8 bv = *(const LAS bf16x8*)(L + (32 * db + r32) * VSTR + s0 * 2);
        acc = MFMA32(__builtin_bit_cast(bf16x8, aw), bv, acc);
    }
    const int d = 32 * db + r32;
    const float* gb = F.in[4] + (size_t)(layer * 4 + g) * 128;
    bf16_t* mo = WSP(bf16_t, WS_MIX) + (size_t)(b * SEQ + c * 128) * D + 256 + g * 64 + d;
#pragma unroll
    for (int r = 0; r < 16; ++r) { const int tt = 32 * tb + crow(r, h2);
        const float u = geluf_(bf2f(Pb[(size_t)tt * PP + C_GMU + g * 64 + d]));
        mo[(size_t)tt * D] = (bf16_t)f2bf(u * (acc[r] + gb[tt])); }
}

DI void rw_load_shift8(const bf16_t* Pt, bool hasprev, int col, const float* mu, float (&o)[8]) {
    const u32x4 cu = *(const u32x4*)(Pt + col); u32x4 pr = (u32x4){0u, 0u, 0u, 0u}; if (hasprev) pr = *(const u32x4*)(Pt - PP + col);
    const f32x4 m0 = *(const f32x4*)(mu), m1 = *(const f32x4*)(mu + 4);
    const float mm[8] = {m0[0], m0[1], m0[2], m0[3], m1[0], m1[1], m1[2], m1[3]};
#pragma unroll
    for (int j = 0; j < 4; ++j) { const float c0 = bf2f(cu[j] & 0xffffu), c1 = bf2f(cu[j] >> 16), p0 = bf2f(pr[j] & 0xffffu), p1 = bf2f(pr[j] >> 16);
        o[2 * j] = c0 + (p0 - c0) * mm[2 * j]; o[2 * j + 1] = c1 + (p1 - c1) * mm[2 * j + 1]; }
}
DI void rw_load_shift4(const bf16_t* Pt, bool hasprev, int col, const float* mu, float (&o)[4]) {
    const u32x2 cu = *(const u32x2*)(Pt + col); u32x2 pr = (u32x2){0u, 0u}; if (hasprev) pr = *(const u32x2*)(Pt - PP + col);
    const f32x4 m0 = *(const f32x4*)(mu);
#pragma unroll
    for (int j = 0; j < 2; ++j) { const float c0 = bf2f(cu[j] & 0xffffu), c1 = bf2f(cu[j] >> 16), p0 = bf2f(pr[j] & 0xffffu), p1 = bf2f(pr[j] >> 16);
        o[2 * j] = c0 + (p0 - c0) * m0[2 * j]; o[2 * j + 1] = c1 + (p1 - c1) * m0[2 * j + 1]; }
}
DI bf16x8 rw_act_frag(const bf16_t* Pt, bool hasprev, const float* mu, int ks, int h2, int mode) {
    float v[8]; rw_load_shift8(Pt, hasprev, C_RWX + 16 * ks + 8 * h2, mu + 768 + 16 * ks + 8 * h2, v);
    if (mode == 1) {
#pragma unroll
        for (int j = 0; j < 8; ++j) v[j] = tanhf_(v[j]);
    } else if (mode == 2) {
#pragma unroll
        for (int j = 0; j < 8; ++j) v[j] = sigmoidf_(v[j]);
    }
    u32x4 pb; pb.x = pk2(v[0], v[1]); pb.y = pk2(v[2], v[3]); pb.z = pk2(v[4], v[5]); pb.w = pk2(v[6], v[7]);
    return __builtin_bit_cast(bf16x8, pb);
}

constexpr int RC_V = 0, RC_KB = 4608, RC_BB = 9216, RC_KT = 13824, RC_CF = 13824, RC_PC = 18432, RC_WAVE = 18688, RC_ROWB = 144;
DI float scan32(float x) {
    x += dppf<0x111, 0xf, true>(x); x += dppf<0x112, 0xf, true>(x); x += dppf<0x114, 0xf, true>(x); x += dppf<0x118, 0xf, true>(x);
    x += dppf<0x142, 0xa, false>(x);
    return x;
}
DI bf16x8 pk8f(const float (&v)[8]) { u32x4 p; p.x = pk2(v[0], v[1]); p.y = pk2(v[2], v[3]); p.z = pk2(v[4], v[5]); p.w = pk2(v[6], v[7]); return __builtin_bit_cast(bf16x8, p); }
DI bf16x8 rc_trfrag(const LAS unsigned char* tile, int lane, int s, int colblk) {
    const int h2 = lane >> 5;
    const LAS unsigned char* p = tile + (16 * s + 4 * h2 + ((lane & 15) >> 2)) * RC_ROWB + (32 * colblk + 16 * ((lane >> 4) & 1) + 4 * (lane & 3)) * 2;
    const s16x4 lo = tr_read(p), hi = tr_read(p + 8 * RC_ROWB);
    return __builtin_shufflevector(lo, hi, 0, 1, 2, 3, 4, 5, 6, 7);
}
constexpr int RG_ACT = 4 * RC_WAVE, RG_RKV = RG_ACT + 16384, RG_PAR = RG_RKV + 12 * 4608, RG_END = RG_PAR + 5120;
static_assert(RG_END <= LDS_MISC, "chunk-pass LDS map");
DI void rw_group_loader(Frame& F, int layer, int tg) {
    asm volatile("" : "+s"(F.in)); asm volatile("" : "+s"(F.ws)); asm volatile("" : "+v"(F.lane));
    const int lane = F.lane, r32 = lane & 31, h2 = lane >> 5, lw = F.wave - 4, bb = tg >> 6, ch = tg & 63;
    LAS unsigned char* L = F.lds;
    const int tl = 32 * ch + r32, tok = bb * SEQ + tl; const bool hasprev = tl > 0;
    const bf16_t* Pt0 = WSP(bf16_t, WS_P) + (size_t)tok * PP;
    const float* mu = F.in[5] + (size_t)layer * 1024;
#pragma unroll
    for (int j = 0; j < 4; ++j) { const int ks = 4 * lw + j; const bf16x8 fr = rw_act_frag(Pt0, hasprev, mu, ks, h2, lw == 0 ? 1 : (lw == 1 ? 0 : 2));
        *(LAS bf16x8*)(L + RG_ACT + ks * 1024 + lane * 16) = fr; }
#pragma unroll
    for (int arr = 0; arr < 3; ++arr) { const int cb = (arr == 0 ? C_RWR : (arr == 1 ? C_RWK : C_RWV)) + 64 * lw, mo = 256 * arr + 64 * lw;
#pragma unroll
        for (int g8 = 0; g8 < 4; ++g8) { const int c0 = 32 * h2 + 8 * g8; float o[8]; rw_load_shift8(Pt0, hasprev, cb + c0, mu + mo + c0, o);
            *(LAS bf16x8*)(L + RG_RKV + (lw * 3 + arr) * 4608 + r32 * RC_ROWB + c0 * 2) = pk8f(o); } }
    asm volatile("s_waitcnt lgkmcnt(0)" ::: "memory");
    asm volatile("" ::: "memory"); __builtin_amdgcn_s_barrier(); asm volatile("" ::: "memory");
    {
        const bf16_t* wcg = WSP(bf16_t, WS_WCAT) + (size_t)layer * 65536 + (size_t)(64 * lw + r32) * 256 + 8 * h2;
#pragma unroll
        for (int blk = 0; blk < 2; ++blk) { f32x16 aG = {};
#pragma unroll
            for (int ks = 8; ks < 16; ++ks) aG = MFMA32(*(const bf16x8*)(wcg + (size_t)blk * 32 * 256 + 16 * ks), *(const LAS bf16x8*)(L + RG_ACT + ks * 1024 + lane * 16), aG);
#pragma unroll
            for (int g = 0; g < 4; ++g) { const int cl = 32 * blk + 8 * g + 4 * h2; u32x2 gq;
                gq.x = pk2(aG[4 * g], aG[4 * g + 1]); gq.y = pk2(aG[4 * g + 2], aG[4 * g + 3]);
                *(u32x2*)(WSP(bf16_t, WS_GBUF) + (size_t)tok * 256 + 64 * lw + cl) = gq; } }
        asm volatile("s_waitcnt lgkmcnt(0)" ::: "memory");
    }
    {
        const bf16_t* wp = WSP(bf16_t, WS_BIN) + (size_t)layer * NIN * D + (size_t)3072 * D + 4 * lane;
        u32x2 wv[4][4];
#pragma unroll
        for (int c = 0; c < 4; ++c)
#pragma unroll
            for (int j = 0; j < 4; ++j) wv[c][j] = *(const u32x2*)(wp + (size_t)c * D + 256 * j);
        const float* xsrc = (layer == 0) ? F.in[0] : F.out;
        const int t0 = bb * SEQ + 32 * ch + 8 * lw;
#pragma unroll
        for (int ib = 0; ib < 2; ++ib) {
            f32x4 xr[4][4]; float sp[4];
#pragma unroll
            for (int i = 0; i < 4; ++i) { const f32x4* xp = (const f32x4*)(xsrc + (size_t)(t0 + 4 * ib + i) * D) + lane;
#pragma unroll
                for (int j = 0; j < 4; ++j) xr[i][j] = xp[64 * j];
                sp[i] = (lane < 16) ? WSP(float, WS_SS1)[(size_t)(t0 + 4 * ib + i) * 16 + lane] : 0.f; }
#pragma unroll
            for (int i = 0; i < 4; ++i) {
                const float ss = wave_sum(sp[i]); const float rstd = __builtin_amdgcn_rsqf(ss * (1.f / 1024.f) + 1e-6f);
                float res = 0.f;
#pragma unroll
                for (int c = 0; c < 4; ++c) { float a = 0.f;
#pragma unroll
                    for (int j = 0; j < 4; ++j) { const f32x4 x4 = xr[i][j]; const u32x2 wq = wv[c][j];
                        a += (x4[0] * bf2f(wq.x & 0xffffu) + x4[1] * bf2f(wq.x >> 16)) + (x4[2] * bf2f(wq.y & 0xffffu) + x4[3] * bf2f(wq.y >> 16)); }
                    a = wave_sum(a); if (lane == c) res = a; }
                if (lane < 4) { const int row = t0 + 4 * ib + i; WSP(float, WS_LF)[(size_t)((row >> 11) * 4 + lane) * SEQ + (row & 2047)] = -softplusf_(-(res * rstd + F.in[16][layer * 4 + lane])); }
            }
        }
    }
    asm volatile("" ::: "memory"); __builtin_amdgcn_s_barrier(); asm volatile("" ::: "memory");
}
DI void rw_group_compute(Frame& F, int layer, int tg) {
    asm volatile("" : "+s"(F.in)); asm volatile("" : "+s"(F.ws)); asm volatile("" : "+v"(F.lane));
    const int lane = F.lane, r32 = lane & 31, h2 = lane >> 5, hd = F.wave, bb = tg >> 6, ch = tg & 63, bh = bb * 4 + hd;
    LAS unsigned char* L = F.lds;
    LAS unsigned char* W = L + F.wave * RC_WAVE;
    const int tl = 32 * ch + r32, tok = bb * SEQ + tl;
    const bf16_t* wc = WSP(bf16_t, WS_WCAT) + (size_t)layer * 65536 + (size_t)(64 * hd + r32) * 256 + 8 * h2;
    const int chunk = bh * 64 + ch;
    const LAS float* PAR = (const LAS float*)(L + RG_PAR) + 64 * hd;
    const LAS unsigned char* TR = L + RG_RKV + (hd * 3 + 0) * 4608 + r32 * RC_ROWB;
    const LAS unsigned char* TK = TR + 4608; const LAS unsigned char* TV = TR + 2 * 4608;
    u32x4 FRr[16];
    asm volatile("" ::: "memory"); __builtin_amdgcn_s_barrier(); asm volatile("" ::: "memory");
    float n2 = 0.f;
#pragma unroll
    for (int g8 = 0; g8 < 4; ++g8) { const u32x4 kq = *(const LAS u32x4*)(TK + 64 * h2 + 16 * g8); const f32x4 k0 = *(const LAS f32x4*)(PAR + 1024 + 32 * h2 + 8 * g8), k1 = *(const LAS f32x4*)(PAR + 1024 + 32 * h2 + 8 * g8 + 4);
#pragma unroll
        for (int j = 0; j < 4; ++j) { const float a = bf2f(kq[j] & 0xffffu) * (j < 2 ? k0[2 * j] : k1[2 * j - 4]), c = bf2f(kq[j] >> 16) * (j < 2 ? k0[2 * j + 1] : k1[2 * j - 3]); n2 += a * a + c * c; } }
    n2 += swap32(n2);
    const float inv = 1.f / fmaxf(sqrtf(n2), 1e-12f);
    float bon = 0.f;
#pragma unroll
    for (int blk = 0; blk < 2; ++blk) {
        const bf16_t* wb = wc + (size_t)blk * 32 * 256;
        f32x16 aW = {}, aA = {};
#pragma unroll
        for (int ks = 0; ks < 4; ++ks) aW = MFMA32(*(const bf16x8*)(wb + 16 * ks), *(const LAS bf16x8*)(L + RG_ACT + ks * 1024 + lane * 16), aW);
#pragma unroll
        for (int ks = 4; ks < 8; ++ks) aA = MFMA32(*(const bf16x8*)(wb + 16 * ks), *(const LAS bf16x8*)(L + RG_ACT + ks * 1024 + lane * 16), aA);
#pragma unroll
        for (int s = 0; s < 2; ++s) {
            float e_kat[8], e_rt[8], e_kt[8], e_bt[8], e_kb[8], e_bb[8];
#pragma unroll
            for (int q = 0; q < 2; ++q) { const int g = 2 * s + q, cl = 32 * blk + 8 * g + 4 * h2;
                const u32x2 rq = *(const LAS u32x2*)(TR + cl * 2), kq = *(const LAS u32x2*)(TK + cl * 2), vq = *(const LAS u32x2*)(TV + cl * 2);
                const float rv[4] = {bf2f(rq.x & 0xffffu), bf2f(rq.x >> 16), bf2f(rq.y & 0xffffu), bf2f(rq.y >> 16)}, kv[4] = {bf2f(kq.x & 0xffffu), bf2f(kq.x >> 16), bf2f(kq.y & 0xffffu), bf2f(kq.y >> 16)};
                const f32x4 w0v = *(const LAS f32x4*)(PAR + cl), a0v = *(const LAS f32x4*)(PAR + 256 + cl), kav = *(const LAS f32x4*)(PAR + 512 + cl), rkv = *(const LAS f32x4*)(PAR + 768 + cl), kwv = *(const LAS f32x4*)(PAR + 1024 + cl);
#pragma unroll
                for (int j = 0; j < 4; ++j) { const int r = 4 * g + j, jj = 4 * q + j;
                    const float w = -softplusf_(-(w0v[j] + aW[r])) - 0.5f;
                    const float l2d = -LOG2E * ex2(w * LOG2E);
                    const float a = sigmoidf_(a0v[j] + aA[r]);
                    const float kkv = kv[j] * kwv[j] * inv, bev = kkv * a, kpv = kv[j] * (1.f + (a - 1.f) * kav[j]);
                    bon += rv[j] * kpv * rkv[j];
                    const float Li = scan32(l2d), Lex = Li - l2d, LC = __shfl(Li, 31 + 32 * h2);
                    const float pin = ex2(Li), pex = ex2(Lex), pinv = ex2(-Li), pc = ex2(LC - Li);
                    e_kat[jj] = kkv * pex; e_rt[jj] = rv[j] * pin; e_kt[jj] = kpv * pinv; e_bt[jj] = bev * pinv; e_kb[jj] = kpv * pc; e_bb[jj] = bev * pc;
                    if (r32 == 31) *(LAS float*)(W + RC_PC + (cl + j) * 4) = ex2(LC); }
                *(LAS u32x2*)(W + RC_V + r32 * RC_ROWB + cl * 2) = vq;
                *(LAS u32x2*)(W + RC_KB + r32 * RC_ROWB + cl * 2) = (u32x2){pk2(e_kb[4 * q], e_kb[4 * q + 1]), pk2(e_kb[4 * q + 2], e_kb[4 * q + 3])};
                *(LAS u32x2*)(W + RC_BB + r32 * RC_ROWB + cl * 2) = (u32x2){pk2(e_bb[4 * q], e_bb[4 * q + 1]), pk2(e_bb[4 * q + 2], e_bb[4 * q + 3])};
                *(LAS u32x2*)(W + RC_KT + r32 * RC_ROWB + cl * 2) = (u32x2){pk2(e_kat[4 * q], e_kat[4 * q + 1]), pk2(e_kat[4 * q + 2], e_kat[4 * q + 3])};
            }
            { const int ks = 2 * blk + s; FRr[ks * 4 + 0] = __builtin_bit_cast(u32x4, pk8f(e_kat)); FRr[ks * 4 + 1] = __builtin_bit_cast(u32x4, pk8f(e_rt)); FRr[ks * 4 + 2] = __builtin_bit_cast(u32x4, pk8f(e_kt)); FRr[ks * 4 + 3] = __builtin_bit_cast(u32x4, pk8f(e_bt)); }
        }
    }
    asm volatile("s_waitcnt lgkmcnt(0)" ::: "memory");
    asm volatile("" ::: "memory"); __builtin_amdgcn_s_barrier(); asm volatile("" ::: "memory");
    bon += swap32(bon);
    asm volatile("" ::: "memory");
#pragma unroll
    for (int blk = 0; blk < 2; ++blk)
#pragma unroll
        for (int g = 0; g < 4; ++g) { const int cl = 32 * blk + 8 * g + 4 * h2; const u32x2 vq = *(const LAS u32x2*)(W + RC_V + r32 * RC_ROWB + cl * 2); u32x2 q;
            q.x = pk2(bon * bf2f(vq.x & 0xffffu), bon * bf2f(vq.x >> 16)); q.y = pk2(bon * bf2f(vq.y & 0xffffu), bon * bf2f(vq.y >> 16));
            *(u32x2*)(WSP(bf16_t, WS_BONV) + (size_t)tok * 256 + 64 * hd + cl) = q; }
    const float pc_lo = *(const LAS float*)(W + RC_PC + r32 * 4), pc_hi = *(const LAS float*)(W + RC_PC + (32 + r32) * 4);
    bf16x8 akkf[2], arkf[2], arbf[2];
    f32x16 Tt;
    {
        f32x16 skk = {}, skb = {}, sl = {};
#pragma unroll
        for (int ks = 0; ks < 4; ++ks) { const bf16x8 katf = __builtin_bit_cast(bf16x8, FRr[ks * 4 + 0]), ktf = __builtin_bit_cast(bf16x8, FRr[ks * 4 + 2]), btf = __builtin_bit_cast(bf16x8, FRr[ks * 4 + 3]);
            skk = MFMA32(ktf, katf, skk); skb = MFMA32(btf, katf, skb); sl = MFMA32(katf, btf, sl); }
#pragma unroll
        for (int r = 0; r < 16; ++r) { const int i = crow(r, h2); if (i >= r32) { skk[r] = 0.f; skb[r] = 0.f; } if (i <= r32) sl[r] = 0.f; }
#pragma unroll
        for (int s = 0; s < 2; ++s) akkf[s] = pack8(skk, s);
        bf16x8 fx[2], fxt[2];
#pragma unroll
        for (int s = 0; s < 2; ++s) { fx[s] = pack8(sl, s); fxt[s] = pack8(skb, s); }
#pragma unroll
        for (int r = 0; r < 16; ++r) Tt[r] = ((crow(r, h2) == r32) ? 1.f : 0.f) - skb[r];
#pragma unroll
        for (int lvl = 0; lvl < 4; ++lvl) {
            f32x16 p = {}, pt = {};
#pragma unroll
            for (int s = 0; s < 2; ++s) { p = MFMA32(fxt[s], fx[s], p); if (lvl < 3) pt = MFMA32(fx[s], fxt[s], pt); }
#pragma unroll
            for (int s = 0; s < 2; ++s) fx[s] = pack8(p, s);
            const bf16x8 t0 = pack8(Tt, 0), t1 = pack8(Tt, 1);
            Tt = MFMA32(fx[0], t0, Tt); Tt = MFMA32(fx[1], t1, Tt);
            if (lvl < 3) {
#pragma unroll
                for (int s = 0; s < 2; ++s) fxt[s] = pack8(pt, s); }
        }
    }
    {
        f32x16 srk = {}, srb = {};
#pragma unroll
        for (int ks = 0; ks < 4; ++ks) { const bf16x8 rtf = __builtin_bit_cast(bf16x8, FRr[ks * 4 + 1]), ktf = __builtin_bit_cast(bf16x8, FRr[ks * 4 + 2]), btf = __builtin_bit_cast(bf16x8, FRr[ks * 4 + 3]);
            srk = MFMA32(ktf, rtf, srk); srb = MFMA32(btf, rtf, srb); }
#pragma unroll
        for (int r = 0; r < 16; ++r) if (crow(r, h2) > r32) { srk[r] = 0.f; srb[r] = 0.f; }
#pragma unroll
        for (int s = 0; s < 2; ++s) { arkf[s] = pack8(srk, s); arbf[s] = pack8(srb, s); }
    }
    asm volatile("" ::: "memory");
    bf16x8 ng1f[2][2], ng2f[2][2];
    {
        const bf16x8 tf0 = pack8(Tt, 0), tf1 = pack8(Tt, 1);
#pragma unroll
        for (int cb = 0; cb < 2; ++cb) {
            f32x16 g = {};
            g = MFMA32(tf0, rc_trfrag(W + RC_KT, lane, 0, cb), g); g = MFMA32(tf1, rc_trfrag(W + RC_KT, lane, 1, cb), g);
#pragma unroll
            for (int r = 0; r < 16; ++r) g[r] = -g[r];
            ng1f[cb][0] = pack8(g, 0); ng1f[cb][1] = pack8(g, 1);
        }
#pragma unroll
        for (int vb = 0; vb < 2; ++vb) {
            f32x16 x1 = {};
#pragma unroll
            for (int s = 0; s < 2; ++s) x1 = MFMA32(akkf[s], rc_trfrag(W + RC_V, lane, s, vb), x1);
            f32x16 g = {};
            g = MFMA32(tf0, pack8(x1, 0), g); g = MFMA32(tf1, pack8(x1, 1), g);
#pragma unroll
            for (int r = 0; r < 16; ++r) g[r] = -g[r];
            ng2f[vb][0] = pack8(g, 0); ng2f[vb][1] = pack8(g, 1);
        }
    }
    asm volatile("" ::: "memory");
    u32x4* mt = WSP(u32x4, WS_CHMT) + (size_t)chunk * 8 * 64 + lane;
#pragma unroll
    for (int bip = 0; bip < 2; ++bip)
#pragma unroll
        for (int bi = 0; bi < 2; ++bi) {
            f32x16 m = {};
#pragma unroll
            for (int s = 0; s < 2; ++s) m = MFMA32(ng1f[bi][s], rc_trfrag(W + RC_BB, lane, s, bip), m);
            if (bi == bip) {
#pragma unroll
                for (int r = 0; r < 16; ++r) if (crow(r, h2) == r32) m[r] += (bi ? pc_hi : pc_lo); }
#pragma unroll
            for (int s = 0; s < 2; ++s) mt[(bip * 4 + bi * 2 + s) * 64] = __builtin_bit_cast(u32x4, pack8(m, s));
        }
    asm volatile("" ::: "memory");
    u32x4* nb_ = WSP(u32x4, WS_CHN) + (size_t)chunk * 8 * 64 + lane;
#pragma unroll
    for (int vb = 0; vb < 2; ++vb)
#pragma unroll
        for (int bip = 0; bip < 2; ++bip) {
            f32x16 n = {};
#pragma unroll
            for (int s = 0; s < 2; ++s) { n = MFMA32(rc_trfrag(W + RC_KB, lane, s, bip), rc_trfrag(W + RC_V, lane, s, vb), n); n = MFMA32(rc_trfrag(W + RC_BB, lane, s, bip), ng2f[vb][s], n); }
#pragma unroll
            for (int s = 0; s < 2; ++s) nb_[((vb * 2 + bip) * 2 + s) * 64] = __builtin_bit_cast(u32x4, pack8(n, s));
        }
    asm volatile("" ::: "memory");
    u32x4* ry = WSP(u32x4, WS_CHRY) + (size_t)chunk * 4 * 64 + lane;
#pragma unroll
    for (int bi = 0; bi < 2; ++bi) {
        f32x16 q = {};
#pragma unroll
        for (int s = 0; s < 2; ++s) q = MFMA32(ng1f[bi][s], arbf[s], q);
#pragma unroll
        for (int s = 0; s < 2; ++s) { const u32x4 rq = FRr[(2 * bi + s) * 4 + 1]; float o[8];
#pragma unroll
            for (int j = 0; j < 4; ++j) { o[2 * j] = q[8 * s + 2 * j] + bf2f(rq[j] & 0xffffu); o[2 * j + 1] = q[8 * s + 2 * j + 1] + bf2f(rq[j] >> 16); }
            ry[(bi * 2 + s) * 64] = __builtin_bit_cast(u32x4, pk8f(o)); }
    }
    asm volatile("" ::: "memory");
    u32x4* y0 = WSP(u32x4, WS_CHY0) + (size_t)chunk * 4 * 64 + lane;
#pragma unroll
    for (int vb = 0; vb < 2; ++vb) {
        f32x16 yy = {};
#pragma unroll
        for (int s = 0; s < 2; ++s) { yy = MFMA32(arkf[s], rc_trfrag(W + RC_V, lane, s, vb), yy); yy = MFMA32(arbf[s], ng2f[vb][s], yy); }
#pragma unroll
        for (int s = 0; s < 2; ++s) y0[(vb * 2 + s) * 64] = __builtin_bit_cast(u32x4, pack8(yy, s));
    }
    asm volatile("s_waitcnt lgkmcnt(0)" ::: "memory");
}
DI void unpack16(const u32x4& a, const u32x4& b, f32x16& o) {
#pragma unroll
    for (int j = 0; j < 4; ++j) { o[2 * j] = bf2f(a[j] & 0xffffu); o[2 * j + 1] = bf2f(a[j] >> 16); o[8 + 2 * j] = bf2f(b[j] & 0xffffu); o[8 + 2 * j + 1] = bf2f(b[j] >> 16); }
}
constexpr int SQ_BH = 24576, SQ_STAGE = 2 * SQ_BH;
DI void rw_seq_wg(Frame& F, int item, unsigned* sd) {
    LAS unsigned char* L = F.lds; const int lane = F.lane, wid = F.wave, r32 = lane & 31, h2 = lane >> 5;
    __syncthreads();
    if (wid >= 4) {
        const int slot = (wid - 4) >> 1, half = (wid - 4) & 1, bh = 2 * item + slot;
        const u32x4* mtb = WSP(u32x4, WS_CHMT) + (size_t)bh * 64 * 8 * 64 + lane;
        const u32x4* nbb = WSP(u32x4, WS_CHN) + (size_t)bh * 64 * 8 * 64 + lane;
        const u32x4* ryb = WSP(u32x4, WS_CHRY) + (size_t)bh * 64 * 4 * 64 + lane;
        const u32x4* y0b = WSP(u32x4, WS_CHY0) + (size_t)bh * 64 * 4 * 64 + lane;
#define SQ_ISSUE(CH) do { const int ch_ = (CH); LAS unsigned char* st_ = L + (ch_ % 3) * SQ_STAGE + slot * SQ_BH; \
            if (half == 0) { _Pragma("unroll") for (int i = 0; i < 8; ++i) __builtin_amdgcn_global_load_lds((const unsigned*)(mtb + (size_t)ch_ * 512 + i * 64), (LAS unsigned*)(st_ + i * 1024), 16, 0, 0); \
                             _Pragma("unroll") for (int i = 0; i < 4; ++i) __builtin_amdgcn_global_load_lds((const unsigned*)(ryb + (size_t)ch_ * 256 + i * 64), (LAS unsigned*)(st_ + (8 + i) * 1024), 16, 0, 0); } \
            else { _Pragma("unroll") for (int i = 0; i < 8; ++i) __builtin_amdgcn_global_load_lds((const unsigned*)(nbb + (size_t)ch_ * 512 + i * 64), (LAS unsigned*)(st_ + (12 + i) * 1024), 16, 0, 0); \
                   _Pragma("unroll") for (int i = 0; i < 4; ++i) __builtin_amdgcn_global_load_lds((const unsigned*)(y0b + (size_t)ch_ * 256 + i * 64), (LAS unsigned*)(st_ + (20 + i) * 1024), 16, 0, 0); } } while (0)
        SQ_ISSUE(0); SQ_ISSUE(1);
        asm volatile("s_waitcnt vmcnt(12)" ::: "memory");
        __builtin_amdgcn_s_barrier();
#pragma unroll 1
        for (int ch = 0; ch < 64; ++ch) {
            if (ch + 2 < 64) { SQ_ISSUE(ch + 2); asm volatile("s_waitcnt vmcnt(12)" ::: "memory"); }
            else asm volatile("s_waitcnt vmcnt(0)" ::: "memory");
            __builtin_amdgcn_s_barrier();
        }
#undef SQ_ISSUE
    } else {
        const int slot = wid >> 1, vb = wid & 1, bh = 2 * item + slot;
        f32x16 H0 = {}, H1 = {};
        float* yb = WSP(float, WS_YBUF) + (size_t)(bh >> 2) * SEQ * 256 + (bh & 3) * 64 + 32 * vb + r32;
        __builtin_amdgcn_s_barrier();
#pragma unroll 1
        for (int ch = 0; ch < 64; ++ch) {
            const LAS unsigned char* st = L + (ch % 3) * SQ_STAGE + slot * SQ_BH + lane * 16;
            u32x4 cmt[8], cry[4], cnn[4], cy0[2];
#pragma unroll
            for (int i = 0; i < 8; ++i) cmt[i] = *(const LAS u32x4*)(st + i * 1024);
#pragma unroll
            for (int i = 0; i < 4; ++i) { cry[i] = *(const LAS u32x4*)(st + (8 + i) * 1024); cnn[i] = *(const LAS u32x4*)(st + (12 + 4 * vb + i) * 1024); }
            cy0[0] = *(const LAS u32x4*)(st + (20 + 2 * vb) * 1024); cy0[1] = *(const LAS u32x4*)(st + (21 + 2 * vb) * 1024);
            bf16x8 hb[4]; hb[0] = pack8(H0, 0); hb[1] = pack8(H0, 1); hb[2] = pack8(H1, 0); hb[3] = pack8(H1, 1);
            f32x16 y, n0, n1;
            unpack16(cy0[0], cy0[1], y); unpack16(cnn[0], cnn[1], n0); unpack16(cnn[2], cnn[3], n1);
            asm volatile("s_waitcnt lgkmcnt(0)" ::: "memory");
#pragma unroll
            for (int ks = 0; ks < 4; ++ks) { n0 = MFMA32(__builtin_bit_cast(bf16x8, cmt[ks]), hb[ks], n0); n1 = MFMA32(__builtin_bit_cast(bf16x8, cmt[4 + ks]), hb[ks], n1); y = MFMA32(__builtin_bit_cast(bf16x8, cry[ks]), hb[ks], y); }
            H0 = n0; H1 = n1;
#pragma unroll
            for (int r = 0; r < 16; ++r) yb[(size_t)(32 * ch + crow(r, h2)) * 256] = y[r];
            __builtin_amdgcn_s_barrier();
        }
        asm volatile("s_waitcnt vmcnt(0)" ::: "memory");
    }
    __syncthreads();
    if (F.tid == 0) {
        __builtin_amdgcn_fence(__ATOMIC_RELEASE, "agent");
        asm volatile("s_waitcnt vmcnt(0)" ::: "memory");
        (void)xb_add(sd, 1u);
    }
}
template <int NB> DI void rw_post_batch(Frame& F, int layer, int w0, int ws) {
    const int lane = F.lane;
    float y[NB], bv[NB], g[NB]; int tokv[NB], cv[NB];
#pragma unroll
    for (int i = 0; i < NB; ++i) { const int w = w0 + i * ws; tokv[i] = w >> 2; cv[i] = 64 * (w & 3) + lane;
        y[i] = WSP(float, WS_YBUF)[(size_t)tokv[i] * 256 + cv[i]];
        bv[i] = bf2f(WSP(bf16_t, WS_BONV)[(size_t)tokv[i] * 256 + cv[i]]); g[i] = bf2f(WSP(bf16_t, WS_GBUF)[(size_t)tokv[i] * 256 + cv[i]]); }
#pragma unroll
    for (int i = 0; i < NB; ++i) {
        const float mean = wave_sum(y[i]) * (1.f / 64.f), dv = y[i] - mean, var = wave_sum(dv * dv) * (1.f / 64.f);
        const float yn = dv * __builtin_amdgcn_rsqf(var + 64e-5f) * F.in[14][layer * 256 + cv[i]] + F.in[15][layer * 256 + cv[i]];
        WSP(bf16_t, WS_MIX)[(size_t)tokv[i] * D + 512 + cv[i]] = (bf16_t)f2bf((yn + bv[i]) * g[i]);
    }
}

constexpr int RT_WSTR = 1028;
DI void p4_router(Frame& F, int layer, bool dry) {
    LAS unsigned char* L = F.lds; const int tid = F.tid, lane = F.lane, wid = F.wave, m16 = lane & 15, q4 = lane >> 4;
    LAS float* W = (LAS float*)L;
    LAS float* wlog = (LAS float*)L + wid * (16 * 49);
    LAS int* ent = (LAS int*)(L + 148032);
    LAS float* entg = (LAS float*)(L + 148032 + 4096);
    LAS int* lcnt = (LAS int*)(L + 148032 + 5120);
    LAS int* lbase = lcnt + 144;
    const float* x = F.out; bf16_t* xb = WSP(bf16_t, WS_XB);
    const float *bg = F.in[20] + layer * 4, *be = F.in[22] + layer * 32;
    unsigned* cnt = (unsigned*)(F.ws + WS_CTL) + CW_CNT + layer * 256;
    int* elist = WSP(int, WS_LIST); float* egate = WSP(float, WS_GLIST); u32x2* plist = WSP(u32x2, WS_PLIST);
    for (int blk = F.bid; blk < NT / 128; blk += F.G) {
        __syncthreads();
        { const f32x4* src = (const f32x4*)(WSP(float, WS_RTW) + (size_t)layer * 36 * 1024);
          for (int i = tid; i < 36 * 256; i += 512) *(LAS f32x4*)(W + (i >> 8) * RT_WSTR + 4 * (i & 255)) = src[i]; }
        if (tid < 144) lcnt[tid] = 0;
        __syncthreads();
        const int row0 = blk * 128 + wid * 16;
        const float* xr = x + (size_t)(row0 + m16) * D + 4 * q4; bf16_t* xbr = xb + (size_t)(row0 + m16) * D + 4 * q4;
        f32x4 a0 = {}, a1 = {}, a2 = {}; float ssq = 0.f;
        const LAS float* w0p = W + (size_t)m16 * RT_WSTR + 4 * q4; const LAS float* w1p = w0p + 16 * RT_WSTR; const LAS float* w2p = W + (size_t)(32 + (m16 & 3)) * RT_WSTR + 4 * q4;
        const bool v2 = m16 < 4;
#pragma unroll 16
        for (int j = 0; j < 64; ++j) {
            const f32x4 xv = *(const f32x4*)(xr + 16 * j);
            const f32x4 wa = *(const LAS f32x4*)(w0p + 16 * j), wb = *(const LAS f32x4*)(w1p + 16 * j); f32x4 wc_ = *(const LAS f32x4*)(w2p + 16 * j);
            if (!v2) wc_ = (f32x4){0.f, 0.f, 0.f, 0.f};
            ssq += (xv[0] * xv[0] + xv[1] * xv[1]) + (xv[2] * xv[2] + xv[3] * xv[3]);
            u32x2 w; w.x = pk2(xv[0], xv[1]); w.y = pk2(xv[2], xv[3]); *(u32x2*)(xbr + 16 * j) = w;
#pragma unroll
            for (int i = 0; i < 4; ++i) { a0 = __builtin_amdgcn_mfma_f32_16x16x4f32(xv[i], wa[i], a0, 0, 0, 0); a1 = __builtin_amdgcn_mfma_f32_16x16x4f32(xv[i], wb[i], a1, 0, 0, 0); a2 = __builtin_amdgcn_mfma_f32_16x16x4f32(xv[i], wc_[i], a2, 0, 0, 0); }
        }
        ssq += __shfl_xor(ssq, 16); ssq += __shfl_xor(ssq, 32);
        __syncthreads();
#pragma unroll
        for (int jj = 0; jj < 4; ++jj) { wlog[(4 * q4 + jj) * 49 + m16] = a0[jj]; wlog[(4 * q4 + jj) * 49 + 16 + m16] = a1[jj]; wlog[(4 * q4 + jj) * 49 + 32 + m16] = a2[jj]; }
        asm volatile("s_waitcnt lgkmcnt(0)" ::: "memory");
        if (lane < 16) {
            const int r = lane, row = row0 + r;
            const float rstd = __builtin_amdgcn_rsqf(ssq * (1.f / 1024.f) + 1e-6f);
            WSP(float, WS_RSTD2)[row] = rstd;
            float gl[4]; int gs = 0; float gmax;
#pragma unroll
            for (int j = 0; j < 4; ++j) gl[j] = wlog[r * 49 + j] * rstd + bg[j];
            gmax = gl[0];
#pragma unroll
            for (int j = 1; j < 4; ++j) if (gl[j] > gmax) { gmax = gl[j]; gs = j; }
            float gsum = 0.f;
#pragma unroll
            for (int j = 0; j < 4; ++j) gsum += ex2((gl[j] - gmax) * LOG2E);
            const float ggate = 1.f / gsum;
            float el[8];
#pragma unroll
            for (int j = 0; j < 8; ++j) el[j] = wlog[r * 49 + 4 + gs * 8 + j] * rstd + be[gs * 8 + j];
            int i0 = 0; float m0 = el[0];
#pragma unroll
            for (int j = 1; j < 8; ++j) if (el[j] > m0) { m0 = el[j]; i0 = j; }
            int i1 = -1; float m1 = -3.0e38f;
#pragma unroll
            for (int j = 0; j < 8; ++j) if (j != i0 && (i1 < 0 || el[j] > m1)) { m1 = el[j]; i1 = j; }
            const float e1 = ex2((m1 - m0) * LOG2E), g0 = ggate / (1.f + e1), g1 = ggate * e1 / (1.f + e1);
            const int la = i0 < i1 ? i0 : i1, lb = i0 < i1 ? i1 : i0; const float ga = i0 < i1 ? g0 : g1, gb = i0 < i1 ? g1 : g0;
            const int ea = gs * 8 + la, eb = gs * 8 + lb, pid = gs * 28 + la * (15 - la) / 2 + (lb - la - 1);
            const int ra = atomicAdd((int*)&lcnt[ea], 1), rb = atomicAdd((int*)&lcnt[eb], 1), rp = atomicAdd((int*)&lcnt[32 + pid], 1);
            const int li = wid * 16 + r;
            ent[li * 8 + 0] = ea; ent[li * 8 + 1] = eb; ent[li * 8 + 2] = pid; ent[li * 8 + 3] = ra; ent[li * 8 + 4] = rb; ent[li * 8 + 5] = rp; entg[li * 2] = ga; entg[li * 2 + 1] = gb;
        }
        __syncthreads();
        if (tid < 144) { const int n = lcnt[tid]; lbase[tid] = (n && !dry) ? (int)xb_add(cnt + tid, (unsigned)n) : 0; }
        __syncthreads();
        if (tid < 128 && !dry) { const int row = blk * 128 + tid; const int ea = ent[tid * 8], eb = ent[tid * 8 + 1], pid = ent[tid * 8 + 2];
            const int pa = lbase[ea] + ent[tid * 8 + 3], pb = lbase[eb] + ent[tid * 8 + 4], pp = lbase[32 + pid] + ent[tid * 8 + 5];
            elist[(size_t)ea * LCAP + pa] = row; egate[(size_t)ea * LCAP + pa] = entg[tid * 2];
            elist[(size_t)eb * LCAP + pb] = row; egate[(size_t)eb * LCAP + pb] = entg[tid * 2 + 1];
            plist[(size_t)pid * LCAP + pp] = (u32x2){(unsigned)row, (unsigned)pa | ((unsigned)pb << 16)}; }
    }
    __syncthreads();
}
DI void moe_tables(Frame& F, int layer) {
    LAS MoeTab* T = (LAS MoeTab*)(F.lds + LDS_AUX);
    unsigned* cnt = (unsigned*)(F.ws + WS_CTL) + CW_CNT + layer * 256;
    __syncthreads();
    if (F.tid < 32) T->ce[F.tid] = (int)xb_ld(cnt + F.tid); else if (F.tid < 144) T->cp[F.tid - 32] = (int)xb_ld(cnt + F.tid);
    __syncthreads();
    if (F.tid == 0) { int sb = 0, tg = 0;
        for (int e = 0; e < 32; ++e) { const int a = T->ce[e]; T->sb[e] = sb; T->tpg[e] = tg; sb += a; tg += (a + 255) >> 8; }
        T->tpg[32] = tg; }
    if (F.tid == 64) { int tf = 0, th = 0;
        for (int p = 0; p < 112; ++p) { const int n = T->cp[p], nt_ = (n + 255) >> 8, half = (nt_ > 0 && n - 256 * (nt_ - 1) <= 128) ? 1 : 0; T->tpf[p] = tf; T->tph[p] = th; tf += nt_ - half; th += half; }
        T->tpf[112] = tf; T->tph[112] = th; }
    __syncthreads();
}
DI void p_final(Frame& F) {
    const int gw = F.bid * 8 + F.wave, NGW = F.G * 8; const f32x4* gq = (const f32x4*)F.in[26] + F.lane;
    f32x4 gv[4];
#pragma unroll
    for (int j = 0; j < 4; ++j) gv[j] = gq[64 * j];
    for (int m0 = gw * 4; m0 < NT; m0 += NGW * 4) {
        f32x4 v[4][4];
#pragma unroll
        for (int r = 0; r < 4; ++r) { const f32x4* xr = (const f32x4*)(F.out + (size_t)(m0 + r) * D) + F.lane;
#pragma unroll
            for (int j = 0; j < 4; ++j) v[r][j] = xr[64 * j]; }
#pragma unroll
        for (int r = 0; r < 4; ++r) { float s = 0.f; f32x4* xw = (f32x4*)(F.out + (size_t)(m0 + r) * D) + F.lane;
#pragma unroll
            for (int j = 0; j < 4; ++j) s += (v[r][j][0] * v[r][j][0] + v[r][j][1] * v[r][j][1]) + (v[r][j][2] * v[r][j][2] + v[r][j][3] * v[r][j][3]);
            const float rstd = __builtin_amdgcn_rsqf(wave_sum(s) * (1.f / 1024.f) + 1e-6f);
#pragma unroll
            for (int j = 0; j < 4; ++j) xw[64 * j] = v[r][j] * rstd * gv[j]; }
    }
}


#ifndef DUP_PH
#define DUP_PH -1
#endif
#define NREP(n) ((DUP_PH == (n)) ? 2 : 1)
constexpr int PH_PER_LAYER = 6, N_PHASES = 1 + DEPTH * PH_PER_LAYER + 1;
__global__ void __launch_bounds__(512, 2) mk_fwd(Args args) {
    extern __shared__ __attribute__((aligned(16))) unsigned char lds_raw[];
    Frame F;
    F.lds = (LAS unsigned char*)lds_raw; F.tid = threadIdx.x; F.lane = F.tid & 63; F.wave = __builtin_amdgcn_readfirstlane(F.tid >> 6);
    F.G = gridDim.x; F.bid = blockIdx.x; F.in = (const __attribute__((address_space(4))) cfp_t*)__builtin_amdgcn_kernarg_segment_ptr(); F.out = args.out; F.ws = args.ws;
    volatile LAS unsigned* MISC = (volatile LAS unsigned*)(F.lds + LDS_MISC);
    if (F.tid < 64) MISC[F.tid] = 0u;
    __syncthreads();
    unsigned* ctl = (unsigned*)(F.ws + WS_CTL);
    const int lo = args.ph_lo, hi = args.ph_hi;
    const bool multi = (hi - lo) > 1;
    XcdBarrier bar; bar.bar = ctl + CW_BAR; bar.x = 0; bar.st = nullptr;
    if (multi) bar = xcd_barrier_post(ctl + CW_BAR, MISC + 8);
#ifndef PHSEL
#define PHSEL -1
#endif
#ifndef PHMASK
#define PHMASK 0xFFFF
#endif
#define PS(n) ((PHSEL < 0 || PHSEL == (n)) && ((PHMASK >> (n)) & 1))
#define LAUNDER() do { asm volatile("" : "+s"(F.in)); asm volatile("" : "+s"(F.ws)); asm volatile("" : "+s"(F.out)); asm volatile("" : "+v"(F.tid)); asm volatile("" : "+v"(F.lane)); asm volatile("" : "+s"(F.bid)); asm volatile("" : "+s"(F.G)); } while (0)
#define IN(k) (lo <= (k) && (k) < hi)
#define SEAM(k) do { if (IN(k) && IN((k) + 1)) { xcd_barrier(bar); if (DUP_PH == 99) xcd_barrier(bar); } LAUNDER(); } while (0)
    LAUNDER();
    if (PS(0) && IN(0)) { _Pragma("unroll 1") for (int rep = 0; rep < NREP(0); ++rep) p0_prologue(F); }
    SEAM(0);
#pragma unroll 1
    for (int layer = 0; layer < DEPTH; ++layer) {
        const int pb = 1 + layer * PH_PER_LAYER;
        LAUNDER();
        if (PS(1) && IN(pb + 0)) _Pragma("unroll 1") for (int rep = 0; rep < NREP(1); ++rep) {
            ProbIn P; P.K = D; P.A = WSP(bf16_t, WS_XB); P.Bt = WSP(bf16_t, WS_BIN) + (size_t)layer * NIN * D; P.G = F.G; P.c = F.bid;
            P.Pout = WSP(bf16_t, WS_P); P.ss1 = WSP(float, WS_SS1); P.lf = WSP(float, WS_LF); P.bfx = F.in[16] + layer * 4; P.kmax = (unsigned*)(F.ws + WS_CTL) + CW_KMAX + layer * 128;
            pg8::gemm_phase<ProbIn, true>(F.lds, P, F.tid);
        }
        SEAM(pb + 0);
        if (IN(pb + 1)) _Pragma("unroll 1") for (int rep = 0; rep < NREP(2); ++rep) {
            if (PS(4)) {
                __syncthreads();
                { LAS float* PARW = (LAS float*)(F.lds + RG_PAR);
                  for (int i = F.tid; i < 1280; i += 512) { const int a = i >> 8, c = i & 255; PARW[i] = F.in[a == 0 ? 6 : (a == 1 ? 8 : (a == 2 ? 12 : (a == 3 ? 13 : 11)))][layer * 256 + c]; } }
                __syncthreads();
                _Pragma("unroll 1") for (int it = F.bid; it < 1024; it += F.G) { if (F.wave < 4) rw_group_compute(F, layer, it); else rw_group_loader(F, layer, it); }
                __syncthreads();
            }
        }
        if (IN(pb + 1)) {
            unsigned* r1d = (unsigned*)(F.ws + WS_CTL) + CW_R1D + layer * 2048;
            xcd_arrive(bar, r1d);
            bool fxw = false;
            unsigned* sdw = (unsigned*)(F.ws + WS_CTL) + CW_SD + layer * 64;
            if (PS(5)) { if (F.G >= 64) { if (F.bid < 32) { xcd_wait_all(bar, r1d); rw_seq_wg(F, F.bid, sdw); } } else { xcd_wait_all(bar, r1d); for (int i = F.bid; i < 32; i += F.G) rw_seq_wg(F, i, sdw); } }
            unsigned* wq = (unsigned*)(F.ws + WS_CTL) + CW_WQ + layer * 64;
            volatile LAS int* qslot = (volatile LAS int*)(F.lds + LDS_MISC + 64);
            __syncthreads();
            if (F.tid == 0) qslot[0] = (int)xb_add(wq, 1u);
            __syncthreads();
            int q = qslot[0];
#pragma unroll 1
            for (;;) {
                if (q >= 1024 + 256 + 256) break;
                unsigned nq = 0u; if (F.tid == 0) nq = xb_add(wq, 1u);
                LAUNDER();
                if (q < 512) { if (PS(6)) sb_unit(F, (q & 63) >> 2, q & 3, 7 - (q >> 6)); }
                else if (q < 1024) { const int r = q - 512; if (!fxw) { xcd_wait_all(bar, r1d); fxw = true; } if (PS(2)) fx_unit(F, layer, (r & 63) >> 2, r & 3, 7 - (r >> 6)); }
                else if (q < 1280) { if (PS(3)) _Pragma("unroll 1") for (int k = 0; k < 4; ++k) { const int i = 4 * (q - 1024) + k; gm_unit(F, layer, i >> 6, (i >> 2) & 15, i & 3); } }
                else if (PS(7)) {
                    if (F.tid == 0) { unsigned sp = 0; while (xb_ld(sdw) < 32u) { __builtin_amdgcn_s_sleep(2); if (++sp > (1u << 22)) break; }
                        __builtin_amdgcn_fence(__ATOMIC_ACQUIRE, "agent"); asm volatile("s_waitcnt vmcnt(0)" ::: "memory"); }
                    __syncthreads();
                    const int w0 = (q - 1280) * 512 + F.wave;
                    _Pragma("unroll 1") for (int k = 0; k < 8; ++k) rw_post_batch<8>(F, layer, w0 + 64 * k, 8);
                }
                __syncthreads();
                if (F.tid == 0) qslot[0] = (int)nq;
                __syncthreads();
                q = qslot[0];
            }
        }
        SEAM(pb + 1);
        if (PS(8) && IN(pb + 2)) {
            ProbOut P; P.K = D; P.A = WSP(bf16_t, WS_MIX); P.Bt = WSP(bf16_t, WS_BOUT) + (size_t)layer * D * D; P.G = F.G; P.c = F.bid;
            P.base = (layer == 0) ? F.in[0] : F.out; P.out = F.out;
            if (DUP_PH == 8) { P.ascale = 0.f; P.base = F.out; pg8::gemm_phase<ProbOut, true>(F.lds, P, F.tid); P.base = (layer == 0) ? F.in[0] : F.out; }
            P.ascale = 1.f; pg8::gemm_phase<ProbOut, true>(F.lds, P, F.tid);
        }
        SEAM(pb + 2);
        if (PS(9) && IN(pb + 3)) { if (DUP_PH == 9) p4_router(F, layer, true); p4_router(F, layer, false); }
        SEAM(pb + 3);
        if (PS(10) && IN(pb + 4)) {
            moe_tables(F, layer);
            ProbGU P; P.K = D; P.A = WSP(bf16_t, WS_XB); P.Bt = WSP(bf16_t, WS_BGU) + (size_t)layer * NE * 1024 * D; P.G = F.G; P.c = F.bid;
            P.T = (const LAS MoeTab*)(F.lds + LDS_AUX); P.elist = WSP(int, WS_LIST); P.egate = WSP(float, WS_GLIST); P.rstd2 = WSP(float, WS_RSTD2); P.HB = WSP(bf16_t, WS_HB);
            pg8::gemm_phase<ProbGU, true>(F.lds, P, F.tid);
        }
        SEAM(pb + 4);
        if (PS(11) && IN(pb + 5)) {
            moe_tables(F, layer);
            ProbDP P; P.A = WSP(bf16_t, WS_HB); P.Bt = WSP(bf16_t, WS_BDN) + (size_t)layer * NE * D * EH; P.G = F.G; P.c = F.bid;
            P.T = (const LAS MoeTab*)(F.lds + LDS_AUX); P.plist = WSP(u32x2, WS_PLIST); P.x = F.out; P.xb = WSP(bf16_t, WS_XB); P.ss1 = WSP(float, WS_SS1);
            pg8::gemm_phase_pair<ProbDP>(F.lds, P, F.tid);
        }
        SEAM(pb + 5);
    }
    if (PS(13) && IN(N_PHASES - 1)) p_final(F);
#undef IN
#undef SEAM
}

#ifndef MK_ONE_LAUNCH
#define MK_ONE_LAUNCH 1
#endif
extern "C" void kernel_launch(void* const* d_in, const int* in_sizes, int n_in, void* d_out, int out_size, void* d_ws, size_t ws_size, hipStream_t stream) {
    static int grid = 0;
    if (grid == 0) {
        if (n_in != 27 || out_size != NT * D || ws_size < WS_END) { fprintf(stderr, "kernel_launch: unexpected shapes (n_in %d out %d ws %zu)\n", n_in, out_size, ws_size); grid = -1; return; }
        int dev = 0, cus = 0;
        if (hipGetDevice(&dev) != hipSuccess || hipDeviceGetAttribute(&cus, hipDeviceAttributeMultiprocessorCount, dev) != hipSuccess) { grid = -1; return; }
        if (hipFuncSetAttribute((const void*)mk_fwd, hipFuncAttributeMaxDynamicSharedMemorySize, LDS_BYTES) != hipSuccess) { fprintf(stderr, "kernel_launch: hipFuncSetAttribute failed\n"); grid = -1; return; }
        (void)hipGetLastError();
        grid = cus;
    }
    if (grid < 0) return;
    (void)hipMemsetAsync((char*)d_ws + WS_CTL, 0, CTL_BYTES, stream);
    Args a{};
    for (int i = 0; i < 27; ++i) a.in[i] = (const float*)d_in[i];
    a.out = (float*)d_out; a.ws = (unsigned char*)d_ws; a.li = 0; a.pad = 0;
#if MK_ONE_LAUNCH
    a.ph_lo = 0; a.ph_hi = N_PHASES;
    hipLaunchKernelGGL(mk_fwd, dim3(grid), dim3(512), LDS_BYTES, stream, a);
#else
    for (int p = 0; p < N_PHASES; ++p) { a.ph_lo = p; a.ph_hi = p + 1; hipLaunchKernelGGL(mk_fwd, dim3(grid), dim3(512), LDS_BYTES, stream, a); }
#endif
}
```

```cpp
#include <hip/hip_runtime.h>
#include <cstdio>
#include <cstdint>

#define DI __device__ __forceinline__
#define LAS __attribute__((address_space(3)))
#define GAS __attribute__((address_space(1)))
typedef unsigned short bf16_t;
typedef short bf16x8 __attribute__((ext_vector_type(8)));
typedef short s16x4 __attribute__((ext_vector_type(4)));
typedef float f32x2 __attribute__((ext_vector_type(2)));
typedef float f32x4 __attribute__((ext_vector_type(4)));
typedef float f32x16 __attribute__((ext_vector_type(16)));
typedef unsigned u32x2 __attribute__((ext_vector_type(2)));
typedef unsigned u32x4 __attribute__((ext_vector_type(4)));
typedef __bf16 bf16x2_t __attribute__((ext_vector_type(2)));
typedef GAS unsigned gu32;

constexpr int NT = 32768, SEQ = 2048, NB = 16, D = 1024, DEPTH = 4, NH = 4;
constexpr int PP = 3072;
constexpr int NIN = 3328;
constexpr int C_SBQ = 0, C_SBK = 256, C_SBV = 512, C_GMU = 768, C_GMV = 1024, C_RWR = 1280, C_RWK = 1536, C_RWV = 1792, C_RWX = 2048, C_FXQ = 2304, C_FXK = 2560, C_FXV = 2816;
constexpr int NE = 32, EH = 512;
constexpr float LOG2E = 1.4426950408889634f, LN2 = 0.6931471805599453f;
constexpr float QSCALE2 = 0.125f * LOG2E;

constexpr size_t MiB = 1u << 20;
constexpr size_t WS_CTL = 0, CTL_BYTES = 1 * MiB;
constexpr size_t WS_BIN = 1 * MiB;
constexpr size_t WS_BOUT = 28 * MiB;
constexpr size_t WS_BGU = 36 * MiB;
constexpr size_t WS_BDN = 292 * MiB;
constexpr size_t WS_WCAT = 420 * MiB;
constexpr size_t WS_RTW = 421 * MiB;
constexpr size_t WS_SS1 = 422 * MiB;
constexpr size_t WS_RSTD2 = 424 * MiB;
constexpr size_t WS_LF = 425 * MiB;
constexpr size_t WS_GMW = 426 * MiB;
constexpr size_t WS_LIST = 428 * MiB;
constexpr size_t WS_GLIST = 436 * MiB;
constexpr size_t WS_GBUF = 444 * MiB;
constexpr size_t WS_YBUF = 460 * MiB;
constexpr size_t WS_MIX = 492 * MiB;
constexpr size_t WS_P = 556 * MiB;
constexpr size_t WS_XB = 748 * MiB;
constexpr size_t WS_HB = 812 * MiB;
constexpr size_t WS_REC = 748 * MiB;
constexpr size_t WS_CHMT = 812 * MiB;
constexpr size_t WS_CHN = 844 * MiB;
constexpr size_t WS_CHFR = 812 * MiB;
constexpr size_t WS_CHRY = 877 * MiB;
constexpr size_t WS_CHY0 = 893 * MiB;
constexpr size_t WS_BONV = 909 * MiB;
constexpr size_t WS_PLIST = 940 * MiB;
constexpr size_t WS_END = 968 * MiB;

constexpr int CW_BAR = 4096;
constexpr int CW_CNT = 16384;
constexpr int CW_R1D = 40960;
constexpr int CW_SD = 28672;
constexpr int CW_WQ = 24576;
constexpr int CW_KMAX = 20480;

constexpr int LDS_BYTES = 163840;
constexpr int LDS_AUX = 131072;
constexpr int LDS_MISC = 163840 - 256;

DI float bf2f(unsigned b) { return __uint_as_float(b << 16); }
DI unsigned pk2(float lo, float hi) { f32x2 v = {lo, hi}; bf16x2_t b = __builtin_convertvector(v, bf16x2_t); return __builtin_bit_cast(unsigned, b); }
DI unsigned f2bf(float f) { return pk2(f, 0.f) & 0xffffu; }
DI bf16x8 pk8f(const float (&v)[8]) { u32x4 p; p.x = pk2(v[0], v[1]); p.y = pk2(v[2], v[3]); p.z = pk2(v[4], v[5]); p.w = pk2(v[6], v[7]); return __builtin_bit_cast(bf16x8, p); }
DI float ex2(float x) { return __builtin_amdgcn_exp2f(x); }
DI float lg2(float x) { return __builtin_amdgcn_logf(x); }
DI float rcpf_(float x) { return __builtin_amdgcn_rcpf(x); }
DI float sigmoidf_(float x) { return rcpf_(1.f + ex2(-x * LOG2E)); }
DI float tanhf_(float x) { return 1.f - 2.f * rcpf_(1.f + ex2(2.f * LOG2E * x)); }
DI float geluf_(float x) { const float u = 0.7978845608028654f * (x + 0.044715f * x * x * x); return x * rcpf_(1.f + ex2(-2.f * LOG2E * u)); }
DI float softplusf_(float x) { return fmaxf(x, 0.f) + LN2 * lg2(1.f + ex2(-fabsf(x) * LOG2E)); }
template <int CTRL, int RMASK, bool BC> DI float dppf(float x) { return __builtin_bit_cast(float, __builtin_amdgcn_update_dpp(0, __builtin_bit_cast(int, x), CTRL, RMASK, 0xf, BC)); }
DI float wave_sum(float v) {
    v += dppf<0xB1, 0xf, true>(v); v += dppf<0x4E, 0xf, true>(v); v += dppf<0x141, 0xf, true>(v); v += dppf<0x140, 0xf, true>(v);
    v += dppf<0x142, 0xa, false>(v); v += dppf<0x143, 0xc, false>(v);
    return __builtin_bit_cast(float, __builtin_amdgcn_readlane(__builtin_bit_cast(int, v), 63));
}
DI float swap32(float v) { return __shfl_xor(v, 32); }
#define MFMA32(a, b, c) __builtin_amdgcn_mfma_f32_32x32x16_bf16((a), (b), (c), 0, 0, 0)
DI int crow(int r, int h) { return (r & 3) + 8 * (r >> 2) + 4 * h; }

#define XB_TMO      128
#define XB_XCNT(j)  (256  + 64 * (j))
#define XB_XSUB(j)  (1280 + 64 * (j))
#define XB_XGEN(j)  (2304 + 64 * (j))
#define XB_TOP      3328
#define XB_TOPGEN   3392
#define XCD_BAR_WORDS 3456
#define XB_SPIN_CAP (1u << 18)
DI unsigned xb_ld(unsigned* p)              { return __hip_atomic_load(p, __ATOMIC_RELAXED, __HIP_MEMORY_SCOPE_AGENT); }
DI unsigned xb_add(unsigned* p, unsigned v) { return __hip_atomic_fetch_add(p, v, __ATOMIC_RELAXED, __HIP_MEMORY_SCOPE_AGENT); }
DI unsigned xb_xcc_id() { return (unsigned)__builtin_amdgcn_s_getreg((3 << 11) | 20) & 0xFu; }
#define XB_SPIN(cond, bar) do { unsigned _sp = 0; while (cond) { __builtin_amdgcn_s_sleep(1); \
    if ((++_sp & 255u) == 0u) { if (xb_ld(&(bar)[XB_TMO])) break; if (_sp > XB_SPIN_CAP) { atomicAdd(&(bar)[XB_TMO], 1u); break; } } } } while (0)
struct XcdBarrier { unsigned* bar; unsigned x; volatile LAS unsigned* st; };
DI XcdBarrier xcd_barrier_post(unsigned* bar, volatile LAS unsigned* st) {
    XcdBarrier b; b.bar = bar; b.x = xb_xcc_id(); b.st = st;
    if (threadIdx.x == 0) (void)xb_add(&bar[XB_XCNT(b.x)], 1u);
    return b;
}
DI void xcd_barrier_complete(unsigned* bar, unsigned x, unsigned& nloc, unsigned& nx) {
    const unsigned G = gridDim.x * gridDim.y * gridDim.z;
    unsigned sum, cnt, mine, sp = 0u;
    for (;;) {
        sum = 0u; cnt = 0u; mine = 0u;
#pragma unroll
        for (unsigned j = 0; j < 16; ++j) { const unsigned c = xb_ld(&bar[XB_XCNT(j)]); sum += c; cnt += (c > 0u) ? 1u : 0u; mine = (j == x) ? c : mine; }
        if (sum == G) break;
        __builtin_amdgcn_s_sleep(1);
        if ((++sp & 255u) == 0u) { if (xb_ld(&bar[XB_TMO])) break; if (sp > XB_SPIN_CAP) { atomicAdd(&bar[XB_TMO], 1u); break; } }
    }
    nloc = mine > 0u ? mine : 1u; nx = cnt > 0u ? cnt : 1u;
}
DI void xcd_barrier(const XcdBarrier& b) {
    asm volatile("s_waitcnt vmcnt(0)" ::: "memory");
    __syncthreads();
    if (threadIdx.x == 0) {
        unsigned* bar = b.bar;
        __builtin_amdgcn_s_waitcnt(0);
        unsigned nloc = b.st[0], nx = b.st[1];
        if (nloc == 0u) { xcd_barrier_complete(bar, b.x, nloc, nx); b.st[0] = nloc; b.st[1] = nx; }
        const unsigned old = xb_add(&bar[XB_XSUB(b.x)], 1u);
        const unsigned gen = old / nloc;
        if (old + 1u == (gen + 1u) * nloc) {
            __builtin_amdgcn_fence(__ATOMIC_RELEASE, "agent");
            asm volatile("s_waitcnt vmcnt(0)" ::: "memory");
            const unsigned og = xb_add(&bar[XB_TOP], 1u);
            const unsigned tg = og / nx;
            if (og + 1u == (tg + 1u) * nx) xb_add(&bar[XB_TOPGEN], 1u);
            else XB_SPIN(xb_ld(&bar[XB_TOPGEN]) == tg, bar);
            __builtin_amdgcn_fence(__ATOMIC_ACQUIRE, "agent");
            xb_add(&bar[XB_XGEN(b.x)], 1u);
            asm volatile("s_waitcnt vmcnt(0)" ::: "memory");
        } else {
            XB_SPIN(xb_ld(&bar[XB_XGEN(b.x)]) == gen, bar);
            __builtin_amdgcn_fence(__ATOMIC_ACQUIRE, "agent");
            asm volatile("s_waitcnt vmcnt(0)" ::: "memory");
        }
    }
    __syncthreads();
}

DI void xcd_arrive(const XcdBarrier& b, unsigned* w) {
    asm volatile("s_waitcnt vmcnt(0)" ::: "memory");
    __syncthreads();
    if (threadIdx.x == 0) {
        const unsigned nloc = b.st[0];
        const unsigned old = xb_add(&w[64 * b.x], 1u);
        if (old + 1u == nloc) { __builtin_amdgcn_fence(__ATOMIC_RELEASE, "agent"); asm volatile("s_waitcnt vmcnt(0)" ::: "memory"); (void)xb_add(&w[64 * 16], 1u); }
    }
}
DI void xcd_wait_all(const XcdBarrier& b, unsigned* w) {
    if (threadIdx.x == 0) { const unsigned nx = b.st[1]; unsigned sp = 0; while (xb_ld(&w[64 * 16]) < nx) { __builtin_amdgcn_s_sleep(1); if (++sp > (1u << 22)) break; }
        __builtin_amdgcn_fence(__ATOMIC_ACQUIRE, "agent"); asm volatile("s_waitcnt vmcnt(0)" ::: "memory"); }
    __syncthreads();
}

typedef const float* cfp_t;
struct Args { const float* in[27]; float* out; unsigned char* ws; int ph_lo, ph_hi, li, pad; };
struct Frame {
    LAS unsigned char* lds;
    int tid, lane, wave, G, bid;
    const __attribute__((address_space(4))) cfp_t* in;
    float* out; unsigned char* ws;
};
#define WSP(T, off) ((T*)(F.ws + (off)))

namespace pg8 {
constexpr int BM = 256, BK = 64, HALF = 128, HTB = HALF * BK * 2, STAGE_BYTES = 8 * HTB, NXCD = 8, WGM = 8;
DI int lds_byte(int r, int c) { const int st = (r >> 4) * 2 + (c >> 5), rr = r & 15, cc = c & 31, ob = rr * 64 + cc * 2; return st * 1024 + (ob ^ (((ob >> 9) & 1) << 5)); }
DI void stage_rc(int b, int& R, int& C) { const int st = b / 1024, sb = b % 1024, swz = sb ^ (((sb >> 9) & 1) << 5); R = (st >> 1) * 16 + swz / 64; C = (st & 1) * 32 + (swz % 64) / 2; }
DI int perm32(int rho) { const int n = rho >> 4, i = rho & 15; return 8 * (i >> 2) + 4 * n + (i & 3); }
struct Unit { int pm, pn, e, cnt, base, aux; };
DI bool static_next(int nM, int nN, int G, int c, int i, Unit& u) {
    const int nwg = nM * nN; const long L = (long)i * G + c; if (L >= nwg) return false;
    int wgid = (int)L; { const int q = nwg / NXCD, r = nwg % NXCD, xcd = wgid % NXCD, off = wgid / NXCD; wgid = (xcd < r ? xcd * (q + 1) : r * (q + 1) + (xcd - r) * q) + off; }
    const int nig = WGM * nN, gid = wgid / nig, fm = gid * WGM, gsz = (nM - fm) < WGM ? (nM - fm) : WGM;
    u.pm = fm + ((wgid % nig) % gsz); u.pn = (wgid % nig) / gsz; u.e = 0; u.cnt = 0; u.base = 0; u.aux = 0; return true;
}

template <class Prob, bool ALIGN_EPI>
DI void gemm_phase(LAS unsigned char* lds, const Prob& P, const int tid) {
    const int wid = __builtin_amdgcn_readfirstlane(tid >> 6), lane = tid & 63, wr = wid >> 2, wc = wid & 3, fr = lane & 15, fq = lane >> 4;
    const int K = P.K, nt = K / BK;
    constexpr bool GA = Prob::GATHER;
    unsigned voffB[2], voffA[2];
#pragma unroll
    for (int i = 0; i < 2; ++i) { int R, C; stage_rc(tid * 16 + i * 8192, R, C); const int Rb = Prob::PERM ? ((R & ~31) + perm32(R & 31)) : R; voffB[i] = (unsigned)(Rb * K + C) * 2u; voffA[i] = (unsigned)(R * K + C) * 2u; }
    const size_t kstep = (size_t)(BK * 2);
    const size_t hstepB = (size_t)HALF * K * 2;
    const unsigned ldsw = (unsigned)wid * 1024u;
    const int aoffL = lds_byte(wr * 64 + fr, fq * 8), boffL = lds_byte(wc * 32 + fr, fq * 8);
    const char* Abase = (const char*)P.A;
#define PG8_SA(b, h) (((b) * 2 + (h)) * HTB)
#define PG8_SB(b, h) ((4 + (b) * 2 + (h)) * HTB)
#define PG8_STG_B(bufoff, gbase) do { _Pragma("unroll") for (int _i = 0; _i < 2; ++_i) \
        __builtin_amdgcn_global_load_lds((const unsigned*)((const char*)(gbase) + voffB[_i]), (LAS unsigned*)(lds + (bufoff) + ldsw + _i * 8192), 16, 0, 0); } while (0)
#define PG8_STG_A(bufoff, h, kbyte) do { _Pragma("unroll") for (int _i = 0; _i < 2; ++_i) { \
        const char* _p; if constexpr (GA) _p = Abase + (size_t)(kbyte) + aoff[h][_i]; else _p = cA + (size_t)(h) * hstepB + (size_t)(kbyte) + voffA[_i]; \
        __builtin_amdgcn_global_load_lds((const unsigned*)_p, (LAS unsigned*)(lds + (bufoff) + ldsw + _i * 8192), 16, 0, 0); } } while (0)
#define PG8_LDA(dst, b, h) do { _Pragma("unroll") for (int m = 0; m < 4; ++m) _Pragma("unroll") for (int k = 0; k < 2; ++k) dst[m][k] = *(const LAS bf16x8*)(lds + PG8_SA(b, h) + aoffL + m * 2048 + k * 1024); } while (0)
#define PG8_LDB(dst, b, h) do { _Pragma("unroll") for (int n = 0; n < 2; ++n) _Pragma("unroll") for (int k = 0; k < 2; ++k) dst[n][k] = *(const LAS bf16x8*)(lds + PG8_SB(b, h) + boffL + n * 2048 + k * 1024); } while (0)
#define PG8_MMA(ai, bj, At, Bt) do { __builtin_amdgcn_s_setprio(1); _Pragma("unroll") for (int m = 0; m < 4; ++m) _Pragma("unroll") for (int n = 0; n < 2; ++n) _Pragma("unroll") for (int k = 0; k < 2; ++k) \
        acc[ai][bj][m][n] = __builtin_amdgcn_mfma_f32_16x16x32_bf16(Bt[n][k], At[m][k], acc[ai][bj][m][n], 0, 0, 0); __builtin_amdgcn_s_setprio(0); } while (0)
#define PG8_WAIT_V(n) asm volatile("s_waitcnt vmcnt(" #n ")" ::: "memory")
#define PG8_WAIT_L(n) asm volatile("s_waitcnt lgkmcnt(" #n ")" ::: "memory")
#define PG8_BAR __builtin_amdgcn_s_barrier()
#define PG8_SCHED __builtin_amdgcn_sched_barrier(0)
    Unit cur, nxt; int ui = 0;
    if (!P.next(0, cur)) return;
    f32x4 acc[2][2][4][2];
#pragma unroll
    for (int a = 0; a < 2; ++a)
#pragma unroll
        for (int b = 0; b < 2; ++b)
#pragma unroll
            for (int m = 0; m < 4; ++m)
#pragma unroll
                for (int n = 0; n < 2; ++n) acc[a][b][m][n] = (f32x4){0.f, 0.f, 0.f, 0.f};
    bf16x8 At[4][2], B0[2][2], B1[2][2];
    unsigned aoff[2][2] = {{0u, 0u}, {0u, 0u}}, noff[2][2] = {{0u, 0u}, {0u, 0u}};
    const char* cA = Abase; const char* nA = Abase;
    if constexpr (GA) P.aoffs(cur, tid, aoff); else cA = Abase + (size_t)P.arow0(cur) * K * 2;
    const char* cB = P.bbase(cur);
    PG8_STG_B(PG8_SB(0, 0), cB); PG8_STG_B(PG8_SB(0, 1), cB + hstepB); PG8_STG_A(PG8_SA(0, 0), 0, 0); PG8_STG_A(PG8_SA(0, 1), 1, 0);
    if (wr == 1) PG8_BAR;
    PG8_WAIT_V(2); PG8_BAR;
    PG8_STG_B(PG8_SB(1, 0), cB + kstep); PG8_STG_A(PG8_SA(1, 0), 0, kstep); PG8_STG_B(PG8_SB(1, 1), cB + hstepB + kstep);
    PG8_WAIT_V(6); PG8_BAR;
    for (;;) {
        const bool has_next = P.next(ui + 1, nxt);
        const char* nB = cB; nA = cA;
        if (has_next) { nB = P.bbase(nxt); if constexpr (GA) P.aoffs(nxt, tid, noff); else nA = Abase + (size_t)P.arow0(nxt) * K * 2; }
        else if constexpr (GA) { noff[0][0] = aoff[0][0]; noff[0][1] = aoff[0][1]; noff[1][0] = aoff[1][0]; noff[1][1] = aoff[1][1]; }
        if constexpr (GA) { *(LAS u32x4*)(lds + LDS_AUX + 2048 + tid * 16) = (u32x4){noff[0][0], noff[0][1], noff[1][0], noff[1][1]}; }
        for (int t = 0; t < nt; t += 2) {
            const bool last = (t == nt - 2);
            const size_t k1 = (size_t)(t + 1) * kstep;
            const size_t k2 = last ? (size_t)0 : (size_t)(t + 2) * kstep, k3 = k2 + kstep;
            const char* b2 = last ? nB : cB + (size_t)(t + 2) * kstep; const char* b3 = b2 + kstep;
            PG8_LDB(B0, 0, 0); PG8_LDB(B1, 0, 1); PG8_SCHED; PG8_LDA(At, 0, 0); PG8_STG_A(PG8_SA(1, 1), 1, k1);
            PG8_WAIT_V(8); PG8_WAIT_L(0); PG8_BAR; PG8_MMA(0, 0, At, B0); PG8_MMA(0, 1, At, B1); PG8_BAR; PG8_SCHED;
            if (last) { if constexpr (GA) { const u32x4 nq = *(const LAS u32x4*)(lds + LDS_AUX + 2048 + tid * 16); aoff[0][0] = nq[0]; aoff[0][1] = nq[1]; aoff[1][0] = nq[2]; aoff[1][1] = nq[3]; } else cA = nA; }
            PG8_LDA(At, 0, 1); PG8_STG_B(PG8_SB(0, 0), b2); PG8_STG_B(PG8_SB(0, 1), b2 + hstepB); PG8_STG_A(PG8_SA(0, 0), 0, k2);
            PG8_WAIT_V(8); PG8_WAIT_L(0); PG8_BAR; PG8_MMA(1, 0, At, B0); PG8_MMA(1, 1, At, B1); PG8_BAR; PG8_SCHED;
            PG8_LDB(B0, 1, 0); PG8_LDB(B1, 1, 1); PG8_SCHED; PG8_LDA(At, 1, 0); PG8_STG_A(PG8_SA(0, 1), 1, k2);
            PG8_WAIT_V(8); PG8_WAIT_L(0); PG8_BAR; PG8_MMA(0, 0, At, B0); PG8_MMA(0, 1, At, B1); PG8_BAR; PG8_SCHED;
            PG8_LDA(At, 1, 1); PG8_STG_B(PG8_SB(1, 0), b3); PG8_STG_B(PG8_SB(1, 1), b3 + hstepB); PG8_STG_A(PG8_SA(1, 0), 0, k3);
            PG8_WAIT_V(8); PG8_WAIT_L(0); PG8_BAR; PG8_MMA(1, 0, At, B0); PG8_MMA(1, 1, At, B1); PG8_BAR; PG8_SCHED;
        }
        if constexpr (ALIGN_EPI) { if (wr == 0) PG8_BAR; }
        P.epi(acc, cur, wr, wc, fr, fq);
        if (!has_next) break;
#pragma unroll
        for (int a = 0; a < 2; ++a)
#pragma unroll
            for (int b = 0; b < 2; ++b)
#pragma unroll
                for (int m = 0; m < 4; ++m)
#pragma unroll
                    for (int n = 0; n < 2; ++n) acc[a][b][m][n] = (f32x4){0.f, 0.f, 0.f, 0.f};
        cur = nxt; cB = nB; ++ui;
        if constexpr (ALIGN_EPI) { if (wr == 1) PG8_BAR; }
    }
    PG8_WAIT_V(0);
    if constexpr (!ALIGN_EPI) { if (wr == 0) PG8_BAR; }
    PG8_BAR;
#undef PG8_SA
#undef PG8_SB
#undef PG8_STG_A
#undef PG8_STG_B
#undef PG8_LDA
#undef PG8_LDB
#undef PG8_MMA
#undef PG8_WAIT_V
#undef PG8_WAIT_L
#undef PG8_BAR
#undef PG8_SCHED
}

template <class Prob>
DI void gemm_phase_pair(LAS unsigned char* lds, const Prob& P, const int tid) {
    const int wid = __builtin_amdgcn_readfirstlane(tid >> 6), lane = tid & 63, wr = wid >> 2, wc = wid & 3, fr = lane & 15, fq = lane >> 4;
    constexpr int KP = 512, nt = 16;
    unsigned voffB[2];
#pragma unroll
    for (int i = 0; i < 2; ++i) { int R, C; stage_rc(tid * 16 + i * 8192, R, C); const int Rb = Prob::PERM ? ((R & ~31) + perm32(R & 31)) : R; voffB[i] = (unsigned)(Rb * KP + C) * 2u; }
    const size_t kstep = (size_t)(BK * 2);
    const size_t hstepB = (size_t)HALF * KP * 2;
    const unsigned ldsw = (unsigned)wid * 1024u;
    const int aoffL = lds_byte(wr * 64 + fr, fq * 8), boffL = lds_byte(wc * 32 + fr, fq * 8);
    const char* Abase = (const char*)P.A;
    LAS unsigned char* park = lds + LDS_AUX + 2048 + tid * 48;
#define PG8_SA(b, h) (((b) * 2 + (h)) * HTB)
#define PG8_SB(b, h) ((4 + (b) * 2 + (h)) * HTB)
#define PG8_STG_B(bufoff, gbase) do { _Pragma("unroll") for (int _i = 0; _i < 2; ++_i) \
        __builtin_amdgcn_global_load_lds((const unsigned*)((const char*)(gbase) + voffB[_i]), (LAS unsigned*)(lds + (bufoff) + ldsw + _i * 8192), 16, 0, 0); } while (0)
#define PG8_STG_A(bufoff, h, kbyte) do { _Pragma("unroll") for (int _i = 0; _i < 2; ++_i) \
        __builtin_amdgcn_global_load_lds((const unsigned*)(Abase + (size_t)(kbyte) + aoff[h][_i]), (LAS unsigned*)(lds + (bufoff) + ldsw + _i * 8192), 16, 0, 0); } while (0)
#define PG8_LDA(dst, b, h) do { _Pragma("unroll") for (int m = 0; m < 4; ++m) _Pragma("unroll") for (int k = 0; k < 2; ++k) dst[m][k] = *(const LAS bf16x8*)(lds + PG8_SA(b, h) + aoffL + m * 2048 + k * 1024); } while (0)
#define PG8_LDB(dst, b, h) do { _Pragma("unroll") for (int n = 0; n < 2; ++n) _Pragma("unroll") for (int k = 0; k < 2; ++k) dst[n][k] = *(const LAS bf16x8*)(lds + PG8_SB(b, h) + boffL + n * 2048 + k * 1024); } while (0)
#define PG8_MMA(ai, bj, At, Bt) do { __builtin_amdgcn_s_setprio(1); _Pragma("unroll") for (int m = 0; m < 4; ++m) _Pragma("unroll") for (int n = 0; n < 2; ++n) _Pragma("unroll") for (int k = 0; k < 2; ++k) \
        acc[ai][bj][m][n] = __builtin_amdgcn_mfma_f32_16x16x32_bf16(Bt[n][k], At[m][k], acc[ai][bj][m][n], 0, 0, 0); __builtin_amdgcn_s_setprio(0); } while (0)
#define PG8_WAIT_V(n) asm volatile("s_waitcnt vmcnt(" #n ")" ::: "memory")
#define PG8_WAIT_L(n) asm volatile("s_waitcnt lgkmcnt(" #n ")" ::: "memory")
#define PG8_BAR __builtin_amdgcn_s_barrier()
#define PG8_SCHED __builtin_amdgcn_sched_barrier(0)
#define PG8_PARK(slot, v) (*(LAS u32x4*)(park + 16 * (slot)) = (u32x4){v[0][0], v[0][1], v[1][0], v[1][1]})
#define PG8_UNPARK(slot) do { const u32x4 _q = *(const LAS u32x4*)(park + 16 * (slot)); aoff[0][0] = _q[0]; aoff[0][1] = _q[1]; aoff[1][0] = _q[2]; aoff[1][1] = _q[3]; } while (0)
    Unit cur, nxt; int ui = 0;
    if (!P.next(0, cur)) return;
    f32x4 acc[2][2][4][2];
#pragma unroll
    for (int a = 0; a < 2; ++a)
#pragma unroll
        for (int b = 0; b < 2; ++b)
#pragma unroll
            for (int m = 0; m < 4; ++m)
#pragma unroll
                for (int n = 0; n < 2; ++n) acc[a][b][m][n] = (f32x4){0.f, 0.f, 0.f, 0.f};
    bf16x8 At[4][2], B0[2][2], B1[2][2];
    unsigned aoff[2][2];
    { unsigned tb[2][2]; P.aoffs2(cur, tid, aoff, tb); PG8_PARK(0, tb); }
    const char* cBa = P.bbase_a(cur); const char* cBb = P.bbase_b(cur);
    PG8_STG_B(PG8_SB(0, 0), cBa); PG8_STG_B(PG8_SB(0, 1), cBa + hstepB); PG8_STG_A(PG8_SA(0, 0), 0, 0); PG8_STG_A(PG8_SA(0, 1), 1, 0);
    if (wr == 1) PG8_BAR;
    PG8_WAIT_V(2); PG8_BAR;
    PG8_STG_B(PG8_SB(1, 0), cBa + kstep); PG8_STG_A(PG8_SA(1, 0), 0, kstep); PG8_STG_B(PG8_SB(1, 1), cBa + hstepB + kstep);
    PG8_WAIT_V(6); PG8_BAR;
    for (;;) {
        const bool has_next = P.next(ui + 1, nxt);
        const char* nBa = cBa; const char* nBb = cBb;
        {
            unsigned ta[2][2], tb[2][2];
            if (has_next) { P.aoffs2(nxt, tid, ta, tb); nBa = P.bbase_a(nxt); nBb = P.bbase_b(nxt); } else P.aoffs2(cur, tid, ta, tb);
            PG8_PARK(2, ta); PG8_PARK((ui + 1) & 1, tb);
        }
        const bool hu = (cur.cnt - cur.pm * 256) <= 128;
        for (int t = 0; t < nt; t += 2) {
            const bool last = (t == nt - 2);
            const size_t k1 = (size_t)((t + 1) & 7) * kstep;
            const int t2 = last ? 0 : t + 2;
            const size_t k2 = (size_t)(t2 & 7) * kstep, k3 = k2 + kstep;
            const char* b2 = last ? nBa : ((t2 < 8 ? cBa : cBb) + k2); const char* b3 = b2 + kstep;
            PG8_LDB(B0, 0, 0); PG8_LDB(B1, 0, 1); PG8_SCHED; PG8_LDA(At, 0, 0); PG8_STG_A(PG8_SA(1, 1), 1, k1);
            PG8_WAIT_V(8); PG8_WAIT_L(0); PG8_BAR; PG8_MMA(0, 0, At, B0); PG8_MMA(0, 1, At, B1); PG8_BAR; PG8_SCHED;
            if (t == 6) PG8_UNPARK(ui & 1);
            if (last) PG8_UNPARK(2);
            PG8_LDA(At, 0, 1); PG8_STG_B(PG8_SB(0, 0), b2); PG8_STG_B(PG8_SB(0, 1), b2 + hstepB); PG8_STG_A(PG8_SA(0, 0), 0, k2);
            PG8_WAIT_V(8); PG8_WAIT_L(0); PG8_BAR; if (!hu) { PG8_MMA(1, 0, At, B0); PG8_MMA(1, 1, At, B1); } PG8_BAR; PG8_SCHED;
            PG8_LDB(B0, 1, 0); PG8_LDB(B1, 1, 1); PG8_SCHED; PG8_LDA(At, 1, 0); PG8_STG_A(PG8_SA(0, 1), 1, k2);
            PG8_WAIT_V(8); PG8_WAIT_L(0); PG8_BAR; PG8_MMA(0, 0, At, B0); PG8_MMA(0, 1, At, B1); PG8_BAR; PG8_SCHED;
            PG8_LDA(At, 1, 1); PG8_STG_B(PG8_SB(1, 0), b3); PG8_STG_B(PG8_SB(1, 1), b3 + hstepB); PG8_STG_A(PG8_SA(1, 0), 0, k3);
            PG8_WAIT_V(8); PG8_WAIT_L(0); PG8_BAR; if (!hu) { PG8_MMA(1, 0, At, B0); PG8_MMA(1, 1, At, B1); } PG8_BAR; PG8_SCHED;
        }
        if (wr == 0) PG8_BAR;
        P.epi(acc, cur, wr, wc, fr, fq);
        if (!has_next) break;
#pragma unroll
        for (int a = 0; a < 2; ++a)
#pragma unroll
            for (int b = 0; b < 2; ++b)
#pragma unroll
                for (int m = 0; m < 4; ++m)
#pragma unroll
                    for (int n = 0; n < 2; ++n) acc[a][b][m][n] = (f32x4){0.f, 0.f, 0.f, 0.f};
        cur = nxt; cBa = nBa; cBb = nBb; ++ui;
        if (wr == 1) PG8_BAR;
    }
    PG8_WAIT_V(0);
    PG8_BAR;
#undef PG8_SA
#undef PG8_SB
#undef PG8_STG_A
#undef PG8_STG_B
#undef PG8_LDA
#undef PG8_LDB
#undef PG8_MMA
#undef PG8_WAIT_V
#undef PG8_WAIT_L
#undef PG8_BAR
#undef PG8_SCHED
#undef PG8_PARK
#undef PG8_UNPARK
}
}
using pg8::Unit;


struct MoeTab { int ce[32], sb[32], tpg[33], cp[112], tpf[113], tph[113]; };
constexpr int LCAP = 32768;
DI int pair_lo(int p) { int i = 0; _Pragma("unroll") for (int k = 1; k < 7; ++k) if (p >= k * (15 - k) / 2) i = k; return i; }
DI int pair_hi(int p, int i) { return p - i * (15 - i) / 2 + i + 1; }

struct ProbIn {
    static constexpr bool PERM = true, GATHER = false;
    int K; const bf16_t* A; const bf16_t* Bt; int G, c;
    bf16_t* Pout; const float* ss1; float* lf; const float* bfx; unsigned* kmax;
    DI bool next(int i, Unit& u) const { return pg8::static_next(128, 12, G, c, i, u); }
    DI int arow0(const Unit& u) const { return u.pm * 256; }
    DI const char* bbase(const Unit& u) const { return (const char*)Bt + (size_t)u.pn * 256 * K * 2; }
    DI void epi(const f32x4 (&acc)[2][2][4][2], const Unit& u, int wr, int wc, int fr, int fq) const {
        float km0 = 0.f, km1 = 0.f;
        float rs[8];
        {
            f32x4 sv[8];
#pragma unroll
            for (int g = 0; g < 8; ++g) sv[g] = *(const f32x4*)(ss1 + (size_t)(u.pm * 256 + (g >> 2) * 128 + wr * 64 + (g & 3) * 16 + fr) * 16 + 4 * fq);
#pragma unroll
            for (int g = 0; g < 8; ++g) { float ss = (sv[g][0] + sv[g][1]) + (sv[g][2] + sv[g][3]); ss += __shfl_xor(ss, 16); ss += __shfl_xor(ss, 32);
                rs[g] = __builtin_amdgcn_rsqf(ss * (1.f / 1024.f) + 1e-6f); }
        }
#pragma unroll
        for (int ai = 0; ai < 2; ++ai)
#pragma unroll
            for (int m = 0; m < 4; ++m) {
                const int row = u.pm * 256 + ai * 128 + wr * 64 + m * 16 + fr;
                const float rstd = rs[ai * 4 + m];
                {
                    bf16_t* rowp = Pout + (size_t)row * PP + u.pn * 256 + wc * 32 + 8 * fq;
#pragma unroll
                    for (int bj = 0; bj < 2; ++bj) { const f32x4 v0 = acc[ai][bj][m][0] * rstd, v1 = acc[ai][bj][m][1] * rstd;
                        u32x4 w; w.x = pk2(v0[0], v0[1]); w.y = pk2(v0[2], v0[3]); w.z = pk2(v1[0], v1[1]); w.w = pk2(v1[2], v1[3]);
                        *(u32x4*)(rowp + bj * 128) = w; }
                    if (u.pn == 10) {
#pragma unroll
                        for (int bj = 0; bj < 2; ++bj) { const f32x4 v0 = acc[ai][bj][m][0] * rstd, v1 = acc[ai][bj][m][1] * rstd;
                            float p = ((v0[0] * v0[0] + v0[1] * v0[1]) + (v0[2] * v0[2] + v0[3] * v0[3])) + ((v1[0] * v1[0] + v1[1] * v1[1]) + (v1[2] * v1[2] + v1[3] * v1[3]));
                            p += __shfl_xor(p, 16); p += __shfl_xor(p, 32);
                            if (bj == 0) km0 = fmaxf(km0, p); else km1 = fmaxf(km1, p); }
                    }
                }
            }
        if (u.pn == 10) {
#pragma unroll
            for (int o = 1; o < 16; o <<= 1) { km0 = fmaxf(km0, __shfl_xor(km0, o)); km1 = fmaxf(km1, __shfl_xor(km1, o)); }
            if (fr == 0 && fq == 0) { const int b = (u.pm * 256) >> 11;
                __hip_atomic_fetch_max(kmax + ((b * 4 + 0 + (wc >> 1)) * 2 + (wc & 1)), __float_as_uint(km0), __ATOMIC_RELAXED, __HIP_MEMORY_SCOPE_AGENT);
                __hip_atomic_fetch_max(kmax + ((b * 4 + 2 + (wc >> 1)) * 2 + (wc & 1)), __float_as_uint(km1), __ATOMIC_RELAXED, __HIP_MEMORY_SCOPE_AGENT); }
        }
    }
};

struct ProbOut {
    static constexpr bool PERM = false, GATHER = false;
    int K; const bf16_t* A; const bf16_t* Bt; int G, c;
    const float* base; float* out; float ascale;
    DI bool next(int i, Unit& u) const { return pg8::static_next(128, 4, G, c, i, u); }
    DI int arow0(const Unit& u) const { return u.pm * 256; }
    DI const char* bbase(const Unit& u) const { return (const char*)Bt + (size_t)u.pn * 256 * K * 2; }
    DI void epi(const f32x4 (&acc)[2][2][4][2], const Unit& u, int wr, int wc, int fr, int fq) const {
#pragma unroll
        for (int ai = 0; ai < 2; ++ai) {
            f32x4 bv[4][2][2]; size_t offs[4];
#pragma unroll
            for (int m = 0; m < 4; ++m) { offs[m] = (size_t)(u.pm * 256 + ai * 128 + wr * 64 + m * 16 + fr) * D + u.pn * 256 + wc * 32 + 4 * fq;
#pragma unroll
                for (int bj = 0; bj < 2; ++bj)
#pragma unroll
                    for (int n = 0; n < 2; ++n) bv[m][bj][n] = *(const f32x4*)(base + offs[m] + bj * 128 + n * 16); }
#pragma unroll
            for (int m = 0; m < 4; ++m)
#pragma unroll
                for (int bj = 0; bj < 2; ++bj)
#pragma unroll
                    for (int n = 0; n < 2; ++n) *(f32x4*)(out + offs[m] + bj * 128 + n * 16) = bv[m][bj][n] + acc[ai][bj][m][n] * ascale;
            asm volatile("" ::: "memory");
        }
    }
};

DI int moe_L(int i, int G, int c) {
    if ((G & 31) != 0) return i * G + c;
    const int x = c & 7, j = c >> 3, per = G >> 5;
    return ((i * (G >> 2) + x * per + (j >> 2)) << 2) + (j & 3);
}
template <int NL> DI bool moe_unit(const LAS int* tp, int L, Unit& u) {
    const int tt = L >> 2; if (tt >= tp[NL]) return false;
    int e = 0;
#pragma unroll 1
    while (tp[e + 1] <= tt) ++e;
    u.e = e; u.pm = tt - tp[e]; u.pn = L & 3; return true;
}

struct ProbGU {
    static constexpr bool PERM = true, GATHER = true;
    int K; const bf16_t* A; const bf16_t* Bt; int G, c;
    const LAS MoeTab* T; const int* elist; const f32x2* egate; bf16_t* HB;
    DI bool next(int i, Unit& u) const {
        if (!moe_unit<32>(T->tpg, moe_L(i, G, c), u)) return false;
        u.cnt = T->ce[u.e]; u.base = T->sb[u.e]; return true;
    }
    DI int tok_of(const Unit& u, int r) const { return (r < u.cnt) ? elist[(size_t)u.e * LCAP + r] : 0; }
    DI void aoffs(const Unit& u, int tid, unsigned (&o)[2][2]) const {
        int Rr[2], Cc[2]; pg8::stage_rc(tid * 16, Rr[0], Cc[0]); pg8::stage_rc(tid * 16 + 8192, Rr[1], Cc[1]);
#pragma unroll
        for (int h = 0; h < 2; ++h)
#pragma unroll
            for (int i = 0; i < 2; ++i) { const int tok = tok_of(u, u.pm * 256 + h * 128 + Rr[i]); o[h][i] = (unsigned)((tok * K + Cc[i]) * 2); }
    }
    DI const char* bbase(const Unit& u) const { return (const char*)Bt + ((size_t)u.e * 1024 + u.pn * 256) * K * 2; }
    DI void epi(const f32x4 (&acc)[2][2][4][2], const Unit& u, int wr, int wc, int fr, int fq) const {
        float rsv[8], gv[8];
#pragma unroll
        for (int g = 0; g < 8; ++g) { const int r = u.pm * 256 + (g >> 2) * 128 + wr * 64 + (g & 3) * 16 + fr; f32x2 gr = {0.f, 0.f}; if (r < u.cnt) gr = egate[(size_t)u.e * LCAP + r]; gv[g] = gr[0]; rsv[g] = gr[1]; }
#pragma unroll
        for (int ai = 0; ai < 2; ++ai)
#pragma unroll
            for (int m = 0; m < 4; ++m) {
                const int r = u.pm * 256 + ai * 128 + wr * 64 + m * 16 + fr;
                if (r < u.cnt) {
                    const float rs = rsv[ai * 4 + m], gt = gv[ai * 4 + m];
                    float hv[8];
#pragma unroll
                    for (int n = 0; n < 2; ++n)
#pragma unroll
                        for (int j = 0; j < 4; ++j) { const float g = acc[ai][0][m][n][j] * rs, uu = acc[ai][1][m][n][j] * rs; hv[n * 4 + j] = g * sigmoidf_(g) * uu * gt; }
                    u32x4 w; w.x = pk2(hv[0], hv[1]); w.y = pk2(hv[2], hv[3]); w.z = pk2(hv[4], hv[5]); w.w = pk2(hv[6], hv[7]);
                    *(u32x4*)(HB + (size_t)(u.base + r) * EH + u.pn * 128 + wc * 32 + 8 * fq) = w;
                }
            }
    }
};

struct ProbDP {
    static constexpr bool PERM = false;
    const bf16_t* A; const bf16_t* Bt; int G, c;
    const LAS MoeTab* T; const u32x2* plist; float* x; bf16_t* xb; float* ss1;
    DI bool next(int i, Unit& u) const {
        const int L = moe_L(i, G, c), tt = L >> 2, nf = T->tpf[112];
        if (tt < nf) { if (!moe_unit<112>(T->tpf, L, u)) return false; }
        else { if (!moe_unit<112>(T->tph, L - 4 * nf, u)) return false; u.pm = (T->cp[u.e] - 1) >> 8; }
        u.cnt = T->cp[u.e]; const int g = u.e / 28, p = u.e - g * 28, lo = pair_lo(p); u.base = g * 8 + lo; u.aux = g * 8 + pair_hi(p, lo); return true;
    }
    DI void aoffs2(const Unit& u, int tid, unsigned (&oa)[2][2], unsigned (&ob)[2][2]) const {
        int Rr[2], Cc[2]; pg8::stage_rc(tid * 16, Rr[0], Cc[0]); pg8::stage_rc(tid * 16 + 8192, Rr[1], Cc[1]);
        const int sba = T->sb[u.base], sbb = T->sb[u.aux];
#pragma unroll
        for (int h = 0; h < 2; ++h)
#pragma unroll
            for (int i = 0; i < 2; ++i) { const int r = u.pm * 256 + h * 128 + Rr[i]; unsigned pos = 0u; if (r < u.cnt) pos = plist[(size_t)u.e * LCAP + r].y;
                const int ra = (r < u.cnt) ? sba + (int)(pos & 0xffffu) : 0, rb = (r < u.cnt) ? sbb + (int)(pos >> 16) : 0;
                oa[h][i] = (unsigned)((ra * EH + Cc[i]) * 2); ob[h][i] = (unsigned)((rb * EH + Cc[i]) * 2); }
    }
    DI const char* bbase_a(const Unit& u) const { return (const char*)Bt + ((size_t)u.base * 1024 + u.pn * 256) * EH * 2; }
    DI const char* bbase_b(const Unit& u) const { return (const char*)Bt + ((size_t)u.aux * 1024 + u.pn * 256) * EH * 2; }
    DI void epi(const f32x4 (&acc)[2][2][4][2], const Unit& u, int wr, int wc, int fr, int fq) const {
        int tk[8];
#pragma unroll
        for (int g = 0; g < 8; ++g) { const int r = u.pm * 256 + (g >> 2) * 128 + wr * 64 + (g & 3) * 16 + fr; tk[g] = (r < u.cnt) ? (int)plist[(size_t)u.e * LCAP + r].x : 0; }
#pragma unroll
        for (int ai = 0; ai < 2; ++ai) {
            f32x4 xv[4][2][2];
#pragma unroll
            for (int m = 0; m < 4; ++m) { const size_t off = (size_t)tk[ai * 4 + m] * D + u.pn * 256 + wc * 32 + 4 * fq;
#pragma unroll
                for (int bj = 0; bj < 2; ++bj)
#pragma unroll
                    for (int n = 0; n < 2; ++n) xv[m][bj][n] = *(const f32x4*)(x + off + bj * 128 + n * 16); }
#pragma unroll
            for (int m = 0; m < 4; ++m) {
                const int r = u.pm * 256 + ai * 128 + wr * 64 + m * 16 + fr; const bool val = r < u.cnt;
                const size_t off = (size_t)tk[ai * 4 + m] * D + u.pn * 256 + wc * 32 + 4 * fq;
                float ssp = 0.f;
#pragma unroll
                for (int bj = 0; bj < 2; ++bj)
#pragma unroll
                    for (int n = 0; n < 2; ++n) { const size_t o = off + bj * 128 + n * 16; const f32x4 v = xv[m][bj][n] + acc[ai][bj][m][n];
                        if (val) { *(f32x4*)(x + o) = v; u32x2 w; w.x = pk2(v[0], v[1]); w.y = pk2(v[2], v[3]); *(u32x2*)(xb + o) = w; }
                        ssp += (v[0] * v[0] + v[1] * v[1]) + (v[2] * v[2] + v[3] * v[3]); }
                ssp += __shfl_xor(ssp, 16); ssp += __shfl_xor(ssp, 32);
                if (val && fq == 0) ss1[(size_t)tk[ai * 4 + m] * 16 + u.pn * 4 + wc] = ssp;
            }
            asm volatile("" ::: "memory");
        }
    }
};


DI void p0_transpose64(const float* W, int K, int N, int ldn, const float* gs, bf16_t* WT, int mode, LAS unsigned* T, int kb, int nb, int lane) {
    const int k0 = 64 * kb, n0 = 64 * nb, nq = lane & 15, kr = lane >> 4;
    const bool nv = (n0 + 4 * nq) < N;
    f32x4 a[8], b[8];
#pragma unroll
    for (int i = 0; i < 8; ++i) { const int k = k0 + 8 * i + 2 * kr;
        a[i] = nv ? *(const f32x4*)(W + (size_t)k * ldn + n0 + 4 * nq) : (f32x4){0.f, 0.f, 0.f, 0.f};
        b[i] = nv ? *(const f32x4*)(W + (size_t)(k + 1) * ldn + n0 + 4 * nq) : (f32x4){0.f, 0.f, 0.f, 0.f}; }
#pragma unroll
    for (int i = 0; i < 8; ++i) { const int k = k0 + 8 * i + 2 * kr; float g0 = 1.f, g1 = 1.f; if (gs) { g0 = gs[k]; g1 = gs[k + 1]; }
#pragma unroll
        for (int jj = 0; jj < 4; ++jj) T[(4 * nq + jj) * 36 + 4 * i + kr] = pk2(a[i][jj] * g0, b[i][jj] * g1); }
    asm volatile("s_waitcnt lgkmcnt(0)" ::: "memory");
    const int c = lane & 7;
#pragma unroll
    for (int p = 0; p < 8; ++p) { const int nl = 8 * p + (lane >> 3), n = n0 + nl;
        const u32x4 o = *(const LAS u32x4*)(T + nl * 36 + 4 * c);
        const int drow = (mode == 0) ? n : (((n >> 7) << 8) + (n & 127) + (mode == 2 ? 128 : 0));
        *(u32x4*)(WT + (size_t)drow * K + k0 + 8 * c) = o; }
    asm volatile("s_waitcnt lgkmcnt(0)" ::: "memory");
}
DI void p0_prologue(Frame& F) {
    LAS unsigned* scr = (LAS unsigned*)(F.lds + F.wave * 16384);
    const int gw = F.bid * 8 + F.wave, NGW = F.G * 8;
    constexpr int I_IN = 16 * 52, I_OUT = 16 * 16, I_GU = 16 * 8, I_DN = 8 * 16;
    constexpr int S0 = DEPTH * I_IN, S1 = S0 + DEPTH * I_OUT, S2 = S1 + DEPTH * NE * I_GU, S3 = S2 + DEPTH * NE * I_GU, S4 = S3 + DEPTH * NE * I_DN;
    for (int it = gw; it < S4; it += NGW) {
        if (it < S0) { const int l = it / I_IN, r = it % I_IN;
            p0_transpose64(F.in[2] + (size_t)l * D * 3076, D, 3076, 3076, F.in[1] + l * D, WSP(bf16_t, WS_BIN) + (size_t)l * NIN * D, 0, scr, r / 52, r % 52, F.lane);
        } else if (it < S1) { const int q = it - S0, l = q / I_OUT, r = q % I_OUT;
            p0_transpose64(F.in[17] + (size_t)l * D * D, D, D, D, nullptr, WSP(bf16_t, WS_BOUT) + (size_t)l * D * D, 0, scr, r / 16, r % 16, F.lane);
        } else if (it < S3) { const int up = it >= S2, q = it - (up ? S2 : S1), le = q / I_GU, r = q % I_GU;
            p0_transpose64(F.in[up ? 24 : 23] + (size_t)le * D * EH, D, EH, EH, F.in[18] + (le / NE) * D, WSP(bf16_t, WS_BGU) + (size_t)le * 1024 * D, up ? 2 : 1, scr, r / 8, r % 8, F.lane);
        } else { const int q = it - S3, le = q / I_DN, r = q % I_DN;
            p0_transpose64(F.in[25] + (size_t)le * EH * D, EH, D, D, nullptr, WSP(bf16_t, WS_BDN) + (size_t)le * D * EH, 0, scr, r / 16, r % 16, F.lane);
        }
    }
    const int gt = F.bid * 512 + F.tid, NGT = F.G * 512;
    for (int i = gt; i < DEPTH * 256 * 256; i += NGT) { const int l = i >> 16, c = (i >> 8) & 255, k = i & 255;
        const float v = k < 64 ? F.in[7][((size_t)l * 64 + k) * 256 + c] : (k < 128 ? F.in[9][((size_t)l * 64 + (k - 64)) * 256 + c] : F.in[10][((size_t)l * 128 + (k - 128)) * 256 + c]);
        WSP(bf16_t, WS_WCAT)[i] = (bf16_t)f2bf(v); }
    for (int i = gt; i < DEPTH * 4 * 128 * 128; i += NGT) { const int t = (i >> 7) & 127, p = i & 15, hh = p >> 3, j = p & 7, s = (i & 112) + (j < 4 ? 4 * hh + j : 8 + 4 * hh + (j - 4));
        WSP(bf16_t, WS_GMW)[i] = (bf16_t)f2bf(s <= t ? F.in[3][(i & ~127) + s] : 0.f); }
    for (int i = gt; i < DEPTH * 36 * 1024; i += NGT) { const int l = i / (36 * 1024), j = (i / 1024) % 36, k = i & 1023;
        const float g = F.in[18][l * D + k];
        const float w = j < 4 ? F.in[19][((size_t)l * D + k) * 4 + j] : F.in[21][((size_t)l * D + k) * 32 + (j - 4)];
        WSP(float, WS_RTW)[i] = g * w; }
    for (int m0 = gw * 4; m0 < NT; m0 += NGW * 4) {
        f32x4 v[4][4];
#pragma unroll
        for (int r = 0; r < 4; ++r) { const f32x4* xr = (const f32x4*)(F.in[0] + (size_t)(m0 + r) * D) + F.lane;
#pragma unroll
            for (int j = 0; j < 4; ++j) v[r][j] = xr[64 * j]; }
#pragma unroll
        for (int r = 0; r < 4; ++r) { float s = 0.f; u32x2* o8 = (u32x2*)(WSP(bf16_t, WS_XB) + (size_t)(m0 + r) * D) + F.lane;
#pragma unroll
            for (int j = 0; j < 4; ++j) { const f32x4 q = v[r][j]; s += (q[0] * q[0] + q[1] * q[1]) + (q[2] * q[2] + q[3] * q[3]); u32x2 w; w.x = pk2(q[0], q[1]); w.y = pk2(q[2], q[3]); o8[64 * j] = w; }
            s = wave_sum(s);
            if (F.lane < 16) WSP(float, WS_SS1)[(size_t)(m0 + r) * 16 + F.lane] = (F.lane == 0) ? s : 0.f; }
    }
}

constexpr int AT_KOFF = 0, AT_VOFF = 18432, AT_CUM = 36864, AT_MISC = 45056, AT_ROWB = 144, AT_BUFB = 64 * 144;
DI void at_load_tile(const bf16_t* Pb, int colK, int colV, int jt, int tid, u32x4& kreg, u32x4& vreg) {
    const int row = tid >> 3, ch = tid & 7; const bf16_t* p = Pb + (size_t)(64 * jt + row) * PP + ch * 8;
    kreg = *(const u32x4*)(p + colK); vreg = *(const u32x4*)(p + colV);
}
DI void at_store_tile(LAS unsigned char* lds, int buf, int tid, const u32x4& kreg, const u32x4& vreg) {
    const int row = tid >> 3, ch = tid & 7;
    *(LAS u32x4*)(lds + AT_KOFF + buf * AT_BUFB + row * AT_ROWB + ch * 16) = kreg;
    *(LAS u32x4*)(lds + AT_VOFF + buf * AT_BUFB + row * AT_ROWB + ch * 16) = vreg;
}
DI void at_qk(const LAS unsigned char* kb, const bf16x8 (&qf)[4], int r32, int h2, f32x16& s0, f32x16& s1) {
    const LAS unsigned char* p = kb + r32 * AT_ROWB + h2 * 16;
#pragma unroll
    for (int d0 = 0; d0 < 4; ++d0) {
        const bf16x8 a0 = *(const LAS bf16x8*)(p + d0 * 32), a1 = *(const LAS bf16x8*)(p + 32 * AT_ROWB + d0 * 32);
        s0 = MFMA32(a0, qf[d0], s0); s1 = MFMA32(a1, qf[d0], s1);
    }
}
DI bf16x8 pack8(const f32x16& x, int s) {
    u32x4 p; p.x = pk2(x[8 * s], x[8 * s + 1]); p.y = pk2(x[8 * s + 2], x[8 * s + 3]); p.z = pk2(x[8 * s + 4], x[8 * s + 5]); p.w = pk2(x[8 * s + 6], x[8 * s + 7]);
    return __builtin_bit_cast(bf16x8, p);
}
DI s16x4 tr_read(const LAS unsigned char* p) { return __builtin_bit_cast(s16x4, __builtin_amdgcn_ds_read_tr16_b64_v4i16((LAS s16x4*)p)); }
DI void at_pv(const LAS unsigned char* vb, const bf16x8 (&pb)[4], int lane, f32x16& o0, f32x16& o1) {
    const int h2 = lane >> 5;
    const LAS unsigned char* base = vb + (4 * h2 + ((lane & 15) >> 2)) * AT_ROWB + (16 * ((lane >> 4) & 1) + 4 * (lane & 3)) * 2;
#pragma unroll
    for (int s = 0; s < 4; ++s) {
        const LAS unsigned char* p = base + 16 * s * AT_ROWB;
        const s16x4 l0 = tr_read(p), h0 = tr_read(p + 8 * AT_ROWB), l1 = tr_read(p + 64), h1 = tr_read(p + 8 * AT_ROWB + 64);
        const bf16x8 a0 = __builtin_shufflevector(l0, h0, 0, 1, 2, 3, 4, 5, 6, 7), a1 = __builtin_shufflevector(l1, h1, 0, 1, 2, 3, 4, 5, 6, 7);
        o0 = MFMA32(a0, pb[s], o0); o1 = MFMA32(a1, pb[s], o1);
    }
}
DI void at_store_out(bf16_t* dst  , const f32x16& o0, const f32x16& o1, float scale, int h2) {
#pragma unroll
    for (int g = 0; g < 4; ++g) {
        u32x2 w0, w1; w0.x = pk2(o0[4 * g] * scale, o0[4 * g + 1] * scale); w0.y = pk2(o0[4 * g + 2] * scale, o0[4 * g + 3] * scale);
        w1.x = pk2(o1[4 * g] * scale, o1[4 * g + 1] * scale); w1.y = pk2(o1[4 * g + 2] * scale, o1[4 * g + 3] * scale);
        *(u32x2*)(dst + 8 * g + 4 * h2) = w0; *(u32x2*)(dst + 32 + 8 * g + 4 * h2) = w1;
    }
}
DI void block_cumsum(const float* src, int n, LAS float* cum, LAS float* wtot, int tid, int lane, int wave) {
    f32x4 v = (f32x4){0.f, 0.f, 0.f, 0.f};
    if (4 * tid < n) v = *(const f32x4*)(src + 4 * tid);
    v[1] += v[0]; v[2] += v[1]; v[3] += v[2];
    float t = v[3];
#pragma unroll
    for (int o = 1; o < 64; o <<= 1) { const float u = __shfl_up(t, o); if (lane >= o) t += u; }
    if (lane == 63) wtot[wave] = t;
    __syncthreads();
    float pre = t - v[3];
    for (int w = 0; w < wave; ++w) pre += wtot[w];
    if (4 * tid < n) { v[0] += pre; v[1] += pre; v[2] += pre; v[3] += pre; *(LAS f32x4*)(cum + 4 * tid) = v; }
    __syncthreads();
}

DI void fx_unit(Frame& F, int layer, int b, int h, int qb) {
    LAS unsigned char* L = F.lds; const int tid = F.tid, lane = F.lane, wid = F.wave, r32 = lane & 31, h2 = lane >> 5;
    const bf16_t* Pb = WSP(bf16_t, WS_P) + (size_t)b * SEQ * PP;
    LAS float* cum = (LAS float*)(L + AT_CUM);
    const int kend = 256 * qb + 256;
    __syncthreads();
    block_cumsum(WSP(float, WS_LF) + (size_t)(b * 4 + h) * SEQ, kend, cum, (LAS float*)(L + AT_MISC), tid, lane, wid);
    const int tw0 = 256 * qb + 32 * wid, tq = tw0 + r32;
    bf16x8 qf[4];
#pragma unroll
    for (int d0 = 0; d0 < 4; ++d0) qf[d0] = *(const bf16x8*)(Pb + (size_t)tq * PP + C_FXQ + h * 64 + 16 * d0 + 8 * h2);
    const float ct2 = cum[tq] * LOG2E;
    float qb2;
    { float qn = 0.f;
#pragma unroll
      for (int d0 = 0; d0 < 4; ++d0) { const u32x4 qq = __builtin_bit_cast(u32x4, qf[d0]);
#pragma unroll
        for (int j = 0; j < 4; ++j) { const float a = bf2f(qq[j] & 0xffffu), c = bf2f(qq[j] >> 16); qn += a * a + c * c; } }
      qn += swap32(qn);
      const unsigned* km = (const unsigned*)(F.ws + WS_CTL) + CW_KMAX + layer * 128 + (b * 4 + h) * 2;
      const float kk2 = __uint_as_float(xb_ld((unsigned*)km)) + __uint_as_float(xb_ld((unsigned*)km + 1));
      qb2 = sqrtf(qn * kk2) * QSCALE2 * 1.01f + 1e-3f; }
    float mrun = -1e30f, lrun = 0.f; f32x16 o0 = {}, o1 = {};
    const int jtop = 4 * qb + 3;
    u32x4 kreg, vreg;
    at_load_tile(Pb, C_FXK + h * 64, C_FXV + h * 64, jtop, tid, kreg, vreg);
    at_store_tile(L, 0, tid, kreg, vreg);
    __syncthreads();
    int buf = 0; bool wskip = false;
    for (int jt = jtop; jt >= 0; --jt) {
        if (jt > 0) at_load_tile(Pb, C_FXK + h * 64, C_FXV + h * 64, jt - 1, tid, kreg, vreg);
        if (64 * jt <= tw0 + 31 && !wskip) {
            f32x16 s0 = {}, s1 = {};
            at_qk(L + AT_KOFF + buf * AT_BUFB, qf, r32, h2, s0, s1);
            const bool needmask = (64 * jt + 63 > tw0);
            float mx = -1e30f;
#pragma unroll
            for (int g = 0; g < 4; ++g) {
                const f32x4 c0 = *(const LAS f32x4*)(cum + 64 * jt + 8 * g + 4 * h2), c1 = *(const LAS f32x4*)(cum + 64 * jt + 32 + 8 * g + 4 * h2);
#pragma unroll
                for (int j = 0; j < 4; ++j) {
                    const int r = 4 * g + j, kv = 64 * jt + 8 * g + 4 * h2 + j;
                    float v0 = s0[r] * QSCALE2 + (ct2 - c0[j] * LOG2E), v1 = s1[r] * QSCALE2 + (ct2 - c1[j] * LOG2E);
                    if (needmask) { if (kv > tq) v0 = -1e30f; if (kv + 32 > tq) v1 = -1e30f; }
                    s0[r] = v0; s1[r] = v1; mx = fmaxf(mx, fmaxf(v0, v1));
                }
            }
            mx = fmaxf(mx, swap32(mx));
            const float mnew = fmaxf(mrun, mx), alpha = ex2(mrun - mnew);
            mrun = mnew;
            float ps = 0.f;
#pragma unroll
            for (int r = 0; r < 16; ++r) { s0[r] = ex2(s0[r] - mnew); s1[r] = ex2(s1[r] - mnew); ps += s0[r] + s1[r]; }
            lrun = lrun * alpha + ps;
#pragma unroll
            for (int r = 0; r < 16; ++r) { o0[r] *= alpha; o1[r] *= alpha; }
            bf16x8 pb[4]; pb[0] = pack8(s0, 0); pb[1] = pack8(s0, 1); pb[2] = pack8(s1, 0); pb[3] = pack8(s1, 1);
            at_pv(L + AT_VOFF + buf * AT_BUFB, pb, lane, o0, o1);
        }
        if (jt > 0) at_store_tile(L, buf ^ 1, tid, kreg, vreg);
        { int wdone = 0; if (jt > 0) wdone = __all(qb2 + (ct2 - cum[64 * jt - 1] * LOG2E) - mrun < -150.f) ? 1 : 0; wskip = wdone != 0; if (lane == 0) *(LAS int*)(L + AT_MISC + 64 + 32 * (jt & 1) + 4 * wid) = wdone; }
        __syncthreads();
        buf ^= 1;
        { const LAS int* fl = (const LAS int*)(L + AT_MISC + 64 + 32 * (jt & 1)); const int alld = fl[0] & fl[1] & fl[2] & fl[3] & fl[4] & fl[5] & fl[6] & fl[7]; if (alld) break; }
    }
    const float ltot = lrun + swap32(lrun);
    at_store_out(WSP(bf16_t, WS_MIX) + (size_t)(b * SEQ + tq) * D + 768 + h * 64, o0, o1, rcpf_(ltot), h2);
}

DI void sb_unit(Frame& F, int b, int h, int qb) {
    LAS unsigned char* L = F.lds; const int tid = F.tid, lane = F.lane, wid = F.wave, r32 = lane & 31, h2 = lane >> 5;
    const bf16_t* Pb = WSP(bf16_t, WS_P) + (size_t)b * SEQ * PP;
    const int tw0 = 256 * qb + 32 * wid, tq = tw0 + r32;
    bf16x8 qf[4];
#pragma unroll
    for (int d0 = 0; d0 < 4; ++d0) qf[d0] = *(const bf16x8*)(Pb + (size_t)tq * PP + C_SBQ + h * 64 + 16 * d0 + 8 * h2);
    bf16x8 uf[2], onesf;
#pragma unroll
    for (int s = 0; s < 2; ++s)
#pragma unroll
        for (int j = 0; j < 8; ++j) uf[s][j] = ((16 * s + 8 * (j >> 2) + 4 * h2 + (j & 3)) > r32) ? (short)0x3F80 : (short)0;
#pragma unroll
    for (int j = 0; j < 8; ++j) onesf[j] = (short)0x3F80;
    float R2 = 0.f; f32x16 o0 = {}, o1 = {};
    const int jtop = 4 * qb + 3;
    u32x4 kreg, vreg;
    __syncthreads();
    at_load_tile(Pb, C_SBK + h * 64, C_SBV + h * 64, jtop, tid, kreg, vreg);
    at_store_tile(L, 0, tid, kreg, vreg);
    __syncthreads();
    int buf = 0; bool wskip = false;
    for (int jt = jtop; jt >= 0; --jt) {
        if (jt > 0) at_load_tile(Pb, C_SBK + h * 64, C_SBV + h * 64, jt - 1, tid, kreg, vreg);
        if (64 * jt <= tw0 + 31 && !wskip) {
            f32x16 s0 = {}, s1 = {};
            at_qk(L + AT_KOFF + buf * AT_BUFB, qf, r32, h2, s0, s1);
            const bool needmask = (64 * jt + 63 >= tw0);
            f32x16 l0, l1;
            float cs = 0.f;
#pragma unroll
            for (int r = 0; r < 16; ++r) {
                const int kv = 64 * jt + crow(r, h2);
                const float z0 = s0[r] * QSCALE2, z1 = s1[r] * QSCALE2;
                const float sp0 = fmaxf(z0, 0.f) + lg2(1.f + ex2(-fabsf(z0))), sp1 = fmaxf(z1, 0.f) + lg2(1.f + ex2(-fabsf(z1)));
                float a0 = -sp0, a1 = -sp1, b0 = z0 - sp0, b1 = z1 - sp1;
                if (needmask) { if (kv >= tq) { a0 = 0.f; b0 = -1e30f; } if (kv + 32 >= tq) { a1 = 0.f; b1 = -1e30f; } }
                l0[r] = a0; l1[r] = a1; s0[r] = b0; s1[r] = b1; cs += a0 + a1;
            }
            f32x16 t0 = {}, t1 = {};
#pragma unroll
            for (int s = 0; s < 2; ++s) {
                const bf16x8 h0 = pack8(l0, s), h1 = pack8(l1, s);
                f32x16 d0_, d1_;
#pragma unroll
                for (int j = 0; j < 8; ++j) { d0_[j] = l0[8 * s + j] - bf2f((unsigned short)h0[j]); d1_[j] = l1[8 * s + j] - bf2f((unsigned short)h1[j]); }
                u32x4 q0, q1; q0.x = pk2(d0_[0], d0_[1]); q0.y = pk2(d0_[2], d0_[3]); q0.z = pk2(d0_[4], d0_[5]); q0.w = pk2(d0_[6], d0_[7]);
                q1.x = pk2(d1_[0], d1_[1]); q1.y = pk2(d1_[2], d1_[3]); q1.z = pk2(d1_[4], d1_[5]); q1.w = pk2(d1_[6], d1_[7]);
                const bf16x8 e0 = __builtin_bit_cast(bf16x8, q0), e1 = __builtin_bit_cast(bf16x8, q1);
                t0 = MFMA32(uf[s], h0, t0); t0 = MFMA32(uf[s], e0, t0); t0 = MFMA32(onesf, h1, t0); t0 = MFMA32(onesf, e1, t0);
                t1 = MFMA32(uf[s], h1, t1); t1 = MFMA32(uf[s], e1, t1);
            }
#pragma unroll
            for (int r = 0; r < 16; ++r) { s0[r] = ex2(s0[r] + R2 + t0[r]); s1[r] = ex2(s1[r] + R2 + t1[r]); }
            R2 += cs + swap32(cs);
            bf16x8 pb[4]; pb[0] = pack8(s0, 0); pb[1] = pack8(s0, 1); pb[2] = pack8(s1, 0); pb[3] = pack8(s1, 1);
            at_pv(L + AT_VOFF + buf * AT_BUFB, pb, lane, o0, o1);
        }
        if (jt > 0) at_store_tile(L, buf ^ 1, tid, kreg, vreg);
        { const int wdone = __all(R2 < -150.f) ? 1 : 0; wskip = wdone != 0; if (lane == 0) *(LAS int*)(L + AT_MISC + 64 + 32 * (jt & 1) + 4 * wid) = wdone; }
        __syncthreads();
        buf ^= 1;
        { const LAS int* fl = (const LAS int*)(L + AT_MISC + 64 + 32 * (jt & 1)); const int alld = fl[0] & fl[1] & fl[2] & fl[3] & fl[4] & fl[5] & fl[6] & fl[7]; if (alld) break; }
    }
    at_store_out(WSP(bf16_t, WS_MIX) + (size_t)(b * SEQ + tq) * D + 0 + h * 64, o0, o1, 1.f, h2);
}
DI void attn_rank_to_unit(int r, int& bh, int& qb) { if (r < 256) { qb = 7 - (r >> 6); bh = r & 63; } else { const int p = r - 256; qb = p >> 6; bh = p & 63; } }

constexpr int GV_ROWB = 544, GO_ROWB = 528, GM_OUTOFF = 128 * GV_ROWB;
DI float sum8(float v) { v += dppf<0xB1, 0xf, true>(v); v += dppf<0x4E, 0xf, true>(v); v += dppf<0x141, 0xf, true>(v); return v; }
DI bf16x8 gm_trfrag(const LAS unsigned char* vn, int lane, int ks, int col0) {
    const int h2 = lane >> 5;
    const LAS unsigned char* p = vn + (16 * ks + 4 * h2 + ((lane & 15) >> 2)) * GV_ROWB + (col0 + 16 * ((lane >> 4) & 1) + 4 * (lane & 3)) * 2;
    const s16x4 lo = tr_read(p), hi = tr_read(p + 8 * GV_ROWB);
    return __builtin_shufflevector(lo, hi, 0, 1, 2, 3, 4, 5, 6, 7);
}
DI void gm_item(Frame& F, int layer, int b, int c) {
    LAS unsigned char* L = F.lds; const int tid = F.tid, lane = F.lane, wid = F.wave, r32 = lane & 31, h2 = lane >> 5;
    const int cg = tid & 31, c0 = 8 * cg, tr = tid >> 5;
    const bf16_t* Pb = WSP(bf16_t, WS_P) + (size_t)(b * SEQ + c * 128) * PP;
    __syncthreads();
#pragma unroll
    for (int hf = 0; hf < 2; ++hf) {
        u32x4 vq[4];
#pragma unroll
        for (int i = 0; i < 4; ++i) vq[i] = *(const u32x4*)(Pb + (size_t)(tr + 16 * (4 * hf + i)) * PP + C_GMV + c0);
#pragma unroll
        for (int i = 0; i < 4; ++i) {
            float ge[8];
#pragma unroll
            for (int j = 0; j < 4; ++j) { ge[2 * j] = geluf_(bf2f(vq[i][j] & 0xffffu)); ge[2 * j + 1] = geluf_(bf2f(vq[i][j] >> 16)); }
            const float mean = sum8(((ge[0] + ge[1]) + (ge[2] + ge[3])) + ((ge[4] + ge[5]) + (ge[6] + ge[7]))) * (1.f / 64.f);
            float sq = 0.f;
#pragma unroll
            for (int j = 0; j < 8; ++j) { ge[j] -= mean; sq += ge[j] * ge[j]; }
            const float rs = __builtin_amdgcn_rsqf(sum8(sq) * (1.f / 64.f) + 1e-5f);
#pragma unroll
            for (int j = 0; j < 8; ++j) ge[j] *= rs;
            *(LAS u32x4*)(L + (tr + 16 * (4 * hf + i)) * GV_ROWB + c0 * 2) = __builtin_bit_cast(u32x4, pk8f(ge));
        }
    }
    u32x4 uq[8];
#pragma unroll
    for (int i = 0; i < 8; ++i) uq[i] = *(const u32x4*)(Pb + (size_t)(tr + 16 * i) * PP + C_GMU + c0);
    __syncthreads();
    const int db = wid & 1;
#pragma unroll
    for (int g = 0; g < 4; ++g) {
        const int tb = ((wid >> 1) + g) & 3, t = 32 * tb + r32;
        const bf16_t* wrow = WSP(bf16_t, WS_GMW) + ((size_t)(layer * 4 + g) * 128 + t) * 128 + 8 * h2;
        const float bias = F.in[4][(size_t)(layer * 4 + g) * 128 + t];
        f32x16 acc = {};
#pragma unroll 1
        for (int ks = 0; ks <= 2 * tb + 1; ++ks)
            acc = MFMA32(gm_trfrag(L, lane, ks, 64 * g + 32 * db), *(const bf16x8*)(wrow + 16 * ks), acc);
#pragma unroll
        for (int q = 0; q < 4; ++q)
            *(LAS u32x2*)(L + GM_OUTOFF + t * GO_ROWB + (64 * g + 32 * db + 8 * q + 4 * h2) * 2) = (u32x2){pk2(acc[4 * q] + bias, acc[4 * q + 1] + bias), pk2(acc[4 * q + 2] + bias, acc[4 * q + 3] + bias)};
    }
    __syncthreads();
    bf16_t* mo = WSP(bf16_t, WS_MIX) + (size_t)(b * SEQ + c * 128) * D + 256 + c0;
#pragma unroll
    for (int i = 0; i < 8; ++i) {
        const u32x4 mq = *(const LAS u32x4*)(L + GM_OUTOFF + (tr + 16 * i) * GO_ROWB + c0 * 2);
        float o[8];
#pragma unroll
        for (int j = 0; j < 4; ++j) { o[2 * j] = geluf_(bf2f(uq[i][j] & 0xffffu)) * bf2f(mq[j] & 0xffffu); o[2 * j + 1] = geluf_(bf2f(uq[i][j] >> 16)) * bf2f(mq[j] >> 16); }
        *(u32x4*)(mo + (size_t)(tr + 16 * i) * D) = __builtin_bit_cast(u32x4, pk8f(o));
    }
}

DI void rw_load_shift8(const bf16_t* Pt, bool hasprev, int col, const float* mu, float (&o)[8]) {
    const u32x4 cu = *(const u32x4*)(Pt + col); u32x4 pr = (u32x4){0u, 0u, 0u, 0u}; if (hasprev) pr = *(const u32x4*)(Pt - PP + col);
    const f32x4 m0 = *(const f32x4*)(mu), m1 = *(const f32x4*)(mu + 4);
    const float mm[8] = {m0[0], m0[1], m0[2], m0[3], m1[0], m1[1], m1[2], m1[3]};
#pragma unroll
    for (int j = 0; j < 4; ++j) { const float c0 = bf2f(cu[j] & 0xffffu), c1 = bf2f(cu[j] >> 16), p0 = bf2f(pr[j] & 0xffffu), p1 = bf2f(pr[j] >> 16);
        o[2 * j] = c0 + (p0 - c0) * mm[2 * j]; o[2 * j + 1] = c1 + (p1 - c1) * mm[2 * j + 1]; }
}
DI void rw_load_shift4(const bf16_t* Pt, bool hasprev, int col, const float* mu, float (&o)[4]) {
    const u32x2 cu = *(const u32x2*)(Pt + col); u32x2 pr = (u32x2){0u, 0u}; if (hasprev) pr = *(const u32x2*)(Pt - PP + col);
    const f32x4 m0 = *(const f32x4*)(mu);
#pragma unroll
    for (int j = 0; j < 2; ++j) { const float c0 = bf2f(cu[j] & 0xffffu), c1 = bf2f(cu[j] >> 16), p0 = bf2f(pr[j] & 0xffffu), p1 = bf2f(pr[j] >> 16);
        o[2 * j] = c0 + (p0 - c0) * m0[2 * j]; o[2 * j + 1] = c1 + (p1 - c1) * m0[2 * j + 1]; }
}
DI bf16x8 rw_act_frag(const bf16_t* Pt, bool hasprev, const float* mu, int ks, int h2, int mode) {
    float v[8]; rw_load_shift8(Pt, hasprev, C_RWX + 16 * ks + 8 * h2, mu + 768 + 16 * ks + 8 * h2, v);
    if (mode == 1) {
#pragma unroll
        for (int j = 0; j < 8; ++j) v[j] = tanhf_(v[j]);
    } else if (mode == 2) {
#pragma unroll
        for (int j = 0; j < 8; ++j) v[j] = sigmoidf_(v[j]);
    }
    u32x4 pb; pb.x = pk2(v[0], v[1]); pb.y = pk2(v[2], v[3]); pb.z = pk2(v[4], v[5]); pb.w = pk2(v[6], v[7]);
    return __builtin_bit_cast(bf16x8, pb);
}

constexpr int RC_V = 0, RC_KB = 4608, RC_BB = 9216, RC_KT = 13824, RC_CF = 13824, RC_PC = 18432, RC_WAVE = 18688, RC_ROWB = 144;
DI float scan32(float x) {
    x += dppf<0x111, 0xf, true>(x); x += dppf<0x112, 0xf, true>(x); x += dppf<0x114, 0xf, true>(x); x += dppf<0x118, 0xf, true>(x);
    x += dppf<0x142, 0xa, false>(x);
    return x;
}
DI bf16x8 rc_trfrag(const LAS unsigned char* tile, int lane, int s, int colblk) {
    const int h2 = lane >> 5;
    const LAS unsigned char* p = tile + (16 * s + 4 * h2 + ((lane & 15) >> 2)) * RC_ROWB + (32 * colblk + 16 * ((lane >> 4) & 1) + 4 * (lane & 3)) * 2;
    const s16x4 lo = tr_read(p), hi = tr_read(p + 8 * RC_ROWB);
    return __builtin_shufflevector(lo, hi, 0, 1, 2, 3, 4, 5, 6, 7);
}
#ifdef TPROBE
#define TPB_T0 const unsigned long long tpb0 = __builtin_amdgcn_s_memrealtime()
#define TPB_ACC(slot, tidv) do { const unsigned long long tpb1 = __builtin_amdgcn_s_memrealtime(); if (F.tid == (tidv)) { volatile LAS unsigned long long* a_ = (volatile LAS unsigned long long*)(F.lds + LDS_MISC + 128) + (slot); *a_ = *a_ + (tpb1 - tpb0); } } while (0)
#else
#define TPB_T0 do { } while (0)
#define TPB_ACC(slot, tidv) do { } while (0)
#endif
constexpr int RG_ACT = 4 * RC_WAVE, RG_RKV = RG_ACT + 16384, RG_PAR = RG_RKV + 12 * 4608, RG_END = RG_PAR + 5120;
static_assert(RG_END <= LDS_MISC, "chunk-pass LDS map");
DI void rw_loader_loop(Frame& F, int layer) {
    int lwl = F.wave - 4; asm volatile("" : "+s"(lwl));
    const int lane = F.lane, r32 = lane & 31, h2 = lane >> 5, lw = lwl;
    LAS unsigned char* L = F.lds;
    const float* mu = F.in[5] + (size_t)layer * 1024;
    const int prow = lane >> 3, pc = lane & 7;
    const int amode = lw == 0 ? 1 : (lw == 1 ? 0 : 2);
    const float asc = amode == 1 ? 2.f * LOG2E : -LOG2E, aa = amode == 1 ? 1.f : 0.f, ab = amode == 1 ? -2.f : 1.f;
    f32x4 mq[4][2];
    { const int o0 = 768 + 8 * (8 * lw + pc), o1 = 64 * lw + 8 * pc;
      mq[0][0] = *(const f32x4*)(mu + o0); mq[0][1] = *(const f32x4*)(mu + o0 + 4);
#pragma unroll
      for (int a = 0; a < 3; ++a) { mq[1 + a][0] = *(const f32x4*)(mu + 256 * a + o1); mq[1 + a][1] = *(const f32x4*)(mu + 256 * a + o1 + 4); } }
    u32x4 wv[4][2];
    { const bf16_t* wp = WSP(bf16_t, WS_BIN) + (size_t)layer * NIN * D + (size_t)3072 * D + 8 * lane;
#pragma unroll
      for (int c = 0; c < 4; ++c) { wv[c][0] = *(const u32x4*)(wp + (size_t)c * D); wv[c][1] = *(const u32x4*)(wp + (size_t)c * D + 512); } }
    const float fbias = F.in[16][layer * 4 + (lane & 3)];
    const bf16_t* wcg = WSP(bf16_t, WS_WCAT) + (size_t)layer * 65536 + (size_t)(64 * lw + r32) * 256 + 8 * h2;
#define RW_SHIFT8(cu, pr, hp, m0, m1, o) do { _Pragma("unroll") for (int j_ = 0; j_ < 4; ++j_) { \
        const float c0_ = bf2f(cu[j_] & 0xffffu), c1_ = bf2f(cu[j_] >> 16), p0_ = (hp) ? bf2f(pr[j_] & 0xffffu) : 0.f, p1_ = (hp) ? bf2f(pr[j_] >> 16) : 0.f; \
        const float ma_ = j_ < 2 ? m0[2 * (j_ & 1)] : m1[2 * (j_ & 1)], mb_ = j_ < 2 ? m0[2 * (j_ & 1) + 1] : m1[2 * (j_ & 1) + 1]; \
        o[2 * j_] = c0_ + (p0_ - c0_) * ma_; o[2 * j_ + 1] = c1_ + (p1_ - c1_) * mb_; } } while (0)
#pragma unroll 1
    for (int tg = F.bid; tg < 1024; tg += F.G) {
        const int bb = tg >> 6, ch = tg & 63;
        const bf16_t* Pg = WSP(bf16_t, WS_P) + (size_t)(bb * SEQ + 32 * ch) * PP;
        const bool nop0 = (ch == 0) && (prow == 0);
        {
            u32x4 cu[4][4], pr[4][4];
            const int cols[4] = {C_RWX + 8 * (8 * lw + pc), C_RWR + 64 * lw + 8 * pc, C_RWK + 64 * lw + 8 * pc, C_RWV + 64 * lw + 8 * pc};
#pragma unroll
            for (int i = 0; i < 4; ++i) { const bf16_t* rowp = Pg + (size_t)(prow + 8 * i) * PP; const bf16_t* prevp = rowp - ((i == 0 && nop0) ? 0 : PP);
#pragma unroll
                for (int a = 0; a < 4; ++a) { cu[a][i] = *(const u32x4*)(rowp + cols[a]); pr[a][i] = *(const u32x4*)(prevp + cols[a]); } }
            asm volatile("" ::: "memory");
#pragma unroll
            for (int i = 0; i < 4; ++i) { const int t = prow + 8 * i; const bool hp = !(i == 0 && nop0); float v[8]; RW_SHIFT8(cu[0][i], pr[0][i], hp, mq[0][0], mq[0][1], v);
#pragma unroll
                for (int k = 0; k < 8; ++k) { const float q = rcpf_(1.f + ex2(asc * v[k])); v[k] = amode == 0 ? v[k] : aa + ab * q; }
                *(LAS bf16x8*)(L + RG_ACT + (4 * lw + (pc >> 1)) * 1024 + (t + 32 * (pc & 1)) * 16) = pk8f(v);
#pragma unroll
                for (int a = 0; a < 3; ++a) { float o[8]; RW_SHIFT8(cu[1 + a][i], pr[1 + a][i], hp, mq[1 + a][0], mq[1 + a][1], o);
                    *(LAS bf16x8*)(L + RG_RKV + (lw * 3 + a) * 4608 + t * RC_ROWB + pc * 16) = pk8f(o); } }
        }
        asm volatile("" ::: "memory");
        {
            const int t0 = bb * SEQ + 32 * ch + 8 * lw;
            u32x4 xr[8][2]; float sp[8];
#pragma unroll
            for (int i = 0; i < 8; ++i) { const bf16_t* xp = WSP(bf16_t, WS_XB) + (size_t)(t0 + i) * D + 8 * lane; xr[i][0] = *(const u32x4*)(xp); xr[i][1] = *(const u32x4*)(xp + 512);
                sp[i] = (lane < 16) ? WSP(float, WS_SS1)[(size_t)(t0 + i) * 16 + lane] : 0.f; }
            asm volatile("" ::: "memory");
#pragma unroll
            for (int i = 0; i < 8; ++i) {
                const float rstd = __builtin_amdgcn_rsqf(wave_sum(sp[i]) * (1.f / 1024.f) + 1e-6f);
                float res = 0.f;
#pragma unroll
                for (int c = 0; c < 4; ++c) { float a = 0.f;
                    asm("v_dot2c_f32_bf16 %0, %1, %9\n\tv_dot2c_f32_bf16 %0, %2, %10\n\tv_dot2c_f32_bf16 %0, %3, %11\n\tv_dot2c_f32_bf16 %0, %4, %12\n\t"
                        "v_dot2c_f32_bf16 %0, %5, %13\n\tv_dot2c_f32_bf16 %0, %6, %14\n\tv_dot2c_f32_bf16 %0, %7, %15\n\tv_dot2c_f32_bf16 %0, %8, %16\n\ts_nop 4"
                        : "+v"(a) : "v"(xr[i][0][0]), "v"(xr[i][0][1]), "v"(xr[i][0][2]), "v"(xr[i][0][3]), "v"(xr[i][1][0]), "v"(xr[i][1][1]), "v"(xr[i][1][2]), "v"(xr[i][1][3]),
                                    "v"(wv[c][0][0]), "v"(wv[c][0][1]), "v"(wv[c][0][2]), "v"(wv[c][0][3]), "v"(wv[c][1][0]), "v"(wv[c][1][1]), "v"(wv[c][1][2]), "v"(wv[c][1][3]));
                    a = wave_sum(a); if ((lane & 3) == c) res = a; }
                if (lane < 4) { const int row = t0 + i; WSP(float, WS_LF)[(size_t)((row >> 11) * 4 + lane) * SEQ + (row & 2047)] = -softplusf_(-(res * rstd + fbias)); }
            }
        }
        asm volatile("s_waitcnt lgkmcnt(0)" ::: "memory");
        { TPB_T0; asm volatile("" ::: "memory"); __builtin_amdgcn_s_barrier(); asm volatile("" ::: "memory"); TPB_ACC(0, 256); }
        {
            const int tok = bb * SEQ + 32 * ch + r32;
            const bf16_t* wcl = wcg; asm volatile("" : "+v"(wcl));
            bf16x8 wg[2][8];
#pragma unroll
            for (int blk = 0; blk < 2; ++blk)
#pragma unroll
                for (int ks = 0; ks < 8; ++ks) wg[blk][ks] = *(const bf16x8*)(wcl + (size_t)blk * 32 * 256 + 16 * (8 + ks));
            asm volatile("" ::: "memory");
#pragma unroll
            for (int blk = 0; blk < 2; ++blk) { f32x16 aG = {};
#pragma unroll
                for (int ks = 0; ks < 8; ++ks) aG = MFMA32(wg[blk][ks], *(const LAS bf16x8*)(L + RG_ACT + (8 + ks) * 1024 + lane * 16), aG);
#pragma unroll
                for (int g = 0; g < 4; ++g) { const int cl = 32 * blk + 8 * g + 4 * h2; u32x2 gq;
                    gq.x = pk2(aG[4 * g], aG[4 * g + 1]); gq.y = pk2(aG[4 * g + 2], aG[4 * g + 3]);
                    *(u32x2*)(WSP(bf16_t, WS_GBUF) + (size_t)tok * 256 + 64 * lw + cl) = gq; } }
            asm volatile("s_waitcnt lgkmcnt(0)" ::: "memory");
        }
        { TPB_T0; asm volatile("" ::: "memory"); __builtin_amdgcn_s_barrier(); asm volatile("" ::: "memory"); TPB_ACC(1, 256); }
    }
#undef RW_SHIFT8
}
DI void rw_group_compute(Frame& F, int layer, int tg) {
    asm volatile("" : "+s"(F.in)); asm volatile("" : "+s"(F.ws)); asm volatile("" : "+v"(F.lane));
    const int lane = F.lane, r32 = lane & 31, h2 = lane >> 5, hd = F.wave, bb = tg >> 6, ch = tg & 63, bh = bb * 4 + hd;
    LAS unsigned char* L = F.lds;
    LAS unsigned char* W = L + F.wave * RC_WAVE;
    const int tl = 32 * ch + r32, tok = bb * SEQ + tl;
    const bf16_t* wc = WSP(bf16_t, WS_WCAT) + (size_t)layer * 65536 + (size_t)(64 * hd + r32) * 256 + 8 * h2;
    const int chunk = bh * 64 + ch;
    const LAS float* PAR = (const LAS float*)(L + RG_PAR) + 64 * hd;
    const LAS unsigned char* TR = L + RG_RKV + (hd * 3 + 0) * 4608 + r32 * RC_ROWB;
    const LAS unsigned char* TK = TR + 4608; const LAS unsigned char* TV = TR + 2 * 4608;
    u32x4 FRr[16];
    { TPB_T0; asm volatile("" ::: "memory"); __builtin_amdgcn_s_barrier(); asm volatile("" ::: "memory"); TPB_ACC(2, 0); }
    float n2 = 0.f;
#pragma unroll
    for (int g8 = 0; g8 < 4; ++g8) { const u32x4 kq = *(const LAS u32x4*)(TK + 64 * h2 + 16 * g8); const f32x4 k0 = *(const LAS f32x4*)(PAR + 1024 + 32 * h2 + 8 * g8), k1 = *(const LAS f32x4*)(PAR + 1024 + 32 * h2 + 8 * g8 + 4);
#pragma unroll
        for (int j = 0; j < 4; ++j) { const float a = bf2f(kq[j] & 0xffffu) * (j < 2 ? k0[2 * j] : k1[2 * j - 4]), c = bf2f(kq[j] >> 16) * (j < 2 ? k0[2 * j + 1] : k1[2 * j - 3]); n2 += a * a + c * c; } }
    n2 += swap32(n2);
    const float inv = 1.f / fmaxf(sqrtf(n2), 1e-12f);
    float bon = 0.f;
#pragma unroll
    for (int blk = 0; blk < 2; ++blk) {
        const bf16_t* wb = wc + (size_t)blk * 32 * 256;
        f32x16 aW = {}, aA = {};
#pragma unroll
        for (int ks = 0; ks < 4; ++ks) aW = MFMA32(*(const bf16x8*)(wb + 16 * ks), *(const LAS bf16x8*)(L + RG_ACT + ks * 1024 + lane * 16), aW);
#pragma unroll
        for (int ks = 4; ks < 8; ++ks) aA = MFMA32(*(const bf16x8*)(wb + 16 * ks), *(const LAS bf16x8*)(L + RG_ACT + ks * 1024 + lane * 16), aA);
#pragma unroll
        for (int s = 0; s < 2; ++s) {
            float e_kat[8], e_rt[8], e_kt[8], e_bt[8], e_kb[8], e_bb[8];
#pragma unroll
            for (int q = 0; q < 2; ++q) { const int g = 2 * s + q, cl = 32 * blk + 8 * g + 4 * h2;
                const u32x2 rq = *(const LAS u32x2*)(TR + cl * 2), kq = *(const LAS u32x2*)(TK + cl * 2), vq = *(const LAS u32x2*)(TV + cl * 2);
                const float rv[4] = {bf2f(rq.x & 0xffffu), bf2f(rq.x >> 16), bf2f(rq.y & 0xffffu), bf2f(rq.y >> 16)}, kv[4] = {bf2f(kq.x & 0xffffu), bf2f(kq.x >> 16), bf2f(kq.y & 0xffffu), bf2f(kq.y >> 16)};
                const f32x4 w0v = *(const LAS f32x4*)(PAR + cl), a0v = *(const LAS f32x4*)(PAR + 256 + cl), kav = *(const LAS f32x4*)(PAR + 512 + cl), rkv = *(const LAS f32x4*)(PAR + 768 + cl), kwv = *(const LAS f32x4*)(PAR + 1024 + cl);
#pragma unroll
                for (int j = 0; j < 4; ++j) { const int r = 4 * g + j, jj = 4 * q + j;
                    const float w = -softplusf_(-(w0v[j] + aW[r])) - 0.5f;
                    const float l2d = -LOG2E * ex2(w * LOG2E);
                    const float a = sigmoidf_(a0v[j] + aA[r]);
                    const float kkv = kv[j] * kwv[j] * inv, bev = kkv * a, kpv = kv[j] * (1.f + (a - 1.f) * kav[j]);
                    bon += rv[j] * kpv * rkv[j];
                    const float Li = scan32(l2d), Lex = Li - l2d, LC = __shfl(Li, 31 + 32 * h2);
                    const float pin = ex2(Li), pex = ex2(Lex), pinv = ex2(-Li), pc = ex2(LC - Li);
                    e_kat[jj] = kkv * pex; e_rt[jj] = rv[j] * pin; e_kt[jj] = kpv * pinv; e_bt[jj] = bev * pinv; e_kb[jj] = kpv * pc; e_bb[jj] = bev * pc;
                    if (r32 == 31) *(LAS float*)(W + RC_PC + (cl + j) * 4) = ex2(LC); }
                *(LAS u32x2*)(W + RC_V + r32 * RC_ROWB + cl * 2) = vq;
                *(LAS u32x2*)(W + RC_KB + r32 * RC_ROWB + cl * 2) = (u32x2){pk2(e_kb[4 * q], e_kb[4 * q + 1]), pk2(e_kb[4 * q + 2], e_kb[4 * q + 3])};
                *(LAS u32x2*)(W + RC_BB + r32 * RC_ROWB + cl * 2) = (u32x2){pk2(e_bb[4 * q], e_bb[4 * q + 1]), pk2(e_bb[4 * q + 2], e_bb[4 * q + 3])};
                *(LAS u32x2*)(W + RC_KT + r32 * RC_ROWB + cl * 2) = (u32x2){pk2(e_kat[4 * q], e_kat[4 * q + 1]), pk2(e_kat[4 * q + 2], e_kat[4 * q + 3])};
            }
            { const int ks = 2 * blk + s; FRr[ks * 4 + 0] = __builtin_bit_cast(u32x4, pk8f(e_kat)); FRr[ks * 4 + 1] = __builtin_bit_cast(u32x4, pk8f(e_rt)); FRr[ks * 4 + 2] = __builtin_bit_cast(u32x4, pk8f(e_kt)); FRr[ks * 4 + 3] = __builtin_bit_cast(u32x4, pk8f(e_bt)); }
        }
    }
    asm volatile("s_waitcnt lgkmcnt(0)" ::: "memory");
    { TPB_T0; asm volatile("" ::: "memory"); __builtin_amdgcn_s_barrier(); asm volatile("" ::: "memory"); TPB_ACC(3, 0); }
    bon += swap32(bon);
    asm volatile("" ::: "memory");
#pragma unroll
    for (int blk = 0; blk < 2; ++blk)
#pragma unroll
        for (int g = 0; g < 4; ++g) { const int cl = 32 * blk + 8 * g + 4 * h2; const u32x2 vq = *(const LAS u32x2*)(W + RC_V + r32 * RC_ROWB + cl * 2); u32x2 q;
            q.x = pk2(bon * bf2f(vq.x & 0xffffu), bon * bf2f(vq.x >> 16)); q.y = pk2(bon * bf2f(vq.y & 0xffffu), bon * bf2f(vq.y >> 16));
            *(u32x2*)(WSP(bf16_t, WS_BONV) + (size_t)tok * 256 + 64 * hd + cl) = q; }
    const float pc_lo = *(const LAS float*)(W + RC_PC + r32 * 4), pc_hi = *(const LAS float*)(W + RC_PC + (32 + r32) * 4);
    bf16x8 akkf[2], arkf[2], arbf[2];
    f32x16 Tt;
    {
        f32x16 skk = {}, skb = {}, sl = {};
#pragma unroll
        for (int ks = 0; ks < 4; ++ks) { const bf16x8 katf = __builtin_bit_cast(bf16x8, FRr[ks * 4 + 0]), ktf = __builtin_bit_cast(bf16x8, FRr[ks * 4 + 2]), btf = __builtin_bit_cast(bf16x8, FRr[ks * 4 + 3]);
            skk = MFMA32(ktf, katf, skk); skb = MFMA32(btf, katf, skb); sl = MFMA32(katf, btf, sl); }
#pragma unroll
        for (int r = 0; r < 16; ++r) { const int i = crow(r, h2); if (i >= r32) { skk[r] = 0.f; skb[r] = 0.f; } if (i <= r32) sl[r] = 0.f; }
#pragma unroll
        for (int s = 0; s < 2; ++s) akkf[s] = pack8(skk, s);
        bf16x8 fx[2], fxt[2];
#pragma unroll
        for (int s = 0; s < 2; ++s) { fx[s] = pack8(sl, s); fxt[s] = pack8(skb, s); }
#pragma unroll
        for (int r = 0; r < 16; ++r) Tt[r] = ((crow(r, h2) == r32) ? 1.f : 0.f) - skb[r];
#pragma unroll
        for (int lvl = 0; lvl < 4; ++lvl) {
            f32x16 p = {}, pt = {};
#pragma unroll
            for (int s = 0; s < 2; ++s) { p = MFMA32(fxt[s], fx[s], p); if (lvl < 3) pt = MFMA32(fx[s], fxt[s], pt); }
#pragma unroll
            for (int s = 0; s < 2; ++s) fx[s] = pack8(p, s);
            const bf16x8 t0 = pack8(Tt, 0), t1 = pack8(Tt, 1);
            Tt = MFMA32(fx[0], t0, Tt); Tt = MFMA32(fx[1], t1, Tt);
            if (lvl < 3) {
#pragma unroll
                for (int s = 0; s < 2; ++s) fxt[s] = pack8(pt, s); }
        }
    }
    {
        f32x16 srk = {}, srb = {};
#pragma unroll
        for (int ks = 0; ks < 4; ++ks) { const bf16x8 rtf = __builtin_bit_cast(bf16x8, FRr[ks * 4 + 1]), ktf = __builtin_bit_cast(bf16x8, FRr[ks * 4 + 2]), btf = __builtin_bit_cast(bf16x8, FRr[ks * 4 + 3]);
            srk = MFMA32(ktf, rtf, srk); srb = MFMA32(btf, rtf, srb); }
#pragma unroll
        for (int r = 0; r < 16; ++r) if (crow(r, h2) > r32) { srk[r] = 0.f; srb[r] = 0.f; }
#pragma unroll
        for (int s = 0; s < 2; ++s) { arkf[s] = pack8(srk, s); arbf[s] = pack8(srb, s); }
    }
    asm volatile("" ::: "memory");
    bf16x8 ng1f[2][2], ng2f[2][2];
    {
        const bf16x8 tf0 = pack8(Tt, 0), tf1 = pack8(Tt, 1);
#pragma unroll
        for (int cb = 0; cb < 2; ++cb) {
            f32x16 g = {};
            g = MFMA32(tf0, rc_trfrag(W + RC_KT, lane, 0, cb), g); g = MFMA32(tf1, rc_trfrag(W + RC_KT, lane, 1, cb), g);
#pragma unroll
            for (int r = 0; r < 16; ++r) g[r] = -g[r];
            ng1f[cb][0] = pack8(g, 0); ng1f[cb][1] = pack8(g, 1);
        }
#pragma unroll
        for (int vb = 0; vb < 2; ++vb) {
            f32x16 x1 = {};
#pragma unroll
            for (int s = 0; s < 2; ++s) x1 = MFMA32(akkf[s], rc_trfrag(W + RC_V, lane, s, vb), x1);
            f32x16 g = {};
            g = MFMA32(tf0, pack8(x1, 0), g); g = MFMA32(tf1, pack8(x1, 1), g);
#pragma unroll
            for (int r = 0; r < 16; ++r) g[r] = -g[r];
            ng2f[vb][0] = pack8(g, 0); ng2f[vb][1] = pack8(g, 1);
        }
    }
    asm volatile("" ::: "memory");
    u32x4* mt = WSP(u32x4, WS_CHMT) + (size_t)chunk * 8 * 64 + lane;
#pragma unroll
    for (int bip = 0; bip < 2; ++bip)
#pragma unroll
        for (int bi = 0; bi < 2; ++bi) {
            f32x16 m = {};
#pragma unroll
            for (int s = 0; s < 2; ++s) m = MFMA32(ng1f[bi][s], rc_trfrag(W + RC_BB, lane, s, bip), m);
            if (bi == bip) {
#pragma unroll
                for (int r = 0; r < 16; ++r) if (crow(r, h2) == r32) m[r] += (bi ? pc_hi : pc_lo); }
#pragma unroll
            for (int s = 0; s < 2; ++s) mt[(bip * 4 + bi * 2 + s) * 64] = __builtin_bit_cast(u32x4, pack8(m, s));
        }
    asm volatile("" ::: "memory");
    u32x4* nb_ = WSP(u32x4, WS_CHN) + (size_t)chunk * 8 * 64 + lane;
#pragma unroll
    for (int vb = 0; vb < 2; ++vb)
#pragma unroll
        for (int bip = 0; bip < 2; ++bip) {
            f32x16 n = {};
#pragma unroll
            for (int s = 0; s < 2; ++s) { n = MFMA32(rc_trfrag(W + RC_KB, lane, s, bip), rc_trfrag(W + RC_V, lane, s, vb), n); n = MFMA32(rc_trfrag(W + RC_BB, lane, s, bip), ng2f[vb][s], n); }
#pragma unroll
            for (int s = 0; s < 2; ++s) nb_[((vb * 2 + bip) * 2 + s) * 64] = __builtin_bit_cast(u32x4, pack8(n, s));
        }
    asm volatile("" ::: "memory");
    u32x4* ry = WSP(u32x4, WS_CHRY) + (size_t)chunk * 4 * 64 + lane;
#pragma unroll
    for (int bi = 0; bi < 2; ++bi) {
        f32x16 q = {};
#pragma unroll
        for (int s = 0; s < 2; ++s) q = MFMA32(ng1f[bi][s], arbf[s], q);
#pragma unroll
        for (int s = 0; s < 2; ++s) { const u32x4 rq = FRr[(2 * bi + s) * 4 + 1]; float o[8];
#pragma unroll
            for (int j = 0; j < 4; ++j) { o[2 * j] = q[8 * s + 2 * j] + bf2f(rq[j] & 0xffffu); o[2 * j + 1] = q[8 * s + 2 * j + 1] + bf2f(rq[j] >> 16); }
            ry[(bi * 2 + s) * 64] = __builtin_bit_cast(u32x4, pk8f(o)); }
    }
    asm volatile("" ::: "memory");
    u32x4* y0 = WSP(u32x4, WS_CHY0) + (size_t)chunk * 4 * 64 + lane;
#pragma unroll
    for (int vb = 0; vb < 2; ++vb) {
        f32x16 yy = {};
#pragma unroll
        for (int s = 0; s < 2; ++s) { yy = MFMA32(arkf[s], rc_trfrag(W + RC_V, lane, s, vb), yy); yy = MFMA32(arbf[s], ng2f[vb][s], yy); }
#pragma unroll
        for (int s = 0; s < 2; ++s) y0[(vb * 2 + s) * 64] = __builtin_bit_cast(u32x4, pack8(yy, s));
    }
    asm volatile("s_waitcnt lgkmcnt(0)" ::: "memory");
}
DI void unpack16(const u32x4& a, const u32x4& b, f32x16& o) {
#pragma unroll
    for (int j = 0; j < 4; ++j) { o[2 * j] = bf2f(a[j] & 0xffffu); o[2 * j + 1] = bf2f(a[j] >> 16); o[8 + 2 * j] = bf2f(b[j] & 0xffffu); o[8 + 2 * j + 1] = bf2f(b[j] >> 16); }
}
constexpr int SQ_BH = 24576, SQ_STAGE = 2 * SQ_BH;
DI void rw_seq_wg(Frame& F, int item, unsigned* sd) {
    LAS unsigned char* L = F.lds; const int lane = F.lane, wid = F.wave, r32 = lane & 31, h2 = lane >> 5;
    __syncthreads();
    if (wid >= 4) {
        const int slot = (wid - 4) >> 1, half = (wid - 4) & 1, bh = 2 * item + slot;
        const u32x4* mtb = WSP(u32x4, WS_CHMT) + (size_t)bh * 64 * 8 * 64 + lane;
        const u32x4* nbb = WSP(u32x4, WS_CHN) + (size_t)bh * 64 * 8 * 64 + lane;
        const u32x4* ryb = WSP(u32x4, WS_CHRY) + (size_t)bh * 64 * 4 * 64 + lane;
        const u32x4* y0b = WSP(u32x4, WS_CHY0) + (size_t)bh * 64 * 4 * 64 + lane;
#define SQ_ISSUE(CH) do { const int ch_ = (CH); LAS unsigned char* st_ = L + (ch_ % 3) * SQ_STAGE + slot * SQ_BH; \
            if (half == 0) { _Pragma("unroll") for (int i = 0; i < 8; ++i) __builtin_amdgcn_global_load_lds((const unsigned*)(mtb + (size_t)ch_ * 512 + i * 64), (LAS unsigned*)(st_ + i * 1024), 16, 0, 0); \
                             _Pragma("unroll") for (int i = 0; i < 4; ++i) __builtin_amdgcn_global_load_lds((const unsigned*)(ryb + (size_t)ch_ * 256 + i * 64), (LAS unsigned*)(st_ + (8 + i) * 1024), 16, 0, 0); } \
            else { _Pragma("unroll") for (int i = 0; i < 8; ++i) __builtin_amdgcn_global_load_lds((const unsigned*)(nbb + (size_t)ch_ * 512 + i * 64), (LAS unsigned*)(st_ + (12 + i) * 1024), 16, 0, 0); \
                   _Pragma("unroll") for (int i = 0; i < 4; ++i) __builtin_amdgcn_global_load_lds((const unsigned*)(y0b + (size_t)ch_ * 256 + i * 64), (LAS unsigned*)(st_ + (20 + i) * 1024), 16, 0, 0); } } while (0)
        SQ_ISSUE(0); SQ_ISSUE(1);
        asm volatile("s_waitcnt vmcnt(12)" ::: "memory");
        __builtin_amdgcn_s_barrier();
#pragma unroll 1
        for (int ch = 0; ch < 64; ++ch) {
            if (ch + 2 < 64) { SQ_ISSUE(ch + 2); asm volatile("s_waitcnt vmcnt(12)" ::: "memory"); }
            else asm volatile("s_waitcnt vmcnt(0)" ::: "memory");
            __builtin_amdgcn_s_barrier();
        }
#undef SQ_ISSUE
    } else {
        const int slot = wid >> 1, vb = wid & 1, bh = 2 * item + slot;
        f32x16 H0 = {}, H1 = {};
        float* yb = WSP(float, WS_YBUF) + (size_t)(bh >> 2) * SEQ * 256 + (bh & 3) * 64 + 32 * vb + r32;
        __builtin_amdgcn_s_barrier();
#pragma unroll 1
        for (int ch = 0; ch < 64; ++ch) {
            const LAS unsigned char* st = L + (ch % 3) * SQ_STAGE + slot * SQ_BH + lane * 16;
            u32x4 cmt[8], cry[4], cnn[4], cy0[2];
#pragma unroll
            for (int i = 0; i < 8; ++i) cmt[i] = *(const LAS u32x4*)(st + i * 1024);
#pragma unroll
            for (int i = 0; i < 4; ++i) { cry[i] = *(const LAS u32x4*)(st + (8 + i) * 1024); cnn[i] = *(const LAS u32x4*)(st + (12 + 4 * vb + i) * 1024); }
            cy0[0] = *(const LAS u32x4*)(st + (20 + 2 * vb) * 1024); cy0[1] = *(const LAS u32x4*)(st + (21 + 2 * vb) * 1024);
            bf16x8 hb[4]; hb[0] = pack8(H0, 0); hb[1] = pack8(H0, 1); hb[2] = pack8(H1, 0); hb[3] = pack8(H1, 1);
            f32x16 y, n0, n1;
            unpack16(cy0[0], cy0[1], y); unpack16(cnn[0], cnn[1], n0); unpack16(cnn[2], cnn[3], n1);
            asm volatile("s_waitcnt lgkmcnt(0)" ::: "memory");
#pragma unroll
            for (int ks = 0; ks < 4; ++ks) { n0 = MFMA32(__builtin_bit_cast(bf16x8, cmt[ks]), hb[ks], n0); n1 = MFMA32(__builtin_bit_cast(bf16x8, cmt[4 + ks]), hb[ks], n1); y = MFMA32(__builtin_bit_cast(bf16x8, cry[ks]), hb[ks], y); }
            H0 = n0; H1 = n1;
#pragma unroll
            for (int r = 0; r < 16; ++r) yb[(size_t)(32 * ch + crow(r, h2)) * 256] = y[r];
            __builtin_amdgcn_s_barrier();
        }
        asm volatile("s_waitcnt vmcnt(0)" ::: "memory");
    }
    __syncthreads();
    if (F.tid == 0) {
        __builtin_amdgcn_fence(__ATOMIC_RELEASE, "agent");
        asm volatile("s_waitcnt vmcnt(0)" ::: "memory");
        (void)xb_add(sd, 1u);
    }
}
DI void rw_post_item(Frame& F, int layer, int tok0) {
    const int tid = F.tid, cg = tid & 31, c0 = 8 * cg, tr = tid >> 5;
    const f32x4 gw0 = *(const f32x4*)(F.in[14] + layer * 256 + c0), gw1 = *(const f32x4*)(F.in[14] + layer * 256 + c0 + 4);
    const f32x4 gb0 = *(const f32x4*)(F.in[15] + layer * 256 + c0), gb1 = *(const f32x4*)(F.in[15] + layer * 256 + c0 + 4);
    const float gw[8] = {gw0[0], gw0[1], gw0[2], gw0[3], gw1[0], gw1[1], gw1[2], gw1[3]}, gb[8] = {gb0[0], gb0[1], gb0[2], gb0[3], gb1[0], gb1[1], gb1[2], gb1[3]};
#pragma unroll
    for (int hf = 0; hf < 2; ++hf) {
        f32x4 ya[4], yb[4]; u32x4 bq[4], gq[4];
#pragma unroll
        for (int i = 0; i < 4; ++i) { const size_t o = (size_t)(tok0 + tr + 16 * (4 * hf + i)) * 256 + c0;
            ya[i] = *(const f32x4*)(WSP(float, WS_YBUF) + o); yb[i] = *(const f32x4*)(WSP(float, WS_YBUF) + o + 4);
            bq[i] = *(const u32x4*)(WSP(bf16_t, WS_BONV) + o); gq[i] = *(const u32x4*)(WSP(bf16_t, WS_GBUF) + o); }
#pragma unroll
        for (int i = 0; i < 4; ++i) {
            float y[8] = {ya[i][0], ya[i][1], ya[i][2], ya[i][3], yb[i][0], yb[i][1], yb[i][2], yb[i][3]};
            const float mean = sum8(((y[0] + y[1]) + (y[2] + y[3])) + ((y[4] + y[5]) + (y[6] + y[7]))) * (1.f / 64.f);
            float sq = 0.f;
#pragma unroll
            for (int j = 0; j < 8; ++j) { y[j] -= mean; sq += y[j] * y[j]; }
            const float rs = __builtin_amdgcn_rsqf(sum8(sq) * (1.f / 64.f) + 64e-5f);
#pragma unroll
            for (int j = 0; j < 8; ++j) { const float bo = bf2f((j & 1) ? (bq[i][j >> 1] >> 16) : (bq[i][j >> 1] & 0xffffu)), gg = bf2f((j & 1) ? (gq[i][j >> 1] >> 16) : (gq[i][j >> 1] & 0xffffu));
                y[j] = (y[j] * rs * gw[j] + gb[j] + bo) * gg; }
            *(u32x4*)(WSP(bf16_t, WS_MIX) + (size_t)(tok0 + tr + 16 * (4 * hf + i)) * D + 512 + c0) = __builtin_bit_cast(u32x4, pk8f(y));
        }
    }
}

constexpr int RT_WSTR = 1028;
DI void p4_router(Frame& F, int layer, bool dry) {
    LAS unsigned char* L = F.lds; const int tid = F.tid, lane = F.lane, wid = F.wave, m16 = lane & 15, q4 = lane >> 4;
    LAS float* W = (LAS float*)L;
    LAS float* wlog = (LAS float*)L + wid * (16 * 49);
    LAS int* ent = (LAS int*)(L + 148032);
    LAS float* entg = (LAS float*)(L + 148032 + 4096);
    LAS int* lcnt = (LAS int*)(L + 148032 + 5120);
    LAS int* lbase = lcnt + 144;
    const float* x = F.out; bf16_t* xb = WSP(bf16_t, WS_XB);
    const float *bg = F.in[20] + layer * 4, *be = F.in[22] + layer * 32;
    unsigned* cnt = (unsigned*)(F.ws + WS_CTL) + CW_CNT + layer * 256;
    int* elist = WSP(int, WS_LIST); f32x2* egate = WSP(f32x2, WS_GLIST); u32x2* plist = WSP(u32x2, WS_PLIST);
    for (int blk = F.bid; blk < NT / 128; blk += F.G) {
        __syncthreads();
        { const f32x4* src = (const f32x4*)(WSP(float, WS_RTW) + (size_t)layer * 36 * 1024);
          for (int i = tid; i < 36 * 256; i += 512) *(LAS f32x4*)(W + (i >> 8) * RT_WSTR + 4 * (i & 255)) = src[i]; }
        if (tid < 144) lcnt[tid] = 0;
        __syncthreads();
        const int row0 = blk * 128 + wid * 16;
        const float* xr = x + (size_t)(row0 + m16) * D + 4 * q4; bf16_t* xbr = xb + (size_t)(row0 + m16) * D + 4 * q4;
        f32x4 a0 = {}, a1 = {}, a2 = {}; float ssq = 0.f;
        const LAS float* w0p = W + (size_t)m16 * RT_WSTR + 4 * q4; const LAS float* w1p = w0p + 16 * RT_WSTR; const LAS float* w2p = W + (size_t)(32 + (m16 & 3)) * RT_WSTR + 4 * q4;
        const bool v2 = m16 < 4;
#pragma unroll 16
        for (int j = 0; j < 64; ++j) {
            const f32x4 xv = *(const f32x4*)(xr + 16 * j);
            const f32x4 wa = *(const LAS f32x4*)(w0p + 16 * j), wb = *(const LAS f32x4*)(w1p + 16 * j); f32x4 wc_ = *(const LAS f32x4*)(w2p + 16 * j);
            if (!v2) wc_ = (f32x4){0.f, 0.f, 0.f, 0.f};
            ssq += (xv[0] * xv[0] + xv[1] * xv[1]) + (xv[2] * xv[2] + xv[3] * xv[3]);
            u32x2 w; w.x = pk2(xv[0], xv[1]); w.y = pk2(xv[2], xv[3]); *(u32x2*)(xbr + 16 * j) = w;
#pragma unroll
            for (int i = 0; i < 4; ++i) { a0 = __builtin_amdgcn_mfma_f32_16x16x4f32(xv[i], wa[i], a0, 0, 0, 0); a1 = __builtin_amdgcn_mfma_f32_16x16x4f32(xv[i], wb[i], a1, 0, 0, 0); a2 = __builtin_amdgcn_mfma_f32_16x16x4f32(xv[i], wc_[i], a2, 0, 0, 0); }
        }
        ssq += __shfl_xor(ssq, 16); ssq += __shfl_xor(ssq, 32);
        __syncthreads();
#pragma unroll
        for (int jj = 0; jj < 4; ++jj) { wlog[(4 * q4 + jj) * 49 + m16] = a0[jj]; wlog[(4 * q4 + jj) * 49 + 16 + m16] = a1[jj]; wlog[(4 * q4 + jj) * 49 + 32 + m16] = a2[jj]; }
        asm volatile("s_waitcnt lgkmcnt(0)" ::: "memory");
        if (lane < 16) {
            const int r = lane, row = row0 + r;
            const float rstd = __builtin_amdgcn_rsqf(ssq * (1.f / 1024.f) + 1e-6f);
            WSP(float, WS_RSTD2)[row] = rstd;
            float gl[4]; int gs = 0; float gmax;
#pragma unroll
            for (int j = 0; j < 4; ++j) gl[j] = wlog[r * 49 + j] * rstd + bg[j];
            gmax = gl[0];
#pragma unroll
            for (int j = 1; j < 4; ++j) if (gl[j] > gmax) { gmax = gl[j]; gs = j; }
            float gsum = 0.f;
#pragma unroll
            for (int j = 0; j < 4; ++j) gsum += ex2((gl[j] - gmax) * LOG2E);
            const float ggate = 1.f / gsum;
            float el[8];
#pragma unroll
            for (int j = 0; j < 8; ++j) el[j] = wlog[r * 49 + 4 + gs * 8 + j] * rstd + be[gs * 8 + j];
            int i0 = 0; float m0 = el[0];
#pragma unroll
            for (int j = 1; j < 8; ++j) if (el[j] > m0) { m0 = el[j]; i0 = j; }
            int i1 = -1; float m1 = -3.0e38f;
#pragma unroll
            for (int j = 0; j < 8; ++j) if (j != i0 && (i1 < 0 || el[j] > m1)) { m1 = el[j]; i1 = j; }
            const float e1 = ex2((m1 - m0) * LOG2E), g0 = ggate / (1.f + e1), g1 = ggate * e1 / (1.f + e1);
            const int la = i0 < i1 ? i0 : i1, lb = i0 < i1 ? i1 : i0; const float ga = i0 < i1 ? g0 : g1, gb = i0 < i1 ? g1 : g0;
            const int ea = gs * 8 + la, eb = gs * 8 + lb, pid = gs * 28 + la * (15 - la) / 2 + (lb - la - 1);
            const int ra = atomicAdd((int*)&lcnt[ea], 1), rb = atomicAdd((int*)&lcnt[eb], 1), rp = atomicAdd((int*)&lcnt[32 + pid], 1);
            const int li = wid * 16 + r;
            ent[li * 8 + 0] = ea; ent[li * 8 + 1] = eb; ent[li * 8 + 2] = pid; ent[li * 8 + 3] = ra; ent[li * 8 + 4] = rb; ent[li * 8 + 5] = rp; ent[li * 8 + 6] = __builtin_bit_cast(int, rstd); entg[li * 2] = ga; entg[li * 2 + 1] = gb;
        }
        __syncthreads();
        if (tid < 144) { const int n = lcnt[tid]; lbase[tid] = (n && !dry) ? (int)xb_add(cnt + tid, (unsigned)n) : 0; }
        __syncthreads();
        if (tid < 128 && !dry) { const int row = blk * 128 + tid; const int ea = ent[tid * 8], eb = ent[tid * 8 + 1], pid = ent[tid * 8 + 2];
            const int pa = lbase[ea] + ent[tid * 8 + 3], pb = lbase[eb] + ent[tid * 8 + 4], pp = lbase[32 + pid] + ent[tid * 8 + 5];
            const float rsd = __builtin_bit_cast(float, ent[tid * 8 + 6]);
            elist[(size_t)ea * LCAP + pa] = row; egate[(size_t)ea * LCAP + pa] = (f32x2){entg[tid * 2], rsd};
            elist[(size_t)eb * LCAP + pb] = row; egate[(size_t)eb * LCAP + pb] = (f32x2){entg[tid * 2 + 1], rsd};
            plist[(size_t)pid * LCAP + pp] = (u32x2){(unsigned)row, (unsigned)pa | ((unsigned)pb << 16)}; }
    }
    __syncthreads();
}
DI void moe_tables(Frame& F, int layer) {
    LAS MoeTab* T = (LAS MoeTab*)(F.lds + LDS_AUX);
    unsigned* cnt = (unsigned*)(F.ws + WS_CTL) + CW_CNT + layer * 256;
    __syncthreads();
    if (F.tid < 32) T->ce[F.tid] = (int)xb_ld(cnt + F.tid); else if (F.tid < 144) T->cp[F.tid - 32] = (int)xb_ld(cnt + F.tid);
    __syncthreads();
    if (F.tid == 0) { int sb = 0, tg = 0;
        for (int e = 0; e < 32; ++e) { const int a = T->ce[e]; T->sb[e] = sb; T->tpg[e] = tg; sb += a; tg += (a + 255) >> 8; }
        T->tpg[32] = tg; }
    if (F.tid == 64) { int tf = 0, th = 0;
        for (int p = 0; p < 112; ++p) { const int n = T->cp[p], nt_ = (n + 255) >> 8, half = (nt_ > 0 && n - 256 * (nt_ - 1) <= 128) ? 1 : 0; T->tpf[p] = tf; T->tph[p] = th; tf += nt_ - half; th += half; }
        T->tpf[112] = tf; T->tph[112] = th; }
    __syncthreads();
}
DI void p_final(Frame& F) {
    const int gw = F.bid * 8 + F.wave, NGW = F.G * 8; const f32x4* gq = (const f32x4*)F.in[26] + F.lane;
    f32x4 gv[4];
#pragma unroll
    for (int j = 0; j < 4; ++j) gv[j] = gq[64 * j];
    for (int m0 = gw * 4; m0 < NT; m0 += NGW * 4) {
        f32x4 v[4][4];
#pragma unroll
        for (int r = 0; r < 4; ++r) { const f32x4* xr = (const f32x4*)(F.out + (size_t)(m0 + r) * D) + F.lane;
#pragma unroll
            for (int j = 0; j < 4; ++j) v[r][j] = xr[64 * j]; }
#pragma unroll
        for (int r = 0; r < 4; ++r) { float s = 0.f; f32x4* xw = (f32x4*)(F.out + (size_t)(m0 + r) * D) + F.lane;
#pragma unroll
            for (int j = 0; j < 4; ++j) s += (v[r][j][0] * v[r][j][0] + v[r][j][1] * v[r][j][1]) + (v[r][j][2] * v[r][j][2] + v[r][j][3] * v[r][j][3]);
            const float rstd = __builtin_amdgcn_rsqf(wave_sum(s) * (1.f / 1024.f) + 1e-6f);
#pragma unroll
            for (int j = 0; j < 4; ++j) xw[64 * j] = v[r][j] * rstd * gv[j]; }
    }
}


#ifndef DUP_PH
#define DUP_PH -1
#endif
#define NREP(n) ((DUP_PH == (n)) ? 2 : 1)
constexpr int PH_PER_LAYER = 6, N_PHASES = 1 + DEPTH * PH_PER_LAYER + 1;
__global__ void __launch_bounds__(512, 2) mk_fwd(Args args) {
    extern __shared__ __attribute__((aligned(16))) unsigned char lds_raw[];
    Frame F;
    F.lds = (LAS unsigned char*)lds_raw; F.tid = threadIdx.x; F.lane = F.tid & 63; F.wave = __builtin_amdgcn_readfirstlane(F.tid >> 6);
    F.G = gridDim.x; F.bid = blockIdx.x; F.in = (const __attribute__((address_space(4))) cfp_t*)__builtin_amdgcn_kernarg_segment_ptr(); F.out = args.out; F.ws = args.ws;
    volatile LAS unsigned* MISC = (volatile LAS unsigned*)(F.lds + LDS_MISC);
    if (F.tid < 64) MISC[F.tid] = 0u;
    __syncthreads();
    unsigned* ctl = (unsigned*)(F.ws + WS_CTL);
    const int lo = args.ph_lo, hi = args.ph_hi;
    const bool multi = (hi - lo) > 1;
    XcdBarrier bar; bar.bar = ctl + CW_BAR; bar.x = 0; bar.st = nullptr;
    if (multi) bar = xcd_barrier_post(ctl + CW_BAR, MISC + 8);
#ifndef PHSEL
#define PHSEL -1
#endif
#ifndef PHMASK
#define PHMASK 0xFFFF
#endif
#define PS(n) ((PHSEL < 0 || PHSEL == (n)) && ((PHMASK >> (n)) & 1))
#define LAUNDER() do { asm volatile("" : "+s"(F.in)); asm volatile("" : "+s"(F.ws)); asm volatile("" : "+s"(F.out)); asm volatile("" : "+v"(F.tid)); asm volatile("" : "+v"(F.lane)); asm volatile("" : "+s"(F.bid)); asm volatile("" : "+s"(F.G)); } while (0)
#define IN(k) (lo <= (k) && (k) < hi)
#define SEAM(k) do { if (IN(k) && IN((k) + 1)) { xcd_barrier(bar); if (DUP_PH == 99) xcd_barrier(bar); } LAUNDER(); } while (0)
#ifdef TPROBE
    unsigned long long tp_acc = 0, tp_prev = __builtin_amdgcn_s_memrealtime();
#define TP(k) do { const unsigned long long tp_now = __builtin_amdgcn_s_memrealtime(); if ((k) == TPROBE || (k) == TPROBE2) tp_acc += tp_now - tp_prev; tp_prev = tp_now; } while (0)
#else
#define TP(k) do { } while (0)
#endif
    LAUNDER();
    if (PS(0) && IN(0)) { _Pragma("unroll 1") for (int rep = 0; rep < NREP(0); ++rep) p0_prologue(F); }
    SEAM(0); TP(0);
#pragma unroll 1
    for (int layer = 0; layer < DEPTH; ++layer) {
        const int pb = 1 + layer * PH_PER_LAYER;
        LAUNDER();
        if (PS(1) && IN(pb + 0)) _Pragma("unroll 1") for (int rep = 0; rep < NREP(1); ++rep) {
            ProbIn P; P.K = D; P.A = WSP(bf16_t, WS_XB); P.Bt = WSP(bf16_t, WS_BIN) + (size_t)layer * NIN * D; P.G = F.G; P.c = F.bid;
            P.Pout = WSP(bf16_t, WS_P); P.ss1 = WSP(float, WS_SS1); P.lf = WSP(float, WS_LF); P.bfx = F.in[16] + layer * 4; P.kmax = (unsigned*)(F.ws + WS_CTL) + CW_KMAX + layer * 128;
            pg8::gemm_phase<ProbIn, true>(F.lds, P, F.tid);
        }
        SEAM(pb + 0); TP(1);
        if (IN(pb + 1)) _Pragma("unroll 1") for (int rep = 0; rep < NREP(2); ++rep) {
            if (PS(4)) {
                __syncthreads();
                { LAS float* PARW = (LAS float*)(F.lds + RG_PAR);
                  for (int i = F.tid; i < 1280; i += 512) { const int a = i >> 8, c = i & 255; PARW[i] = F.in[a == 0 ? 6 : (a == 1 ? 8 : (a == 2 ? 12 : (a == 3 ? 13 : 11)))][layer * 256 + c]; } }
                __syncthreads();
                if (F.wave < 4) { _Pragma("unroll 1") for (int it = F.bid; it < 1024; it += F.G) rw_group_compute(F, layer, it); } else rw_loader_loop(F, layer);
                __syncthreads();
            }
        }
        if (IN(pb + 1)) {
            unsigned* r1d = (unsigned*)(F.ws + WS_CTL) + CW_R1D + layer * 2048;
            xcd_arrive(bar, r1d); TP(2);
            bool fxw = false;
            unsigned* sdw = (unsigned*)(F.ws + WS_CTL) + CW_SD + layer * 64;
            if (PS(5)) { if (F.G >= 64) { if (F.bid < 32) { xcd_wait_all(bar, r1d); TP(8); rw_seq_wg(F, F.bid, sdw); TP(9); } } else { xcd_wait_all(bar, r1d); for (int i = F.bid; i < 32; i += F.G) rw_seq_wg(F, i, sdw); } }
            unsigned* wq = (unsigned*)(F.ws + WS_CTL) + CW_WQ + layer * 64;
            volatile LAS int* qslot = (volatile LAS int*)(F.lds + LDS_MISC + 64);
            __syncthreads();
            if (F.tid == 0) qslot[0] = (int)xb_add(wq, 1u);
            __syncthreads();
            int q = qslot[0];
#pragma unroll 1
            for (;;) {
                if (q >= 1024 + 256 + 256) break;
                unsigned nq = 0u; if (F.tid == 0) nq = xb_add(wq, 1u);
                LAUNDER();
                if (q < 512) { if (PS(6)) sb_unit(F, (q & 63) >> 2, q & 3, 7 - (q >> 6)); }
                else if (q < 1024) { const int r = q - 512; if (!fxw) { xcd_wait_all(bar, r1d); fxw = true; } if (PS(2)) fx_unit(F, layer, (r & 63) >> 2, r & 3, 7 - (r >> 6)); }
                else if (q < 1280) { if (PS(3)) gm_item(F, layer, (q - 1024) >> 4, (q - 1024) & 15); }
                else if (PS(7)) {
                    if (F.tid == 0) { unsigned sp = 0; while (xb_ld(sdw) < 32u) { __builtin_amdgcn_s_sleep(2); if (++sp > (1u << 22)) break; }
                        __builtin_amdgcn_fence(__ATOMIC_ACQUIRE, "agent"); asm volatile("s_waitcnt vmcnt(0)" ::: "memory"); }
                    __syncthreads();
                    rw_post_item(F, layer, (q - 1280) * 128);
                }
                TP(q < 512 ? 20 : (q < 1024 ? 21 : (q < 1280 ? 22 : 23)));
                __syncthreads();
                if (F.tid == 0) qslot[0] = (int)nq;
                __syncthreads();
                q = qslot[0];
            }
        }
        SEAM(pb + 1); TP(3);
        if (PS(8) && IN(pb + 2)) {
            ProbOut P; P.K = D; P.A = WSP(bf16_t, WS_MIX); P.Bt = WSP(bf16_t, WS_BOUT) + (size_t)layer * D * D; P.G = F.G; P.c = F.bid;
            P.base = (layer == 0) ? F.in[0] : F.out; P.out = F.out;
            if (DUP_PH == 8) { P.ascale = 0.f; P.base = F.out; pg8::gemm_phase<ProbOut, true>(F.lds, P, F.tid); P.base = (layer == 0) ? F.in[0] : F.out; }
            P.ascale = 1.f; pg8::gemm_phase<ProbOut, true>(F.lds, P, F.tid);
        }
        SEAM(pb + 2); TP(4);
        if (PS(9) && IN(pb + 3)) { if (DUP_PH == 9) p4_router(F, layer, true); p4_router(F, layer, false); }
        SEAM(pb + 3); TP(5);
        if (PS(10) && IN(pb + 4)) {
            moe_tables(F, layer);
            ProbGU P; P.K = D; P.A = WSP(bf16_t, WS_XB); P.Bt = WSP(bf16_t, WS_BGU) + (size_t)layer * NE * 1024 * D; P.G = F.G; P.c = F.bid;
            P.T = (const LAS MoeTab*)(F.lds + LDS_AUX); P.elist = WSP(int, WS_LIST); P.egate = WSP(f32x2, WS_GLIST); P.HB = WSP(bf16_t, WS_HB);
            pg8::gemm_phase<ProbGU, true>(F.lds, P, F.tid);
        }
        SEAM(pb + 4); TP(6);
        if (PS(11) && IN(pb + 5)) {
            moe_tables(F, layer);
            ProbDP P; P.A = WSP(bf16_t, WS_HB); P.Bt = WSP(bf16_t, WS_BDN) + (size_t)layer * NE * D * EH; P.G = F.G; P.c = F.bid;
            P.T = (const LAS MoeTab*)(F.lds + LDS_AUX); P.plist = WSP(u32x2, WS_PLIST); P.x = F.out; P.xb = WSP(bf16_t, WS_XB); P.ss1 = WSP(float, WS_SS1);
            pg8::gemm_phase_pair<ProbDP>(F.lds, P, F.tid);
        }
        SEAM(pb + 5); TP(7);
    }
    if (PS(13) && IN(N_PHASES - 1)) p_final(F);
#ifdef TPROBE
    TP(10);
    #ifdef TPSLOT
    __syncthreads(); tp_acc = *((volatile LAS unsigned long long*)(F.lds + LDS_MISC + 128) + TPSLOT);
#endif
    if (F.bid == TPWG) { const unsigned long long t0 = __builtin_amdgcn_s_memrealtime(); while (__builtin_amdgcn_s_memrealtime() - t0 < 8ull * tp_acc) __builtin_amdgcn_s_sleep(8); }
#endif
#undef IN
#undef SEAM
}

#ifndef MK_ONE_LAUNCH
#define MK_ONE_LAUNCH 1
#endif
extern "C" void kernel_launch(void* const* d_in, const int* in_sizes, int n_in, void* d_out, int out_size, void* d_ws, size_t ws_size, hipStream_t stream) {
    static int grid = 0;
    if (grid == 0) {
        if (n_in != 27 || out_size != NT * D || ws_size < WS_END) { fprintf(stderr, "kernel_launch: unexpected shapes (n_in %d out %d ws %zu)\n", n_in, out_size, ws_size); grid = -1; return; }
        int dev = 0, cus = 0;
        if (hipGetDevice(&dev) != hipSuccess || hipDeviceGetAttribute(&cus, hipDeviceAttributeMultiprocessorCount, dev) != hipSuccess) { grid = -1; return; }
        if (hipFuncSetAttribute((const void*)mk_fwd, hipFuncAttributeMaxDynamicSharedMemorySize, LDS_BYTES) != hipSuccess) { fprintf(stderr, "kernel_launch: hipFuncSetAttribute failed\n"); grid = -1; return; }
        (void)hipGetLastError();
        grid = cus;
    }
    if (grid < 0) return;
    (void)hipMemsetAsync((char*)d_ws + WS_CTL, 0, CTL_BYTES, stream);
    Args a{};
    for (int i = 0; i < 27; ++i) a.in[i] = (const float*)d_in[i];
    a.out = (float*)d_out; a.ws = (unsigned char*)d_ws; a.li = 0; a.pad = 0;
#if MK_ONE_LAUNCH
    a.ph_lo = 0; a.ph_hi = N_PHASES;
    hipLaunchKernelGGL(mk_fwd, dim3(grid), dim3(512), LDS_BYTES, stream, a);
#else
    for (int p = 0; p < N_PHASES; ++p) { a.ph_lo = p; a.ph_hi = p + 1; hipLaunchKernelGGL(mk_fwd, dim3(grid), dim3(512), LDS_BYTES, stream, a); }
#endif
}
```

```cpp
#include <hip/hip_runtime.h>
#include <cstdio>
#include <cstdint>

#define DI __device__ __forceinline__
#define LAS __attribute__((address_space(3)))
#define GAS __attribute__((address_space(1)))
typedef unsigned short bf16_t;
typedef short bf16x8 __attribute__((ext_vector_type(8)));
typedef short s16x4 __attribute__((ext_vector_type(4)));
typedef float f32x2 __attribute__((ext_vector_type(2)));
typedef float f32x4 __attribute__((ext_vector_type(4)));
typedef float f32x16 __attribute__((ext_vector_type(16)));
typedef unsigned u32x2 __attribute__((ext_vector_type(2)));
typedef unsigned u32x4 __attribute__((ext_vector_type(4)));
typedef __bf16 bf16x2_t __attribute__((ext_vector_type(2)));
typedef GAS unsigned gu32;

constexpr int NT = 32768, SEQ = 2048, NB = 16, D = 1024, DEPTH = 4, NH = 4;
constexpr int PP = 3072;
constexpr int NIN = 3328;
constexpr int C_SBQ = 0, C_SBK = 256, C_SBV = 512, C_GMU = 768, C_GMV = 1024, C_RWR = 1280, C_RWK = 1536, C_RWV = 1792, C_RWX = 2048, C_FXQ = 2304, C_FXK = 2560, C_FXV = 2816;
constexpr int NE = 32, EH = 512;
constexpr float LOG2E = 1.4426950408889634f, LN2 = 0.6931471805599453f;
constexpr float QSCALE2 = 0.125f * LOG2E;

constexpr size_t MiB = 1u << 20;
constexpr size_t WS_CTL = 0, CTL_BYTES = 1 * MiB;
constexpr size_t WS_BIN = 1 * MiB;
constexpr size_t WS_BOUT = 28 * MiB;
constexpr size_t WS_BGU = 36 * MiB;
constexpr size_t WS_BDN = 292 * MiB;
constexpr size_t WS_WCAT = 420 * MiB;
constexpr size_t WS_RTW = 421 * MiB;
constexpr size_t WS_SS1 = 422 * MiB;
constexpr size_t WS_RSTD2 = 424 * MiB;
constexpr size_t WS_LF = 425 * MiB;
constexpr size_t WS_GMW = 426 * MiB;
constexpr size_t WS_LIST = 428 * MiB;
constexpr size_t WS_GLIST = 436 * MiB;
constexpr size_t WS_GBUF = 444 * MiB;
constexpr size_t WS_YBUF = 460 * MiB;
constexpr size_t WS_MIX = 492 * MiB;
constexpr size_t WS_P = 556 * MiB;
constexpr size_t WS_XB = 748 * MiB;
constexpr size_t WS_HB = 812 * MiB;
constexpr size_t WS_REC = 748 * MiB;
constexpr size_t WS_CHMT = 812 * MiB;
constexpr size_t WS_CHN = 844 * MiB;
constexpr size_t WS_CHFR = 812 * MiB;
constexpr size_t WS_CHRY = 877 * MiB;
constexpr size_t WS_CHY0 = 893 * MiB;
constexpr size_t WS_BONV = 909 * MiB;
constexpr size_t WS_PLIST = 940 * MiB;
constexpr size_t WS_END = 968 * MiB;

constexpr int CW_BAR = 4096;
constexpr int CW_CNT = 16384;
constexpr int CW_R1D = 40960;
constexpr int CW_SD = 28672;
constexpr int CW_WQ = 24576;
constexpr int CW_KMAX = 20480;

constexpr int LDS_BYTES = 163840;
constexpr int LDS_AUX = 131072;
constexpr int LDS_MISC = 163840 - 256;

DI float bf2f(unsigned b) { return __uint_as_float(b << 16); }
DI unsigned pk2(float lo, float hi) { f32x2 v = {lo, hi}; bf16x2_t b = __builtin_convertvector(v, bf16x2_t); return __builtin_bit_cast(unsigned, b); }
DI unsigned f2bf(float f) { return pk2(f, 0.f) & 0xffffu; }
DI bf16x8 pk8f(const float (&v)[8]) { u32x4 p; p.x = pk2(v[0], v[1]); p.y = pk2(v[2], v[3]); p.z = pk2(v[4], v[5]); p.w = pk2(v[6], v[7]); return __builtin_bit_cast(bf16x8, p); }
DI float ex2(float x) { return __builtin_amdgcn_exp2f(x); }
DI float lg2(float x) { return __builtin_amdgcn_logf(x); }
DI float rcpf_(float x) { return __builtin_amdgcn_rcpf(x); }
DI float sigmoidf_(float x) { return rcpf_(1.f + ex2(-x * LOG2E)); }
DI float tanhf_(float x) { return 1.f - 2.f * rcpf_(1.f + ex2(2.f * LOG2E * x)); }
DI float geluf_(float x) { const float u = 0.7978845608028654f * (x + 0.044715f * x * x * x); return x * rcpf_(1.f + ex2(-2.f * LOG2E * u)); }
DI float softplusf_(float x) { return fmaxf(x, 0.f) + LN2 * lg2(1.f + ex2(-fabsf(x) * LOG2E)); }
template <int CTRL, int RMASK, bool BC> DI float dppf(float x) { return __builtin_bit_cast(float, __builtin_amdgcn_update_dpp(0, __builtin_bit_cast(int, x), CTRL, RMASK, 0xf, BC)); }
DI float wave_sum(float v) {
    v += dppf<0xB1, 0xf, true>(v); v += dppf<0x4E, 0xf, true>(v); v += dppf<0x141, 0xf, true>(v); v += dppf<0x140, 0xf, true>(v);
    v += dppf<0x142, 0xa, false>(v); v += dppf<0x143, 0xc, false>(v);
    return __builtin_bit_cast(float, __builtin_amdgcn_readlane(__builtin_bit_cast(int, v), 63));
}
DI float swap32(float v) { return __shfl_xor(v, 32); }
#define MFMA32(a, b, c) __builtin_amdgcn_mfma_f32_32x32x16_bf16((a), (b), (c), 0, 0, 0)
DI int crow(int r, int h) { return (r & 3) + 8 * (r >> 2) + 4 * h; }

#define XB_TMO      128
#define XB_XCNT(j)  (256  + 64 * (j))
#define XB_XSUB(j)  (1280 + 64 * (j))
#define XB_XGEN(j)  (2304 + 64 * (j))
#define XB_TOP      3328
#define XB_TOPGEN   3392
#define XCD_BAR_WORDS 3456
#define XB_SPIN_CAP (1u << 18)
DI unsigned xb_ld(unsigned* p)              { return __hip_atomic_load(p, __ATOMIC_RELAXED, __HIP_MEMORY_SCOPE_AGENT); }
DI unsigned xb_add(unsigned* p, unsigned v) { return __hip_atomic_fetch_add(p, v, __ATOMIC_RELAXED, __HIP_MEMORY_SCOPE_AGENT); }
DI unsigned xb_xcc_id() { return (unsigned)__builtin_amdgcn_s_getreg((3 << 11) | 20) & 0xFu; }
#define XB_SPIN(cond, bar) do { unsigned _sp = 0; while (cond) { __builtin_amdgcn_s_sleep(1); \
    if ((++_sp & 255u) == 0u) { if (xb_ld(&(bar)[XB_TMO])) break; if (_sp > XB_SPIN_CAP) { atomicAdd(&(bar)[XB_TMO], 1u); break; } } } } while (0)
struct XcdBarrier { unsigned* bar; unsigned x; volatile LAS unsigned* st; };
DI XcdBarrier xcd_barrier_post(unsigned* bar, volatile LAS unsigned* st) {
    XcdBarrier b; b.bar = bar; b.x = xb_xcc_id(); b.st = st;
    if (threadIdx.x == 0) (void)xb_add(&bar[XB_XCNT(b.x)], 1u);
    return b;
}
DI void xcd_barrier_complete(unsigned* bar, unsigned x, unsigned& nloc, unsigned& nx) {
    const unsigned G = gridDim.x * gridDim.y * gridDim.z;
    unsigned sum, cnt, mine, sp = 0u;
    for (;;) {
        sum = 0u; cnt = 0u; mine = 0u;
#pragma unroll
        for (unsigned j = 0; j < 16; ++j) { const unsigned c = xb_ld(&bar[XB_XCNT(j)]); sum += c; cnt += (c > 0u) ? 1u : 0u; mine = (j == x) ? c : mine; }
        if (sum == G) break;
        __builtin_amdgcn_s_sleep(1);
        if ((++sp & 255u) == 0u) { if (xb_ld(&bar[XB_TMO])) break; if (sp > XB_SPIN_CAP) { atomicAdd(&bar[XB_TMO], 1u); break; } }
    }
    nloc = mine > 0u ? mine : 1u; nx = cnt > 0u ? cnt : 1u;
}
DI void xcd_barrier(const XcdBarrier& b) {
    asm volatile("s_waitcnt vmcnt(0)" ::: "memory");
    __syncthreads();
    if (threadIdx.x == 0) {
        unsigned* bar = b.bar;
        __builtin_amdgcn_s_waitcnt(0);
        unsigned nloc = b.st[0], nx = b.st[1];
        if (nloc == 0u) { xcd_barrier_complete(bar, b.x, nloc, nx); b.st[0] = nloc; b.st[1] = nx; }
        const unsigned old = xb_add(&bar[XB_XSUB(b.x)], 1u);
        const unsigned gen = old / nloc;
        if (old + 1u == (gen + 1u) * nloc) {
            __builtin_amdgcn_fence(__ATOMIC_RELEASE, "agent");
            asm volatile("s_waitcnt vmcnt(0)" ::: "memory");
            const unsigned og = xb_add(&bar[XB_TOP], 1u);
            const unsigned tg = og / nx;
            if (og + 1u == (tg + 1u) * nx) xb_add(&bar[XB_TOPGEN], 1u);
            else XB_SPIN(xb_ld(&bar[XB_TOPGEN]) == tg, bar);
            __builtin_amdgcn_fence(__ATOMIC_ACQUIRE, "agent");
            xb_add(&bar[XB_XGEN(b.x)], 1u);
            asm volatile("s_waitcnt vmcnt(0)" ::: "memory");
        } else {
            XB_SPIN(xb_ld(&bar[XB_XGEN(b.x)]) == gen, bar);
            __builtin_amdgcn_fence(__ATOMIC_ACQUIRE, "agent");
            asm volatile("s_waitcnt vmcnt(0)" ::: "memory");
        }
    }
    __syncthreads();
}

DI void xcd_arrive(const XcdBarrier& b, unsigned* w) {
    asm volatile("s_waitcnt vmcnt(0)" ::: "memory");
    __syncthreads();
    if (threadIdx.x == 0) {
        const unsigned nloc = b.st[0];
        const unsigned old = xb_add(&w[64 * b.x], 1u);
        if (old + 1u == nloc) { __builtin_amdgcn_fence(__ATOMIC_RELEASE, "agent"); asm volatile("s_waitcnt vmcnt(0)" ::: "memory"); (void)xb_add(&w[64 * 16], 1u); }
    }
}
DI void xcd_wait_all(const XcdBarrier& b, unsigned* w) {
    if (threadIdx.x == 0) { const unsigned nx = b.st[1]; unsigned sp = 0; while (xb_ld(&w[64 * 16]) < nx) { __builtin_amdgcn_s_sleep(1); if (++sp > (1u << 22)) break; }
        __builtin_amdgcn_fence(__ATOMIC_ACQUIRE, "agent"); asm volatile("s_waitcnt vmcnt(0)" ::: "memory"); }
    __syncthreads();
}

typedef const float* cfp_t;
struct Args { const float* in[27]; float* out; unsigned char* ws; int ph_lo, ph_hi, li, pad; };
struct Frame {
    LAS unsigned char* lds;
    int tid, lane, wave, G, bid;
    const __attribute__((address_space(4))) cfp_t* in;
    float* out; unsigned char* ws;
};
#define WSP(T, off) ((T*)(F.ws + (off)))

namespace pg8 {
constexpr int BM = 256, BK = 64, HALF = 128, HTB = HALF * BK * 2, STAGE_BYTES = 8 * HTB, NXCD = 8, WGM = 8;
DI int lds_byte(int r, int c) { const int st = (r >> 4) * 2 + (c >> 5), rr = r & 15, cc = c & 31, ob = rr * 64 + cc * 2; return st * 1024 + (ob ^ (((ob >> 9) & 1) << 5)); }
DI void stage_rc(int b, int& R, int& C) { const int st = b / 1024, sb = b % 1024, swz = sb ^ (((sb >> 9) & 1) << 5); R = (st >> 1) * 16 + swz / 64; C = (st & 1) * 32 + (swz % 64) / 2; }
DI int perm32(int rho) { const int n = rho >> 4, i = rho & 15; return 8 * (i >> 2) + 4 * n + (i & 3); }
struct Unit { int pm, pn, e, cnt, base, aux; };
DI bool static_next(int nM, int nN, int G, int c, int i, Unit& u) {
    const int nwg = nM * nN; const long L = (long)i * G + c; if (L >= nwg) return false;
    int wgid = (int)L; { const int q = nwg / NXCD, r = nwg % NXCD, xcd = wgid % NXCD, off = wgid / NXCD; wgid = (xcd < r ? xcd * (q + 1) : r * (q + 1) + (xcd - r) * q) + off; }
    const int nig = WGM * nN, gid = wgid / nig, fm = gid * WGM, gsz = (nM - fm) < WGM ? (nM - fm) : WGM;
    u.pm = fm + ((wgid % nig) % gsz); u.pn = (wgid % nig) / gsz; u.e = 0; u.cnt = 0; u.base = 0; u.aux = 0; return true;
}

template <class Prob, bool ALIGN_EPI>
DI void gemm_phase(LAS unsigned char* lds, const Prob& P, const int tid) {
    const int wid = __builtin_amdgcn_readfirstlane(tid >> 6), lane = tid & 63, wr = wid >> 2, wc = wid & 3, fr = lane & 15, fq = lane >> 4;
    const int K = P.K, nt = K / BK;
    constexpr bool GA = Prob::GATHER;
    unsigned voffB[2], voffA[2];
#pragma unroll
    for (int i = 0; i < 2; ++i) { int R, C; stage_rc(tid * 16 + i * 8192, R, C); const int Rb = Prob::PERM ? ((R & ~31) + perm32(R & 31)) : R; voffB[i] = (unsigned)(Rb * K + C) * 2u; voffA[i] = (unsigned)(R * K + C) * 2u; }
    const size_t kstep = (size_t)(BK * 2);
    const size_t hstepB = (size_t)HALF * K * 2;
    const unsigned ldsw = (unsigned)wid * 1024u;
    const int aoffL = lds_byte(wr * 64 + fr, fq * 8), boffL = lds_byte(wc * 32 + fr, fq * 8);
    const char* Abase = (const char*)P.A;
#define PG8_SA(b, h) (((b) * 2 + (h)) * HTB)
#define PG8_SB(b, h) ((4 + (b) * 2 + (h)) * HTB)
#define PG8_STG_B(bufoff, gbase) do { _Pragma("unroll") for (int _i = 0; _i < 2; ++_i) \
        __builtin_amdgcn_global_load_lds((const unsigned*)((const char*)(gbase) + voffB[_i]), (LAS unsigned*)(lds + (bufoff) + ldsw + _i * 8192), 16, 0, 0); } while (0)
#define PG8_STG_A(bufoff, h, kbyte) do { _Pragma("unroll") for (int _i = 0; _i < 2; ++_i) { \
        const char* _p; if constexpr (GA) _p = Abase + (size_t)(kbyte) + aoff[h][_i]; else _p = cA + (size_t)(h) * hstepB + (size_t)(kbyte) + voffA[_i]; \
        __builtin_amdgcn_global_load_lds((const unsigned*)_p, (LAS unsigned*)(lds + (bufoff) + ldsw + _i * 8192), 16, 0, 0); } } while (0)
#define PG8_LDA(dst, b, h) do { _Pragma("unroll") for (int m = 0; m < 4; ++m) _Pragma("unroll") for (int k = 0; k < 2; ++k) dst[m][k] = *(const LAS bf16x8*)(lds + PG8_SA(b, h) + aoffL + m * 2048 + k * 1024); } while (0)
#define PG8_LDB(dst, b, h) do { _Pragma("unroll") for (int n = 0; n < 2; ++n) _Pragma("unroll") for (int k = 0; k < 2; ++k) dst[n][k] = *(const LAS bf16x8*)(lds + PG8_SB(b, h) + boffL + n * 2048 + k * 1024); } while (0)
#define PG8_MMA(ai, bj, At, Bt) do { __builtin_amdgcn_s_setprio(1); _Pragma("unroll") for (int m = 0; m < 4; ++m) _Pragma("unroll") for (int n = 0; n < 2; ++n) _Pragma("unroll") for (int k = 0; k < 2; ++k) \
        acc[ai][bj][m][n] = __builtin_amdgcn_mfma_f32_16x16x32_bf16(Bt[n][k], At[m][k], acc[ai][bj][m][n], 0, 0, 0); __builtin_amdgcn_s_setprio(0); } while (0)
#define PG8_WAIT_V(n) asm volatile("s_waitcnt vmcnt(" #n ")" ::: "memory")
#define PG8_WAIT_L(n) asm volatile("s_waitcnt lgkmcnt(" #n ")" ::: "memory")
#define PG8_BAR __builtin_amdgcn_s_barrier()
#define PG8_SCHED __builtin_amdgcn_sched_barrier(0)
    Unit cur, nxt; int ui = 0;
    if (!P.next(0, cur)) return;
    f32x4 acc[2][2][4][2];
#pragma unroll
    for (int a = 0; a < 2; ++a)
#pragma unroll
        for (int b = 0; b < 2; ++b)
#pragma unroll
            for (int m = 0; m < 4; ++m)
#pragma unroll
                for (int n = 0; n < 2; ++n) acc[a][b][m][n] = (f32x4){0.f, 0.f, 0.f, 0.f};
    bf16x8 At[4][2], B0[2][2], B1[2][2];
    unsigned aoff[2][2] = {{0u, 0u}, {0u, 0u}}, noff[2][2] = {{0u, 0u}, {0u, 0u}};
    const char* cA = Abase; const char* nA = Abase;
    if constexpr (GA) P.aoffs(cur, tid, aoff); else cA = Abase + (size_t)P.arow0(cur) * K * 2;
    const char* cB = P.bbase(cur);
    PG8_STG_B(PG8_SB(0, 0), cB); PG8_STG_B(PG8_SB(0, 1), cB + hstepB); PG8_STG_A(PG8_SA(0, 0), 0, 0); PG8_STG_A(PG8_SA(0, 1), 1, 0);
    if (wr == 1) PG8_BAR;
    PG8_WAIT_V(2); PG8_BAR;
    PG8_STG_B(PG8_SB(1, 0), cB + kstep); PG8_STG_A(PG8_SA(1, 0), 0, kstep); PG8_STG_B(PG8_SB(1, 1), cB + hstepB + kstep);
    PG8_WAIT_V(6); PG8_BAR;
    for (;;) {
        const bool has_next = P.next(ui + 1, nxt);
        const char* nB = cB; nA = cA;
        if (has_next) { nB = P.bbase(nxt); if constexpr (GA) P.aoffs(nxt, tid, noff); else nA = Abase + (size_t)P.arow0(nxt) * K * 2; }
        else if constexpr (GA) { noff[0][0] = aoff[0][0]; noff[0][1] = aoff[0][1]; noff[1][0] = aoff[1][0]; noff[1][1] = aoff[1][1]; }
        if constexpr (GA) { *(LAS u32x4*)(lds + LDS_AUX + 2048 + tid * 16) = (u32x4){noff[0][0], noff[0][1], noff[1][0], noff[1][1]}; }
        for (int t = 0; t < nt; t += 2) {
            const bool last = (t == nt - 2);
            const size_t k1 = (size_t)(t + 1) * kstep;
            const size_t k2 = last ? (size_t)0 : (size_t)(t + 2) * kstep, k3 = k2 + kstep;
            const char* b2 = last ? nB : cB + (size_t)(t + 2) * kstep; const char* b3 = b2 + kstep;
            PG8_LDB(B0, 0, 0); PG8_LDB(B1, 0, 1); PG8_SCHED; PG8_LDA(At, 0, 0); PG8_STG_A(PG8_SA(1, 1), 1, k1);
            PG8_WAIT_V(8); PG8_WAIT_L(0); PG8_BAR; PG8_MMA(0, 0, At, B0); PG8_MMA(0, 1, At, B1); PG8_BAR; PG8_SCHED;
            if (last) { if constexpr (GA) { const u32x4 nq = *(const LAS u32x4*)(lds + LDS_AUX + 2048 + tid * 16); aoff[0][0] = nq[0]; aoff[0][1] = nq[1]; aoff[1][0] = nq[2]; aoff[1][1] = nq[3]; } else cA = nA; }
            PG8_LDA(At, 0, 1); PG8_STG_B(PG8_SB(0, 0), b2); PG8_STG_B(PG8_SB(0, 1), b2 + hstepB); PG8_STG_A(PG8_SA(0, 0), 0, k2);
            PG8_WAIT_V(8); PG8_WAIT_L(0); PG8_BAR; PG8_MMA(1, 0, At, B0); PG8_MMA(1, 1, At, B1); PG8_BAR; PG8_SCHED;
            PG8_LDB(B0, 1, 0); PG8_LDB(B1, 1, 1); PG8_SCHED; PG8_LDA(At, 1, 0); PG8_STG_A(PG8_SA(0, 1), 1, k2);
            PG8_WAIT_V(8); PG8_WAIT_L(0); PG8_BAR; PG8_MMA(0, 0, At, B0); PG8_MMA(0, 1, At, B1); PG8_BAR; PG8_SCHED;
            PG8_LDA(At, 1, 1); PG8_STG_B(PG8_SB(1, 0), b3); PG8_STG_B(PG8_SB(1, 1), b3 + hstepB); PG8_STG_A(PG8_SA(1, 0), 0, k3);
            PG8_WAIT_V(8); PG8_WAIT_L(0); PG8_BAR; PG8_MMA(1, 0, At, B0); PG8_MMA(1, 1, At, B1); PG8_BAR; PG8_SCHED;
        }
        if constexpr (ALIGN_EPI) { if (wr == 0) PG8_BAR; }
        P.epi(acc, cur, wr, wc, fr, fq);
        if (!has_next) break;
#pragma unroll
        for (int a = 0; a < 2; ++a)
#pragma unroll
            for (int b = 0; b < 2; ++b)
#pragma unroll
                for (int m = 0; m < 4; ++m)
#pragma unroll
                    for (int n = 0; n < 2; ++n) acc[a][b][m][n] = (f32x4){0.f, 0.f, 0.f, 0.f};
        cur = nxt; cB = nB; ++ui;
        if constexpr (ALIGN_EPI) { if (wr == 1) PG8_BAR; }
    }
    PG8_WAIT_V(0);
    if constexpr (!ALIGN_EPI) { if (wr == 0) PG8_BAR; }
    PG8_BAR;
#undef PG8_SA
#undef PG8_SB
#undef PG8_STG_A
#undef PG8_STG_B
#undef PG8_LDA
#undef PG8_LDB
#undef PG8_MMA
#undef PG8_WAIT_V
#undef PG8_WAIT_L
#undef PG8_BAR
#undef PG8_SCHED
}

template <class Prob>
DI void gemm_phase_pair(LAS unsigned char* lds, const Prob& P, const int tid) {
    const int wid = __builtin_amdgcn_readfirstlane(tid >> 6), lane = tid & 63, wr = wid >> 2, wc = wid & 3, fr = lane & 15, fq = lane >> 4;
    constexpr int KP = 512, nt = 16;
    unsigned voffB[2];
#pragma unroll
    for (int i = 0; i < 2; ++i) { int R, C; stage_rc(tid * 16 + i * 8192, R, C); const int Rb = Prob::PERM ? ((R & ~31) + perm32(R & 31)) : R; voffB[i] = (unsigned)(Rb * KP + C) * 2u; }
    const size_t kstep = (size_t)(BK * 2);
    const size_t hstepB = (size_t)HALF * KP * 2;
    const unsigned ldsw = (unsigned)wid * 1024u;
    const int aoffL = lds_byte(wr * 64 + fr, fq * 8), boffL = lds_byte(wc * 32 + fr, fq * 8);
    const char* Abase = (const char*)P.A;
    LAS unsigned char* park = lds + LDS_AUX + 2048 + tid * 48;
#define PG8_SA(b, h) (((b) * 2 + (h)) * HTB)
#define PG8_SB(b, h) ((4 + (b) * 2 + (h)) * HTB)
#define PG8_STG_B(bufoff, gbase) do { _Pragma("unroll") for (int _i = 0; _i < 2; ++_i) \
        __builtin_amdgcn_global_load_lds((const unsigned*)((const char*)(gbase) + voffB[_i]), (LAS unsigned*)(lds + (bufoff) + ldsw + _i * 8192), 16, 0, 0); } while (0)
#define PG8_STG_A(bufoff, h, kbyte) do { _Pragma("unroll") for (int _i = 0; _i < 2; ++_i) \
        __builtin_amdgcn_global_load_lds((const unsigned*)(Abase + (size_t)(kbyte) + aoff[h][_i]), (LAS unsigned*)(lds + (bufoff) + ldsw + _i * 8192), 16, 0, 0); } while (0)
#define PG8_LDA(dst, b, h) do { _Pragma("unroll") for (int m = 0; m < 4; ++m) _Pragma("unroll") for (int k = 0; k < 2; ++k) dst[m][k] = *(const LAS bf16x8*)(lds + PG8_SA(b, h) + aoffL + m * 2048 + k * 1024); } while (0)
#define PG8_LDB(dst, b, h) do { _Pragma("unroll") for (int n = 0; n < 2; ++n) _Pragma("unroll") for (int k = 0; k < 2; ++k) dst[n][k] = *(const LAS bf16x8*)(lds + PG8_SB(b, h) + boffL + n * 2048 + k * 1024); } while (0)
#define PG8_MMA(ai, bj, At, Bt) do { __builtin_amdgcn_s_setprio(1); _Pragma("unroll") for (int m = 0; m < 4; ++m) _Pragma("unroll") for (int n = 0; n < 2; ++n) _Pragma("unroll") for (int k = 0; k < 2; ++k) \
        acc[ai][bj][m][n] = __builtin_amdgcn_mfma_f32_16x16x32_bf16(Bt[n][k], At[m][k], acc[ai][bj][m][n], 0, 0, 0); __builtin_amdgcn_s_setprio(0); } while (0)
#define PG8_WAIT_V(n) asm volatile("s_waitcnt vmcnt(" #n ")" ::: "memory")
#define PG8_WAIT_L(n) asm volatile("s_waitcnt lgkmcnt(" #n ")" ::: "memory")
#define PG8_BAR __builtin_amdgcn_s_barrier()
#define PG8_SCHED __builtin_amdgcn_sched_barrier(0)
#define PG8_PARK(slot, v) (*(LAS u32x4*)(park + 16 * (slot)) = (u32x4){v[0][0], v[0][1], v[1][0], v[1][1]})
#define PG8_UNPARK(slot) do { const u32x4 _q = *(const LAS u32x4*)(park + 16 * (slot)); aoff[0][0] = _q[0]; aoff[0][1] = _q[1]; aoff[1][0] = _q[2]; aoff[1][1] = _q[3]; } while (0)
    Unit cur, nxt; int ui = 0;
    if (!P.next(0, cur)) return;
    f32x4 acc[2][2][4][2];
#pragma unroll
    for (int a = 0; a < 2; ++a)
#pragma unroll
        for (int b = 0; b < 2; ++b)
#pragma unroll
            for (int m = 0; m < 4; ++m)
#pragma unroll
                for (int n = 0; n < 2; ++n) acc[a][b][m][n] = (f32x4){0.f, 0.f, 0.f, 0.f};
    bf16x8 At[4][2], B0[2][2], B1[2][2];
    unsigned aoff[2][2];
    { unsigned tb[2][2]; P.aoffs2(cur, tid, aoff, tb); PG8_PARK(0, tb); }
    const char* cBa = P.bbase_a(cur); const char* cBb = P.bbase_b(cur);
    PG8_STG_B(PG8_SB(0, 0), cBa); PG8_STG_B(PG8_SB(0, 1), cBa + hstepB); PG8_STG_A(PG8_SA(0, 0), 0, 0); PG8_STG_A(PG8_SA(0, 1), 1, 0);
    if (wr == 1) PG8_BAR;
    PG8_WAIT_V(2); PG8_BAR;
    PG8_STG_B(PG8_SB(1, 0), cBa + kstep); PG8_STG_A(PG8_SA(1, 0), 0, kstep); PG8_STG_B(PG8_SB(1, 1), cBa + hstepB + kstep);
    PG8_WAIT_V(6); PG8_BAR;
    for (;;) {
        const bool has_next = P.next(ui + 1, nxt);
        const char* nBa = cBa; const char* nBb = cBb;
        {
            unsigned ta[2][2], tb[2][2];
            if (has_next) { P.aoffs2(nxt, tid, ta, tb); nBa = P.bbase_a(nxt); nBb = P.bbase_b(nxt); } else P.aoffs2(cur, tid, ta, tb);
            PG8_PARK(2, ta); PG8_PARK((ui + 1) & 1, tb);
        }
        const bool hu = (cur.cnt - cur.pm * 256) <= 128;
        for (int t = 0; t < nt; t += 2) {
            const bool last = (t == nt - 2);
            const size_t k1 = (size_t)((t + 1) & 7) * kstep;
            const int t2 = last ? 0 : t + 2;
            const size_t k2 = (size_t)(t2 & 7) * kstep, k3 = k2 + kstep;
            const char* b2 = last ? nBa : ((t2 < 8 ? cBa : cBb) + k2); const char* b3 = b2 + kstep;
            PG8_LDB(B0, 0, 0); PG8_LDB(B1, 0, 1); PG8_SCHED; PG8_LDA(At, 0, 0); PG8_STG_A(PG8_SA(1, 1), 1, k1);
            PG8_WAIT_V(8); PG8_WAIT_L(0); PG8_BAR; PG8_MMA(0, 0, At, B0); PG8_MMA(0, 1, At, B1); PG8_BAR; PG8_SCHED;
            if (t == 6) PG8_UNPARK(ui & 1);
            if (last) PG8_UNPARK(2);
            PG8_LDA(At, 0, 1); PG8_STG_B(PG8_SB(0, 0), b2); PG8_STG_B(PG8_SB(0, 1), b2 + hstepB); PG8_STG_A(PG8_SA(0, 0), 0, k2);
            PG8_WAIT_V(8); PG8_WAIT_L(0); PG8_BAR; if (!hu) { PG8_MMA(1, 0, At, B0); PG8_MMA(1, 1, At, B1); } PG8_BAR; PG8_SCHED;
            PG8_LDB(B0, 1, 0); PG8_LDB(B1, 1, 1); PG8_SCHED; PG8_LDA(At, 1, 0); PG8_STG_A(PG8_SA(0, 1), 1, k2);
            PG8_WAIT_V(8); PG8_WAIT_L(0); PG8_BAR; PG8_MMA(0, 0, At, B0); PG8_MMA(0, 1, At, B1); PG8_BAR; PG8_SCHED;
            PG8_LDA(At, 1, 1); PG8_STG_B(PG8_SB(1, 0), b3); PG8_STG_B(PG8_SB(1, 1), b3 + hstepB); PG8_STG_A(PG8_SA(1, 0), 0, k3);
            PG8_WAIT_V(8); PG8_WAIT_L(0); PG8_BAR; if (!hu) { PG8_MMA(1, 0, At, B0); PG8_MMA(1, 1, At, B1); } PG8_BAR; PG8_SCHED;
        }
        if (wr == 0) PG8_BAR;
        P.epi(acc, cur, wr, wc, fr, fq);
        if (!has_next) break;
#pragma unroll
        for (int a = 0; a < 2; ++a)
#pragma unroll
            for (int b = 0; b < 2; ++b)
#pragma unroll
                for (int m = 0; m < 4; ++m)
#pragma unroll
                    for (int n = 0; n < 2; ++n) acc[a][b][m][n] = (f32x4){0.f, 0.f, 0.f, 0.f};
        cur = nxt; cBa = nBa; cBb = nBb; ++ui;
        if (wr == 1) PG8_BAR;
    }
    PG8_WAIT_V(0);
    PG8_BAR;
#undef PG8_SA
#undef PG8_SB
#undef PG8_STG_A
#undef PG8_STG_B
#undef PG8_LDA
#undef PG8_LDB
#undef PG8_MMA
#undef PG8_WAIT_V
#undef PG8_WAIT_L
#undef PG8_BAR
#undef PG8_SCHED
#undef PG8_PARK
#undef PG8_UNPARK
}
}
using pg8::Unit;


struct MoeTab { int ce[32], sb[32], tpg[33], cp[112], tpf[113], tph[113]; };
constexpr int LCAP = 32768;
DI int pair_lo(int p) { int i = 0; _Pragma("unroll") for (int k = 1; k < 7; ++k) if (p >= k * (15 - k) / 2) i = k; return i; }
DI int pair_hi(int p, int i) { return p - i * (15 - i) / 2 + i + 1; }

struct ProbIn {
    static constexpr bool PERM = true, GATHER = false;
    int K; const bf16_t* A; const bf16_t* Bt; int G, c;
    bf16_t* Pout; const float* ss1; float* lf; const float* bfx; unsigned* kmax;
    DI bool next(int i, Unit& u) const { return pg8::static_next(128, 12, G, c, i, u); }
    DI int arow0(const Unit& u) const { return u.pm * 256; }
    DI const char* bbase(const Unit& u) const { return (const char*)Bt + (size_t)u.pn * 256 * K * 2; }
    DI void epi(const f32x4 (&acc)[2][2][4][2], const Unit& u, int wr, int wc, int fr, int fq) const {
        float km0 = 0.f, km1 = 0.f;
        float rs[8];
        {
            f32x4 sv[8];
#pragma unroll
            for (int g = 0; g < 8; ++g) sv[g] = *(const f32x4*)(ss1 + (size_t)(u.pm * 256 + (g >> 2) * 128 + wr * 64 + (g & 3) * 16 + fr) * 16 + 4 * fq);
#pragma unroll
            for (int g = 0; g < 8; ++g) { float ss = (sv[g][0] + sv[g][1]) + (sv[g][2] + sv[g][3]); ss += __shfl_xor(ss, 16); ss += __shfl_xor(ss, 32);
                rs[g] = __builtin_amdgcn_rsqf(ss * (1.f / 1024.f) + 1e-6f); }
        }
#pragma unroll
        for (int ai = 0; ai < 2; ++ai)
#pragma unroll
            for (int m = 0; m < 4; ++m) {
                const int row = u.pm * 256 + ai * 128 + wr * 64 + m * 16 + fr;
                const float rstd = rs[ai * 4 + m];
                {
                    bf16_t* rowp = Pout + (size_t)row * PP + u.pn * 256 + wc * 32 + 8 * fq;
#pragma unroll
                    for (int bj = 0; bj < 2; ++bj) { const f32x4 v0 = acc[ai][bj][m][0] * rstd, v1 = acc[ai][bj][m][1] * rstd;
                        u32x4 w; w.x = pk2(v0[0], v0[1]); w.y = pk2(v0[2], v0[3]); w.z = pk2(v1[0], v1[1]); w.w = pk2(v1[2], v1[3]);
                        *(u32x4*)(rowp + bj * 128) = w; }
                    if (u.pn == 10) {
#pragma unroll
                        for (int bj = 0; bj < 2; ++bj) { const f32x4 v0 = acc[ai][bj][m][0] * rstd, v1 = acc[ai][bj][m][1] * rstd;
                            float p = ((v0[0] * v0[0] + v0[1] * v0[1]) + (v0[2] * v0[2] + v0[3] * v0[3])) + ((v1[0] * v1[0] + v1[1] * v1[1]) + (v1[2] * v1[2] + v1[3] * v1[3]));
                            p += __shfl_xor(p, 16); p += __shfl_xor(p, 32);
                            if (bj == 0) km0 = fmaxf(km0, p); else km1 = fmaxf(km1, p); }
                    }
                }
            }
        if (u.pn == 10) {
#pragma unroll
            for (int o = 1; o < 16; o <<= 1) { km0 = fmaxf(km0, __shfl_xor(km0, o)); km1 = fmaxf(km1, __shfl_xor(km1, o)); }
            if (fr == 0 && fq == 0) { const int b = (u.pm * 256) >> 11;
                __hip_atomic_fetch_max(kmax + ((b * 4 + 0 + (wc >> 1)) * 2 + (wc & 1)), __float_as_uint(km0), __ATOMIC_RELAXED, __HIP_MEMORY_SCOPE_AGENT);
                __hip_atomic_fetch_max(kmax + ((b * 4 + 2 + (wc >> 1)) * 2 + (wc & 1)), __float_as_uint(km1), __ATOMIC_RELAXED, __HIP_MEMORY_SCOPE_AGENT); }
        }
    }
};

struct ProbOut {
    static constexpr bool PERM = false, GATHER = false;
    int K; const bf16_t* A; const bf16_t* Bt; int G, c;
    const float* base; float* out; float ascale;
    DI bool next(int i, Unit& u) const { return pg8::static_next(128, 4, G, c, i, u); }
    DI int arow0(const Unit& u) const { return u.pm * 256; }
    DI const char* bbase(const Unit& u) const { return (const char*)Bt + (size_t)u.pn * 256 * K * 2; }
    DI void epi(const f32x4 (&acc)[2][2][4][2], const Unit& u, int wr, int wc, int fr, int fq) const {
#pragma unroll
        for (int ai = 0; ai < 2; ++ai) {
            f32x4 bv[4][2][2]; size_t offs[4];
#pragma unroll
            for (int m = 0; m < 4; ++m) { offs[m] = (size_t)(u.pm * 256 + ai * 128 + wr * 64 + m * 16 + fr) * D + u.pn * 256 + wc * 32 + 4 * fq;
#pragma unroll
                for (int bj = 0; bj < 2; ++bj)
#pragma unroll
                    for (int n = 0; n < 2; ++n) bv[m][bj][n] = *(const f32x4*)(base + offs[m] + bj * 128 + n * 16); }
#pragma unroll
            for (int m = 0; m < 4; ++m)
#pragma unroll
                for (int bj = 0; bj < 2; ++bj)
#pragma unroll
                    for (int n = 0; n < 2; ++n) *(f32x4*)(out + offs[m] + bj * 128 + n * 16) = bv[m][bj][n] + acc[ai][bj][m][n] * ascale;
            asm volatile("" ::: "memory");
        }
    }
};

DI int moe_L(int i, int G, int c) {
    if ((G & 31) != 0) return i * G + c;
    const int x = c & 7, j = c >> 3, per = G >> 5;
    return ((i * (G >> 2) + x * per + (j >> 2)) << 2) + (j & 3);
}
template <int NL> DI bool moe_unit(const LAS int* tp, int L, Unit& u) {
    const int tt = L >> 2; if (tt >= tp[NL]) return false;
    int e = 0;
#pragma unroll 1
    while (tp[e + 1] <= tt) ++e;
    u.e = e; u.pm = tt - tp[e]; u.pn = L & 3; return true;
}

struct ProbGU {
    static constexpr bool PERM = true, GATHER = true;
    int K; const bf16_t* A; const bf16_t* Bt; int G, c;
    const LAS MoeTab* T; const int* elist; const f32x2* egate; bf16_t* HB;
    DI bool next(int i, Unit& u) const {
        if (!moe_unit<32>(T->tpg, moe_L(i, G, c), u)) return false;
        u.cnt = T->ce[u.e]; u.base = T->sb[u.e]; return true;
    }
    DI int tok_of(const Unit& u, int r) const { return (r < u.cnt) ? elist[(size_t)u.e * LCAP + r] : 0; }
    DI void aoffs(const Unit& u, int tid, unsigned (&o)[2][2]) const {
        int Rr[2], Cc[2]; pg8::stage_rc(tid * 16, Rr[0], Cc[0]); pg8::stage_rc(tid * 16 + 8192, Rr[1], Cc[1]);
#pragma unroll
        for (int h = 0; h < 2; ++h)
#pragma unroll
            for (int i = 0; i < 2; ++i) { const int tok = tok_of(u, u.pm * 256 + h * 128 + Rr[i]); o[h][i] = (unsigned)((tok * K + Cc[i]) * 2); }
    }
    DI const char* bbase(const Unit& u) const { return (const char*)Bt + ((size_t)u.e * 1024 + u.pn * 256) * K * 2; }
    DI void epi(const f32x4 (&acc)[2][2][4][2], const Unit& u, int wr, int wc, int fr, int fq) const {
        float rsv[8], gv[8];
#pragma unroll
        for (int g = 0; g < 8; ++g) { const int r = u.pm * 256 + (g >> 2) * 128 + wr * 64 + (g & 3) * 16 + fr; f32x2 gr = {0.f, 0.f}; if (r < u.cnt) gr = egate[(size_t)u.e * LCAP + r]; gv[g] = gr[0]; rsv[g] = gr[1]; }
#pragma unroll
        for (int ai = 0; ai < 2; ++ai)
#pragma unroll
            for (int m = 0; m < 4; ++m) {
                const int r = u.pm * 256 + ai * 128 + wr * 64 + m * 16 + fr;
                if (r < u.cnt) {
                    const float rs = rsv[ai * 4 + m], gt = gv[ai * 4 + m];
                    float hv[8];
#pragma unroll
                    for (int n = 0; n < 2; ++n)
#pragma unroll
                        for (int j = 0; j < 4; ++j) { const float g = acc[ai][0][m][n][j] * rs, uu = acc[ai][1][m][n][j] * rs; hv[n * 4 + j] = g * sigmoidf_(g) * uu * gt; }
                    u32x4 w; w.x = pk2(hv[0], hv[1]); w.y = pk2(hv[2], hv[3]); w.z = pk2(hv[4], hv[5]); w.w = pk2(hv[6], hv[7]);
                    *(u32x4*)(HB + (size_t)(u.base + r) * EH + u.pn * 128 + wc * 32 + 8 * fq) = w;
                }
            }
    }
};

struct ProbDP {
    static constexpr bool PERM = false;
    const bf16_t* A; const bf16_t* Bt; int G, c;
    const LAS MoeTab* T; const u32x2* plist; float* x; bf16_t* xb; float* ss1;
    DI bool next(int i, Unit& u) const {
        const int L = moe_L(i, G, c), tt = L >> 2, nf = T->tpf[112];
        if (tt < nf) { if (!moe_unit<112>(T->tpf, L, u)) return false; }
        else { if (!moe_unit<112>(T->tph, L - 4 * nf, u)) return false; u.pm = (T->cp[u.e] - 1) >> 8; }
        u.cnt = T->cp[u.e]; const int g = u.e / 28, p = u.e - g * 28, lo = pair_lo(p); u.base = g * 8 + lo; u.aux = g * 8 + pair_hi(p, lo); return true;
    }
    DI void aoffs2(const Unit& u, int tid, unsigned (&oa)[2][2], unsigned (&ob)[2][2]) const {
        int Rr[2], Cc[2]; pg8::stage_rc(tid * 16, Rr[0], Cc[0]); pg8::stage_rc(tid * 16 + 8192, Rr[1], Cc[1]);
        const int sba = T->sb[u.base], sbb = T->sb[u.aux];
#pragma unroll
        for (int h = 0; h < 2; ++h)
#pragma unroll
            for (int i = 0; i < 2; ++i) { const int r = u.pm * 256 + h * 128 + Rr[i]; unsigned pos = 0u; if (r < u.cnt) pos = plist[(size_t)u.e * LCAP + r].y;
                const int ra = (r < u.cnt) ? sba + (int)(pos & 0xffffu) : 0, rb = (r < u.cnt) ? sbb + (int)(pos >> 16) : 0;
                oa[h][i] = (unsigned)((ra * EH + Cc[i]) * 2); ob[h][i] = (unsigned)((rb * EH + Cc[i]) * 2); }
    }
    DI const char* bbase_a(const Unit& u) const { return (const char*)Bt + ((size_t)u.base * 1024 + u.pn * 256) * EH * 2; }
    DI const char* bbase_b(const Unit& u) const { return (const char*)Bt + ((size_t)u.aux * 1024 + u.pn * 256) * EH * 2; }
    DI void epi(const f32x4 (&acc)[2][2][4][2], const Unit& u, int wr, int wc, int fr, int fq) const {
        int tk[8];
#pragma unroll
        for (int g = 0; g < 8; ++g) { const int r = u.pm * 256 + (g >> 2) * 128 + wr * 64 + (g & 3) * 16 + fr; tk[g] = (r < u.cnt) ? (int)plist[(size_t)u.e * LCAP + r].x : 0; }
#pragma unroll
        for (int ai = 0; ai < 2; ++ai) {
            f32x4 xv[4][2][2];
#pragma unroll
            for (int m = 0; m < 4; ++m) { const size_t off = (size_t)tk[ai * 4 + m] * D + u.pn * 256 + wc * 32 + 4 * fq;
#pragma unroll
                for (int bj = 0; bj < 2; ++bj)
#pragma unroll
                    for (int n = 0; n < 2; ++n) xv[m][bj][n] = *(const f32x4*)(x + off + bj * 128 + n * 16); }
#pragma unroll
            for (int m = 0; m < 4; ++m) {
                const int r = u.pm * 256 + ai * 128 + wr * 64 + m * 16 + fr; const bool val = r < u.cnt;
                const size_t off = (size_t)tk[ai * 4 + m] * D + u.pn * 256 + wc * 32 + 4 * fq;
                float ssp = 0.f;
#pragma unroll
                for (int bj = 0; bj < 2; ++bj)
#pragma unroll
                    for (int n = 0; n < 2; ++n) { const size_t o = off + bj * 128 + n * 16; const f32x4 v = xv[m][bj][n] + acc[ai][bj][m][n];
                        if (val) { *(f32x4*)(x + o) = v; u32x2 w; w.x = pk2(v[0], v[1]); w.y = pk2(v[2], v[3]); *(u32x2*)(xb + o) = w; }
                        ssp += (v[0] * v[0] + v[1] * v[1]) + (v[2] * v[2] + v[3] * v[3]); }
                ssp += __shfl_xor(ssp, 16); ssp += __shfl_xor(ssp, 32);
                if (val && fq == 0) ss1[(size_t)tk[ai * 4 + m] * 16 + u.pn * 4 + wc] = ssp;
            }
            asm volatile("" ::: "memory");
        }
    }
};


DI void p0_transpose64(const float* W, int K, int N, int ldn, const float* gs, bf16_t* WT, int mode, LAS unsigned* T, int kb, int nb, int lane) {
    const int k0 = 64 * kb, n0 = 64 * nb, nq = lane & 15, kr = lane >> 4;
    const bool nv = (n0 + 4 * nq) < N;
    f32x4 a[8], b[8];
#pragma unroll
    for (int i = 0; i < 8; ++i) { const int k = k0 + 8 * i + 2 * kr;
        a[i] = nv ? *(const f32x4*)(W + (size_t)k * ldn + n0 + 4 * nq) : (f32x4){0.f, 0.f, 0.f, 0.f};
        b[i] = nv ? *(const f32x4*)(W + (size_t)(k + 1) * ldn + n0 + 4 * nq) : (f32x4){0.f, 0.f, 0.f, 0.f}; }
#pragma unroll
    for (int i = 0; i < 8; ++i) { const int k = k0 + 8 * i + 2 * kr; float g0 = 1.f, g1 = 1.f; if (gs) { g0 = gs[k]; g1 = gs[k + 1]; }
#pragma unroll
        for (int jj = 0; jj < 4; ++jj) T[(4 * nq + jj) * 36 + 4 * i + kr] = pk2(a[i][jj] * g0, b[i][jj] * g1); }
    asm volatile("s_waitcnt lgkmcnt(0)" ::: "memory");
    const int c = lane & 7;
#pragma unroll
    for (int p = 0; p < 8; ++p) { const int nl = 8 * p + (lane >> 3), n = n0 + nl;
        const u32x4 o = *(const LAS u32x4*)(T + nl * 36 + 4 * c);
        const int drow = (mode == 0) ? n : (((n >> 7) << 8) + (n & 127) + (mode == 2 ? 128 : 0));
        *(u32x4*)(WT + (size_t)drow * K + k0 + 8 * c) = o; }
    asm volatile("s_waitcnt lgkmcnt(0)" ::: "memory");
}
DI void p0_prologue(Frame& F) {
    LAS unsigned* scr = (LAS unsigned*)(F.lds + F.wave * 16384);
    const int gw = F.bid * 8 + F.wave, NGW = F.G * 8;
    constexpr int I_IN = 16 * 52, I_OUT = 16 * 16, I_GU = 16 * 8, I_DN = 8 * 16;
    constexpr int S0 = DEPTH * I_IN, S1 = S0 + DEPTH * I_OUT, S2 = S1 + DEPTH * NE * I_GU, S3 = S2 + DEPTH * NE * I_GU, S4 = S3 + DEPTH * NE * I_DN;
    for (int it = gw; it < S4; it += NGW) {
        if (it < S0) { const int l = it / I_IN, r = it % I_IN;
            p0_transpose64(F.in[2] + (size_t)l * D * 3076, D, 3076, 3076, F.in[1] + l * D, WSP(bf16_t, WS_BIN) + (size_t)l * NIN * D, 0, scr, r / 52, r % 52, F.lane);
        } else if (it < S1) { const int q = it - S0, l = q / I_OUT, r = q % I_OUT;
            p0_transpose64(F.in[17] + (size_t)l * D * D, D, D, D, nullptr, WSP(bf16_t, WS_BOUT) + (size_t)l * D * D, 0, scr, r / 16, r % 16, F.lane);
        } else if (it < S3) { const int up = it >= S2, q = it - (up ? S2 : S1), le = q / I_GU, r = q % I_GU;
            p0_transpose64(F.in[up ? 24 : 23] + (size_t)le * D * EH, D, EH, EH, F.in[18] + (le / NE) * D, WSP(bf16_t, WS_BGU) + (size_t)le * 1024 * D, up ? 2 : 1, scr, r / 8, r % 8, F.lane);
        } else { const int q = it - S3, le = q / I_DN, r = q % I_DN;
            p0_transpose64(F.in[25] + (size_t)le * EH * D, EH, D, D, nullptr, WSP(bf16_t, WS_BDN) + (size_t)le * D * EH, 0, scr, r / 16, r % 16, F.lane);
        }
    }
    const int gt = F.bid * 512 + F.tid, NGT = F.G * 512;
    for (int i = gt; i < DEPTH * 256 * 256; i += NGT) { const int l = i >> 16, c = (i >> 8) & 255, k = i & 255;
        const float v = k < 64 ? F.in[7][((size_t)l * 64 + k) * 256 + c] : (k < 128 ? F.in[9][((size_t)l * 64 + (k - 64)) * 256 + c] : F.in[10][((size_t)l * 128 + (k - 128)) * 256 + c]);
        WSP(bf16_t, WS_WCAT)[i] = (bf16_t)f2bf(v); }
    for (int i = gt; i < DEPTH * 4 * 128 * 128; i += NGT) { const int t = (i >> 7) & 127, p = i & 15, hh = p >> 3, j = p & 7, s = (i & 112) + (j < 4 ? 4 * hh + j : 8 + 4 * hh + (j - 4));
        WSP(bf16_t, WS_GMW)[i] = (bf16_t)f2bf(s <= t ? F.in[3][(i & ~127) + s] : 0.f); }
    for (int i = gt; i < DEPTH * 36 * 1024; i += NGT) { const int l = i / (36 * 1024), j = (i / 1024) % 36, k = i & 1023;
        const float g = F.in[18][l * D + k];
        const float w = j < 4 ? F.in[19][((size_t)l * D + k) * 4 + j] : F.in[21][((size_t)l * D + k) * 32 + (j - 4)];
        WSP(float, WS_RTW)[i] = g * w; }
    for (int m0 = gw * 4; m0 < NT; m0 += NGW * 4) {
        f32x4 v[4][4];
#pragma unroll
        for (int r = 0; r < 4; ++r) { const f32x4* xr = (const f32x4*)(F.in[0] + (size_t)(m0 + r) * D) + F.lane;
#pragma unroll
            for (int j = 0; j < 4; ++j) v[r][j] = xr[64 * j]; }
#pragma unroll
        for (int r = 0; r < 4; ++r) { float s = 0.f; u32x2* o8 = (u32x2*)(WSP(bf16_t, WS_XB) + (size_t)(m0 + r) * D) + F.lane;
#pragma unroll
            for (int j = 0; j < 4; ++j) { const f32x4 q = v[r][j]; s += (q[0] * q[0] + q[1] * q[1]) + (q[2] * q[2] + q[3] * q[3]); u32x2 w; w.x = pk2(q[0], q[1]); w.y = pk2(q[2], q[3]); o8[64 * j] = w; }
            s = wave_sum(s);
            if (F.lane < 16) WSP(float, WS_SS1)[(size_t)(m0 + r) * 16 + F.lane] = (F.lane == 0) ? s : 0.f; }
    }
}

constexpr int AT_KOFF = 0, AT_VOFF = 18432, AT_CUM = 36864, AT_MISC = 45056, AT_ROWB = 144, AT_BUFB = 64 * 144;
DI void at_load_tile(const bf16_t* Pb, int colK, int colV, int jt, int tid, u32x4& kreg, u32x4& vreg) {
    const int row = tid >> 3, ch = tid & 7; const bf16_t* p = Pb + (size_t)(64 * jt + row) * PP + ch * 8;
    kreg = *(const u32x4*)(p + colK); vreg = *(const u32x4*)(p + colV);
}
DI void at_store_tile(LAS unsigned char* lds, int buf, int tid, const u32x4& kreg, const u32x4& vreg) {
    const int row = tid >> 3, ch = tid & 7;
    *(LAS u32x4*)(lds + AT_KOFF + buf * AT_BUFB + row * AT_ROWB + ch * 16) = kreg;
    *(LAS u32x4*)(lds + AT_VOFF + buf * AT_BUFB + row * AT_ROWB + ch * 16) = vreg;
}
DI void at_qk(const LAS unsigned char* kb, const bf16x8 (&qf)[4], int r32, int h2, f32x16& s0, f32x16& s1) {
    const LAS unsigned char* p = kb + r32 * AT_ROWB + h2 * 16;
#pragma unroll
    for (int d0 = 0; d0 < 4; ++d0) {
        const bf16x8 a0 = *(const LAS bf16x8*)(p + d0 * 32), a1 = *(const LAS bf16x8*)(p + 32 * AT_ROWB + d0 * 32);
        s0 = MFMA32(a0, qf[d0], s0); s1 = MFMA32(a1, qf[d0], s1);
    }
}
DI bf16x8 pack8(const f32x16& x, int s) {
    u32x4 p; p.x = pk2(x[8 * s], x[8 * s + 1]); p.y = pk2(x[8 * s + 2], x[8 * s + 3]); p.z = pk2(x[8 * s + 4], x[8 * s + 5]); p.w = pk2(x[8 * s + 6], x[8 * s + 7]);
    return __builtin_bit_cast(bf16x8, p);
}
DI s16x4 tr_read(const LAS unsigned char* p) { return __builtin_bit_cast(s16x4, __builtin_amdgcn_ds_read_tr16_b64_v4i16((LAS s16x4*)p)); }
DI void at_pv(const LAS unsigned char* vb, const bf16x8 (&pb)[4], int lane, f32x16& o0, f32x16& o1) {
    const int h2 = lane >> 5;
    const LAS unsigned char* base = vb + (4 * h2 + ((lane & 15) >> 2)) * AT_ROWB + (16 * ((lane >> 4) & 1) + 4 * (lane & 3)) * 2;
#pragma unroll
    for (int s = 0; s < 4; ++s) {
        const LAS unsigned char* p = base + 16 * s * AT_ROWB;
        const s16x4 l0 = tr_read(p), h0 = tr_read(p + 8 * AT_ROWB), l1 = tr_read(p + 64), h1 = tr_read(p + 8 * AT_ROWB + 64);
        const bf16x8 a0 = __builtin_shufflevector(l0, h0, 0, 1, 2, 3, 4, 5, 6, 7), a1 = __builtin_shufflevector(l1, h1, 0, 1, 2, 3, 4, 5, 6, 7);
        o0 = MFMA32(a0, pb[s], o0); o1 = MFMA32(a1, pb[s], o1);
    }
}
DI void at_store_out(bf16_t* dst  , const f32x16& o0, const f32x16& o1, float scale, int h2) {
#pragma unroll
    for (int g = 0; g < 4; ++g) {
        u32x2 w0, w1; w0.x = pk2(o0[4 * g] * scale, o0[4 * g + 1] * scale); w0.y = pk2(o0[4 * g + 2] * scale, o0[4 * g + 3] * scale);
        w1.x = pk2(o1[4 * g] * scale, o1[4 * g + 1] * scale); w1.y = pk2(o1[4 * g + 2] * scale, o1[4 * g + 3] * scale);
        *(u32x2*)(dst + 8 * g + 4 * h2) = w0; *(u32x2*)(dst + 32 + 8 * g + 4 * h2) = w1;
    }
}
DI void block_cumsum(const float* src, int n, LAS float* cum, LAS float* wtot, int tid, int lane, int wave) {
    f32x4 v = (f32x4){0.f, 0.f, 0.f, 0.f};
    if (4 * tid < n) v = *(const f32x4*)(src + 4 * tid);
    v[1] += v[0]; v[2] += v[1]; v[3] += v[2];
    float t = v[3];
#pragma unroll
    for (int o = 1; o < 64; o <<= 1) { const float u = __shfl_up(t, o); if (lane >= o) t += u; }
    if (lane == 63) wtot[wave] = t;
    __syncthreads();
    float pre = t - v[3];
    for (int w = 0; w < wave; ++w) pre += wtot[w];
    if (4 * tid < n) { v[0] += pre; v[1] += pre; v[2] += pre; v[3] += pre; *(LAS f32x4*)(cum + 4 * tid) = v; }
    __syncthreads();
}

DI void fx_unit(Frame& F, int layer, int b, int h, int qb) {
    LAS unsigned char* L = F.lds; const int tid = F.tid, lane = F.lane, wid = F.wave, r32 = lane & 31, h2 = lane >> 5;
    const bf16_t* Pb = WSP(bf16_t, WS_P) + (size_t)b * SEQ * PP;
    LAS float* cum = (LAS float*)(L + AT_CUM);
    const int kend = 256 * qb + 256;
    __syncthreads();
    block_cumsum(WSP(float, WS_LF) + (size_t)(b * 4 + h) * SEQ, kend, cum, (LAS float*)(L + AT_MISC), tid, lane, wid);
    const int tw0 = 256 * qb + 32 * wid, tq = tw0 + r32;
    bf16x8 qf[4];
#pragma unroll
    for (int d0 = 0; d0 < 4; ++d0) qf[d0] = *(const bf16x8*)(Pb + (size_t)tq * PP + C_FXQ + h * 64 + 16 * d0 + 8 * h2);
    const float ct2 = cum[tq] * LOG2E;
    float qb2;
    { float qn = 0.f;
#pragma unroll
      for (int d0 = 0; d0 < 4; ++d0) { const u32x4 qq = __builtin_bit_cast(u32x4, qf[d0]);
#pragma unroll
        for (int j = 0; j < 4; ++j) { const float a = bf2f(qq[j] & 0xffffu), c = bf2f(qq[j] >> 16); qn += a * a + c * c; } }
      qn += swap32(qn);
      const unsigned* km = (const unsigned*)(F.ws + WS_CTL) + CW_KMAX + layer * 128 + (b * 4 + h) * 2;
      const float kk2 = __uint_as_float(xb_ld((unsigned*)km)) + __uint_as_float(xb_ld((unsigned*)km + 1));
      qb2 = sqrtf(qn * kk2) * QSCALE2 * 1.01f + 1e-3f; }
    float mrun = -1e30f, lrun = 0.f; f32x16 o0 = {}, o1 = {};
    const int jtop = 4 * qb + 3;
    u32x4 kreg, vreg;
    at_load_tile(Pb, C_FXK + h * 64, C_FXV + h * 64, jtop, tid, kreg, vreg);
    at_store_tile(L, 0, tid, kreg, vreg);
    __syncthreads();
    int buf = 0; bool wskip = false;
    for (int jt = jtop; jt >= 0; --jt) {
        if (jt > 0) at_load_tile(Pb, C_FXK + h * 64, C_FXV + h * 64, jt - 1, tid, kreg, vreg);
        if (64 * jt <= tw0 + 31 && !wskip) {
            f32x16 s0 = {}, s1 = {};
            at_qk(L + AT_KOFF + buf * AT_BUFB, qf, r32, h2, s0, s1);
            const bool needmask = (64 * jt + 63 > tw0);
            float mx = -1e30f;
#pragma unroll
            for (int g = 0; g < 4; ++g) {
                const f32x4 c0 = *(const LAS f32x4*)(cum + 64 * jt + 8 * g + 4 * h2), c1 = *(const LAS f32x4*)(cum + 64 * jt + 32 + 8 * g + 4 * h2);
#pragma unroll
                for (int j = 0; j < 4; ++j) {
                    const int r = 4 * g + j, kv = 64 * jt + 8 * g + 4 * h2 + j;
                    float v0 = s0[r] * QSCALE2 + (ct2 - c0[j] * LOG2E), v1 = s1[r] * QSCALE2 + (ct2 - c1[j] * LOG2E);
                    if (needmask) { if (kv > tq) v0 = -1e30f; if (kv + 32 > tq) v1 = -1e30f; }
                    s0[r] = v0; s1[r] = v1; mx = fmaxf(mx, fmaxf(v0, v1));
                }
            }
            mx = fmaxf(mx, swap32(mx));
            const float mnew = fmaxf(mrun, mx), alpha = ex2(mrun - mnew);
            mrun = mnew;
            float ps = 0.f;
#pragma unroll
            for (int r = 0; r < 16; ++r) { s0[r] = ex2(s0[r] - mnew); s1[r] = ex2(s1[r] - mnew); ps += s0[r] + s1[r]; }
            lrun = lrun * alpha + ps;
#pragma unroll
            for (int r = 0; r < 16; ++r) { o0[r] *= alpha; o1[r] *= alpha; }
            bf16x8 pb[4]; pb[0] = pack8(s0, 0); pb[1] = pack8(s0, 1); pb[2] = pack8(s1, 0); pb[3] = pack8(s1, 1);
            at_pv(L + AT_VOFF + buf * AT_BUFB, pb, lane, o0, o1);
        }
        if (jt > 0) at_store_tile(L, buf ^ 1, tid, kreg, vreg);
        { int wdone = 0; if (jt > 0) wdone = __all(qb2 + (ct2 - cum[64 * jt - 1] * LOG2E) - mrun < -150.f) ? 1 : 0; wskip = wdone != 0; if (lane == 0) *(LAS int*)(L + AT_MISC + 64 + 32 * (jt & 1) + 4 * wid) = wdone; }
        __syncthreads();
        buf ^= 1;
        { const LAS int* fl = (const LAS int*)(L + AT_MISC + 64 + 32 * (jt & 1)); const int alld = fl[0] & fl[1] & fl[2] & fl[3] & fl[4] & fl[5] & fl[6] & fl[7]; if (alld) break; }
    }
    const float ltot = lrun + swap32(lrun);
    at_store_out(WSP(bf16_t, WS_MIX) + (size_t)(b * SEQ + tq) * D + 768 + h * 64, o0, o1, rcpf_(ltot), h2);
}

DI void sb_unit(Frame& F, int b, int h, int qb) {
    LAS unsigned char* L = F.lds; const int tid = F.tid, lane = F.lane, wid = F.wave, r32 = lane & 31, h2 = lane >> 5;
    const bf16_t* Pb = WSP(bf16_t, WS_P) + (size_t)b * SEQ * PP;
    const int tw0 = 256 * qb + 32 * wid, tq = tw0 + r32;
    bf16x8 qf[4];
#pragma unroll
    for (int d0 = 0; d0 < 4; ++d0) qf[d0] = *(const bf16x8*)(Pb + (size_t)tq * PP + C_SBQ + h * 64 + 16 * d0 + 8 * h2);
    bf16x8 uf[2], onesf;
#pragma unroll
    for (int s = 0; s < 2; ++s)
#pragma unroll
        for (int j = 0; j < 8; ++j) uf[s][j] = ((16 * s + 8 * (j >> 2) + 4 * h2 + (j & 3)) > r32) ? (short)0x3F80 : (short)0;
#pragma unroll
    for (int j = 0; j < 8; ++j) onesf[j] = (short)0x3F80;
    float R2 = 0.f; f32x16 o0 = {}, o1 = {};
    const int jtop = 4 * qb + 3;
    u32x4 kreg, vreg;
    __syncthreads();
    at_load_tile(Pb, C_SBK + h * 64, C_SBV + h * 64, jtop, tid, kreg, vreg);
    at_store_tile(L, 0, tid, kreg, vreg);
    __syncthreads();
    int buf = 0; bool wskip = false;
    for (int jt = jtop; jt >= 0; --jt) {
        if (jt > 0) at_load_tile(Pb, C_SBK + h * 64, C_SBV + h * 64, jt - 1, tid, kreg, vreg);
        if (64 * jt <= tw0 + 31 && !wskip) {
            f32x16 s0 = {}, s1 = {};
            at_qk(L + AT_KOFF + buf * AT_BUFB, qf, r32, h2, s0, s1);
            const bool needmask = (64 * jt + 63 >= tw0);
            f32x16 l0, l1;
            float cs = 0.f;
#pragma unroll
            for (int r = 0; r < 16; ++r) {
                const int kv = 64 * jt + crow(r, h2);
                const float z0 = s0[r] * QSCALE2, z1 = s1[r] * QSCALE2;
                const float sp0 = fmaxf(z0, 0.f) + lg2(1.f + ex2(-fabsf(z0))), sp1 = fmaxf(z1, 0.f) + lg2(1.f + ex2(-fabsf(z1)));
                float a0 = -sp0, a1 = -sp1, b0 = z0 - sp0, b1 = z1 - sp1;
                if (needmask) { if (kv >= tq) { a0 = 0.f; b0 = -1e30f; } if (kv + 32 >= tq) { a1 = 0.f; b1 = -1e30f; } }
                l0[r] = a0; l1[r] = a1; s0[r] = b0; s1[r] = b1; cs += a0 + a1;
            }
            f32x16 t0 = {}, t1 = {};
#pragma unroll
            for (int s = 0; s < 2; ++s) {
                const bf16x8 h0 = pack8(l0, s), h1 = pack8(l1, s);
                f32x16 d0_, d1_;
#pragma unroll
                for (int j = 0; j < 8; ++j) { d0_[j] = l0[8 * s + j] - bf2f((unsigned short)h0[j]); d1_[j] = l1[8 * s + j] - bf2f((unsigned short)h1[j]); }
                u32x4 q0, q1; q0.x = pk2(d0_[0], d0_[1]); q0.y = pk2(d0_[2], d0_[3]); q0.z = pk2(d0_[4], d0_[5]); q0.w = pk2(d0_[6], d0_[7]);
                q1.x = pk2(d1_[0], d1_[1]); q1.y = pk2(d1_[2], d1_[3]); q1.z = pk2(d1_[4], d1_[5]); q1.w = pk2(d1_[6], d1_[7]);
                const bf16x8 e0 = __builtin_bit_cast(bf16x8, q0), e1 = __builtin_bit_cast(bf16x8, q1);
                t0 = MFMA32(uf[s], h0, t0); t0 = MFMA32(uf[s], e0, t0); t0 = MFMA32(onesf, h1, t0); t0 = MFMA32(onesf, e1, t0);
                t1 = MFMA32(uf[s], h1, t1); t1 = MFMA32(uf[s], e1, t1);
            }
#pragma unroll
            for (int r = 0; r < 16; ++r) { s0[r] = ex2(s0[r] + R2 + t0[r]); s1[r] = ex2(s1[r] + R2 + t1[r]); }
            R2 += cs + swap32(cs);
            bf16x8 pb[4]; pb[0] = pack8(s0, 0); pb[1] = pack8(s0, 1); pb[2] = pack8(s1, 0); pb[3] = pack8(s1, 1);
            at_pv(L + AT_VOFF + buf * AT_BUFB, pb, lane, o0, o1);
        }
        if (jt > 0) at_store_tile(L, buf ^ 1, tid, kreg, vreg);
        { const int wdone = __all(R2 < -150.f) ? 1 : 0; wskip = wdone != 0; if (lane == 0) *(LAS int*)(L + AT_MISC + 64 + 32 * (jt & 1) + 4 * wid) = wdone; }
        __syncthreads();
        buf ^= 1;
        { const LAS int* fl = (const LAS int*)(L + AT_MISC + 64 + 32 * (jt & 1)); const int alld = fl[0] & fl[1] & fl[2] & fl[3] & fl[4] & fl[5] & fl[6] & fl[7]; if (alld) break; }
    }
    at_store_out(WSP(bf16_t, WS_MIX) + (size_t)(b * SEQ + tq) * D + 0 + h * 64, o0, o1, 1.f, h2);
}
DI void attn_rank_to_unit(int r, int& bh, int& qb) { if (r < 256) { qb = 7 - (r >> 6); bh = r & 63; } else { const int p = r - 256; qb = p >> 6; bh = p & 63; } }

constexpr int GV_ROWB = 544, GO_ROWB = 528, GM_OUTOFF = 128 * GV_ROWB;
DI float sum8(float v) { v += dppf<0xB1, 0xf, true>(v); v += dppf<0x4E, 0xf, true>(v); v += dppf<0x141, 0xf, true>(v); return v; }
DI bf16x8 gm_trfrag(const LAS unsigned char* vn, int lane, int ks, int col0) {
    const int h2 = lane >> 5;
    const LAS unsigned char* p = vn + (16 * ks + 4 * h2 + ((lane & 15) >> 2)) * GV_ROWB + (col0 + 16 * ((lane >> 4) & 1) + 4 * (lane & 3)) * 2;
    const s16x4 lo = tr_read(p), hi = tr_read(p + 8 * GV_ROWB);
    return __builtin_shufflevector(lo, hi, 0, 1, 2, 3, 4, 5, 6, 7);
}
DI void gm_item(Frame& F, int layer, int b, int c) {
    LAS unsigned char* L = F.lds; const int tid = F.tid, lane = F.lane, wid = F.wave, r32 = lane & 31, h2 = lane >> 5;
    const int cg = tid & 31, c0 = 8 * cg, tr = tid >> 5;
    const bf16_t* Pb = WSP(bf16_t, WS_P) + (size_t)(b * SEQ + c * 128) * PP;
    __syncthreads();
#pragma unroll
    for (int hf = 0; hf < 2; ++hf) {
        u32x4 vq[4];
#pragma unroll
        for (int i = 0; i < 4; ++i) vq[i] = *(const u32x4*)(Pb + (size_t)(tr + 16 * (4 * hf + i)) * PP + C_GMV + c0);
#pragma unroll
        for (int i = 0; i < 4; ++i) {
            float ge[8];
#pragma unroll
            for (int j = 0; j < 4; ++j) { ge[2 * j] = geluf_(bf2f(vq[i][j] & 0xffffu)); ge[2 * j + 1] = geluf_(bf2f(vq[i][j] >> 16)); }
            const float mean = sum8(((ge[0] + ge[1]) + (ge[2] + ge[3])) + ((ge[4] + ge[5]) + (ge[6] + ge[7]))) * (1.f / 64.f);
            float sq = 0.f;
#pragma unroll
            for (int j = 0; j < 8; ++j) { ge[j] -= mean; sq += ge[j] * ge[j]; }
            const float rs = __builtin_amdgcn_rsqf(sum8(sq) * (1.f / 64.f) + 1e-5f);
#pragma unroll
            for (int j = 0; j < 8; ++j) ge[j] *= rs;
            *(LAS u32x4*)(L + (tr + 16 * (4 * hf + i)) * GV_ROWB + c0 * 2) = __builtin_bit_cast(u32x4, pk8f(ge));
        }
    }
    u32x4 uq[8];
#pragma unroll
    for (int i = 0; i < 8; ++i) uq[i] = *(const u32x4*)(Pb + (size_t)(tr + 16 * i) * PP + C_GMU + c0);
    __syncthreads();
    const int db = wid & 1;
#pragma unroll
    for (int g = 0; g < 4; ++g) {
        const int tb = ((wid >> 1) + g) & 3, t = 32 * tb + r32;
        const bf16_t* wrow = WSP(bf16_t, WS_GMW) + ((size_t)(layer * 4 + g) * 128 + t) * 128 + 8 * h2;
        const float bias = F.in[4][(size_t)(layer * 4 + g) * 128 + t];
        f32x16 acc = {};
#pragma unroll 1
        for (int ks = 0; ks <= 2 * tb + 1; ++ks)
            acc = MFMA32(gm_trfrag(L, lane, ks, 64 * g + 32 * db), *(const bf16x8*)(wrow + 16 * ks), acc);
#pragma unroll
        for (int q = 0; q < 4; ++q)
            *(LAS u32x2*)(L + GM_OUTOFF + t * GO_ROWB + (64 * g + 32 * db + 8 * q + 4 * h2) * 2) = (u32x2){pk2(acc[4 * q] + bias, acc[4 * q + 1] + bias), pk2(acc[4 * q + 2] + bias, acc[4 * q + 3] + bias)};
    }
    __syncthreads();
    bf16_t* mo = WSP(bf16_t, WS_MIX) + (size_t)(b * SEQ + c * 128) * D + 256 + c0;
#pragma unroll
    for (int i = 0; i < 8; ++i) {
        const u32x4 mq = *(const LAS u32x4*)(L + GM_OUTOFF + (tr + 16 * i) * GO_ROWB + c0 * 2);
        float o[8];
#pragma unroll
        for (int j = 0; j < 4; ++j) { o[2 * j] = geluf_(bf2f(uq[i][j] & 0xffffu)) * bf2f(mq[j] & 0xffffu); o[2 * j + 1] = geluf_(bf2f(uq[i][j] >> 16)) * bf2f(mq[j] >> 16); }
        *(u32x4*)(mo + (size_t)(tr + 16 * i) * D) = __builtin_bit_cast(u32x4, pk8f(o));
    }
}

DI void rw_load_shift8(const bf16_t* Pt, bool hasprev, int col, const float* mu, float (&o)[8]) {
    const u32x4 cu = *(const u32x4*)(Pt + col); u32x4 pr = (u32x4){0u, 0u, 0u, 0u}; if (hasprev) pr = *(const u32x4*)(Pt - PP + col);
    const f32x4 m0 = *(const f32x4*)(mu), m1 = *(const f32x4*)(mu + 4);
    const float mm[8] = {m0[0], m0[1], m0[2], m0[3], m1[0], m1[1], m1[2], m1[3]};
#pragma unroll
    for (int j = 0; j < 4; ++j) { const float c0 = bf2f(cu[j] & 0xffffu), c1 = bf2f(cu[j] >> 16), p0 = bf2f(pr[j] & 0xffffu), p1 = bf2f(pr[j] >> 16);
        o[2 * j] = c0 + (p0 - c0) * mm[2 * j]; o[2 * j + 1] = c1 + (p1 - c1) * mm[2 * j + 1]; }
}
DI void rw_load_shift4(const bf16_t* Pt, bool hasprev, int col, const float* mu, float (&o)[4]) {
    const u32x2 cu = *(const u32x2*)(Pt + col); u32x2 pr = (u32x2){0u, 0u}; if (hasprev) pr = *(const u32x2*)(Pt - PP + col);
    const f32x4 m0 = *(const f32x4*)(mu);
#pragma unroll
    for (int j = 0; j < 2; ++j) { const float c0 = bf2f(cu[j] & 0xffffu), c1 = bf2f(cu[j] >> 16), p0 = bf2f(pr[j] & 0xffffu), p1 = bf2f(pr[j] >> 16);
        o[2 * j] = c0 + (p0 - c0) * m0[2 * j]; o[2 * j + 1] = c1 + (p1 - c1) * m0[2 * j + 1]; }
}
DI bf16x8 rw_act_frag(const bf16_t* Pt, bool hasprev, const float* mu, int ks, int h2, int mode) {
    float v[8]; rw_load_shift8(Pt, hasprev, C_RWX + 16 * ks + 8 * h2, mu + 768 + 16 * ks + 8 * h2, v);
    if (mode == 1) {
#pragma unroll
        for (int j = 0; j < 8; ++j) v[j] = tanhf_(v[j]);
    } else if (mode == 2) {
#pragma unroll
        for (int j = 0; j < 8; ++j) v[j] = sigmoidf_(v[j]);
    }
    u32x4 pb; pb.x = pk2(v[0], v[1]); pb.y = pk2(v[2], v[3]); pb.z = pk2(v[4], v[5]); pb.w = pk2(v[6], v[7]);
    return __builtin_bit_cast(bf16x8, pb);
}

constexpr int RC_V = 0, RC_KB = 4608, RC_BB = 9216, RC_KT = 13824, RC_CF = 13824, RC_PC = 18432, RC_WAVE = 18688, RC_ROWB = 144;
DI float scan32(float x) {
    x += dppf<0x111, 0xf, true>(x); x += dppf<0x112, 0xf, true>(x); x += dppf<0x114, 0xf, true>(x); x += dppf<0x118, 0xf, true>(x);
    x += dppf<0x142, 0xa, false>(x);
    return x;
}
DI bf16x8 rc_trfrag(const LAS unsigned char* tile, int lane, int s, int colblk) {
    const int h2 = lane >> 5;
    const LAS unsigned char* p = tile + (16 * s + 4 * h2 + ((lane & 15) >> 2)) * RC_ROWB + (32 * colblk + 16 * ((lane >> 4) & 1) + 4 * (lane & 3)) * 2;
    const s16x4 lo = tr_read(p), hi = tr_read(p + 8 * RC_ROWB);
    return __builtin_shufflevector(lo, hi, 0, 1, 2, 3, 4, 5, 6, 7);
}
#ifdef TPROBE
#define TPB_T0 const unsigned long long tpb0 = __builtin_amdgcn_s_memrealtime()
#define TPB_ACC(slot, tidv) do { const unsigned long long tpb1 = __builtin_amdgcn_s_memrealtime(); if (F.tid == (tidv)) { volatile LAS unsigned long long* a_ = (volatile LAS unsigned long long*)(F.lds + LDS_MISC + 128) + (slot); *a_ = *a_ + (tpb1 - tpb0); } } while (0)
#else
#define TPB_T0 do { } while (0)
#define TPB_ACC(slot, tidv) do { } while (0)
#endif
constexpr int RG_ACT = 4 * RC_WAVE, RG_RKV = RG_ACT + 16384, RG_PAR = RG_RKV + 12 * 4608, RG_END = RG_PAR + 5120;
static_assert(RG_END <= LDS_MISC, "chunk-pass LDS map");
DI void rw_loader_loop(Frame& F, int layer) {
    int lwl = F.wave - 4; asm volatile("" : "+s"(lwl));
    const int lane = F.lane, r32 = lane & 31, h2 = lane >> 5, lw = lwl;
    LAS unsigned char* L = F.lds;
    const float* mu = F.in[5] + (size_t)layer * 1024;
    const int prow = lane >> 3, pc = lane & 7;
    const int amode = lw == 0 ? 1 : (lw == 1 ? 0 : 2);
    const float asc = amode == 1 ? 2.f * LOG2E : -LOG2E, aa = amode == 1 ? 1.f : 0.f, ab = amode == 1 ? -2.f : 1.f;
    f32x4 mq[4][2];
    { const int o0 = 768 + 8 * (8 * lw + pc), o1 = 64 * lw + 8 * pc;
      mq[0][0] = *(const f32x4*)(mu + o0); mq[0][1] = *(const f32x4*)(mu + o0 + 4);
#pragma unroll
      for (int a = 0; a < 3; ++a) { mq[1 + a][0] = *(const f32x4*)(mu + 256 * a + o1); mq[1 + a][1] = *(const f32x4*)(mu + 256 * a + o1 + 4); } }
    u32x4 wv[4][2];
    { const bf16_t* wp = WSP(bf16_t, WS_BIN) + (size_t)layer * NIN * D + (size_t)3072 * D + 8 * lane;
#pragma unroll
      for (int c = 0; c < 4; ++c) { wv[c][0] = *(const u32x4*)(wp + (size_t)c * D); wv[c][1] = *(const u32x4*)(wp + (size_t)c * D + 512); } }
    const float fbias = F.in[16][layer * 4 + (lane & 3)];
    const bf16_t* wcg = WSP(bf16_t, WS_WCAT) + (size_t)layer * 65536 + (size_t)(64 * lw + r32) * 256 + 8 * h2;
#define RW_SHIFT8(cu, pr, hp, m0, m1, o) do { _Pragma("unroll") for (int j_ = 0; j_ < 4; ++j_) { \
        const float c0_ = bf2f(cu[j_] & 0xffffu), c1_ = bf2f(cu[j_] >> 16), p0_ = (hp) ? bf2f(pr[j_] & 0xffffu) : 0.f, p1_ = (hp) ? bf2f(pr[j_] >> 16) : 0.f; \
        const float ma_ = j_ < 2 ? m0[2 * (j_ & 1)] : m1[2 * (j_ & 1)], mb_ = j_ < 2 ? m0[2 * (j_ & 1) + 1] : m1[2 * (j_ & 1) + 1]; \
        o[2 * j_] = c0_ + (p0_ - c0_) * ma_; o[2 * j_ + 1] = c1_ + (p1_ - c1_) * mb_; } } while (0)
#pragma unroll 1
    for (int tg = F.bid; tg < 1024; tg += F.G) {
        const int bb = tg >> 6, ch = tg & 63;
        const bf16_t* Pg = WSP(bf16_t, WS_P) + (size_t)(bb * SEQ + 32 * ch) * PP;
        const bool nop0 = (ch == 0) && (prow == 0);
        {
            u32x4 cu[4][4], pr[4][4];
            const int cols[4] = {C_RWX + 8 * (8 * lw + pc), C_RWR + 64 * lw + 8 * pc, C_RWK + 64 * lw + 8 * pc, C_RWV + 64 * lw + 8 * pc};
#pragma unroll
            for (int i = 0; i < 4; ++i) { const bf16_t* rowp = Pg + (size_t)(prow + 8 * i) * PP; const bf16_t* prevp = rowp - ((i == 0 && nop0) ? 0 : PP);
#pragma unroll
                for (int a = 0; a < 4; ++a) { cu[a][i] = *(const u32x4*)(rowp + cols[a]); pr[a][i] = *(const u32x4*)(prevp + cols[a]); } }
            asm volatile("" ::: "memory");
#pragma unroll
            for (int i = 0; i < 4; ++i) { const int t = prow + 8 * i; const bool hp = !(i == 0 && nop0); float v[8]; RW_SHIFT8(cu[0][i], pr[0][i], hp, mq[0][0], mq[0][1], v);
#pragma unroll
                for (int k = 0; k < 8; ++k) { const float q = rcpf_(1.f + ex2(asc * v[k])); v[k] = amode == 0 ? v[k] : aa + ab * q; }
                *(LAS bf16x8*)(L + RG_ACT + (4 * lw + (pc >> 1)) * 1024 + (t + 32 * (pc & 1)) * 16) = pk8f(v);
#pragma unroll
                for (int a = 0; a < 3; ++a) { float o[8]; RW_SHIFT8(cu[1 + a][i], pr[1 + a][i], hp, mq[1 + a][0], mq[1 + a][1], o);
                    *(LAS bf16x8*)(L + RG_RKV + (lw * 3 + a) * 4608 + t * RC_ROWB + pc * 16) = pk8f(o); } }
        }
        asm volatile("" ::: "memory");
        {
            const int t0 = bb * SEQ + 32 * ch + 8 * lw;
            u32x4 xr[8][2]; float sp[8];
#pragma unroll
            for (int i = 0; i < 8; ++i) { const bf16_t* xp = WSP(bf16_t, WS_XB) + (size_t)(t0 + i) * D + 8 * lane; xr[i][0] = *(const u32x4*)(xp); xr[i][1] = *(const u32x4*)(xp + 512);
                sp[i] = (lane < 16) ? WSP(float, WS_SS1)[(size_t)(t0 + i) * 16 + lane] : 0.f; }
            asm volatile("" ::: "memory");
#pragma unroll
            for (int i = 0; i < 8; ++i) {
                const float rstd = __builtin_amdgcn_rsqf(wave_sum(sp[i]) * (1.f / 1024.f) + 1e-6f);
                float res = 0.f;
#pragma unroll
                for (int c = 0; c < 4; ++c) { float a = 0.f;
                    asm("v_dot2c_f32_bf16 %0, %1, %9\n\tv_dot2c_f32_bf16 %0, %2, %10\n\tv_dot2c_f32_bf16 %0, %3, %11\n\tv_dot2c_f32_bf16 %0, %4, %12\n\t"
                        "v_dot2c_f32_bf16 %0, %5, %13\n\tv_dot2c_f32_bf16 %0, %6, %14\n\tv_dot2c_f32_bf16 %0, %7, %15\n\tv_dot2c_f32_bf16 %0, %8, %16\n\ts_nop 4"
                        : "+v"(a) : "v"(xr[i][0][0]), "v"(xr[i][0][1]), "v"(xr[i][0][2]), "v"(xr[i][0][3]), "v"(xr[i][1][0]), "v"(xr[i][1][1]), "v"(xr[i][1][2]), "v"(xr[i][1][3]),
                                    "v"(wv[c][0][0]), "v"(wv[c][0][1]), "v"(wv[c][0][2]), "v"(wv[c][0][3]), "v"(wv[c][1][0]), "v"(wv[c][1][1]), "v"(wv[c][1][2]), "v"(wv[c][1][3]));
                    a = wave_sum(a); if ((lane & 3) == c) res = a; }
                if (lane < 4) { const int row = t0 + i; WSP(float, WS_LF)[(size_t)((row >> 11) * 4 + lane) * SEQ + (row & 2047)] = -softplusf_(-(res * rstd + fbias)); }
            }
        }
        asm volatile("s_waitcnt lgkmcnt(0)" ::: "memory");
        { TPB_T0; asm volatile("" ::: "memory"); __builtin_amdgcn_s_barrier(); asm volatile("" ::: "memory"); TPB_ACC(0, 256); }
        {
            const int tok = bb * SEQ + 32 * ch + r32;
            const bf16_t* wcl = wcg; asm volatile("" : "+v"(wcl));
            bf16x8 wg[2][8];
#pragma unroll
            for (int blk = 0; blk < 2; ++blk)
#pragma unroll
                for (int ks = 0; ks < 8; ++ks) wg[blk][ks] = *(const bf16x8*)(wcl + (size_t)blk * 32 * 256 + 16 * (8 + ks));
            asm volatile("" ::: "memory");
#pragma unroll
            for (int blk = 0; blk < 2; ++blk) { f32x16 aG = {};
#pragma unroll
                for (int ks = 0; ks < 8; ++ks) aG = MFMA32(wg[blk][ks], *(const LAS bf16x8*)(L + RG_ACT + (8 + ks) * 1024 + lane * 16), aG);
#pragma unroll
                for (int g = 0; g < 4; ++g) { const int cl = 32 * blk + 8 * g + 4 * h2; u32x2 gq;
                    gq.x = pk2(aG[4 * g], aG[4 * g + 1]); gq.y = pk2(aG[4 * g + 2], aG[4 * g + 3]);
                    *(u32x2*)(WSP(bf16_t, WS_GBUF) + (size_t)tok * 256 + 64 * lw + cl) = gq; } }
            asm volatile("s_waitcnt lgkmcnt(0)" ::: "memory");
        }
        { TPB_T0; asm volatile("" ::: "memory"); __builtin_amdgcn_s_barrier(); asm volatile("" ::: "memory"); TPB_ACC(1, 256); }
    }
#undef RW_SHIFT8
}
DI void rw_group_compute(Frame& F, int layer, int tg) {
    asm volatile("" : "+s"(F.in)); asm volatile("" : "+s"(F.ws)); asm volatile("" : "+v"(F.lane));
    const int lane = F.lane, r32 = lane & 31, h2 = lane >> 5, hd = F.wave, bb = tg >> 6, ch = tg & 63, bh = bb * 4 + hd;
    LAS unsigned char* L = F.lds;
    LAS unsigned char* W = L + F.wave * RC_WAVE;
    const int tl = 32 * ch + r32, tok = bb * SEQ + tl;
    const bf16_t* wc = WSP(bf16_t, WS_WCAT) + (size_t)layer * 65536 + (size_t)(64 * hd + r32) * 256 + 8 * h2;
    const int chunk = bh * 64 + ch;
    const LAS float* PAR = (const LAS float*)(L + RG_PAR) + 64 * hd;
    const LAS unsigned char* TR = L + RG_RKV + (hd * 3 + 0) * 4608 + r32 * RC_ROWB;
    const LAS unsigned char* TK = TR + 4608; const LAS unsigned char* TV = TR + 2 * 4608;
    u32x4 FRr[16];
    { TPB_T0; asm volatile("" ::: "memory"); __builtin_amdgcn_s_barrier(); asm volatile("" ::: "memory"); TPB_ACC(2, 0); }
    float n2 = 0.f;
#pragma unroll
    for (int g8 = 0; g8 < 4; ++g8) { const u32x4 kq = *(const LAS u32x4*)(TK + 64 * h2 + 16 * g8); const f32x4 k0 = *(const LAS f32x4*)(PAR + 1024 + 32 * h2 + 8 * g8), k1 = *(const LAS f32x4*)(PAR + 1024 + 32 * h2 + 8 * g8 + 4);
#pragma unroll
        for (int j = 0; j < 4; ++j) { const float a = bf2f(kq[j] & 0xffffu) * (j < 2 ? k0[2 * j] : k1[2 * j - 4]), c = bf2f(kq[j] >> 16) * (j < 2 ? k0[2 * j + 1] : k1[2 * j - 3]); n2 += a * a + c * c; } }
    n2 += swap32(n2);
    const float inv = 1.f / fmaxf(sqrtf(n2), 1e-12f);
    float bon = 0.f;
#pragma unroll
    for (int blk = 0; blk < 2; ++blk) {
        const bf16_t* wb = wc + (size_t)blk * 32 * 256;
        f32x16 aW = {}, aA = {};
#pragma unroll
        for (int ks = 0; ks < 4; ++ks) aW = MFMA32(*(const bf16x8*)(wb + 16 * ks), *(const LAS bf16x8*)(L + RG_ACT + ks * 1024 + lane * 16), aW);
#pragma unroll
        for (int ks = 4; ks < 8; ++ks) aA = MFMA32(*(const bf16x8*)(wb + 16 * ks), *(const LAS bf16x8*)(L + RG_ACT + ks * 1024 + lane * 16), aA);
#pragma unroll
        for (int s = 0; s < 2; ++s) {
            float e_kat[8], e_rt[8], e_kt[8], e_bt[8], e_kb[8], e_bb[8];
#pragma unroll
            for (int q = 0; q < 2; ++q) { const int g = 2 * s + q, cl = 32 * blk + 8 * g + 4 * h2;
                const u32x2 rq = *(const LAS u32x2*)(TR + cl * 2), kq = *(const LAS u32x2*)(TK + cl * 2), vq = *(const LAS u32x2*)(TV + cl * 2);
                const float rv[4] = {bf2f(rq.x & 0xffffu), bf2f(rq.x >> 16), bf2f(rq.y & 0xffffu), bf2f(rq.y >> 16)}, kv[4] = {bf2f(kq.x & 0xffffu), bf2f(kq.x >> 16), bf2f(kq.y & 0xffffu), bf2f(kq.y >> 16)};
                const f32x4 w0v = *(const LAS f32x4*)(PAR + cl), a0v = *(const LAS f32x4*)(PAR + 256 + cl), kav = *(const LAS f32x4*)(PAR + 512 + cl), rkv = *(const LAS f32x4*)(PAR + 768 + cl), kwv = *(const LAS f32x4*)(PAR + 1024 + cl);
#pragma unroll
                for (int j = 0; j < 4; ++j) { const int r = 4 * g + j, jj = 4 * q + j;
                    const float w = -softplusf_(-(w0v[j] + aW[r])) - 0.5f;
                    const float l2d = -LOG2E * ex2(w * LOG2E);
                    const float a = sigmoidf_(a0v[j] + aA[r]);
                    const float kkv = kv[j] * kwv[j] * inv, bev = kkv * a, kpv = kv[j] * (1.f + (a - 1.f) * kav[j]);
                    bon += rv[j] * kpv * rkv[j];
                    const float Li = scan32(l2d), Lex = Li - l2d, LC = __shfl(Li, 31 + 32 * h2);
                    const float pin = ex2(Li), pex = ex2(Lex), pinv = ex2(-Li), pc = ex2(LC - Li);
                    e_kat[jj] = kkv * pex; e_rt[jj] = rv[j] * pin; e_kt[jj] = kpv * pinv; e_bt[jj] = bev * pinv; e_kb[jj] = kpv * pc; e_bb[jj] = bev * pc;
                    if (r32 == 31) *(LAS float*)(W + RC_PC + (cl + j) * 4) = ex2(LC); }
                *(LAS u32x2*)(W + RC_V + r32 * RC_ROWB + cl * 2) = vq;
                *(LAS u32x2*)(W + RC_KB + r32 * RC_ROWB + cl * 2) = (u32x2){pk2(e_kb[4 * q], e_kb[4 * q + 1]), pk2(e_kb[4 * q + 2], e_kb[4 * q + 3])};
                *(LAS u32x2*)(W + RC_BB + r32 * RC_ROWB + cl * 2) = (u32x2){pk2(e_bb[4 * q], e_bb[4 * q + 1]), pk2(e_bb[4 * q + 2], e_bb[4 * q + 3])};
                *(LAS u32x2*)(W + RC_KT + r32 * RC_ROWB + cl * 2) = (u32x2){pk2(e_kat[4 * q], e_kat[4 * q + 1]), pk2(e_kat[4 * q + 2], e_kat[4 * q + 3])};
            }
            { const int ks = 2 * blk + s; FRr[ks * 4 + 0] = __builtin_bit_cast(u32x4, pk8f(e_kat)); FRr[ks * 4 + 1] = __builtin_bit_cast(u32x4, pk8f(e_rt)); FRr[ks * 4 + 2] = __builtin_bit_cast(u32x4, pk8f(e_kt)); FRr[ks * 4 + 3] = __builtin_bit_cast(u32x4, pk8f(e_bt)); }
        }
    }
    asm volatile("s_waitcnt lgkmcnt(0)" ::: "memory");
    { TPB_T0; asm volatile("" ::: "memory"); __builtin_amdgcn_s_barrier(); asm volatile("" ::: "memory"); TPB_ACC(3, 0); }
    bon += swap32(bon);
    asm volatile("" ::: "memory");
#pragma unroll
    for (int blk = 0; blk < 2; ++blk)
#pragma unroll
        for (int g = 0; g < 4; ++g) { const int cl = 32 * blk + 8 * g + 4 * h2; const u32x2 vq = *(const LAS u32x2*)(W + RC_V + r32 * RC_ROWB + cl * 2); u32x2 q;
            q.x = pk2(bon * bf2f(vq.x & 0xffffu), bon * bf2f(vq.x >> 16)); q.y = pk2(bon * bf2f(vq.y & 0xffffu), bon * bf2f(vq.y >> 16));
            *(u32x2*)(WSP(bf16_t, WS_BONV) + (size_t)tok * 256 + 64 * hd + cl) = q; }
    const float pc_lo = *(const LAS float*)(W + RC_PC + r32 * 4), pc_hi = *(const LAS float*)(W + RC_PC + (32 + r32) * 4);
    bf16x8 akkf[2], arkf[2], arbf[2];
    f32x16 Tt;
    {
        f32x16 skk = {}, skb = {}, sl = {};
#pragma unroll
        for (int ks = 0; ks < 4; ++ks) { const bf16x8 katf = __builtin_bit_cast(bf16x8, FRr[ks * 4 + 0]), ktf = __builtin_bit_cast(bf16x8, FRr[ks * 4 + 2]), btf = __builtin_bit_cast(bf16x8, FRr[ks * 4 + 3]);
            skk = MFMA32(ktf, katf, skk); skb = MFMA32(btf, katf, skb); sl = MFMA32(katf, btf, sl); }
#pragma unroll
        for (int r = 0; r < 16; ++r) { const int i = crow(r, h2); if (i >= r32) { skk[r] = 0.f; skb[r] = 0.f; } if (i <= r32) sl[r] = 0.f; }
#pragma unroll
        for (int s = 0; s < 2; ++s) akkf[s] = pack8(skk, s);
        bf16x8 fx[2], fxt[2];
#pragma unroll
        for (int s = 0; s < 2; ++s) { fx[s] = pack8(sl, s); fxt[s] = pack8(skb, s); }
#pragma unroll
        for (int r = 0; r < 16; ++r) Tt[r] = ((crow(r, h2) == r32) ? 1.f : 0.f) - skb[r];
#pragma unroll
        for (int lvl = 0; lvl < 4; ++lvl) {
            f32x16 p = {}, pt = {};
#pragma unroll
            for (int s = 0; s < 2; ++s) { p = MFMA32(fxt[s], fx[s], p); if (lvl < 3) pt = MFMA32(fx[s], fxt[s], pt); }
#pragma unroll
            for (int s = 0; s < 2; ++s) fx[s] = pack8(p, s);
            const bf16x8 t0 = pack8(Tt, 0), t1 = pack8(Tt, 1);
            Tt = MFMA32(fx[0], t0, Tt); Tt = MFMA32(fx[1], t1, Tt);
            if (lvl < 3) {
#pragma unroll
                for (int s = 0; s < 2; ++s) fxt[s] = pack8(pt, s); }
        }
    }
    {
        f32x16 srk = {}, srb = {};
#pragma unroll
        for (int ks = 0; ks < 4; ++ks) { const bf16x8 rtf = __builtin_bit_cast(bf16x8, FRr[ks * 4 + 1]), ktf = __builtin_bit_cast(bf16x8, FRr[ks * 4 + 2]), btf = __builtin_bit_cast(bf16x8, FRr[ks * 4 + 3]);
            srk = MFMA32(ktf, rtf, srk); srb = MFMA32(btf, rtf, srb); }
#pragma unroll
        for (int r = 0; r < 16; ++r) if (crow(r, h2) > r32) { srk[r] = 0.f; srb[r] = 0.f; }
#pragma unroll
        for (int s = 0; s < 2; ++s) { arkf[s] = pack8(srk, s); arbf[s] = pack8(srb, s); }
    }
    asm volatile("" ::: "memory");
    bf16x8 ng1f[2][2], ng2f[2][2];
    {
        const bf16x8 tf0 = pack8(Tt, 0), tf1 = pack8(Tt, 1);
#pragma unroll
        for (int cb = 0; cb < 2; ++cb) {
            f32x16 g = {};
            g = MFMA32(tf0, rc_trfrag(W + RC_KT, lane, 0, cb), g); g = MFMA32(tf1, rc_trfrag(W + RC_KT, lane, 1, cb), g);
#pragma unroll
            for (int r = 0; r < 16; ++r) g[r] = -g[r];
            ng1f[cb][0] = pack8(g, 0); ng1f[cb][1] = pack8(g, 1);
        }
#pragma unroll
        for (int vb = 0; vb < 2; ++vb) {
            f32x16 x1 = {};
#pragma unroll
            for (int s = 0; s < 2; ++s) x1 = MFMA32(akkf[s], rc_trfrag(W + RC_V, lane, s, vb), x1);
            f32x16 g = {};
            g = MFMA32(tf0, pack8(x1, 0), g); g = MFMA32(tf1, pack8(x1, 1), g);
#pragma unroll
            for (int r = 0; r < 16; ++r) g[r] = -g[r];
            ng2f[vb][0] = pack8(g, 0); ng2f[vb][1] = pack8(g, 1);
        }
    }
    asm volatile("" ::: "memory");
    u32x4* mt = WSP(u32x4, WS_CHMT) + (size_t)chunk * 8 * 64 + lane;
#pragma unroll
    for (int bip = 0; bip < 2; ++bip)
#pragma unroll
        for (int bi = 0; bi < 2; ++bi) {
            f32x16 m = {};
#pragma unroll
            for (int s = 0; s < 2; ++s) m = MFMA32(ng1f[bi][s], rc_trfrag(W + RC_BB, lane, s, bip), m);
            if (bi == bip) {
#pragma unroll
                for (int r = 0; r < 16; ++r) if (crow(r, h2) == r32) m[r] += (bi ? pc_hi : pc_lo); }
#pragma unroll
            for (int s = 0; s < 2; ++s) mt[(bip * 4 + bi * 2 + s) * 64] = __builtin_bit_cast(u32x4, pack8(m, s));
        }
    asm volatile("" ::: "memory");
    u32x4* nb_ = WSP(u32x4, WS_CHN) + (size_t)chunk * 8 * 64 + lane;
#pragma unroll
    for (int vb = 0; vb < 2; ++vb)
#pragma unroll
        for (int bip = 0; bip < 2; ++bip) {
            f32x16 n = {};
#pragma unroll
            for (int s = 0; s < 2; ++s) { n = MFMA32(rc_trfrag(W + RC_KB, lane, s, bip), rc_trfrag(W + RC_V, lane, s, vb), n); n = MFMA32(rc_trfrag(W + RC_BB, lane, s, bip), ng2f[vb][s], n); }
#pragma unroll
            for (int s = 0; s < 2; ++s) nb_[((vb * 2 + bip) * 2 + s) * 64] = __builtin_bit_cast(u32x4, pack8(n, s));
        }
    asm volatile("" ::: "memory");
    u32x4* ry = WSP(u32x4, WS_CHRY) + (size_t)chunk * 4 * 64 + lane;
#pragma unroll
    for (int bi = 0; bi < 2; ++bi) {
        f32x16 q = {};
#pragma unroll
        for (int s = 0; s < 2; ++s) q = MFMA32(ng1f[bi][s], arbf[s], q);
#pragma unroll
        for (int s = 0; s < 2; ++s) { const u32x4 rq = FRr[(2 * bi + s) * 4 + 1]; float o[8];
#pragma unroll
            for (int j = 0; j < 4; ++j) { o[2 * j] = q[8 * s + 2 * j] + bf2f(rq[j] & 0xffffu); o[2 * j + 1] = q[8 * s + 2 * j + 1] + bf2f(rq[j] >> 16); }
            ry[(bi * 2 + s) * 64] = __builtin_bit_cast(u32x4, pk8f(o)); }
    }
    asm volatile("" ::: "memory");
    u32x4* y0 = WSP(u32x4, WS_CHY0) + (size_t)chunk * 4 * 64 + lane;
#pragma unroll
    for (int vb = 0; vb < 2; ++vb) {
        f32x16 yy = {};
#pragma unroll
        for (int s = 0; s < 2; ++s) { yy = MFMA32(arkf[s], rc_trfrag(W + RC_V, lane, s, vb), yy); yy = MFMA32(arbf[s], ng2f[vb][s], yy); }
#pragma unroll
        for (int s = 0; s < 2; ++s) y0[(vb * 2 + s) * 64] = __builtin_bit_cast(u32x4, pack8(yy, s));
    }
    asm volatile("s_waitcnt lgkmcnt(0)" ::: "memory");
}
DI void unpack16(const u32x4& a, const u32x4& b, f32x16& o) {
#pragma unroll
    for (int j = 0; j < 4; ++j) { o[2 * j] = bf2f(a[j] & 0xffffu); o[2 * j + 1] = bf2f(a[j] >> 16); o[8 + 2 * j] = bf2f(b[j] & 0xffffu); o[8 + 2 * j + 1] = bf2f(b[j] >> 16); }
}
constexpr int SQ_BH = 24576, SQ_STAGE = 2 * SQ_BH;
DI void rw_seq_wg(Frame& F, int item, unsigned* sd) {
    LAS unsigned char* L = F.lds; const int lane = F.lane, wid = F.wave, r32 = lane & 31, h2 = lane >> 5;
    __syncthreads();
    if (wid >= 4) {
        const int slot = (wid - 4) >> 1, half = (wid - 4) & 1, bh = 2 * item + slot;
        const u32x4* mtb = WSP(u32x4, WS_CHMT) + (size_t)bh * 64 * 8 * 64 + lane;
        const u32x4* nbb = WSP(u32x4, WS_CHN) + (size_t)bh * 64 * 8 * 64 + lane;
        const u32x4* ryb = WSP(u32x4, WS_CHRY) + (size_t)bh * 64 * 4 * 64 + lane;
        const u32x4* y0b = WSP(u32x4, WS_CHY0) + (size_t)bh * 64 * 4 * 64 + lane;
#define SQ_ISSUE(CH) do { const int ch_ = (CH); LAS unsigned char* st_ = L + (ch_ % 3) * SQ_STAGE + slot * SQ_BH; \
            if (half == 0) { _Pragma("unroll") for (int i = 0; i < 8; ++i) __builtin_amdgcn_global_load_lds((const unsigned*)(mtb + (size_t)ch_ * 512 + i * 64), (LAS unsigned*)(st_ + i * 1024), 16, 0, 0); \
                             _Pragma("unroll") for (int i = 0; i < 4; ++i) __builtin_amdgcn_global_load_lds((const unsigned*)(ryb + (size_t)ch_ * 256 + i * 64), (LAS unsigned*)(st_ + (8 + i) * 1024), 16, 0, 0); } \
            else { _Pragma("unroll") for (int i = 0; i < 8; ++i) __builtin_amdgcn_global_load_lds((const unsigned*)(nbb + (size_t)ch_ * 512 + i * 64), (LAS unsigned*)(st_ + (12 + i) * 1024), 16, 0, 0); \
                   _Pragma("unroll") for (int i = 0; i < 4; ++i) __builtin_amdgcn_global_load_lds((const unsigned*)(y0b + (size_t)ch_ * 256 + i * 64), (LAS unsigned*)(st_ + (20 + i) * 1024), 16, 0, 0); } } while (0)
        SQ_ISSUE(0); SQ_ISSUE(1);
        asm volatile("s_waitcnt vmcnt(12)" ::: "memory");
        __builtin_amdgcn_s_barrier();
#pragma unroll 1
        for (int ch = 0; ch < 64; ++ch) {
            if (ch + 2 < 64) { SQ_ISSUE(ch + 2); asm volatile("s_waitcnt vmcnt(12)" ::: "memory"); }
            else asm volatile("s_waitcnt vmcnt(0)" ::: "memory");
            __builtin_amdgcn_s_barrier();
        }
#undef SQ_ISSUE
    } else {
        const int slot = wid >> 1, vb = wid & 1, bh = 2 * item + slot;
        f32x16 H0 = {}, H1 = {};
        float* yb = WSP(float, WS_YBUF) + (size_t)(bh >> 2) * SEQ * 256 + (bh & 3) * 64 + 32 * vb + r32;
        __builtin_amdgcn_s_barrier();
#pragma unroll 1
        for (int ch = 0; ch < 64; ++ch) {
            const LAS unsigned char* st = L + (ch % 3) * SQ_STAGE + slot * SQ_BH + lane * 16;
            u32x4 cmt[8], cry[4], cnn[4], cy0[2];
#pragma unroll
            for (int i = 0; i < 8; ++i) cmt[i] = *(const LAS u32x4*)(st + i * 1024);
#pragma unroll
            for (int i = 0; i < 4; ++i) { cry[i] = *(const LAS u32x4*)(st + (8 + i) * 1024); cnn[i] = *(const LAS u32x4*)(st + (12 + 4 * vb + i) * 1024); }
            cy0[0] = *(const LAS u32x4*)(st + (20 + 2 * vb) * 1024); cy0[1] = *(const LAS u32x4*)(st + (21 + 2 * vb) * 1024);
            bf16x8 hb[4]; hb[0] = pack8(H0, 0); hb[1] = pack8(H0, 1); hb[2] = pack8(H1, 0); hb[3] = pack8(H1, 1);
            f32x16 y, n0, n1;
            unpack16(cy0[0], cy0[1], y); unpack16(cnn[0], cnn[1], n0); unpack16(cnn[2], cnn[3], n1);
            asm volatile("s_waitcnt lgkmcnt(0)" ::: "memory");
#pragma unroll
            for (int ks = 0; ks < 4; ++ks) { n0 = MFMA32(__builtin_bit_cast(bf16x8, cmt[ks]), hb[ks], n0); n1 = MFMA32(__builtin_bit_cast(bf16x8, cmt[4 + ks]), hb[ks], n1); y = MFMA32(__builtin_bit_cast(bf16x8, cry[ks]), hb[ks], y); }
            H0 = n0; H1 = n1;
#pragma unroll
            for (int r = 0; r < 16; ++r) yb[(size_t)(32 * ch + crow(r, h2)) * 256] = y[r];
            __builtin_amdgcn_s_barrier();
        }
        asm volatile("s_waitcnt vmcnt(0)" ::: "memory");
    }
    __syncthreads();
    if (F.tid == 0) {
        __builtin_amdgcn_fence(__ATOMIC_RELEASE, "agent");
        asm volatile("s_waitcnt vmcnt(0)" ::: "memory");
        (void)xb_add(sd, 1u);
    }
}
DI void rw_post_item(Frame& F, int layer, int tok0) {
    const int tid = F.tid, cg = tid & 31, c0 = 8 * cg, tr = tid >> 5;
    const f32x4 gw0 = *(const f32x4*)(F.in[14] + layer * 256 + c0), gw1 = *(const f32x4*)(F.in[14] + layer * 256 + c0 + 4);
    const f32x4 gb0 = *(const f32x4*)(F.in[15] + layer * 256 + c0), gb1 = *(const f32x4*)(F.in[15] + layer * 256 + c0 + 4);
    const float gw[8] = {gw0[0], gw0[1], gw0[2], gw0[3], gw1[0], gw1[1], gw1[2], gw1[3]}, gb[8] = {gb0[0], gb0[1], gb0[2], gb0[3], gb1[0], gb1[1], gb1[2], gb1[3]};
#pragma unroll
    for (int hf = 0; hf < 2; ++hf) {
        f32x4 ya[4], yb[4]; u32x4 bq[4], gq[4];
#pragma unroll
        for (int i = 0; i < 4; ++i) { const size_t o = (size_t)(tok0 + tr + 16 * (4 * hf + i)) * 256 + c0;
            ya[i] = *(const f32x4*)(WSP(float, WS_YBUF) + o); yb[i] = *(const f32x4*)(WSP(float, WS_YBUF) + o + 4);
            bq[i] = *(const u32x4*)(WSP(bf16_t, WS_BONV) + o); gq[i] = *(const u32x4*)(WSP(bf16_t, WS_GBUF) + o); }
#pragma unroll
        for (int i = 0; i < 4; ++i) {
            float y[8] = {ya[i][0], ya[i][1], ya[i][2], ya[i][3], yb[i][0], yb[i][1], yb[i][2], yb[i][3]};
            const float mean = sum8(((y[0] + y[1]) + (y[2] + y[3])) + ((y[4] + y[5]) + (y[6] + y[7]))) * (1.f / 64.f);
            float sq = 0.f;
#pragma unroll
            for (int j = 0; j < 8; ++j) { y[j] -= mean; sq += y[j] * y[j]; }
            const float rs = __builtin_amdgcn_rsqf(sum8(sq) * (1.f / 64.f) + 64e-5f);
#pragma unroll
            for (int j = 0; j < 8; ++j) { const float bo = bf2f((j & 1) ? (bq[i][j >> 1] >> 16) : (bq[i][j >> 1] & 0xffffu)), gg = bf2f((j & 1) ? (gq[i][j >> 1] >> 16) : (gq[i][j >> 1] & 0xffffu));
                y[j] = (y[j] * rs * gw[j] + gb[j] + bo) * gg; }
            *(u32x4*)(WSP(bf16_t, WS_MIX) + (size_t)(tok0 + tr + 16 * (4 * hf + i)) * D + 512 + c0) = __builtin_bit_cast(u32x4, pk8f(y));
        }
    }
}

constexpr int RT_WSTR = 1028;
DI void p4_router(Frame& F, int layer, bool dry) {
    LAS unsigned char* L = F.lds; const int tid = F.tid, lane = F.lane, wid = F.wave, m16 = lane & 15, q4 = lane >> 4;
    LAS float* W = (LAS float*)L;
    LAS float* wlog = (LAS float*)L + wid * (16 * 49);
    LAS int* ent = (LAS int*)(L + 148032);
    LAS float* entg = (LAS float*)(L + 148032 + 4096);
    LAS int* lcnt = (LAS int*)(L + 148032 + 5120);
    LAS int* lbase = lcnt + 144;
    const float* x = F.out; bf16_t* xb = WSP(bf16_t, WS_XB);
    const float *bg = F.in[20] + layer * 4, *be = F.in[22] + layer * 32;
    unsigned* cnt = (unsigned*)(F.ws + WS_CTL) + CW_CNT + layer * 256;
    int* elist = WSP(int, WS_LIST); f32x2* egate = WSP(f32x2, WS_GLIST); u32x2* plist = WSP(u32x2, WS_PLIST);
    for (int blk = F.bid; blk < NT / 128; blk += F.G) {
        __syncthreads();
        { const f32x4* src = (const f32x4*)(WSP(float, WS_RTW) + (size_t)layer * 36 * 1024);
          for (int i = tid; i < 36 * 256; i += 512) *(LAS f32x4*)(W + (i >> 8) * RT_WSTR + 4 * (i & 255)) = src[i]; }
        if (tid < 144) lcnt[tid] = 0;
        __syncthreads();
        const int row0 = blk * 128 + wid * 16;
        const float* xr = x + (size_t)(row0 + m16) * D + 4 * q4; bf16_t* xbr = xb + (size_t)(row0 + m16) * D + 4 * q4;
        f32x4 a0 = {}, a1 = {}, a2 = {}; float ssq = 0.f;
        const LAS float* w0p = W + (size_t)m16 * RT_WSTR + 4 * q4; const LAS float* w1p = w0p + 16 * RT_WSTR; const LAS float* w2p = W + (size_t)(32 + (m16 & 3)) * RT_WSTR + 4 * q4;
        const bool v2 = m16 < 4;
        f32x4 xq[2][16];
#pragma unroll
        for (int j = 0; j < 16; ++j) xq[0][j] = *(const f32x4*)(xr + 16 * j);
#pragma unroll
        for (int jb = 0; jb < 4; ++jb) {
            if (jb < 3) {
#pragma unroll
                for (int j = 0; j < 16; ++j) xq[(jb + 1) & 1][j] = *(const f32x4*)(xr + 16 * (16 * (jb + 1) + j));
            }
            asm volatile("" ::: "memory");
#pragma unroll
            for (int jj = 0; jj < 16; ++jj) { const int j = 16 * jb + jj;
                const f32x4 xv = xq[jb & 1][jj];
                const f32x4 wa = *(const LAS f32x4*)(w0p + 16 * j), wb = *(const LAS f32x4*)(w1p + 16 * j); f32x4 wc_ = *(const LAS f32x4*)(w2p + 16 * j);
                if (!v2) wc_ = (f32x4){0.f, 0.f, 0.f, 0.f};
                ssq += (xv[0] * xv[0] + xv[1] * xv[1]) + (xv[2] * xv[2] + xv[3] * xv[3]);
                u32x2 w; w.x = pk2(xv[0], xv[1]); w.y = pk2(xv[2], xv[3]); *(u32x2*)(xbr + 16 * j) = w;
#pragma unroll
                for (int i = 0; i < 4; ++i) { a0 = __builtin_amdgcn_mfma_f32_16x16x4f32(xv[i], wa[i], a0, 0, 0, 0); a1 = __builtin_amdgcn_mfma_f32_16x16x4f32(xv[i], wb[i], a1, 0, 0, 0); a2 = __builtin_amdgcn_mfma_f32_16x16x4f32(xv[i], wc_[i], a2, 0, 0, 0); }
            }
            asm volatile("" ::: "memory");
        }
        ssq += __shfl_xor(ssq, 16); ssq += __shfl_xor(ssq, 32);
        __syncthreads();
#pragma unroll
        for (int jj = 0; jj < 4; ++jj) { wlog[(4 * q4 + jj) * 49 + m16] = a0[jj]; wlog[(4 * q4 + jj) * 49 + 16 + m16] = a1[jj]; wlog[(4 * q4 + jj) * 49 + 32 + m16] = a2[jj]; }
        asm volatile("s_waitcnt lgkmcnt(0)" ::: "memory");
        if (lane < 16) {
            const int r = lane, row = row0 + r;
            const float rstd = __builtin_amdgcn_rsqf(ssq * (1.f / 1024.f) + 1e-6f);
            WSP(float, WS_RSTD2)[row] = rstd;
            float gl[4]; int gs = 0; float gmax;
#pragma unroll
            for (int j = 0; j < 4; ++j) gl[j] = wlog[r * 49 + j] * rstd + bg[j];
            gmax = gl[0];
#pragma unroll
            for (int j = 1; j < 4; ++j) if (gl[j] > gmax) { gmax = gl[j]; gs = j; }
            float gsum = 0.f;
#pragma unroll
            for (int j = 0; j < 4; ++j) gsum += ex2((gl[j] - gmax) * LOG2E);
            const float ggate = 1.f / gsum;
            float el[8];
#pragma unroll
            for (int j = 0; j < 8; ++j) el[j] = wlog[r * 49 + 4 + gs * 8 + j] * rstd + be[gs * 8 + j];
            int i0 = 0; float m0 = el[0];
#pragma unroll
            for (int j = 1; j < 8; ++j) if (el[j] > m0) { m0 = el[j]; i0 = j; }
            int i1 = -1; float m1 = -3.0e38f;
#pragma unroll
            for (int j = 0; j < 8; ++j) if (j != i0 && (i1 < 0 || el[j] > m1)) { m1 = el[j]; i1 = j; }
            const float e1 = ex2((m1 - m0) * LOG2E), g0 = ggate / (1.f + e1), g1 = ggate * e1 / (1.f + e1);
            const int la = i0 < i1 ? i0 : i1, lb = i0 < i1 ? i1 : i0; const float ga = i0 < i1 ? g0 : g1, gb = i0 < i1 ? g1 : g0;
            const int ea = gs * 8 + la, eb = gs * 8 + lb, pid = gs * 28 + la * (15 - la) / 2 + (lb - la - 1);
            const int ra = atomicAdd((int*)&lcnt[ea], 1), rb = atomicAdd((int*)&lcnt[eb], 1), rp = atomicAdd((int*)&lcnt[32 + pid], 1);
            const int li = wid * 16 + r;
            ent[li * 8 + 0] = ea; ent[li * 8 + 1] = eb; ent[li * 8 + 2] = pid; ent[li * 8 + 3] = ra; ent[li * 8 + 4] = rb; ent[li * 8 + 5] = rp; ent[li * 8 + 6] = __builtin_bit_cast(int, rstd); entg[li * 2] = ga; entg[li * 2 + 1] = gb;
        }
        __syncthreads();
        if (tid < 144) { const int n = lcnt[tid]; lbase[tid] = (n && !dry) ? (int)xb_add(cnt + tid, (unsigned)n) : 0; }
        __syncthreads();
        if (tid < 128 && !dry) { const int row = blk * 128 + tid; const int ea = ent[tid * 8], eb = ent[tid * 8 + 1], pid = ent[tid * 8 + 2];
            const int pa = lbase[ea] + ent[tid * 8 + 3], pb = lbase[eb] + ent[tid * 8 + 4], pp = lbase[32 + pid] + ent[tid * 8 + 5];
            const float rsd = __builtin_bit_cast(float, ent[tid * 8 + 6]);
            elist[(size_t)ea * LCAP + pa] = row; egate[(size_t)ea * LCAP + pa] = (f32x2){entg[tid * 2], rsd};
            elist[(size_t)eb * LCAP + pb] = row; egate[(size_t)eb * LCAP + pb] = (f32x2){entg[tid * 2 + 1], rsd};
            plist[(size_t)pid * LCAP + pp] = (u32x2){(unsigned)row, (unsigned)pa | ((unsigned)pb << 16)}; }
    }
    __syncthreads();
}
DI void moe_tables(Frame& F, int layer) {
    LAS MoeTab* T = (LAS MoeTab*)(F.lds + LDS_AUX);
    unsigned* cnt = (unsigned*)(F.ws + WS_CTL) + CW_CNT + layer * 256;
    __syncthreads();
    if (F.tid < 32) T->ce[F.tid] = (int)xb_ld(cnt + F.tid); else if (F.tid < 144) T->cp[F.tid - 32] = (int)xb_ld(cnt + F.tid);
    __syncthreads();
    if (F.tid == 0) { int sb = 0, tg = 0;
        for (int e = 0; e < 32; ++e) { const int a = T->ce[e]; T->sb[e] = sb; T->tpg[e] = tg; sb += a; tg += (a + 255) >> 8; }
        T->tpg[32] = tg; }
    if (F.tid == 64) { int tf = 0, th = 0;
        for (int p = 0; p < 112; ++p) { const int n = T->cp[p], nt_ = (n + 255) >> 8, half = (nt_ > 0 && n - 256 * (nt_ - 1) <= 128) ? 1 : 0; T->tpf[p] = tf; T->tph[p] = th; tf += nt_ - half; th += half; }
        T->tpf[112] = tf; T->tph[112] = th; }
    __syncthreads();
}
DI void p_final(Frame& F) {
    const int gw = F.bid * 8 + F.wave, NGW = F.G * 8; const f32x4* gq = (const f32x4*)F.in[26] + F.lane;
    f32x4 gv[4];
#pragma unroll
    for (int j = 0; j < 4; ++j) gv[j] = gq[64 * j];
    for (int m0 = gw * 4; m0 < NT; m0 += NGW * 4) {
        f32x4 v[4][4];
#pragma unroll
        for (int r = 0; r < 4; ++r) { const f32x4* xr = (const f32x4*)(F.out + (size_t)(m0 + r) * D) + F.lane;
#pragma unroll
            for (int j = 0; j < 4; ++j) v[r][j] = xr[64 * j]; }
#pragma unroll
        for (int r = 0; r < 4; ++r) { float s = 0.f; f32x4* xw = (f32x4*)(F.out + (size_t)(m0 + r) * D) + F.lane;
#pragma unroll
            for (int j = 0; j < 4; ++j) s += (v[r][j][0] * v[r][j][0] + v[r][j][1] * v[r][j][1]) + (v[r][j][2] * v[r][j][2] + v[r][j][3] * v[r][j][3]);
            const float rstd = __builtin_amdgcn_rsqf(wave_sum(s) * (1.f / 1024.f) + 1e-6f);
#pragma unroll
            for (int j = 0; j < 4; ++j) xw[64 * j] = v[r][j] * rstd * gv[j]; }
    }
}


#ifndef DUP_PH
#define DUP_PH -1
#endif
#define NREP(n) ((DUP_PH == (n)) ? 2 : 1)
constexpr int PH_PER_LAYER = 6, N_PHASES = 1 + DEPTH * PH_PER_LAYER + 1;
__global__ void __launch_bounds__(512, 2) mk_fwd(Args args) {
    extern __shared__ __attribute__((aligned(16))) unsigned char lds_raw[];
    Frame F;
    F.lds = (LAS unsigned char*)lds_raw; F.tid = threadIdx.x; F.lane = F.tid & 63; F.wave = __builtin_amdgcn_readfirstlane(F.tid >> 6);
    F.G = gridDim.x; F.bid = blockIdx.x; F.in = (const __attribute__((address_space(4))) cfp_t*)__builtin_amdgcn_kernarg_segment_ptr(); F.out = args.out; F.ws = args.ws;
    volatile LAS unsigned* MISC = (volatile LAS unsigned*)(F.lds + LDS_MISC);
    if (F.tid < 64) MISC[F.tid] = 0u;
    __syncthreads();
    unsigned* ctl = (unsigned*)(F.ws + WS_CTL);
    const int lo = args.ph_lo, hi = args.ph_hi;
    const bool multi = (hi - lo) > 1;
    XcdBarrier bar; bar.bar = ctl + CW_BAR; bar.x = 0; bar.st = nullptr;
    if (multi) bar = xcd_barrier_post(ctl + CW_BAR, MISC + 8);
#ifndef PHSEL
#define PHSEL -1
#endif
#ifndef PHMASK
#define PHMASK 0xFFFF
#endif
#define PS(n) ((PHSEL < 0 || PHSEL == (n)) && ((PHMASK >> (n)) & 1))
#define LAUNDER() do { asm volatile("" : "+s"(F.in)); asm volatile("" : "+s"(F.ws)); asm volatile("" : "+s"(F.out)); asm volatile("" : "+v"(F.tid)); asm volatile("" : "+v"(F.lane)); asm volatile("" : "+s"(F.bid)); asm volatile("" : "+s"(F.G)); } while (0)
#define IN(k) (lo <= (k) && (k) < hi)
#define SEAM(k) do { if (IN(k) && IN((k) + 1)) { xcd_barrier(bar); if (DUP_PH == 99) xcd_barrier(bar); } LAUNDER(); } while (0)
#ifdef TPROBE
    unsigned long long tp_acc = 0, tp_prev = __builtin_amdgcn_s_memrealtime();
#define TP(k) do { const unsigned long long tp_now = __builtin_amdgcn_s_memrealtime(); if ((k) == TPROBE || (k) == TPROBE2) tp_acc += tp_now - tp_prev; tp_prev = tp_now; } while (0)
#else
#define TP(k) do { } while (0)
#endif
    LAUNDER();
    if (PS(0) && IN(0)) { _Pragma("unroll 1") for (int rep = 0; rep < NREP(0); ++rep) p0_prologue(F); }
    SEAM(0); TP(0);
#pragma unroll 1
    for (int layer = 0; layer < DEPTH; ++layer) {
        const int pb = 1 + layer * PH_PER_LAYER;
        LAUNDER();
        if (PS(1) && IN(pb + 0)) _Pragma("unroll 1") for (int rep = 0; rep < NREP(1); ++rep) {
            ProbIn P; P.K = D; P.A = WSP(bf16_t, WS_XB); P.Bt = WSP(bf16_t, WS_BIN) + (size_t)layer * NIN * D; P.G = F.G; P.c = F.bid;
            P.Pout = WSP(bf16_t, WS_P); P.ss1 = WSP(float, WS_SS1); P.lf = WSP(float, WS_LF); P.bfx = F.in[16] + layer * 4; P.kmax = (unsigned*)(F.ws + WS_CTL) + CW_KMAX + layer * 128;
            pg8::gemm_phase<ProbIn, true>(F.lds, P, F.tid);
        }
        SEAM(pb + 0); TP(1);
        if (IN(pb + 1)) _Pragma("unroll 1") for (int rep = 0; rep < NREP(2); ++rep) {
            if (PS(4)) {
                __syncthreads();
                { LAS float* PARW = (LAS float*)(F.lds + RG_PAR);
                  for (int i = F.tid; i < 1280; i += 512) { const int a = i >> 8, c = i & 255; PARW[i] = F.in[a == 0 ? 6 : (a == 1 ? 8 : (a == 2 ? 12 : (a == 3 ? 13 : 11)))][layer * 256 + c]; } }
                __syncthreads();
                if (F.wave < 4) { _Pragma("unroll 1") for (int it = F.bid; it < 1024; it += F.G) rw_group_compute(F, layer, it); } else rw_loader_loop(F, layer);
                __syncthreads();
            }
        }
        if (IN(pb + 1)) {
            unsigned* r1d = (unsigned*)(F.ws + WS_CTL) + CW_R1D + layer * 2048;
            xcd_arrive(bar, r1d); TP(2);
            bool fxw = false;
            unsigned* sdw = (unsigned*)(F.ws + WS_CTL) + CW_SD + layer * 64;
            if (PS(5)) { if (F.G >= 64) { if (F.bid < 32) { xcd_wait_all(bar, r1d); TP(8); rw_seq_wg(F, F.bid, sdw); TP(9); } } else { xcd_wait_all(bar, r1d); for (int i = F.bid; i < 32; i += F.G) rw_seq_wg(F, i, sdw); } }
            unsigned* wq = (unsigned*)(F.ws + WS_CTL) + CW_WQ + layer * 64;
            volatile LAS int* qslot = (volatile LAS int*)(F.lds + LDS_MISC + 64);
            __syncthreads();
            if (F.tid == 0) qslot[0] = (int)xb_add(wq, 1u);
            __syncthreads();
            int q = qslot[0];
#pragma unroll 1
            for (;;) {
                if (q >= 1024 + 256 + 256) break;
                unsigned nq = 0u; if (F.tid == 0) nq = xb_add(wq, 1u);
                LAUNDER();
                if (q < 512) { if (PS(6)) sb_unit(F, (q & 63) >> 2, q & 3, 7 - (q >> 6)); }
                else if (q < 1024) { const int r = q - 512; if (!fxw) { xcd_wait_all(bar, r1d); fxw = true; } if (PS(2)) fx_unit(F, layer, (r & 63) >> 2, r & 3, 7 - (r >> 6)); }
                else if (q < 1280) { if (PS(3)) gm_item(F, layer, (q - 1024) >> 4, (q - 1024) & 15); }
                else if (PS(7)) {
                    if (F.tid == 0) { unsigned sp = 0; while (xb_ld(sdw) < 32u) { __builtin_amdgcn_s_sleep(2); if (++sp > (1u << 22)) break; }
                        __builtin_amdgcn_fence(__ATOMIC_ACQUIRE, "agent"); asm volatile("s_waitcnt vmcnt(0)" ::: "memory"); }
                    __syncthreads();
                    rw_post_item(F, layer, (q - 1280) * 128);
                }
                TP(q < 512 ? 20 : (q < 1024 ? 21 : (q < 1280 ? 22 : 23)));
                __syncthreads();
                if (F.tid == 0) qslot[0] = (int)nq;
                __syncthreads();
                q = qslot[0];
            }
        }
        SEAM(pb + 1); TP(3);
        if (PS(8) && IN(pb + 2)) {
            ProbOut P; P.K = D; P.A = WSP(bf16_t, WS_MIX); P.Bt = WSP(bf16_t, WS_BOUT) + (size_t)layer * D * D; P.G = F.G; P.c = F.bid;
            P.base = (layer == 0) ? F.in[0] : F.out; P.out = F.out;
            if (DUP_PH == 8) { P.ascale = 0.f; P.base = F.out; pg8::gemm_phase<ProbOut, true>(F.lds, P, F.tid); P.base = (layer == 0) ? F.in[0] : F.out; }
            P.ascale = 1.f; pg8::gemm_phase<ProbOut, true>(F.lds, P, F.tid);
        }
        SEAM(pb + 2); TP(4);
        if (PS(9) && IN(pb + 3)) { if (DUP_PH == 9) p4_router(F, layer, true); p4_router(F, layer, false); }
        SEAM(pb + 3); TP(5);
        if (PS(10) && IN(pb + 4)) {
            moe_tables(F, layer);
            ProbGU P; P.K = D; P.A = WSP(bf16_t, WS_XB); P.Bt = WSP(bf16_t, WS_BGU) + (size_t)layer * NE * 1024 * D; P.G = F.G; P.c = F.bid;
            P.T = (const LAS MoeTab*)(F.lds + LDS_AUX); P.elist = WSP(int, WS_LIST); P.egate = WSP(f32x2, WS_GLIST); P.HB = WSP(bf16_t, WS_HB);
            pg8::gemm_phase<ProbGU, true>(F.lds, P, F.tid);
        }
        SEAM(pb + 4); TP(6);
        if (PS(11) && IN(pb + 5)) {
            moe_tables(F, layer);
            ProbDP P; P.A = WSP(bf16_t, WS_HB); P.Bt = WSP(bf16_t, WS_BDN) + (size_t)layer * NE * D * EH; P.G = F.G; P.c = F.bid;
            P.T = (const LAS MoeTab*)(F.lds + LDS_AUX); P.plist = WSP(u32x2, WS_PLIST); P.x = F.out; P.xb = WSP(bf16_t, WS_XB); P.ss1 = WSP(float, WS_SS1);
            pg8::gemm_phase_pair<ProbDP>(F.lds, P, F.tid);
        }
        SEAM(pb + 5); TP(7);
    }
    if (PS(13) && IN(N_PHASES - 1)) p_final(F);
#ifdef TPROBE
    TP(10);
    #ifdef TPSLOT
    __syncthreads(); tp_acc = *((volatile LAS unsigned long long*)(F.lds + LDS_MISC + 128) + TPSLOT);
#endif
    if (F.bid == TPWG) { const unsigned long long t0 = __builtin_amdgcn_s_memrealtime(); while (__builtin_amdgcn_s_memrealtime() - t0 < 8ull * tp_acc) __builtin_amdgcn_s_sleep(8); }
#endif
#undef IN
#undef SEAM
}

#ifndef MK_ONE_LAUNCH
#define MK_ONE_LAUNCH 1
#endif
extern "C" void kernel_launch(void* const* d_in, const int* in_sizes, int n_in, void* d_out, int out_size, void* d_ws, size_t ws_size, hipStream_t stream) {
    static int grid = 0;
    if (grid == 0) {
        if (n_in != 27 || out_size != NT * D || ws_size < WS_END) { fprintf(stderr, "kernel_launch: unexpected shapes (n_in %d out %d ws %zu)\n", n_in, out_size, ws_size); grid = -1; return; }
        int dev = 0, cus = 0;
        if (hipGetDevice(&dev) != hipSuccess || hipDeviceGetAttribute(&cus, hipDeviceAttributeMultiprocessorCount, dev) != hipSuccess) { grid = -1; return; }
        if (hipFuncSetAttribute((const void*)mk_fwd, hipFuncAttributeMaxDynamicSharedMemorySize, LDS_BYTES) != hipSuccess) { fprintf(stderr, "kernel_launch: hipFuncSetAttribute failed\n"); grid = -1; return; }
        (void)hipGetLastError();
        grid = cus;
    }
    if (grid < 0) return;
    (void)hipMemsetAsync((char*)d_ws + WS_CTL, 0, CTL_BYTES, stream);
    Args a{};
    for (int i = 0; i < 27; ++i) a.in[i] = (const float*)d_in[i];
    a.out = (float*)d_out; a.ws = (unsigned char*)d_ws; a.li = 0; a.pad = 0;
#if MK_ONE_LAUNCH
    a.ph_lo = 0; a.ph_hi = N_PHASES;
    hipLaunchKernelGGL(mk_fwd, dim3(grid), dim3(512), LDS_BYTES, stream, a);
#else
    for (int p = 0; p < N_PHASES; ++p) { a.ph_lo = p; a.ph_hi = p + 1; hipLaunchKernelGGL(mk_fwd, dim3(grid), dim3(512), LDS_BYTES, stream, a); }
#endif
}
```

```cpp
#include <hip/hip_runtime.h>
#include <cstdio>
#include <cstdint>

#define DI __device__ __forceinline__
#define LAS __attribute__((address_space(3)))
#define GAS __attribute__((address_space(1)))
typedef unsigned short bf16_t;
typedef short bf16x8 __attribute__((ext_vector_type(8)));
typedef short s16x4 __attribute__((ext_vector_type(4)));
typedef float f32x2 __attribute__((ext_vector_type(2)));
typedef float f32x4 __attribute__((ext_vector_type(4)));
typedef float f32x16 __attribute__((ext_vector_type(16)));
typedef unsigned u32x2 __attribute__((ext_vector_type(2)));
typedef unsigned u32x4 __attribute__((ext_vector_type(4)));
typedef __bf16 bf16x2_t __attribute__((ext_vector_type(2)));
typedef GAS unsigned gu32;

constexpr int NT = 32768, SEQ = 2048, NB = 16, D = 1024, DEPTH = 4, NH = 4;
constexpr int PP = 3072;
constexpr int NIN = 3328;
constexpr int C_SBQ = 0, C_SBK = 256, C_SBV = 512, C_GMU = 768, C_GMV = 1024, C_RWR = 1280, C_RWK = 1536, C_RWV = 1792, C_RWX = 2048, C_FXQ = 2304, C_FXK = 2560, C_FXV = 2816;
constexpr int NE = 32, EH = 512;
constexpr float LOG2E = 1.4426950408889634f, LN2 = 0.6931471805599453f;
constexpr float QSCALE2 = 0.125f * LOG2E;

constexpr size_t MiB = 1u << 20;
constexpr size_t WS_CTL = 0, CTL_BYTES = 1 * MiB;
constexpr size_t WS_BIN = 1 * MiB;
constexpr size_t WS_BOUT = 28 * MiB;
constexpr size_t WS_BGU = 36 * MiB;
constexpr size_t WS_BDN = 292 * MiB;
constexpr size_t WS_WCAT = 420 * MiB;
constexpr size_t WS_RTW = 421 * MiB;
constexpr size_t WS_SS1 = 422 * MiB;
constexpr size_t WS_RSTD2 = 424 * MiB;
constexpr size_t WS_LF = 425 * MiB;
constexpr size_t WS_GMW = 426 * MiB;
constexpr size_t WS_LIST = 428 * MiB;
constexpr size_t WS_GLIST = 436 * MiB;
constexpr size_t WS_GBUF = 444 * MiB;
constexpr size_t WS_YBUF = 460 * MiB;
constexpr size_t WS_MIX = 492 * MiB;
constexpr size_t WS_P = 556 * MiB;
constexpr size_t WS_XB = 748 * MiB;
constexpr size_t WS_HB = 812 * MiB;
constexpr size_t WS_REC = 748 * MiB;
constexpr size_t WS_CHMT = 812 * MiB;
constexpr size_t WS_CHN = 844 * MiB;
constexpr size_t WS_CHFR = 812 * MiB;
constexpr size_t WS_CHRY = 877 * MiB;
constexpr size_t WS_CHY0 = 893 * MiB;
constexpr size_t WS_BONV = 909 * MiB;
constexpr size_t WS_PLIST = 940 * MiB;
constexpr size_t WS_END = 968 * MiB;

constexpr int CW_BAR = 4096;
constexpr int CW_CNT = 16384;
constexpr int CW_R1D = 40960;
constexpr int CW_SD = 28672;
constexpr int CW_WQ = 24576;
constexpr int CW_KMAX = 20480;

constexpr int LDS_BYTES = 163840;
constexpr int LDS_AUX = 131072;
constexpr int LDS_MISC = 163840 - 256;

DI float bf2f(unsigned b) { return __uint_as_float(b << 16); }
DI unsigned pk2(float lo, float hi) { f32x2 v = {lo, hi}; bf16x2_t b = __builtin_convertvector(v, bf16x2_t); return __builtin_bit_cast(unsigned, b); }
DI unsigned f2bf(float f) { return pk2(f, 0.f) & 0xffffu; }
DI bf16x8 pk8f(const float (&v)[8]) { u32x4 p; p.x = pk2(v[0], v[1]); p.y = pk2(v[2], v[3]); p.z = pk2(v[4], v[5]); p.w = pk2(v[6], v[7]); return __builtin_bit_cast(bf16x8, p); }
DI float ex2(float x) { return __builtin_amdgcn_exp2f(x); }
DI float lg2(float x) { return __builtin_amdgcn_logf(x); }
DI float rcpf_(float x) { return __builtin_amdgcn_rcpf(x); }
DI float sigmoidf_(float x) { return rcpf_(1.f + ex2(-x * LOG2E)); }
DI float tanhf_(float x) { return 1.f - 2.f * rcpf_(1.f + ex2(2.f * LOG2E * x)); }
DI float geluf_(float x) { const float u = 0.7978845608028654f * (x + 0.044715f * x * x * x); return x * rcpf_(1.f + ex2(-2.f * LOG2E * u)); }
DI float softplusf_(float x) { return fmaxf(x, 0.f) + LN2 * lg2(1.f + ex2(-fabsf(x) * LOG2E)); }
template <int CTRL, int RMASK, bool BC> DI float dppf(float x) { return __builtin_bit_cast(float, __builtin_amdgcn_update_dpp(0, __builtin_bit_cast(int, x), CTRL, RMASK, 0xf, BC)); }
DI float wave_sum(float v) {
    v += dppf<0xB1, 0xf, true>(v); v += dppf<0x4E, 0xf, true>(v); v += dppf<0x141, 0xf, true>(v); v += dppf<0x140, 0xf, true>(v);
    v += dppf<0x142, 0xa, false>(v); v += dppf<0x143, 0xc, false>(v);
    return __builtin_bit_cast(float, __builtin_amdgcn_readlane(__builtin_bit_cast(int, v), 63));
}
DI float swap32(float v) { return __shfl_xor(v, 32); }
#define MFMA32(a, b, c) __builtin_amdgcn_mfma_f32_32x32x16_bf16((a), (b), (c), 0, 0, 0)
DI int crow(int r, int h) { return (r & 3) + 8 * (r >> 2) + 4 * h; }

#define XB_TMO      128
#define XB_XCNT(j)  (256  + 64 * (j))
#define XB_XSUB(j)  (1280 + 64 * (j))
#define XB_XGEN(j)  (2304 + 64 * (j))
#define XB_TOP      3328
#define XB_TOPGEN   3392
#define XCD_BAR_WORDS 3456
#define XB_SPIN_CAP (1u << 18)
DI unsigned xb_ld(unsigned* p)              { return __hip_atomic_load(p, __ATOMIC_RELAXED, __HIP_MEMORY_SCOPE_AGENT); }
DI unsigned xb_add(unsigned* p, unsigned v) { return __hip_atomic_fetch_add(p, v, __ATOMIC_RELAXED, __HIP_MEMORY_SCOPE_AGENT); }
DI unsigned xb_xcc_id() { return (unsigned)__builtin_amdgcn_s_getreg((3 << 11) | 20) & 0xFu; }
#define XB_SPIN(cond, bar) do { unsigned _sp = 0; while (cond) { __builtin_amdgcn_s_sleep(1); \
    if ((++_sp & 255u) == 0u) { if (xb_ld(&(bar)[XB_TMO])) break; if (_sp > XB_SPIN_CAP) { atomicAdd(&(bar)[XB_TMO], 1u); break; } } } } while (0)
struct XcdBarrier { unsigned* bar; unsigned x; volatile LAS unsigned* st; };
DI XcdBarrier xcd_barrier_post(unsigned* bar, volatile LAS unsigned* st) {
    XcdBarrier b; b.bar = bar; b.x = xb_xcc_id(); b.st = st;
    if (threadIdx.x == 0) (void)xb_add(&bar[XB_XCNT(b.x)], 1u);
    return b;
}
DI void xcd_barrier_complete(unsigned* bar, unsigned x, unsigned& nloc, unsigned& nx) {
    const unsigned G = gridDim.x * gridDim.y * gridDim.z;
    unsigned sum, cnt, mine, sp = 0u;
    for (;;) {
        sum = 0u; cnt = 0u; mine = 0u;
#pragma unroll
        for (unsigned j = 0; j < 16; ++j) { const unsigned c = xb_ld(&bar[XB_XCNT(j)]); sum += c; cnt += (c > 0u) ? 1u : 0u; mine = (j == x) ? c : mine; }
        if (sum == G) break;
        __builtin_amdgcn_s_sleep(1);
        if ((++sp & 255u) == 0u) { if (xb_ld(&bar[XB_TMO])) break; if (sp > XB_SPIN_CAP) { atomicAdd(&bar[XB_TMO], 1u); break; } }
    }
    nloc = mine > 0u ? mine : 1u; nx = cnt > 0u ? cnt : 1u;
}
DI void xcd_barrier(const XcdBarrier& b) {
    asm volatile("s_waitcnt vmcnt(0)" ::: "memory");
    __syncthreads();
    if (threadIdx.x == 0) {
        unsigned* bar = b.bar;
        __builtin_amdgcn_s_waitcnt(0);
        unsigned nloc = b.st[0], nx = b.st[1];
        if (nloc == 0u) { xcd_barrier_complete(bar, b.x, nloc, nx); b.st[0] = nloc; b.st[1] = nx; }
        const unsigned old = xb_add(&bar[XB_XSUB(b.x)], 1u);
        const unsigned gen = old / nloc;
        if (old + 1u == (gen + 1u) * nloc) {
            __builtin_amdgcn_fence(__ATOMIC_RELEASE, "agent");
            asm volatile("s_waitcnt vmcnt(0)" ::: "memory");
            const unsigned og = xb_add(&bar[XB_TOP], 1u);
            const unsigned tg = og / nx;
            if (og + 1u == (tg + 1u) * nx) xb_add(&bar[XB_TOPGEN], 1u);
            else XB_SPIN(xb_ld(&bar[XB_TOPGEN]) == tg, bar);
            __builtin_amdgcn_fence(__ATOMIC_ACQUIRE, "agent");
            xb_add(&bar[XB_XGEN(b.x)], 1u);
            asm volatile("s_waitcnt vmcnt(0)" ::: "memory");
        } else {
            XB_SPIN(xb_ld(&bar[XB_XGEN(b.x)]) == gen, bar);
            __builtin_amdgcn_fence(__ATOMIC_ACQUIRE, "agent");
            asm volatile("s_waitcnt vmcnt(0)" ::: "memory");
        }
    }
    __syncthreads();
}

DI void xcd_arrive(const XcdBarrier& b, unsigned* w) {
    asm volatile("s_waitcnt vmcnt(0)" ::: "memory");
    __syncthreads();
    if (threadIdx.x == 0) {
        const unsigned nloc = b.st[0];
        const unsigned old = xb_add(&w[64 * b.x], 1u);
        if (old + 1u == nloc) { __builtin_amdgcn_fence(__ATOMIC_RELEASE, "agent"); asm volatile("s_waitcnt vmcnt(0)" ::: "memory"); (void)xb_add(&w[64 * 16], 1u); }
    }
}
DI void xcd_wait_all(const XcdBarrier& b, unsigned* w) {
    if (threadIdx.x == 0) { const unsigned nx = b.st[1]; unsigned sp = 0; while (xb_ld(&w[64 * 16]) < nx) { __builtin_amdgcn_s_sleep(1); if (++sp > (1u << 22)) break; }
        __builtin_amdgcn_fence(__ATOMIC_ACQUIRE, "agent"); asm volatile("s_waitcnt vmcnt(0)" ::: "memory"); }
    __syncthreads();
}

typedef const float* cfp_t;
struct Args { const float* in[27]; float* out; unsigned char* ws; int ph_lo, ph_hi, li, pad; };
struct Frame {
    LAS unsigned char* lds;
    int tid, lane, wave, G, bid;
    const __attribute__((address_space(4))) cfp_t* in;
    float* out; unsigned char* ws;
};
#define WSP(T, off) ((T*)(F.ws + (off)))

namespace pg8 {
constexpr int BM = 256, BK = 64, HALF = 128, HTB = HALF * BK * 2, STAGE_BYTES = 8 * HTB, NXCD = 8, WGM = 8;
DI int lds_byte(int r, int c) { const int st = (r >> 4) * 2 + (c >> 5), rr = r & 15, cc = c & 31, ob = rr * 64 + cc * 2; return st * 1024 + (ob ^ (((ob >> 9) & 1) << 5)); }
DI void stage_rc(int b, int& R, int& C) { const int st = b / 1024, sb = b % 1024, swz = sb ^ (((sb >> 9) & 1) << 5); R = (st >> 1) * 16 + swz / 64; C = (st & 1) * 32 + (swz % 64) / 2; }
DI int perm32(int rho) { const int n = rho >> 4, i = rho & 15; return 8 * (i >> 2) + 4 * n + (i & 3); }
struct Unit { int pm, pn, e, cnt, base, aux; };
DI bool static_next(int nM, int nN, int G, int c, int i, Unit& u) {
    const int nwg = nM * nN; const long L = (long)i * G + c; if (L >= nwg) return false;
    int wgid = (int)L; { const int q = nwg / NXCD, r = nwg % NXCD, xcd = wgid % NXCD, off = wgid / NXCD; wgid = (xcd < r ? xcd * (q + 1) : r * (q + 1) + (xcd - r) * q) + off; }
    const int nig = WGM * nN, gid = wgid / nig, fm = gid * WGM, gsz = (nM - fm) < WGM ? (nM - fm) : WGM;
    u.pm = fm + ((wgid % nig) % gsz); u.pn = (wgid % nig) / gsz; u.e = 0; u.cnt = 0; u.base = 0; u.aux = 0; return true;
}

template <class Prob, bool ALIGN_EPI>
DI void gemm_phase(LAS unsigned char* lds, const Prob& P, const int tid) {
    const int wid = __builtin_amdgcn_readfirstlane(tid >> 6), lane = tid & 63, wr = wid >> 2, wc = wid & 3, fr = lane & 15, fq = lane >> 4;
    const int K = P.K, nt = K / BK;
    constexpr bool GA = Prob::GATHER;
    unsigned voffB[2], voffA[2];
#pragma unroll
    for (int i = 0; i < 2; ++i) { int R, C; stage_rc(tid * 16 + i * 8192, R, C); const int Rb = Prob::PERM ? ((R & ~31) + perm32(R & 31)) : R; voffB[i] = (unsigned)(Rb * K + C) * 2u; voffA[i] = (unsigned)(R * K + C) * 2u; }
    const size_t kstep = (size_t)(BK * 2);
    const size_t hstepB = (size_t)HALF * K * 2;
    const unsigned ldsw = (unsigned)wid * 1024u;
    const int aoffL = lds_byte(wr * 64 + fr, fq * 8), boffL = lds_byte(wc * 32 + fr, fq * 8);
    const char* Abase = (const char*)P.A;
#define PG8_SA(b, h) (((b) * 2 + (h)) * HTB)
#define PG8_SB(b, h) ((4 + (b) * 2 + (h)) * HTB)
#define PG8_STG_B(bufoff, gbase) do { _Pragma("unroll") for (int _i = 0; _i < 2; ++_i) \
        __builtin_amdgcn_global_load_lds((const unsigned*)((const char*)(gbase) + voffB[_i]), (LAS unsigned*)(lds + (bufoff) + ldsw + _i * 8192), 16, 0, 0); } while (0)
#define PG8_STG_A(bufoff, h, kbyte) do { _Pragma("unroll") for (int _i = 0; _i < 2; ++_i) { \
        const char* _p; if constexpr (GA) _p = Abase + (size_t)(kbyte) + aoff[h][_i]; else _p = cA + (size_t)(h) * hstepB + (size_t)(kbyte) + voffA[_i]; \
        __builtin_amdgcn_global_load_lds((const unsigned*)_p, (LAS unsigned*)(lds + (bufoff) + ldsw + _i * 8192), 16, 0, 0); } } while (0)
#define PG8_LDA(dst, b, h) do { _Pragma("unroll") for (int m = 0; m < 4; ++m) _Pragma("unroll") for (int k = 0; k < 2; ++k) dst[m][k] = *(const LAS bf16x8*)(lds + PG8_SA(b, h) + aoffL + m * 2048 + k * 1024); } while (0)
#define PG8_LDB(dst, b, h) do { _Pragma("unroll") for (int n = 0; n < 2; ++n) _Pragma("unroll") for (int k = 0; k < 2; ++k) dst[n][k] = *(const LAS bf16x8*)(lds + PG8_SB(b, h) + boffL + n * 2048 + k * 1024); } while (0)
#define PG8_MMA(ai, bj, At, Bt) do { __builtin_amdgcn_s_setprio(1); _Pragma("unroll") for (int m = 0; m < 4; ++m) _Pragma("unroll") for (int n = 0; n < 2; ++n) _Pragma("unroll") for (int k = 0; k < 2; ++k) \
        acc[ai][bj][m][n] = __builtin_amdgcn_mfma_f32_16x16x32_bf16(Bt[n][k], At[m][k], acc[ai][bj][m][n], 0, 0, 0); __builtin_amdgcn_s_setprio(0); } while (0)
#define PG8_WAIT_V(n) asm volatile("s_waitcnt vmcnt(" #n ")" ::: "memory")
#define PG8_WAIT_L(n) asm volatile("s_waitcnt lgkmcnt(" #n ")" ::: "memory")
#define PG8_BAR __builtin_amdgcn_s_barrier()
#define PG8_SCHED __builtin_amdgcn_sched_barrier(0)
    Unit cur, nxt; int ui = 0;
    if (!P.next(0, cur)) return;
    f32x4 acc[2][2][4][2];
#pragma unroll
    for (int a = 0; a < 2; ++a)
#pragma unroll
        for (int b = 0; b < 2; ++b)
#pragma unroll
            for (int m = 0; m < 4; ++m)
#pragma unroll
                for (int n = 0; n < 2; ++n) acc[a][b][m][n] = (f32x4){0.f, 0.f, 0.f, 0.f};
    bf16x8 At[4][2], B0[2][2], B1[2][2];
    unsigned aoff[2][2] = {{0u, 0u}, {0u, 0u}}, noff[2][2] = {{0u, 0u}, {0u, 0u}};
    const char* cA = Abase; const char* nA = Abase;
    if constexpr (GA) P.aoffs(cur, tid, aoff); else cA = Abase + (size_t)P.arow0(cur) * K * 2;
    const char* cB = P.bbase(cur);
    PG8_STG_B(PG8_SB(0, 0), cB); PG8_STG_B(PG8_SB(0, 1), cB + hstepB); PG8_STG_A(PG8_SA(0, 0), 0, 0); PG8_STG_A(PG8_SA(0, 1), 1, 0);
    if (wr == 1) PG8_BAR;
    PG8_WAIT_V(2); PG8_BAR;
    PG8_STG_B(PG8_SB(1, 0), cB + kstep); PG8_STG_A(PG8_SA(1, 0), 0, kstep); PG8_STG_B(PG8_SB(1, 1), cB + hstepB + kstep);
    PG8_WAIT_V(6); PG8_BAR;
    for (;;) {
        const bool has_next = P.next(ui + 1, nxt);
        const char* nB = cB; nA = cA;
        if (has_next) { nB = P.bbase(nxt); if constexpr (GA) P.aoffs(nxt, tid, noff); else nA = Abase + (size_t)P.arow0(nxt) * K * 2; }
        else if constexpr (GA) { noff[0][0] = aoff[0][0]; noff[0][1] = aoff[0][1]; noff[1][0] = aoff[1][0]; noff[1][1] = aoff[1][1]; }
        if constexpr (GA) { *(LAS u32x4*)(lds + LDS_AUX + 2048 + tid * 16) = (u32x4){noff[0][0], noff[0][1], noff[1][0], noff[1][1]}; }
        for (int t = 0; t < nt; t += 2) {
            const bool last = (t == nt - 2);
            const size_t k1 = (size_t)(t + 1) * kstep;
            const size_t k2 = last ? (size_t)0 : (size_t)(t + 2) * kstep, k3 = k2 + kstep;
            const char* b2 = last ? nB : cB + (size_t)(t + 2) * kstep; const char* b3 = b2 + kstep;
            PG8_LDB(B0, 0, 0); PG8_LDB(B1, 0, 1); PG8_SCHED; PG8_LDA(At, 0, 0); PG8_STG_A(PG8_SA(1, 1), 1, k1);
            PG8_WAIT_V(8); PG8_WAIT_L(0); PG8_BAR; PG8_MMA(0, 0, At, B0); PG8_MMA(0, 1, At, B1); PG8_BAR; PG8_SCHED;
            if (last) { if constexpr (GA) { const u32x4 nq = *(const LAS u32x4*)(lds + LDS_AUX + 2048 + tid * 16); aoff[0][0] = nq[0]; aoff[0][1] = nq[1]; aoff[1][0] = nq[2]; aoff[1][1] = nq[3]; } else cA = nA; }
            PG8_LDA(At, 0, 1); PG8_STG_B(PG8_SB(0, 0), b2); PG8_STG_B(PG8_SB(0, 1), b2 + hstepB); PG8_STG_A(PG8_SA(0, 0), 0, k2);
            PG8_WAIT_V(8); PG8_WAIT_L(0); PG8_BAR; PG8_MMA(1, 0, At, B0); PG8_MMA(1, 1, At, B1); PG8_BAR; PG8_SCHED;
            PG8_LDB(B0, 1, 0); PG8_LDB(B1, 1, 1); PG8_SCHED; PG8_LDA(At, 1, 0); PG8_STG_A(PG8_SA(0, 1), 1, k2);
            PG8_WAIT_V(8); PG8_WAIT_L(0); PG8_BAR; PG8_MMA(0, 0, At, B0); PG8_MMA(0, 1, At, B1); PG8_BAR; PG8_SCHED;
            PG8_LDA(At, 1, 1); PG8_STG_B(PG8_SB(1, 0), b3); PG8_STG_B(PG8_SB(1, 1), b3 + hstepB); PG8_STG_A(PG8_SA(1, 0), 0, k3);
            PG8_WAIT_V(8); PG8_WAIT_L(0); PG8_BAR; PG8_MMA(1, 0, At, B0); PG8_MMA(1, 1, At, B1); PG8_BAR; PG8_SCHED;
        }
        if constexpr (ALIGN_EPI) { if (wr == 0) PG8_BAR; }
        P.epi(acc, cur, wr, wc, fr, fq);
        if (!has_next) break;
#pragma unroll
        for (int a = 0; a < 2; ++a)
#pragma unroll
            for (int b = 0; b < 2; ++b)
#pragma unroll
                for (int m = 0; m < 4; ++m)
#pragma unroll
                    for (int n = 0; n < 2; ++n) acc[a][b][m][n] = (f32x4){0.f, 0.f, 0.f, 0.f};
        cur = nxt; cB = nB; ++ui;
        if constexpr (ALIGN_EPI) { if (wr == 1) PG8_BAR; }
    }
    PG8_WAIT_V(0);
    if constexpr (!ALIGN_EPI) { if (wr == 0) PG8_BAR; }
    PG8_BAR;
#undef PG8_SA
#undef PG8_SB
#undef PG8_STG_A
#undef PG8_STG_B
#undef PG8_LDA
#undef PG8_LDB
#undef PG8_MMA
#undef PG8_WAIT_V
#undef PG8_WAIT_L
#undef PG8_BAR
#undef PG8_SCHED
}

template <class Prob>
DI void gemm_phase_pair(LAS unsigned char* lds, const Prob& P, const int tid) {
    const int wid = __builtin_amdgcn_readfirstlane(tid >> 6), lane = tid & 63, wr = wid >> 2, wc = wid & 3, fr = lane & 15, fq = lane >> 4;
    constexpr int KP = 512, nt = 16;
    unsigned voffB[2];
#pragma unroll
    for (int i = 0; i < 2; ++i) { int R, C; stage_rc(tid * 16 + i * 8192, R, C); const int Rb = Prob::PERM ? ((R & ~31) + perm32(R & 31)) : R; voffB[i] = (unsigned)(Rb * KP + C) * 2u; }
    const size_t kstep = (size_t)(BK * 2);
    const size_t hstepB = (size_t)HALF * KP * 2;
    const unsigned ldsw = (unsigned)wid * 1024u;
    const int aoffL = lds_byte(wr * 64 + fr, fq * 8), boffL = lds_byte(wc * 32 + fr, fq * 8);
    const char* Abase = (const char*)P.A;
    LAS unsigned char* park = lds + LDS_AUX + 2048 + tid * 48;
#define PG8_SA(b, h) (((b) * 2 + (h)) * HTB)
#define PG8_SB(b, h) ((4 + (b) * 2 + (h)) * HTB)
#define PG8_STG_B(bufoff, gbase) do { _Pragma("unroll") for (int _i = 0; _i < 2; ++_i) \
        __builtin_amdgcn_global_load_lds((const unsigned*)((const char*)(gbase) + voffB[_i]), (LAS unsigned*)(lds + (bufoff) + ldsw + _i * 8192), 16, 0, 0); } while (0)
#define PG8_STG_A(bufoff, h, kbyte) do { _Pragma("unroll") for (int _i = 0; _i < 2; ++_i) \
        __builtin_amdgcn_global_load_lds((const unsigned*)(Abase + (size_t)(kbyte) + aoff[h][_i]), (LAS unsigned*)(lds + (bufoff) + ldsw + _i * 8192), 16, 0, 0); } while (0)
#define PG8_LDA(dst, b, h) do { _Pragma("unroll") for (int m = 0; m < 4; ++m) _Pragma("unroll") for (int k = 0; k < 2; ++k) dst[m][k] = *(const LAS bf16x8*)(lds + PG8_SA(b, h) + aoffL + m * 2048 + k * 1024); } while (0)
#define PG8_LDB(dst, b, h) do { _Pragma("unroll") for (int n = 0; n < 2; ++n) _Pragma("unroll") for (int k = 0; k < 2; ++k) dst[n][k] = *(const LAS bf16x8*)(lds + PG8_SB(b, h) + boffL + n * 2048 + k * 1024); } while (0)
#define PG8_MMA(ai, bj, At, Bt) do { __builtin_amdgcn_s_setprio(1); _Pragma("unroll") for (int m = 0; m < 4; ++m) _Pragma("unroll") for (int n = 0; n < 2; ++n) _Pragma("unroll") for (int k = 0; k < 2; ++k) \
        acc[ai][bj][m][n] = __builtin_amdgcn_mfma_f32_16x16x32_bf16(Bt[n][k], At[m][k], acc[ai][bj][m][n], 0, 0, 0); __builtin_amdgcn_s_setprio(0); } while (0)
#define PG8_WAIT_V(n) asm volatile("s_waitcnt vmcnt(" #n ")" ::: "memory")
#define PG8_WAIT_L(n) asm volatile("s_waitcnt lgkmcnt(" #n ")" ::: "memory")
#define PG8_BAR __builtin_amdgcn_s_barrier()
#define PG8_SCHED __builtin_amdgcn_sched_barrier(0)
#define PG8_PARK(slot, v) (*(LAS u32x4*)(park + 16 * (slot)) = (u32x4){v[0][0], v[0][1], v[1][0], v[1][1]})
#define PG8_UNPARK(slot) do { const u32x4 _q = *(const LAS u32x4*)(park + 16 * (slot)); aoff[0][0] = _q[0]; aoff[0][1] = _q[1]; aoff[1][0] = _q[2]; aoff[1][1] = _q[3]; } while (0)
    Unit cur, nxt; int ui = 0;
    if (!P.next(0, cur)) return;
    f32x4 acc[2][2][4][2];
#pragma unroll
    for (int a = 0; a < 2; ++a)
#pragma unroll
        for (int b = 0; b < 2; ++b)
#pragma unroll
            for (int m = 0; m < 4; ++m)
#pragma unroll
                for (int n = 0; n < 2; ++n) acc[a][b][m][n] = (f32x4){0.f, 0.f, 0.f, 0.f};
    bf16x8 At[4][2], B0[2][2], B1[2][2];
    unsigned aoff[2][2];
    { unsigned tb[2][2]; P.aoffs2(cur, tid, aoff, tb); PG8_PARK(0, tb); }
    const char* cBa = P.bbase_a(cur); const char* cBb = P.bbase_b(cur);
    PG8_STG_B(PG8_SB(0, 0), cBa); PG8_STG_B(PG8_SB(0, 1), cBa + hstepB); PG8_STG_A(PG8_SA(0, 0), 0, 0); PG8_STG_A(PG8_SA(0, 1), 1, 0);
    if (wr == 1) PG8_BAR;
    PG8_WAIT_V(2); PG8_BAR;
    PG8_STG_B(PG8_SB(1, 0), cBa + kstep); PG8_STG_A(PG8_SA(1, 0), 0, kstep); PG8_STG_B(PG8_SB(1, 1), cBa + hstepB + kstep);
    PG8_WAIT_V(6); PG8_BAR;
    for (;;) {
        const bool has_next = P.next(ui + 1, nxt);
        const char* nBa = cBa; const char* nBb = cBb;
        {
            unsigned ta[2][2], tb[2][2];
            if (has_next) { P.aoffs2(nxt, tid, ta, tb); nBa = P.bbase_a(nxt); nBb = P.bbase_b(nxt); } else P.aoffs2(cur, tid, ta, tb);
            PG8_PARK(2, ta); PG8_PARK((ui + 1) & 1, tb);
        }
        const bool hu = (cur.cnt - cur.pm * 256) <= 128;
        for (int t = 0; t < nt; t += 2) {
            const bool last = (t == nt - 2);
            const size_t k1 = (size_t)((t + 1) & 7) * kstep;
            const int t2 = last ? 0 : t + 2;
            const size_t k2 = (size_t)(t2 & 7) * kstep, k3 = k2 + kstep;
            const char* b2 = last ? nBa : ((t2 < 8 ? cBa : cBb) + k2); const char* b3 = b2 + kstep;
            PG8_LDB(B0, 0, 0); PG8_LDB(B1, 0, 1); PG8_SCHED; PG8_LDA(At, 0, 0); PG8_STG_A(PG8_SA(1, 1), 1, k1);
            PG8_WAIT_V(8); PG8_WAIT_L(0); PG8_BAR; PG8_MMA(0, 0, At, B0); PG8_MMA(0, 1, At, B1); PG8_BAR; PG8_SCHED;
            if (t == 6) PG8_UNPARK(ui & 1);
            if (last) PG8_UNPARK(2);
            PG8_LDA(At, 0, 1); PG8_STG_B(PG8_SB(0, 0), b2); PG8_STG_B(PG8_SB(0, 1), b2 + hstepB); PG8_STG_A(PG8_SA(0, 0), 0, k2);
            PG8_WAIT_V(8); PG8_WAIT_L(0); PG8_BAR; if (!hu) { PG8_MMA(1, 0, At, B0); PG8_MMA(1, 1, At, B1); } PG8_BAR; PG8_SCHED;
            PG8_LDB(B0, 1, 0); PG8_LDB(B1, 1, 1); PG8_SCHED; PG8_LDA(At, 1, 0); PG8_STG_A(PG8_SA(0, 1), 1, k2);
            PG8_WAIT_V(8); PG8_WAIT_L(0); PG8_BAR; PG8_MMA(0, 0, At, B0); PG8_MMA(0, 1, At, B1); PG8_BAR; PG8_SCHED;
            PG8_LDA(At, 1, 1); PG8_STG_B(PG8_SB(1, 0), b3); PG8_STG_B(PG8_SB(1, 1), b3 + hstepB); PG8_STG_A(PG8_SA(1, 0), 0, k3);
            PG8_WAIT_V(8); PG8_WAIT_L(0); PG8_BAR; if (!hu) { PG8_MMA(1, 0, At, B0); PG8_MMA(1, 1, At, B1); } PG8_BAR; PG8_SCHED;
        }
        if (wr == 0) PG8_BAR;
        P.epi(acc, cur, wr, wc, fr, fq);
        if (!has_next) break;
#pragma unroll
        for (int a = 0; a < 2; ++a)
#pragma unroll
            for (int b = 0; b < 2; ++b)
#pragma unroll
                for (int m = 0; m < 4; ++m)
#pragma unroll
                    for (int n = 0; n < 2; ++n) acc[a][b][m][n] = (f32x4){0.f, 0.f, 0.f, 0.f};
        cur = nxt; cBa = nBa; cBb = nBb; ++ui;
        if (wr == 1) PG8_BAR;
    }
    PG8_WAIT_V(0);
    PG8_BAR;
#undef PG8_SA
#undef PG8_SB
#undef PG8_STG_A
#undef PG8_STG_B
#undef PG8_LDA
#undef PG8_LDB
#undef PG8_MMA
#undef PG8_WAIT_V
#undef PG8_WAIT_L
#undef PG8_BAR
#undef PG8_SCHED
#undef PG8_PARK
#undef PG8_UNPARK
}
}
using pg8::Unit;


struct MoeTab { int ce[32], sb[32], tpg[33], cp[112], tpf[113], tph[113]; };
constexpr int LCAP = 32768;
DI int pair_lo(int p) { int i = 0; _Pragma("unroll") for (int k = 1; k < 7; ++k) if (p >= k * (15 - k) / 2) i = k; return i; }
DI int pair_hi(int p, int i) { return p - i * (15 - i) / 2 + i + 1; }

struct ProbIn {
    static constexpr bool PERM = true, GATHER = false;
    int K; const bf16_t* A; const bf16_t* Bt; int G, c;
    bf16_t* Pout; const float* ss1; float* lf; const float* bfx; unsigned* kmax;
    DI bool next(int i, Unit& u) const { return pg8::static_next(128, 12, G, c, i, u); }
    DI int arow0(const Unit& u) const { return u.pm * 256; }
    DI const char* bbase(const Unit& u) const { return (const char*)Bt + (size_t)u.pn * 256 * K * 2; }
    DI void epi(const f32x4 (&acc)[2][2][4][2], const Unit& u, int wr, int wc, int fr, int fq) const {
        float km0 = 0.f, km1 = 0.f;
        float rs[8];
        {
            f32x4 sv[8];
#pragma unroll
            for (int g = 0; g < 8; ++g) sv[g] = *(const f32x4*)(ss1 + (size_t)(u.pm * 256 + (g >> 2) * 128 + wr * 64 + (g & 3) * 16 + fr) * 16 + 4 * fq);
#pragma unroll
            for (int g = 0; g < 8; ++g) { float ss = (sv[g][0] + sv[g][1]) + (sv[g][2] + sv[g][3]); ss += __shfl_xor(ss, 16); ss += __shfl_xor(ss, 32);
                rs[g] = __builtin_amdgcn_rsqf(ss * (1.f / 1024.f) + 1e-6f); }
        }
#pragma unroll
        for (int ai = 0; ai < 2; ++ai)
#pragma unroll
            for (int m = 0; m < 4; ++m) {
                const int row = u.pm * 256 + ai * 128 + wr * 64 + m * 16 + fr;
                const float rstd = rs[ai * 4 + m];
                {
                    bf16_t* rowp = Pout + (size_t)row * PP + u.pn * 256 + wc * 32 + 8 * fq;
#pragma unroll
                    for (int bj = 0; bj < 2; ++bj) { const f32x4 v0 = acc[ai][bj][m][0] * rstd, v1 = acc[ai][bj][m][1] * rstd;
                        u32x4 w; w.x = pk2(v0[0], v0[1]); w.y = pk2(v0[2], v0[3]); w.z = pk2(v1[0], v1[1]); w.w = pk2(v1[2], v1[3]);
                        *(u32x4*)(rowp + bj * 128) = w; }
                    if (u.pn == 10) {
#pragma unroll
                        for (int bj = 0; bj < 2; ++bj) { const f32x4 v0 = acc[ai][bj][m][0] * rstd, v1 = acc[ai][bj][m][1] * rstd;
                            float p = ((v0[0] * v0[0] + v0[1] * v0[1]) + (v0[2] * v0[2] + v0[3] * v0[3])) + ((v1[0] * v1[0] + v1[1] * v1[1]) + (v1[2] * v1[2] + v1[3] * v1[3]));
                            p += __shfl_xor(p, 16); p += __shfl_xor(p, 32);
                            if (bj == 0) km0 = fmaxf(km0, p); else km1 = fmaxf(km1, p); }
                    }
                }
            }
        if (u.pn == 10) {
#pragma unroll
            for (int o = 1; o < 16; o <<= 1) { km0 = fmaxf(km0, __shfl_xor(km0, o)); km1 = fmaxf(km1, __shfl_xor(km1, o)); }
            if (fr == 0 && fq == 0) { const int b = (u.pm * 256) >> 11;
                __hip_atomic_fetch_max(kmax + ((b * 4 + 0 + (wc >> 1)) * 2 + (wc & 1)), __float_as_uint(km0), __ATOMIC_RELAXED, __HIP_MEMORY_SCOPE_AGENT);
                __hip_atomic_fetch_max(kmax + ((b * 4 + 2 + (wc >> 1)) * 2 + (wc & 1)), __float_as_uint(km1), __ATOMIC_RELAXED, __HIP_MEMORY_SCOPE_AGENT); }
        }
    }
};

struct ProbOut {
    static constexpr bool PERM = false, GATHER = false;
    int K; const bf16_t* A; const bf16_t* Bt; int G, c;
    const float* base; float* out; float ascale;
    DI bool next(int i, Unit& u) const { return pg8::static_next(128, 4, G, c, i, u); }
    DI int arow0(const Unit& u) const { return u.pm * 256; }
    DI const char* bbase(const Unit& u) const { return (const char*)Bt + (size_t)u.pn * 256 * K * 2; }
    DI void epi(const f32x4 (&acc)[2][2][4][2], const Unit& u, int wr, int wc, int fr, int fq) const {
#pragma unroll
        for (int ai = 0; ai < 2; ++ai) {
            f32x4 bv[4][2][2]; size_t offs[4];
#pragma unroll
            for (int m = 0; m < 4; ++m) { offs[m] = (size_t)(u.pm * 256 + ai * 128 + wr * 64 + m * 16 + fr) * D + u.pn * 256 + wc * 32 + 4 * fq;
#pragma unroll
                for (int bj = 0; bj < 2; ++bj)
#pragma unroll
                    for (int n = 0; n < 2; ++n) bv[m][bj][n] = *(const f32x4*)(base + offs[m] + bj * 128 + n * 16); }
#pragma unroll
            for (int m = 0; m < 4; ++m)
#pragma unroll
                for (int bj = 0; bj < 2; ++bj)
#pragma unroll
                    for (int n = 0; n < 2; ++n) *(f32x4*)(out + offs[m] + bj * 128 + n * 16) = bv[m][bj][n] + acc[ai][bj][m][n] * ascale;
            asm volatile("" ::: "memory");
        }
    }
};

DI int moe_L(int i, int G, int c) {
    if ((G & 31) != 0) return i * G + c;
    const int x = c & 7, j = c >> 3, per = G >> 5;
    return ((i * (G >> 2) + x * per + (j >> 2)) << 2) + (j & 3);
}
template <int NL> DI bool moe_unit(const LAS int* tp, int L, Unit& u) {
    const int tt = L >> 2; if (tt >= tp[NL]) return false;
    int e = 0;
#pragma unroll 1
    while (tp[e + 1] <= tt) ++e;
    u.e = e; u.pm = tt - tp[e]; u.pn = L & 3; return true;
}

struct ProbGU {
    static constexpr bool PERM = true, GATHER = true;
    int K; const bf16_t* A; const bf16_t* Bt; int G, c;
    const LAS MoeTab* T; const int* elist; const f32x2* egate; bf16_t* HB;
    DI bool next(int i, Unit& u) const {
        if (!moe_unit<32>(T->tpg, moe_L(i, G, c), u)) return false;
        u.cnt = T->ce[u.e]; u.base = T->sb[u.e]; return true;
    }
    DI int tok_of(const Unit& u, int r) const { return (r < u.cnt) ? elist[(size_t)u.e * LCAP + r] : 0; }
    DI void aoffs(const Unit& u, int tid, unsigned (&o)[2][2]) const {
        int Rr[2], Cc[2]; pg8::stage_rc(tid * 16, Rr[0], Cc[0]); pg8::stage_rc(tid * 16 + 8192, Rr[1], Cc[1]);
#pragma unroll
        for (int h = 0; h < 2; ++h)
#pragma unroll
            for (int i = 0; i < 2; ++i) { const int tok = tok_of(u, u.pm * 256 + h * 128 + Rr[i]); o[h][i] = (unsigned)((tok * K + Cc[i]) * 2); }
    }
    DI const char* bbase(const Unit& u) const { return (const char*)Bt + ((size_t)u.e * 1024 + u.pn * 256) * K * 2; }
    DI void epi(const f32x4 (&acc)[2][2][4][2], const Unit& u, int wr, int wc, int fr, int fq) const {
        float rsv[8], gv[8];
#pragma unroll
        for (int g = 0; g < 8; ++g) { const int r = u.pm * 256 + (g >> 2) * 128 + wr * 64 + (g & 3) * 16 + fr; f32x2 gr = {0.f, 0.f}; if (r < u.cnt) gr = egate[(size_t)u.e * LCAP + r]; gv[g] = gr[0]; rsv[g] = gr[1]; }
#pragma unroll
        for (int ai = 0; ai < 2; ++ai)
#pragma unroll
            for (int m = 0; m < 4; ++m) {
                const int r = u.pm * 256 + ai * 128 + wr * 64 + m * 16 + fr;
                if (r < u.cnt) {
                    const float rs = rsv[ai * 4 + m], gt = gv[ai * 4 + m];
                    float hv[8];
#pragma unroll
                    for (int n = 0; n < 2; ++n)
#pragma unroll
                        for (int j = 0; j < 4; ++j) { const float g = acc[ai][0][m][n][j] * rs, uu = acc[ai][1][m][n][j] * rs; hv[n * 4 + j] = g * sigmoidf_(g) * uu * gt; }
                    u32x4 w; w.x = pk2(hv[0], hv[1]); w.y = pk2(hv[2], hv[3]); w.z = pk2(hv[4], hv[5]); w.w = pk2(hv[6], hv[7]);
                    *(u32x4*)(HB + (size_t)(u.base + r) * EH + u.pn * 128 + wc * 32 + 8 * fq) = w;
                }
            }
    }
};

struct ProbDP {
    static constexpr bool PERM = false;
    const bf16_t* A; const bf16_t* Bt; int G, c;
    const LAS MoeTab* T; const u32x2* plist; float* x; bf16_t* xb; float* ss1;
    DI bool next(int i, Unit& u) const {
        const int L = moe_L(i, G, c), tt = L >> 2, nf = T->tpf[112];
        if (tt < nf) { if (!moe_unit<112>(T->tpf, L, u)) return false; }
        else {
            const int tpr = G >> 2, r0t = ((nf + tpr - 1) / tpr) * tpr; int th = tt - nf;
            if (tt >= r0t) { const int rr = (tt - r0t) / tpr, pos = (tt - r0t) - rr * tpr; th = (r0t - nf) + rr * tpr + (tpr - 1 - pos); }
            if (!moe_unit<112>(T->tph, 4 * th + (L & 3), u)) return false; u.pm = (T->cp[u.e] - 1) >> 8; }
        u.cnt = T->cp[u.e]; const int g = u.e / 28, p = u.e - g * 28, lo = pair_lo(p); u.base = g * 8 + lo; u.aux = g * 8 + pair_hi(p, lo); return true;
    }
    DI void aoffs2(const Unit& u, int tid, unsigned (&oa)[2][2], unsigned (&ob)[2][2]) const {
        int Rr[2], Cc[2]; pg8::stage_rc(tid * 16, Rr[0], Cc[0]); pg8::stage_rc(tid * 16 + 8192, Rr[1], Cc[1]);
        const int sba = T->sb[u.base], sbb = T->sb[u.aux];
#pragma unroll
        for (int h = 0; h < 2; ++h)
#pragma unroll
            for (int i = 0; i < 2; ++i) { const int r = u.pm * 256 + h * 128 + Rr[i]; unsigned pos = 0u; if (r < u.cnt) pos = plist[(size_t)u.e * LCAP + r].y;
                const int ra = (r < u.cnt) ? sba + (int)(pos & 0xffffu) : 0, rb = (r < u.cnt) ? sbb + (int)(pos >> 16) : 0;
                oa[h][i] = (unsigned)((ra * EH + Cc[i]) * 2); ob[h][i] = (unsigned)((rb * EH + Cc[i]) * 2); }
    }
    DI const char* bbase_a(const Unit& u) const { return (const char*)Bt + ((size_t)u.base * 1024 + u.pn * 256) * EH * 2; }
    DI const char* bbase_b(const Unit& u) const { return (const char*)Bt + ((size_t)u.aux * 1024 + u.pn * 256) * EH * 2; }
    DI void epi(const f32x4 (&acc)[2][2][4][2], const Unit& u, int wr, int wc, int fr, int fq) const {
        int tk[8];
#pragma unroll
        for (int g = 0; g < 8; ++g) { const int r = u.pm * 256 + (g >> 2) * 128 + wr * 64 + (g & 3) * 16 + fr; tk[g] = (r < u.cnt) ? (int)plist[(size_t)u.e * LCAP + r].x : 0; }
#pragma unroll
        for (int ai = 0; ai < 2; ++ai) {
            f32x4 xv[4][2][2];
#pragma unroll
            for (int m = 0; m < 4; ++m) { const size_t off = (size_t)tk[ai * 4 + m] * D + u.pn * 256 + wc * 32 + 4 * fq;
#pragma unroll
                for (int bj = 0; bj < 2; ++bj)
#pragma unroll
                    for (int n = 0; n < 2; ++n) xv[m][bj][n] = *(const f32x4*)(x + off + bj * 128 + n * 16); }
#pragma unroll
            for (int m = 0; m < 4; ++m) {
                const int r = u.pm * 256 + ai * 128 + wr * 64 + m * 16 + fr; const bool val = r < u.cnt;
                const size_t off = (size_t)tk[ai * 4 + m] * D + u.pn * 256 + wc * 32 + 4 * fq;
                float ssp = 0.f;
#pragma unroll
                for (int bj = 0; bj < 2; ++bj)
#pragma unroll
                    for (int n = 0; n < 2; ++n) { const size_t o = off + bj * 128 + n * 16; const f32x4 v = xv[m][bj][n] + acc[ai][bj][m][n];
                        if (val) { *(f32x4*)(x + o) = v; u32x2 w; w.x = pk2(v[0], v[1]); w.y = pk2(v[2], v[3]); *(u32x2*)(xb + o) = w; }
                        ssp += (v[0] * v[0] + v[1] * v[1]) + (v[2] * v[2] + v[3] * v[3]); }
                ssp += __shfl_xor(ssp, 16); ssp += __shfl_xor(ssp, 32);
                if (val && fq == 0) ss1[(size_t)tk[ai * 4 + m] * 16 + u.pn * 4 + wc] = ssp;
            }
            asm volatile("" ::: "memory");
        }
    }
};


DI void p0_transpose64(const float* W, int K, int N, int ldn, const float* gs, bf16_t* WT, int mode, LAS unsigned* T, int kb, int nb, int lane) {
    const int k0 = 64 * kb, n0 = 64 * nb, nq = lane & 15, kr = lane >> 4;
    const bool nv = (n0 + 4 * nq) < N;
    f32x4 a[8], b[8];
#pragma unroll
    for (int i = 0; i < 8; ++i) { const int k = k0 + 8 * i + 2 * kr;
        a[i] = nv ? *(const f32x4*)(W + (size_t)k * ldn + n0 + 4 * nq) : (f32x4){0.f, 0.f, 0.f, 0.f};
        b[i] = nv ? *(const f32x4*)(W + (size_t)(k + 1) * ldn + n0 + 4 * nq) : (f32x4){0.f, 0.f, 0.f, 0.f}; }
#pragma unroll
    for (int i = 0; i < 8; ++i) { const int k = k0 + 8 * i + 2 * kr; float g0 = 1.f, g1 = 1.f; if (gs) { g0 = gs[k]; g1 = gs[k + 1]; }
#pragma unroll
        for (int jj = 0; jj < 4; ++jj) T[(4 * nq + jj) * 36 + 4 * i + kr] = pk2(a[i][jj] * g0, b[i][jj] * g1); }
    asm volatile("s_waitcnt lgkmcnt(0)" ::: "memory");
    const int c = lane & 7;
#pragma unroll
    for (int p = 0; p < 8; ++p) { const int nl = 8 * p + (lane >> 3), n = n0 + nl;
        const u32x4 o = *(const LAS u32x4*)(T + nl * 36 + 4 * c);
        const int drow = (mode == 0) ? n : (((n >> 7) << 8) + (n & 127) + (mode == 2 ? 128 : 0));
        *(u32x4*)(WT + (size_t)drow * K + k0 + 8 * c) = o; }
    asm volatile("s_waitcnt lgkmcnt(0)" ::: "memory");
}
DI void p0_prologue(Frame& F) {
    LAS unsigned* scr = (LAS unsigned*)(F.lds + F.wave * 16384);
    const int gw = F.bid * 8 + F.wave, NGW = F.G * 8;
    constexpr int I_IN = 16 * 52, I_OUT = 16 * 16, I_GU = 16 * 8, I_DN = 8 * 16;
    constexpr int S0 = DEPTH * I_IN, S1 = S0 + DEPTH * I_OUT, S2 = S1 + DEPTH * NE * I_GU, S3 = S2 + DEPTH * NE * I_GU, S4 = S3 + DEPTH * NE * I_DN;
    for (int it = gw; it < S4; it += NGW) {
        if (it < S0) { const int l = it / I_IN, r = it % I_IN;
            p0_transpose64(F.in[2] + (size_t)l * D * 3076, D, 3076, 3076, F.in[1] + l * D, WSP(bf16_t, WS_BIN) + (size_t)l * NIN * D, 0, scr, r / 52, r % 52, F.lane);
        } else if (it < S1) { const int q = it - S0, l = q / I_OUT, r = q % I_OUT;
            p0_transpose64(F.in[17] + (size_t)l * D * D, D, D, D, nullptr, WSP(bf16_t, WS_BOUT) + (size_t)l * D * D, 0, scr, r / 16, r % 16, F.lane);
        } else if (it < S3) { const int up = it >= S2, q = it - (up ? S2 : S1), le = q / I_GU, r = q % I_GU;
            p0_transpose64(F.in[up ? 24 : 23] + (size_t)le * D * EH, D, EH, EH, F.in[18] + (le / NE) * D, WSP(bf16_t, WS_BGU) + (size_t)le * 1024 * D, up ? 2 : 1, scr, r / 8, r % 8, F.lane);
        } else { const int q = it - S3, le = q / I_DN, r = q % I_DN;
            p0_transpose64(F.in[25] + (size_t)le * EH * D, EH, D, D, nullptr, WSP(bf16_t, WS_BDN) + (size_t)le * D * EH, 0, scr, r / 16, r % 16, F.lane);
        }
    }
    const int gt = F.bid * 512 + F.tid, NGT = F.G * 512;
    for (int i = gt; i < DEPTH * 256 * 256; i += NGT) { const int l = i >> 16, c = (i >> 8) & 255, k = i & 255;
        const float v = k < 64 ? F.in[7][((size_t)l * 64 + k) * 256 + c] : (k < 128 ? F.in[9][((size_t)l * 64 + (k - 64)) * 256 + c] : F.in[10][((size_t)l * 128 + (k - 128)) * 256 + c]);
        WSP(bf16_t, WS_WCAT)[i] = (bf16_t)f2bf(v); }
    for (int i = gt; i < DEPTH * 4 * 128 * 128; i += NGT) { const int t = (i >> 7) & 127, p = i & 15, hh = p >> 3, j = p & 7, s = (i & 112) + (j < 4 ? 4 * hh + j : 8 + 4 * hh + (j - 4));
        WSP(bf16_t, WS_GMW)[i] = (bf16_t)f2bf(s <= t ? F.in[3][(i & ~127) + s] : 0.f); }
    for (int i = gt; i < DEPTH * 36 * 1024; i += NGT) { const int l = i / (36 * 1024), j = (i / 1024) % 36, k = i & 1023;
        const float g = F.in[18][l * D + k];
        const float w = j < 4 ? F.in[19][((size_t)l * D + k) * 4 + j] : F.in[21][((size_t)l * D + k) * 32 + (j - 4)];
        WSP(float, WS_RTW)[i] = g * w; }
    for (int m0 = gw * 4; m0 < NT; m0 += NGW * 4) {
        f32x4 v[4][4];
#pragma unroll
        for (int r = 0; r < 4; ++r) { const f32x4* xr = (const f32x4*)(F.in[0] + (size_t)(m0 + r) * D) + F.lane;
#pragma unroll
            for (int j = 0; j < 4; ++j) v[r][j] = xr[64 * j]; }
#pragma unroll
        for (int r = 0; r < 4; ++r) { float s = 0.f; u32x2* o8 = (u32x2*)(WSP(bf16_t, WS_XB) + (size_t)(m0 + r) * D) + F.lane;
#pragma unroll
            for (int j = 0; j < 4; ++j) { const f32x4 q = v[r][j]; s += (q[0] * q[0] + q[1] * q[1]) + (q[2] * q[2] + q[3] * q[3]); u32x2 w; w.x = pk2(q[0], q[1]); w.y = pk2(q[2], q[3]); o8[64 * j] = w; }
            s = wave_sum(s);
            if (F.lane < 16) WSP(float, WS_SS1)[(size_t)(m0 + r) * 16 + F.lane] = (F.lane == 0) ? s : 0.f; }
    }
}

constexpr int AT_KOFF = 0, AT_VOFF = 18432, AT_CUM = 36864, AT_MISC = 45056, AT_ROWB = 144, AT_BUFB = 64 * 144;
DI void at_load_tile(const bf16_t* Pb, int colK, int colV, int jt, int tid, u32x4& kreg, u32x4& vreg) {
    const int row = tid >> 3, ch = tid & 7; const bf16_t* p = Pb + (size_t)(64 * jt + row) * PP + ch * 8;
    kreg = *(const u32x4*)(p + colK); vreg = *(const u32x4*)(p + colV);
}
DI void at_store_tile(LAS unsigned char* lds, int buf, int tid, const u32x4& kreg, const u32x4& vreg) {
    const int row = tid >> 3, ch = tid & 7;
    *(LAS u32x4*)(lds + AT_KOFF + buf * AT_BUFB + row * AT_ROWB + ch * 16) = kreg;
    *(LAS u32x4*)(lds + AT_VOFF + buf * AT_BUFB + row * AT_ROWB + ch * 16) = vreg;
}
DI void at_qk(const LAS unsigned char* kb, const bf16x8 (&qf)[4], int r32, int h2, f32x16& s0, f32x16& s1) {
    const LAS unsigned char* p = kb + r32 * AT_ROWB + h2 * 16;
#pragma unroll
    for (int d0 = 0; d0 < 4; ++d0) {
        const bf16x8 a0 = *(const LAS bf16x8*)(p + d0 * 32), a1 = *(const LAS bf16x8*)(p + 32 * AT_ROWB + d0 * 32);
        s0 = MFMA32(a0, qf[d0], s0); s1 = MFMA32(a1, qf[d0], s1);
    }
}
DI bf16x8 pack8(const f32x16& x, int s) {
    u32x4 p; p.x = pk2(x[8 * s], x[8 * s + 1]); p.y = pk2(x[8 * s + 2], x[8 * s + 3]); p.z = pk2(x[8 * s + 4], x[8 * s + 5]); p.w = pk2(x[8 * s + 6], x[8 * s + 7]);
    return __builtin_bit_cast(bf16x8, p);
}
DI s16x4 tr_read(const LAS unsigned char* p) { return __builtin_bit_cast(s16x4, __builtin_amdgcn_ds_read_tr16_b64_v4i16((LAS s16x4*)p)); }
DI void at_pv(const LAS unsigned char* vb, const bf16x8 (&pb)[4], int lane, f32x16& o0, f32x16& o1) {
    const int h2 = lane >> 5;
    const LAS unsigned char* base = vb + (4 * h2 + ((lane & 15) >> 2)) * AT_ROWB + (16 * ((lane >> 4) & 1) + 4 * (lane & 3)) * 2;
#pragma unroll
    for (int s = 0; s < 4; ++s) {
        const LAS unsigned char* p = base + 16 * s * AT_ROWB;
        const s16x4 l0 = tr_read(p), h0 = tr_read(p + 8 * AT_ROWB), l1 = tr_read(p + 64), h1 = tr_read(p + 8 * AT_ROWB + 64);
        const bf16x8 a0 = __builtin_shufflevector(l0, h0, 0, 1, 2, 3, 4, 5, 6, 7), a1 = __builtin_shufflevector(l1, h1, 0, 1, 2, 3, 4, 5, 6, 7);
        o0 = MFMA32(a0, pb[s], o0); o1 = MFMA32(a1, pb[s], o1);
    }
}
DI void at_store_out(bf16_t* dst  , const f32x16& o0, const f32x16& o1, float scale, int h2) {
#pragma unroll
    for (int g = 0; g < 4; ++g) {
        u32x2 w0, w1; w0.x = pk2(o0[4 * g] * scale, o0[4 * g + 1] * scale); w0.y = pk2(o0[4 * g + 2] * scale, o0[4 * g + 3] * scale);
        w1.x = pk2(o1[4 * g] * scale, o1[4 * g + 1] * scale); w1.y = pk2(o1[4 * g + 2] * scale, o1[4 * g + 3] * scale);
        *(u32x2*)(dst + 8 * g + 4 * h2) = w0; *(u32x2*)(dst + 32 + 8 * g + 4 * h2) = w1;
    }
}
DI void block_cumsum(const float* src, int n, LAS float* cum, LAS float* wtot, int tid, int lane, int wave) {
    f32x4 v = (f32x4){0.f, 0.f, 0.f, 0.f};
    if (4 * tid < n) v = *(const f32x4*)(src + 4 * tid);
    v[1] += v[0]; v[2] += v[1]; v[3] += v[2];
    float t = v[3];
#pragma unroll
    for (int o = 1; o < 64; o <<= 1) { const float u = __shfl_up(t, o); if (lane >= o) t += u; }
    if (lane == 63) wtot[wave] = t;
    __syncthreads();
    float pre = t - v[3];
    for (int w = 0; w < wave; ++w) pre += wtot[w];
    if (4 * tid < n) { v[0] += pre; v[1] += pre; v[2] += pre; v[3] += pre; *(LAS f32x4*)(cum + 4 * tid) = v; }
    __syncthreads();
}

DI void fx_unit(Frame& F, int layer, int b, int h, int qb) {
    LAS unsigned char* L = F.lds; const int tid = F.tid, lane = F.lane, wid = F.wave, r32 = lane & 31, h2 = lane >> 5;
    const bf16_t* Pb = WSP(bf16_t, WS_P) + (size_t)b * SEQ * PP;
    LAS float* cum = (LAS float*)(L + AT_CUM);
    const int kend = 256 * qb + 256;
    __syncthreads();
    block_cumsum(WSP(float, WS_LF) + (size_t)(b * 4 + h) * SEQ, kend, cum, (LAS float*)(L + AT_MISC), tid, lane, wid);
    const int tw0 = 256 * qb + 32 * wid, tq = tw0 + r32;
    bf16x8 qf[4];
#pragma unroll
    for (int d0 = 0; d0 < 4; ++d0) qf[d0] = *(const bf16x8*)(Pb + (size_t)tq * PP + C_FXQ + h * 64 + 16 * d0 + 8 * h2);
    const float ct2 = cum[tq] * LOG2E;
    float qb2;
    { float qn = 0.f;
#pragma unroll
      for (int d0 = 0; d0 < 4; ++d0) { const u32x4 qq = __builtin_bit_cast(u32x4, qf[d0]);
#pragma unroll
        for (int j = 0; j < 4; ++j) { const float a = bf2f(qq[j] & 0xffffu), c = bf2f(qq[j] >> 16); qn += a * a + c * c; } }
      qn += swap32(qn);
      const unsigned* km = (const unsigned*)(F.ws + WS_CTL) + CW_KMAX + layer * 128 + (b * 4 + h) * 2;
      const float kk2 = __uint_as_float(xb_ld((unsigned*)km)) + __uint_as_float(xb_ld((unsigned*)km + 1));
      qb2 = sqrtf(qn * kk2) * QSCALE2 * 1.01f + 1e-3f; }
    float mrun = -1e30f, lrun = 0.f; f32x16 o0 = {}, o1 = {};
    const int jtop = 4 * qb + 3;
    u32x4 kreg, vreg;
    at_load_tile(Pb, C_FXK + h * 64, C_FXV + h * 64, jtop, tid, kreg, vreg);
    at_store_tile(L, 0, tid, kreg, vreg);
    __syncthreads();
    int buf = 0; bool wskip = false;
    for (int jt = jtop; jt >= 0; --jt) {
        if (jt > 0) at_load_tile(Pb, C_FXK + h * 64, C_FXV + h * 64, jt - 1, tid, kreg, vreg);
        if (64 * jt <= tw0 + 31 && !wskip) {
            f32x16 s0 = {}, s1 = {};
            at_qk(L + AT_KOFF + buf * AT_BUFB, qf, r32, h2, s0, s1);
            const bool needmask = (64 * jt + 63 > tw0);
            float mx = -1e30f;
#pragma unroll
            for (int g = 0; g < 4; ++g) {
                const f32x4 c0 = *(const LAS f32x4*)(cum + 64 * jt + 8 * g + 4 * h2), c1 = *(const LAS f32x4*)(cum + 64 * jt + 32 + 8 * g + 4 * h2);
#pragma unroll
                for (int j = 0; j < 4; ++j) {
                    const int r = 4 * g + j, kv = 64 * jt + 8 * g + 4 * h2 + j;
                    float v0 = s0[r] * QSCALE2 + (ct2 - c0[j] * LOG2E), v1 = s1[r] * QSCALE2 + (ct2 - c1[j] * LOG2E);
                    if (needmask) { if (kv > tq) v0 = -1e30f; if (kv + 32 > tq) v1 = -1e30f; }
                    s0[r] = v0; s1[r] = v1; mx = fmaxf(mx, fmaxf(v0, v1));
                }
            }
            mx = fmaxf(mx, swap32(mx));
            const float mnew = fmaxf(mrun, mx), alpha = ex2(mrun - mnew);
            mrun = mnew;
            float ps = 0.f;
#pragma unroll
            for (int r = 0; r < 16; ++r) { s0[r] = ex2(s0[r] - mnew); s1[r] = ex2(s1[r] - mnew); ps += s0[r] + s1[r]; }
            lrun = lrun * alpha + ps;
#pragma unroll
            for (int r = 0; r < 16; ++r) { o0[r] *= alpha; o1[r] *= alpha; }
            bf16x8 pb[4]; pb[0] = pack8(s0, 0); pb[1] = pack8(s0, 1); pb[2] = pack8(s1, 0); pb[3] = pack8(s1, 1);
            at_pv(L + AT_VOFF + buf * AT_BUFB, pb, lane, o0, o1);
        }
        if (jt > 0) at_store_tile(L, buf ^ 1, tid, kreg, vreg);
        { int wdone = 0; if (jt > 0) wdone = __all(qb2 + (ct2 - cum[64 * jt - 1] * LOG2E) - mrun < -150.f) ? 1 : 0; wskip = wdone != 0; if (lane == 0) *(LAS int*)(L + AT_MISC + 64 + 32 * (jt & 1) + 4 * wid) = wdone; }
        __syncthreads();
        buf ^= 1;
        { const LAS int* fl = (const LAS int*)(L + AT_MISC + 64 + 32 * (jt & 1)); const int alld = fl[0] & fl[1] & fl[2] & fl[3] & fl[4] & fl[5] & fl[6] & fl[7]; if (alld) break; }
    }
    const float ltot = lrun + swap32(lrun);
    at_store_out(WSP(bf16_t, WS_MIX) + (size_t)(b * SEQ + tq) * D + 768 + h * 64, o0, o1, rcpf_(ltot), h2);
}

DI void sb_unit(Frame& F, int b, int h, int qb) {
    LAS unsigned char* L = F.lds; const int tid = F.tid, lane = F.lane, wid = F.wave, r32 = lane & 31, h2 = lane >> 5;
    const bf16_t* Pb = WSP(bf16_t, WS_P) + (size_t)b * SEQ * PP;
    const int tw0 = 256 * qb + 32 * wid, tq = tw0 + r32;
    bf16x8 qf[4];
#pragma unroll
    for (int d0 = 0; d0 < 4; ++d0) qf[d0] = *(const bf16x8*)(Pb + (size_t)tq * PP + C_SBQ + h * 64 + 16 * d0 + 8 * h2);
    bf16x8 uf[2], onesf;
#pragma unroll
    for (int s = 0; s < 2; ++s)
#pragma unroll
        for (int j = 0; j < 8; ++j) uf[s][j] = ((16 * s + 8 * (j >> 2) + 4 * h2 + (j & 3)) > r32) ? (short)0x3F80 : (short)0;
#pragma unroll
    for (int j = 0; j < 8; ++j) onesf[j] = (short)0x3F80;
    float R2 = 0.f; f32x16 o0 = {}, o1 = {};
    const int jtop = 4 * qb + 3;
    u32x4 kreg, vreg;
    __syncthreads();
    at_load_tile(Pb, C_SBK + h * 64, C_SBV + h * 64, jtop, tid, kreg, vreg);
    at_store_tile(L, 0, tid, kreg, vreg);
    __syncthreads();
    int buf = 0; bool wskip = false;
    for (int jt = jtop; jt >= 0; --jt) {
        if (jt > 0) at_load_tile(Pb, C_SBK + h * 64, C_SBV + h * 64, jt - 1, tid, kreg, vreg);
        if (64 * jt <= tw0 + 31 && !wskip) {
            f32x16 s0 = {}, s1 = {};
            at_qk(L + AT_KOFF + buf * AT_BUFB, qf, r32, h2, s0, s1);
            const bool needmask = (64 * jt + 63 >= tw0);
            f32x16 l0, l1;
            float cs = 0.f;
#pragma unroll
            for (int r = 0; r < 16; ++r) {
                const int kv = 64 * jt + crow(r, h2);
                const float z0 = s0[r] * QSCALE2, z1 = s1[r] * QSCALE2;
                const float sp0 = fmaxf(z0, 0.f) + lg2(1.f + ex2(-fabsf(z0))), sp1 = fmaxf(z1, 0.f) + lg2(1.f + ex2(-fabsf(z1)));
                float a0 = -sp0, a1 = -sp1, b0 = z0 - sp0, b1 = z1 - sp1;
                if (needmask) { if (kv >= tq) { a0 = 0.f; b0 = -1e30f; } if (kv + 32 >= tq) { a1 = 0.f; b1 = -1e30f; } }
                l0[r] = a0; l1[r] = a1; s0[r] = b0; s1[r] = b1; cs += a0 + a1;
            }
            f32x16 t0 = {}, t1 = {};
#pragma unroll
            for (int s = 0; s < 2; ++s) {
                const bf16x8 h0 = pack8(l0, s), h1 = pack8(l1, s);
                f32x16 d0_, d1_;
#pragma unroll
                for (int j = 0; j < 8; ++j) { d0_[j] = l0[8 * s + j] - bf2f((unsigned short)h0[j]); d1_[j] = l1[8 * s + j] - bf2f((unsigned short)h1[j]); }
                u32x4 q0, q1; q0.x = pk2(d0_[0], d0_[1]); q0.y = pk2(d0_[2], d0_[3]); q0.z = pk2(d0_[4], d0_[5]); q0.w = pk2(d0_[6], d0_[7]);
                q1.x = pk2(d1_[0], d1_[1]); q1.y = pk2(d1_[2], d1_[3]); q1.z = pk2(d1_[4], d1_[5]); q1.w = pk2(d1_[6], d1_[7]);
                const bf16x8 e0 = __builtin_bit_cast(bf16x8, q0), e1 = __builtin_bit_cast(bf16x8, q1);
                t0 = MFMA32(uf[s], h0, t0); t0 = MFMA32(uf[s], e0, t0); t0 = MFMA32(onesf, h1, t0); t0 = MFMA32(onesf, e1, t0);
                t1 = MFMA32(uf[s], h1, t1); t1 = MFMA32(uf[s], e1, t1);
            }
#pragma unroll
            for (int r = 0; r < 16; ++r) { s0[r] = ex2(s0[r] + R2 + t0[r]); s1[r] = ex2(s1[r] + R2 + t1[r]); }
            R2 += cs + swap32(cs);
            bf16x8 pb[4]; pb[0] = pack8(s0, 0); pb[1] = pack8(s0, 1); pb[2] = pack8(s1, 0); pb[3] = pack8(s1, 1);
            at_pv(L + AT_VOFF + buf * AT_BUFB, pb, lane, o0, o1);
        }
        if (jt > 0) at_store_tile(L, buf ^ 1, tid, kreg, vreg);
        { const int wdone = __all(R2 < -150.f) ? 1 : 0; wskip = wdone != 0; if (lane == 0) *(LAS int*)(L + AT_MISC + 64 + 32 * (jt & 1) + 4 * wid) = wdone; }
        __syncthreads();
        buf ^= 1;
        { const LAS int* fl = (const LAS int*)(L + AT_MISC + 64 + 32 * (jt & 1)); const int alld = fl[0] & fl[1] & fl[2] & fl[3] & fl[4] & fl[5] & fl[6] & fl[7]; if (alld) break; }
    }
    at_store_out(WSP(bf16_t, WS_MIX) + (size_t)(b * SEQ + tq) * D + 0 + h * 64, o0, o1, 1.f, h2);
}
DI void attn_rank_to_unit(int r, int& bh, int& qb) { if (r < 256) { qb = 7 - (r >> 6); bh = r & 63; } else { const int p = r - 256; qb = p >> 6; bh = p & 63; } }

constexpr int GV_ROWB = 544, GO_ROWB = 528, GM_OUTOFF = 128 * GV_ROWB;
DI float sum8(float v) { v += dppf<0xB1, 0xf, true>(v); v += dppf<0x4E, 0xf, true>(v); v += dppf<0x141, 0xf, true>(v); return v; }
DI bf16x8 gm_trfrag(const LAS unsigned char* vn, int lane, int ks, int col0) {
    const int h2 = lane >> 5;
    const LAS unsigned char* p = vn + (16 * ks + 4 * h2 + ((lane & 15) >> 2)) * GV_ROWB + (col0 + 16 * ((lane >> 4) & 1) + 4 * (lane & 3)) * 2;
    const s16x4 lo = tr_read(p), hi = tr_read(p + 8 * GV_ROWB);
    return __builtin_shufflevector(lo, hi, 0, 1, 2, 3, 4, 5, 6, 7);
}
DI void gm_item(Frame& F, int layer, int b, int c) {
    LAS unsigned char* L = F.lds; const int tid = F.tid, lane = F.lane, wid = F.wave, r32 = lane & 31, h2 = lane >> 5;
    const int cg = tid & 31, c0 = 8 * cg, tr = tid >> 5;
    const bf16_t* Pb = WSP(bf16_t, WS_P) + (size_t)(b * SEQ + c * 128) * PP;
    __syncthreads();
#pragma unroll
    for (int hf = 0; hf < 2; ++hf) {
        u32x4 vq[4];
#pragma unroll
        for (int i = 0; i < 4; ++i) vq[i] = *(const u32x4*)(Pb + (size_t)(tr + 16 * (4 * hf + i)) * PP + C_GMV + c0);
#pragma unroll
        for (int i = 0; i < 4; ++i) {
            float ge[8];
#pragma unroll
            for (int j = 0; j < 4; ++j) { ge[2 * j] = geluf_(bf2f(vq[i][j] & 0xffffu)); ge[2 * j + 1] = geluf_(bf2f(vq[i][j] >> 16)); }
            const float mean = sum8(((ge[0] + ge[1]) + (ge[2] + ge[3])) + ((ge[4] + ge[5]) + (ge[6] + ge[7]))) * (1.f / 64.f);
            float sq = 0.f;
#pragma unroll
            for (int j = 0; j < 8; ++j) { ge[j] -= mean; sq += ge[j] * ge[j]; }
            const float rs = __builtin_amdgcn_rsqf(sum8(sq) * (1.f / 64.f) + 1e-5f);
#pragma unroll
            for (int j = 0; j < 8; ++j) ge[j] *= rs;
            *(LAS u32x4*)(L + (tr + 16 * (4 * hf + i)) * GV_ROWB + c0 * 2) = __builtin_bit_cast(u32x4, pk8f(ge));
        }
    }
    u32x4 uq[8];
#pragma unroll
    for (int i = 0; i < 8; ++i) uq[i] = *(const u32x4*)(Pb + (size_t)(tr + 16 * i) * PP + C_GMU + c0);
    __syncthreads();
    const int db = wid & 1;
#pragma unroll
    for (int g = 0; g < 4; ++g) {
        const int tb = ((wid >> 1) + g) & 3, t = 32 * tb + r32;
        const bf16_t* wrow = WSP(bf16_t, WS_GMW) + ((size_t)(layer * 4 + g) * 128 + t) * 128 + 8 * h2;
        const float bias = F.in[4][(size_t)(layer * 4 + g) * 128 + t];
        f32x16 acc = {};
#pragma unroll 1
        for (int ks = 0; ks <= 2 * tb + 1; ++ks)
            acc = MFMA32(gm_trfrag(L, lane, ks, 64 * g + 32 * db), *(const bf16x8*)(wrow + 16 * ks), acc);
#pragma unroll
        for (int q = 0; q < 4; ++q)
            *(LAS u32x2*)(L + GM_OUTOFF + t * GO_ROWB + (64 * g + 32 * db + 8 * q + 4 * h2) * 2) = (u32x2){pk2(acc[4 * q] + bias, acc[4 * q + 1] + bias), pk2(acc[4 * q + 2] + bias, acc[4 * q + 3] + bias)};
    }
    __syncthreads();
    bf16_t* mo = WSP(bf16_t, WS_MIX) + (size_t)(b * SEQ + c * 128) * D + 256 + c0;
#pragma unroll
    for (int i = 0; i < 8; ++i) {
        const u32x4 mq = *(const LAS u32x4*)(L + GM_OUTOFF + (tr + 16 * i) * GO_ROWB + c0 * 2);
        float o[8];
#pragma unroll
        for (int j = 0; j < 4; ++j) { o[2 * j] = geluf_(bf2f(uq[i][j] & 0xffffu)) * bf2f(mq[j] & 0xffffu); o[2 * j + 1] = geluf_(bf2f(uq[i][j] >> 16)) * bf2f(mq[j] >> 16); }
        *(u32x4*)(mo + (size_t)(tr + 16 * i) * D) = __builtin_bit_cast(u32x4, pk8f(o));
    }
}

DI void rw_load_shift8(const bf16_t* Pt, bool hasprev, int col, const float* mu, float (&o)[8]) {
    const u32x4 cu = *(const u32x4*)(Pt + col); u32x4 pr = (u32x4){0u, 0u, 0u, 0u}; if (hasprev) pr = *(const u32x4*)(Pt - PP + col);
    const f32x4 m0 = *(const f32x4*)(mu), m1 = *(const f32x4*)(mu + 4);
    const float mm[8] = {m0[0], m0[1], m0[2], m0[3], m1[0], m1[1], m1[2], m1[3]};
#pragma unroll
    for (int j = 0; j < 4; ++j) { const float c0 = bf2f(cu[j] & 0xffffu), c1 = bf2f(cu[j] >> 16), p0 = bf2f(pr[j] & 0xffffu), p1 = bf2f(pr[j] >> 16);
        o[2 * j] = c0 + (p0 - c0) * mm[2 * j]; o[2 * j + 1] = c1 + (p1 - c1) * mm[2 * j + 1]; }
}
DI void rw_load_shift4(const bf16_t* Pt, bool hasprev, int col, const float* mu, float (&o)[4]) {
    const u32x2 cu = *(const u32x2*)(Pt + col); u32x2 pr = (u32x2){0u, 0u}; if (hasprev) pr = *(const u32x2*)(Pt - PP + col);
    const f32x4 m0 = *(const f32x4*)(mu);
#pragma unroll
    for (int j = 0; j < 2; ++j) { const float c0 = bf2f(cu[j] & 0xffffu), c1 = bf2f(cu[j] >> 16), p0 = bf2f(pr[j] & 0xffffu), p1 = bf2f(pr[j] >> 16);
        o[2 * j] = c0 + (p0 - c0) * m0[2 * j]; o[2 * j + 1] = c1 + (p1 - c1) * m0[2 * j + 1]; }
}
DI bf16x8 rw_act_frag(const bf16_t* Pt, bool hasprev, const float* mu, int ks, int h2, int mode) {
    float v[8]; rw_load_shift8(Pt, hasprev, C_RWX + 16 * ks + 8 * h2, mu + 768 + 16 * ks + 8 * h2, v);
    if (mode == 1) {
#pragma unroll
        for (int j = 0; j < 8; ++j) v[j] = tanhf_(v[j]);
    } else if (mode == 2) {
#pragma unroll
        for (int j = 0; j < 8; ++j) v[j] = sigmoidf_(v[j]);
    }
    u32x4 pb; pb.x = pk2(v[0], v[1]); pb.y = pk2(v[2], v[3]); pb.z = pk2(v[4], v[5]); pb.w = pk2(v[6], v[7]);
    return __builtin_bit_cast(bf16x8, pb);
}

constexpr int RC_V = 0, RC_KB = 4608, RC_BB = 9216, RC_KT = 13824, RC_CF = 13824, RC_PC = 18432, RC_WAVE = 18688, RC_ROWB = 144;
DI float scan32(float x) {
    x += dppf<0x111, 0xf, true>(x); x += dppf<0x112, 0xf, true>(x); x += dppf<0x114, 0xf, true>(x); x += dppf<0x118, 0xf, true>(x);
    x += dppf<0x142, 0xa, false>(x);
    return x;
}
DI bf16x8 rc_trfrag(const LAS unsigned char* tile, int lane, int s, int colblk) {
    const int h2 = lane >> 5;
    const LAS unsigned char* p = tile + (16 * s + 4 * h2 + ((lane & 15) >> 2)) * RC_ROWB + (32 * colblk + 16 * ((lane >> 4) & 1) + 4 * (lane & 3)) * 2;
    const s16x4 lo = tr_read(p), hi = tr_read(p + 8 * RC_ROWB);
    return __builtin_shufflevector(lo, hi, 0, 1, 2, 3, 4, 5, 6, 7);
}
#ifdef TPROBE
#define TPB_T0 const unsigned long long tpb0 = __builtin_amdgcn_s_memrealtime()
#define TPB_ACC(slot, tidv) do { const unsigned long long tpb1 = __builtin_amdgcn_s_memrealtime(); if (F.tid == (tidv)) { volatile LAS unsigned long long* a_ = (volatile LAS unsigned long long*)(F.lds + LDS_MISC + 128) + (slot); *a_ = *a_ + (tpb1 - tpb0); } } while (0)
#else
#define TPB_T0 do { } while (0)
#define TPB_ACC(slot, tidv) do { } while (0)
#endif
constexpr int RG_ACT = 4 * RC_WAVE, RG_RKV = RG_ACT + 16384, RG_PAR = RG_RKV + 12 * 4608, RG_END = RG_PAR + 5120;
static_assert(RG_END <= LDS_MISC, "chunk-pass LDS map");
DI void rw_loader_loop(Frame& F, int layer) {
    int lwl = F.wave - 4; asm volatile("" : "+s"(lwl));
    const int lane = F.lane, r32 = lane & 31, h2 = lane >> 5, lw = lwl;
    LAS unsigned char* L = F.lds;
    const float* mu = F.in[5] + (size_t)layer * 1024;
    const int prow = lane >> 3, pc = lane & 7;
    const int amode = lw == 0 ? 1 : (lw == 1 ? 0 : 2);
    const float asc = amode == 1 ? 2.f * LOG2E : -LOG2E, aa = amode == 1 ? 1.f : 0.f, ab = amode == 1 ? -2.f : 1.f;
    f32x4 mq[4][2];
    { const int o0 = 768 + 8 * (8 * lw + pc), o1 = 64 * lw + 8 * pc;
      mq[0][0] = *(const f32x4*)(mu + o0); mq[0][1] = *(const f32x4*)(mu + o0 + 4);
#pragma unroll
      for (int a = 0; a < 3; ++a) { mq[1 + a][0] = *(const f32x4*)(mu + 256 * a + o1); mq[1 + a][1] = *(const f32x4*)(mu + 256 * a + o1 + 4); } }
    u32x4 wv[4][2];
    { const bf16_t* wp = WSP(bf16_t, WS_BIN) + (size_t)layer * NIN * D + (size_t)3072 * D + 8 * lane;
#pragma unroll
      for (int c = 0; c < 4; ++c) { wv[c][0] = *(const u32x4*)(wp + (size_t)c * D); wv[c][1] = *(const u32x4*)(wp + (size_t)c * D + 512); } }
    const float fbias = F.in[16][layer * 4 + (lane & 3)];
    const bf16_t* wcg = WSP(bf16_t, WS_WCAT) + (size_t)layer * 65536 + (size_t)(64 * lw + r32) * 256 + 8 * h2;
#define RW_SHIFT8(cu, pr, hp, m0, m1, o) do { _Pragma("unroll") for (int j_ = 0; j_ < 4; ++j_) { \
        const float c0_ = bf2f(cu[j_] & 0xffffu), c1_ = bf2f(cu[j_] >> 16), p0_ = (hp) ? bf2f(pr[j_] & 0xffffu) : 0.f, p1_ = (hp) ? bf2f(pr[j_] >> 16) : 0.f; \
        const float ma_ = j_ < 2 ? m0[2 * (j_ & 1)] : m1[2 * (j_ & 1)], mb_ = j_ < 2 ? m0[2 * (j_ & 1) + 1] : m1[2 * (j_ & 1) + 1]; \
        o[2 * j_] = c0_ + (p0_ - c0_) * ma_; o[2 * j_ + 1] = c1_ + (p1_ - c1_) * mb_; } } while (0)
#pragma unroll 1
    for (int tg = F.bid; tg < 1024; tg += F.G) {
        const int bb = tg >> 6, ch = tg & 63;
        const bf16_t* Pg = WSP(bf16_t, WS_P) + (size_t)(bb * SEQ + 32 * ch) * PP;
        const bool nop0 = (ch == 0) && (prow == 0);
        {
            u32x4 cu[4][4], pr[4][4];
            const int cols[4] = {C_RWX + 8 * (8 * lw + pc), C_RWR + 64 * lw + 8 * pc, C_RWK + 64 * lw + 8 * pc, C_RWV + 64 * lw + 8 * pc};
#pragma unroll
            for (int i = 0; i < 4; ++i) { const bf16_t* rowp = Pg + (size_t)(prow + 8 * i) * PP; const bf16_t* prevp = rowp - ((i == 0 && nop0) ? 0 : PP);
#pragma unroll
                for (int a = 0; a < 4; ++a) { cu[a][i] = *(const u32x4*)(rowp + cols[a]); pr[a][i] = *(const u32x4*)(prevp + cols[a]); } }
            asm volatile("" ::: "memory");
#pragma unroll
            for (int i = 0; i < 4; ++i) { const int t = prow + 8 * i; const bool hp = !(i == 0 && nop0); float v[8]; RW_SHIFT8(cu[0][i], pr[0][i], hp, mq[0][0], mq[0][1], v);
#pragma unroll
                for (int k = 0; k < 8; ++k) { const float q = rcpf_(1.f + ex2(asc * v[k])); v[k] = amode == 0 ? v[k] : aa + ab * q; }
                *(LAS bf16x8*)(L + RG_ACT + (4 * lw + (pc >> 1)) * 1024 + (t + 32 * (pc & 1)) * 16) = pk8f(v);
#pragma unroll
                for (int a = 0; a < 3; ++a) { float o[8]; RW_SHIFT8(cu[1 + a][i], pr[1 + a][i], hp, mq[1 + a][0], mq[1 + a][1], o);
                    *(LAS bf16x8*)(L + RG_RKV + (lw * 3 + a) * 4608 + t * RC_ROWB + pc * 16) = pk8f(o); } }
        }
        asm volatile("" ::: "memory");
        {
            const int t0 = bb * SEQ + 32 * ch + 8 * lw;
            u32x4 xr[8][2]; float sp[8];
#pragma unroll
            for (int i = 0; i < 8; ++i) { const bf16_t* xp = WSP(bf16_t, WS_XB) + (size_t)(t0 + i) * D + 8 * lane; xr[i][0] = *(const u32x4*)(xp); xr[i][1] = *(const u32x4*)(xp + 512);
                sp[i] = (lane < 16) ? WSP(float, WS_SS1)[(size_t)(t0 + i) * 16 + lane] : 0.f; }
            asm volatile("" ::: "memory");
#pragma unroll
            for (int i = 0; i < 8; ++i) {
                const float rstd = __builtin_amdgcn_rsqf(wave_sum(sp[i]) * (1.f / 1024.f) + 1e-6f);
                float res = 0.f;
#pragma unroll
                for (int c = 0; c < 4; ++c) { float a = 0.f;
                    asm("v_dot2c_f32_bf16 %0, %1, %9\n\tv_dot2c_f32_bf16 %0, %2, %10\n\tv_dot2c_f32_bf16 %0, %3, %11\n\tv_dot2c_f32_bf16 %0, %4, %12\n\t"
                        "v_dot2c_f32_bf16 %0, %5, %13\n\tv_dot2c_f32_bf16 %0, %6, %14\n\tv_dot2c_f32_bf16 %0, %7, %15\n\tv_dot2c_f32_bf16 %0, %8, %16\n\ts_nop 4"
                        : "+v"(a) : "v"(xr[i][0][0]), "v"(xr[i][0][1]), "v"(xr[i][0][2]), "v"(xr[i][0][3]), "v"(xr[i][1][0]), "v"(xr[i][1][1]), "v"(xr[i][1][2]), "v"(xr[i][1][3]),
                                    "v"(wv[c][0][0]), "v"(wv[c][0][1]), "v"(wv[c][0][2]), "v"(wv[c][0][3]), "v"(wv[c][1][0]), "v"(wv[c][1][1]), "v"(wv[c][1][2]), "v"(wv[c][1][3]));
                    a = wave_sum(a); if ((lane & 3) == c) res = a; }
                if (lane < 4) { const int row = t0 + i; WSP(float, WS_LF)[(size_t)((row >> 11) * 4 + lane) * SEQ + (row & 2047)] = -softplusf_(-(res * rstd + fbias)); }
            }
        }
        asm volatile("s_waitcnt lgkmcnt(0)" ::: "memory");
        { TPB_T0; asm volatile("" ::: "memory"); __builtin_amdgcn_s_barrier(); asm volatile("" ::: "memory"); TPB_ACC(0, 256); }
        {
            const int tok = bb * SEQ + 32 * ch + r32;
            const bf16_t* wcl = wcg; asm volatile("" : "+v"(wcl));
            bf16x8 wg[2][8];
#pragma unroll
            for (int blk = 0; blk < 2; ++blk)
#pragma unroll
                for (int ks = 0; ks < 8; ++ks) wg[blk][ks] = *(const bf16x8*)(wcl + (size_t)blk * 32 * 256 + 16 * (8 + ks));
            asm volatile("" ::: "memory");
#pragma unroll
            for (int blk = 0; blk < 2; ++blk) { f32x16 aG = {};
#pragma unroll
                for (int ks = 0; ks < 8; ++ks) aG = MFMA32(wg[blk][ks], *(const LAS bf16x8*)(L + RG_ACT + (8 + ks) * 1024 + lane * 16), aG);
#pragma unroll
                for (int g = 0; g < 4; ++g) { const int cl = 32 * blk + 8 * g + 4 * h2; u32x2 gq;
                    gq.x = pk2(aG[4 * g], aG[4 * g + 1]); gq.y = pk2(aG[4 * g + 2], aG[4 * g + 3]);
                    *(u32x2*)(WSP(bf16_t, WS_GBUF) + (size_t)tok * 256 + 64 * lw + cl) = gq; } }
            asm volatile("s_waitcnt lgkmcnt(0)" ::: "memory");
        }
        { TPB_T0; asm volatile("" ::: "memory"); __builtin_amdgcn_s_barrier(); asm volatile("" ::: "memory"); TPB_ACC(1, 256); }
    }
#undef RW_SHIFT8
}
DI void rw_group_compute(Frame& F, int layer, int tg) {
    asm volatile("" : "+s"(F.in)); asm volatile("" : "+s"(F.ws)); asm volatile("" : "+v"(F.lane));
    const int lane = F.lane, r32 = lane & 31, h2 = lane >> 5, hd = F.wave, bb = tg >> 6, ch = tg & 63, bh = bb * 4 + hd;
    LAS unsigned char* L = F.lds;
    LAS unsigned char* W = L + F.wave * RC_WAVE;
    const int tl = 32 * ch + r32, tok = bb * SEQ + tl;
    const bf16_t* wc = WSP(bf16_t, WS_WCAT) + (size_t)layer * 65536 + (size_t)(64 * hd + r32) * 256 + 8 * h2;
    const int chunk = bh * 64 + ch;
    const LAS float* PAR = (const LAS float*)(L + RG_PAR) + 64 * hd;
    const LAS unsigned char* TR = L + RG_RKV + (hd * 3 + 0) * 4608 + r32 * RC_ROWB;
    const LAS unsigned char* TK = TR + 4608; const LAS unsigned char* TV = TR + 2 * 4608;
    u32x4 FRr[16];
    { TPB_T0; asm volatile("" ::: "memory"); __builtin_amdgcn_s_barrier(); asm volatile("" ::: "memory"); TPB_ACC(2, 0); }
    float n2 = 0.f;
#pragma unroll
    for (int g8 = 0; g8 < 4; ++g8) { const u32x4 kq = *(const LAS u32x4*)(TK + 64 * h2 + 16 * g8); const f32x4 k0 = *(const LAS f32x4*)(PAR + 1024 + 32 * h2 + 8 * g8), k1 = *(const LAS f32x4*)(PAR + 1024 + 32 * h2 + 8 * g8 + 4);
#pragma unroll
        for (int j = 0; j < 4; ++j) { const float a = bf2f(kq[j] & 0xffffu) * (j < 2 ? k0[2 * j] : k1[2 * j - 4]), c = bf2f(kq[j] >> 16) * (j < 2 ? k0[2 * j + 1] : k1[2 * j - 3]); n2 += a * a + c * c; } }
    n2 += swap32(n2);
    const float inv = 1.f / fmaxf(sqrtf(n2), 1e-12f);
    float bon = 0.f;
#pragma unroll
    for (int blk = 0; blk < 2; ++blk) {
        const bf16_t* wb = wc + (size_t)blk * 32 * 256;
        f32x16 aW = {}, aA = {};
#pragma unroll
        for (int ks = 0; ks < 4; ++ks) aW = MFMA32(*(const bf16x8*)(wb + 16 * ks), *(const LAS bf16x8*)(L + RG_ACT + ks * 1024 + lane * 16), aW);
#pragma unroll
        for (int ks = 4; ks < 8; ++ks) aA = MFMA32(*(const bf16x8*)(wb + 16 * ks), *(const LAS bf16x8*)(L + RG_ACT + ks * 1024 + lane * 16), aA);
#pragma unroll
        for (int s = 0; s < 2; ++s) {
            float e_kat[8], e_rt[8], e_kt[8], e_bt[8], e_kb[8], e_bb[8];
#pragma unroll
            for (int q = 0; q < 2; ++q) { const int g = 2 * s + q, cl = 32 * blk + 8 * g + 4 * h2;
                const u32x2 rq = *(const LAS u32x2*)(TR + cl * 2), kq = *(const LAS u32x2*)(TK + cl * 2), vq = *(const LAS u32x2*)(TV + cl * 2);
                const float rv[4] = {bf2f(rq.x & 0xffffu), bf2f(rq.x >> 16), bf2f(rq.y & 0xffffu), bf2f(rq.y >> 16)}, kv[4] = {bf2f(kq.x & 0xffffu), bf2f(kq.x >> 16), bf2f(kq.y & 0xffffu), bf2f(kq.y >> 16)};
                const f32x4 w0v = *(const LAS f32x4*)(PAR + cl), a0v = *(const LAS f32x4*)(PAR + 256 + cl), kav = *(const LAS f32x4*)(PAR + 512 + cl), rkv = *(const LAS f32x4*)(PAR + 768 + cl), kwv = *(const LAS f32x4*)(PAR + 1024 + cl);
#pragma unroll
                for (int j = 0; j < 4; ++j) { const int r = 4 * g + j, jj = 4 * q + j;
                    const float w = -softplusf_(-(w0v[j] + aW[r])) - 0.5f;
                    const float l2d = -LOG2E * ex2(w * LOG2E);
                    const float a = sigmoidf_(a0v[j] + aA[r]);
                    const float kkv = kv[j] * kwv[j] * inv, bev = kkv * a, kpv = kv[j] * (1.f + (a - 1.f) * kav[j]);
                    bon += rv[j] * kpv * rkv[j];
                    const float Li = scan32(l2d), Lex = Li - l2d, LC = __shfl(Li, 31 + 32 * h2);
                    const float pin = ex2(Li), pex = ex2(Lex), pinv = ex2(-Li), pc = ex2(LC - Li);
                    e_kat[jj] = kkv * pex; e_rt[jj] = rv[j] * pin; e_kt[jj] = kpv * pinv; e_bt[jj] = bev * pinv; e_kb[jj] = kpv * pc; e_bb[jj] = bev * pc;
                    if (r32 == 31) *(LAS float*)(W + RC_PC + (cl + j) * 4) = ex2(LC); }
                *(LAS u32x2*)(W + RC_V + r32 * RC_ROWB + cl * 2) = vq;
                *(LAS u32x2*)(W + RC_KB + r32 * RC_ROWB + cl * 2) = (u32x2){pk2(e_kb[4 * q], e_kb[4 * q + 1]), pk2(e_kb[4 * q + 2], e_kb[4 * q + 3])};
                *(LAS u32x2*)(W + RC_BB + r32 * RC_ROWB + cl * 2) = (u32x2){pk2(e_bb[4 * q], e_bb[4 * q + 1]), pk2(e_bb[4 * q + 2], e_bb[4 * q + 3])};
                *(LAS u32x2*)(W + RC_KT + r32 * RC_ROWB + cl * 2) = (u32x2){pk2(e_kat[4 * q], e_kat[4 * q + 1]), pk2(e_kat[4 * q + 2], e_kat[4 * q + 3])};
            }
            { const int ks = 2 * blk + s; FRr[ks * 4 + 0] = __builtin_bit_cast(u32x4, pk8f(e_kat)); FRr[ks * 4 + 1] = __builtin_bit_cast(u32x4, pk8f(e_rt)); FRr[ks * 4 + 2] = __builtin_bit_cast(u32x4, pk8f(e_kt)); FRr[ks * 4 + 3] = __builtin_bit_cast(u32x4, pk8f(e_bt)); }
        }
    }
    asm volatile("s_waitcnt lgkmcnt(0)" ::: "memory");
    { TPB_T0; asm volatile("" ::: "memory"); __builtin_amdgcn_s_barrier(); asm volatile("" ::: "memory"); TPB_ACC(3, 0); }
    bon += swap32(bon);
    asm volatile("" ::: "memory");
#pragma unroll
    for (int blk = 0; blk < 2; ++blk)
#pragma unroll
        for (int g = 0; g < 4; ++g) { const int cl = 32 * blk + 8 * g + 4 * h2; const u32x2 vq = *(const LAS u32x2*)(W + RC_V + r32 * RC_ROWB + cl * 2); u32x2 q;
            q.x = pk2(bon * bf2f(vq.x & 0xffffu), bon * bf2f(vq.x >> 16)); q.y = pk2(bon * bf2f(vq.y & 0xffffu), bon * bf2f(vq.y >> 16));
            *(u32x2*)(WSP(bf16_t, WS_BONV) + (size_t)tok * 256 + 64 * hd + cl) = q; }
    const float pc_lo = *(const LAS float*)(W + RC_PC + r32 * 4), pc_hi = *(const LAS float*)(W + RC_PC + (32 + r32) * 4);
    bf16x8 akkf[2], arkf[2], arbf[2];
    f32x16 Tt;
    {
        f32x16 skk = {}, skb = {}, sl = {};
#pragma unroll
        for (int ks = 0; ks < 4; ++ks) { const bf16x8 katf = __builtin_bit_cast(bf16x8, FRr[ks * 4 + 0]), ktf = __builtin_bit_cast(bf16x8, FRr[ks * 4 + 2]), btf = __builtin_bit_cast(bf16x8, FRr[ks * 4 + 3]);
            skk = MFMA32(ktf, katf, skk); skb = MFMA32(btf, katf, skb); sl = MFMA32(katf, btf, sl); }
#pragma unroll
        for (int r = 0; r < 16; ++r) { const int i = crow(r, h2); if (i >= r32) { skk[r] = 0.f; skb[r] = 0.f; } if (i <= r32) sl[r] = 0.f; }
#pragma unroll
        for (int s = 0; s < 2; ++s) akkf[s] = pack8(skk, s);
        bf16x8 fx[2], fxt[2];
#pragma unroll
        for (int s = 0; s < 2; ++s) { fx[s] = pack8(sl, s); fxt[s] = pack8(skb, s); }
#pragma unroll
        for (int r = 0; r < 16; ++r) Tt[r] = ((crow(r, h2) == r32) ? 1.f : 0.f) - skb[r];
#pragma unroll
        for (int lvl = 0; lvl < 4; ++lvl) {
            f32x16 p = {}, pt = {};
#pragma unroll
            for (int s = 0; s < 2; ++s) { p = MFMA32(fxt[s], fx[s], p); if (lvl < 3) pt = MFMA32(fx[s], fxt[s], pt); }
#pragma unroll
            for (int s = 0; s < 2; ++s) fx[s] = pack8(p, s);
            const bf16x8 t0 = pack8(Tt, 0), t1 = pack8(Tt, 1);
            Tt = MFMA32(fx[0], t0, Tt); Tt = MFMA32(fx[1], t1, Tt);
            if (lvl < 3) {
#pragma unroll
                for (int s = 0; s < 2; ++s) fxt[s] = pack8(pt, s); }
        }
    }
    {
        f32x16 srk = {}, srb = {};
#pragma unroll
        for (int ks = 0; ks < 4; ++ks) { const bf16x8 rtf = __builtin_bit_cast(bf16x8, FRr[ks * 4 + 1]), ktf = __builtin_bit_cast(bf16x8, FRr[ks * 4 + 2]), btf = __builtin_bit_cast(bf16x8, FRr[ks * 4 + 3]);
            srk = MFMA32(ktf, rtf, srk); srb = MFMA32(btf, rtf, srb); }
#pragma unroll
        for (int r = 0; r < 16; ++r) if (crow(r, h2) > r32) { srk[r] = 0.f; srb[r] = 0.f; }
#pragma unroll
        for (int s = 0; s < 2; ++s) { arkf[s] = pack8(srk, s); arbf[s] = pack8(srb, s); }
    }
    asm volatile("" ::: "memory");
    bf16x8 ng1f[2][2], ng2f[2][2];
    {
        const bf16x8 tf0 = pack8(Tt, 0), tf1 = pack8(Tt, 1);
#pragma unroll
        for (int cb = 0; cb < 2; ++cb) {
            f32x16 g = {};
            g = MFMA32(tf0, rc_trfrag(W + RC_KT, lane, 0, cb), g); g = MFMA32(tf1, rc_trfrag(W + RC_KT, lane, 1, cb), g);
#pragma unroll
            for (int r = 0; r < 16; ++r) g[r] = -g[r];
            ng1f[cb][0] = pack8(g, 0); ng1f[cb][1] = pack8(g, 1);
        }
#pragma unroll
        for (int vb = 0; vb < 2; ++vb) {
            f32x16 x1 = {};
#pragma unroll
            for (int s = 0; s < 2; ++s) x1 = MFMA32(akkf[s], rc_trfrag(W + RC_V, lane, s, vb), x1);
            f32x16 g = {};
            g = MFMA32(tf0, pack8(x1, 0), g); g = MFMA32(tf1, pack8(x1, 1), g);
#pragma unroll
            for (int r = 0; r < 16; ++r) g[r] = -g[r];
            ng2f[vb][0] = pack8(g, 0); ng2f[vb][1] = pack8(g, 1);
        }
    }
    asm volatile("" ::: "memory");
    u32x4* mt = WSP(u32x4, WS_CHMT) + (size_t)chunk * 8 * 64 + lane;
#pragma unroll
    for (int bip = 0; bip < 2; ++bip)
#pragma unroll
        for (int bi = 0; bi < 2; ++bi) {
            f32x16 m = {};
#pragma unroll
            for (int s = 0; s < 2; ++s) m = MFMA32(ng1f[bi][s], rc_trfrag(W + RC_BB, lane, s, bip), m);
            if (bi == bip) {
#pragma unroll
                for (int r = 0; r < 16; ++r) if (crow(r, h2) == r32) m[r] += (bi ? pc_hi : pc_lo); }
#pragma unroll
            for (int s = 0; s < 2; ++s) mt[(bip * 4 + bi * 2 + s) * 64] = __builtin_bit_cast(u32x4, pack8(m, s));
        }
    asm volatile("" ::: "memory");
    u32x4* nb_ = WSP(u32x4, WS_CHN) + (size_t)chunk * 8 * 64 + lane;
#pragma unroll
    for (int vb = 0; vb < 2; ++vb)
#pragma unroll
        for (int bip = 0; bip < 2; ++bip) {
            f32x16 n = {};
#pragma unroll
            for (int s = 0; s < 2; ++s) { n = MFMA32(rc_trfrag(W + RC_KB, lane, s, bip), rc_trfrag(W + RC_V, lane, s, vb), n); n = MFMA32(rc_trfrag(W + RC_BB, lane, s, bip), ng2f[vb][s], n); }
#pragma unroll
            for (int s = 0; s < 2; ++s) nb_[((vb * 2 + bip) * 2 + s) * 64] = __builtin_bit_cast(u32x4, pack8(n, s));
        }
    asm volatile("" ::: "memory");
    u32x4* ry = WSP(u32x4, WS_CHRY) + (size_t)chunk * 4 * 64 + lane;
#pragma unroll
    for (int bi = 0; bi < 2; ++bi) {
        f32x16 q = {};
#pragma unroll
        for (int s = 0; s < 2; ++s) q = MFMA32(ng1f[bi][s], arbf[s], q);
#pragma unroll
        for (int s = 0; s < 2; ++s) { const u32x4 rq = FRr[(2 * bi + s) * 4 + 1]; float o[8];
#pragma unroll
            for (int j = 0; j < 4; ++j) { o[2 * j] = q[8 * s + 2 * j] + bf2f(rq[j] & 0xffffu); o[2 * j + 1] = q[8 * s + 2 * j + 1] + bf2f(rq[j] >> 16); }
            ry[(bi * 2 + s) * 64] = __builtin_bit_cast(u32x4, pk8f(o)); }
    }
    asm volatile("" ::: "memory");
    u32x4* y0 = WSP(u32x4, WS_CHY0) + (size_t)chunk * 4 * 64 + lane;
#pragma unroll
    for (int vb = 0; vb < 2; ++vb) {
        f32x16 yy = {};
#pragma unroll
        for (int s = 0; s < 2; ++s) { yy = MFMA32(arkf[s], rc_trfrag(W + RC_V, lane, s, vb), yy); yy = MFMA32(arbf[s], ng2f[vb][s], yy); }
#pragma unroll
        for (int s = 0; s < 2; ++s) y0[(vb * 2 + s) * 64] = __builtin_bit_cast(u32x4, pack8(yy, s));
    }
    asm volatile("s_waitcnt lgkmcnt(0)" ::: "memory");
}
DI void unpack16(const u32x4& a, const u32x4& b, f32x16& o) {
#pragma unroll
    for (int j = 0; j < 4; ++j) { o[2 * j] = bf2f(a[j] & 0xffffu); o[2 * j + 1] = bf2f(a[j] >> 16); o[8 + 2 * j] = bf2f(b[j] & 0xffffu); o[8 + 2 * j + 1] = bf2f(b[j] >> 16); }
}
constexpr int SQ_BH = 24576, SQ_STAGE = 2 * SQ_BH;
DI void rw_seq_wg(Frame& F, int item, unsigned* sd) {
    LAS unsigned char* L = F.lds; const int lane = F.lane, wid = F.wave, r32 = lane & 31, h2 = lane >> 5;
    __syncthreads();
    if (wid >= 4) {
        const int slot = (wid - 4) >> 1, half = (wid - 4) & 1, bh = 2 * item + slot;
        const u32x4* mtb = WSP(u32x4, WS_CHMT) + (size_t)bh * 64 * 8 * 64 + lane;
        const u32x4* nbb = WSP(u32x4, WS_CHN) + (size_t)bh * 64 * 8 * 64 + lane;
        const u32x4* ryb = WSP(u32x4, WS_CHRY) + (size_t)bh * 64 * 4 * 64 + lane;
        const u32x4* y0b = WSP(u32x4, WS_CHY0) + (size_t)bh * 64 * 4 * 64 + lane;
#define SQ_ISSUE(CH) do { const int ch_ = (CH); LAS unsigned char* st_ = L + (ch_ % 3) * SQ_STAGE + slot * SQ_BH; \
            if (half == 0) { _Pragma("unroll") for (int i = 0; i < 8; ++i) __builtin_amdgcn_global_load_lds((const unsigned*)(mtb + (size_t)ch_ * 512 + i * 64), (LAS unsigned*)(st_ + i * 1024), 16, 0, 0); \
                             _Pragma("unroll") for (int i = 0; i < 4; ++i) __builtin_amdgcn_global_load_lds((const unsigned*)(ryb + (size_t)ch_ * 256 + i * 64), (LAS unsigned*)(st_ + (8 + i) * 1024), 16, 0, 0); } \
            else { _Pragma("unroll") for (int i = 0; i < 8; ++i) __builtin_amdgcn_global_load_lds((const unsigned*)(nbb + (size_t)ch_ * 512 + i * 64), (LAS unsigned*)(st_ + (12 + i) * 1024), 16, 0, 0); \
                   _Pragma("unroll") for (int i = 0; i < 4; ++i) __builtin_amdgcn_global_load_lds((const unsigned*)(y0b + (size_t)ch_ * 256 + i * 64), (LAS unsigned*)(st_ + (20 + i) * 1024), 16, 0, 0); } } while (0)
        SQ_ISSUE(0); SQ_ISSUE(1);
        asm volatile("s_waitcnt vmcnt(12)" ::: "memory");
        __builtin_amdgcn_s_barrier();
#pragma unroll 1
        for (int ch = 0; ch < 64; ++ch) {
            if (ch + 2 < 64) { SQ_ISSUE(ch + 2); asm volatile("s_waitcnt vmcnt(12)" ::: "memory"); }
            else asm volatile("s_waitcnt vmcnt(0)" ::: "memory");
            __builtin_amdgcn_s_barrier();
        }
#undef SQ_ISSUE
    } else {
        const int slot = wid >> 1, vb = wid & 1, bh = 2 * item + slot;
        f32x16 H0 = {}, H1 = {};
        float* yb = WSP(float, WS_YBUF) + (size_t)(bh >> 2) * SEQ * 256 + (bh & 3) * 64 + 32 * vb + r32;
        __builtin_amdgcn_s_barrier();
#pragma unroll 1
        for (int ch = 0; ch < 64; ++ch) {
            const LAS unsigned char* st = L + (ch % 3) * SQ_STAGE + slot * SQ_BH + lane * 16;
            u32x4 cmt[8], cry[4], cnn[4], cy0[2];
#pragma unroll
            for (int i = 0; i < 8; ++i) cmt[i] = *(const LAS u32x4*)(st + i * 1024);
#pragma unroll
            for (int i = 0; i < 4; ++i) { cry[i] = *(const LAS u32x4*)(st + (8 + i) * 1024); cnn[i] = *(const LAS u32x4*)(st + (12 + 4 * vb + i) * 1024); }
            cy0[0] = *(const LAS u32x4*)(st + (20 + 2 * vb) * 1024); cy0[1] = *(const LAS u32x4*)(st + (21 + 2 * vb) * 1024);
            bf16x8 hb[4]; hb[0] = pack8(H0, 0); hb[1] = pack8(H0, 1); hb[2] = pack8(H1, 0); hb[3] = pack8(H1, 1);
            f32x16 y, n0, n1;
            unpack16(cy0[0], cy0[1], y); unpack16(cnn[0], cnn[1], n0); unpack16(cnn[2], cnn[3], n1);
            asm volatile("s_waitcnt lgkmcnt(0)" ::: "memory");
#pragma unroll
            for (int ks = 0; ks < 4; ++ks) { n0 = MFMA32(__builtin_bit_cast(bf16x8, cmt[ks]), hb[ks], n0); n1 = MFMA32(__builtin_bit_cast(bf16x8, cmt[4 + ks]), hb[ks], n1); y = MFMA32(__builtin_bit_cast(bf16x8, cry[ks]), hb[ks], y); }
            H0 = n0; H1 = n1;
#pragma unroll
            for (int r = 0; r < 16; ++r) yb[(size_t)(32 * ch + crow(r, h2)) * 256] = y[r];
            __builtin_amdgcn_s_barrier();
        }
        asm volatile("s_waitcnt vmcnt(0)" ::: "memory");
    }
    __syncthreads();
    if (F.tid == 0) {
        __builtin_amdgcn_fence(__ATOMIC_RELEASE, "agent");
        asm volatile("s_waitcnt vmcnt(0)" ::: "memory");
        (void)xb_add(sd, 1u);
    }
}
DI void rw_post_item(Frame& F, int layer, int tok0) {
    const int tid = F.tid, cg = tid & 31, c0 = 8 * cg, tr = tid >> 5;
    const f32x4 gw0 = *(const f32x4*)(F.in[14] + layer * 256 + c0), gw1 = *(const f32x4*)(F.in[14] + layer * 256 + c0 + 4);
    const f32x4 gb0 = *(const f32x4*)(F.in[15] + layer * 256 + c0), gb1 = *(const f32x4*)(F.in[15] + layer * 256 + c0 + 4);
    const float gw[8] = {gw0[0], gw0[1], gw0[2], gw0[3], gw1[0], gw1[1], gw1[2], gw1[3]}, gb[8] = {gb0[0], gb0[1], gb0[2], gb0[3], gb1[0], gb1[1], gb1[2], gb1[3]};
#pragma unroll
    for (int hf = 0; hf < 2; ++hf) {
        f32x4 ya[4], yb[4]; u32x4 bq[4], gq[4];
#pragma unroll
        for (int i = 0; i < 4; ++i) { const size_t o = (size_t)(tok0 + tr + 16 * (4 * hf + i)) * 256 + c0;
            ya[i] = *(const f32x4*)(WSP(float, WS_YBUF) + o); yb[i] = *(const f32x4*)(WSP(float, WS_YBUF) + o + 4);
            bq[i] = *(const u32x4*)(WSP(bf16_t, WS_BONV) + o); gq[i] = *(const u32x4*)(WSP(bf16_t, WS_GBUF) + o); }
#pragma unroll
        for (int i = 0; i < 4; ++i) {
            float y[8] = {ya[i][0], ya[i][1], ya[i][2], ya[i][3], yb[i][0], yb[i][1], yb[i][2], yb[i][3]};
            const float mean = sum8(((y[0] + y[1]) + (y[2] + y[3])) + ((y[4] + y[5]) + (y[6] + y[7]))) * (1.f / 64.f);
            float sq = 0.f;
#pragma unroll
            for (int j = 0; j < 8; ++j) { y[j] -= mean; sq += y[j] * y[j]; }
            const float rs = __builtin_amdgcn_rsqf(sum8(sq) * (1.f / 64.f) + 64e-5f);
#pragma unroll
            for (int j = 0; j < 8; ++j) { const float bo = bf2f((j & 1) ? (bq[i][j >> 1] >> 16) : (bq[i][j >> 1] & 0xffffu)), gg = bf2f((j & 1) ? (gq[i][j >> 1] >> 16) : (gq[i][j >> 1] & 0xffffu));
                y[j] = (y[j] * rs * gw[j] + gb[j] + bo) * gg; }
            *(u32x4*)(WSP(bf16_t, WS_MIX) + (size_t)(tok0 + tr + 16 * (4 * hf + i)) * D + 512 + c0) = __builtin_bit_cast(u32x4, pk8f(y));
        }
    }
}

constexpr int RT_WSTR = 1028;
DI void p4_router(Frame& F, int layer, bool dry) {
    LAS unsigned char* L = F.lds; const int tid = F.tid, lane = F.lane, wid = F.wave, m16 = lane & 15, q4 = lane >> 4;
    LAS float* W = (LAS float*)L;
    LAS float* wlog = (LAS float*)L + wid * (16 * 49);
    LAS int* ent = (LAS int*)(L + 148032);
    LAS float* entg = (LAS float*)(L + 148032 + 4096);
    LAS int* lcnt = (LAS int*)(L + 148032 + 5120);
    LAS int* lbase = lcnt + 144;
    const float* x = F.out; bf16_t* xb = WSP(bf16_t, WS_XB);
    const float *bg = F.in[20] + layer * 4, *be = F.in[22] + layer * 32;
    unsigned* cnt = (unsigned*)(F.ws + WS_CTL) + CW_CNT + layer * 256;
    int* elist = WSP(int, WS_LIST); f32x2* egate = WSP(f32x2, WS_GLIST); u32x2* plist = WSP(u32x2, WS_PLIST);
    for (int blk = F.bid; blk < NT / 128; blk += F.G) {
        __syncthreads();
        { const f32x4* src = (const f32x4*)(WSP(float, WS_RTW) + (size_t)layer * 36 * 1024);
          for (int i = tid; i < 36 * 256; i += 512) *(LAS f32x4*)(W + (i >> 8) * RT_WSTR + 4 * (i & 255)) = src[i]; }
        if (tid < 144) lcnt[tid] = 0;
        __syncthreads();
        const int row0 = blk * 128 + wid * 16;
        const float* xr = x + (size_t)(row0 + m16) * D + 4 * q4; bf16_t* xbr = xb + (size_t)(row0 + m16) * D + 4 * q4;
        f32x4 a0 = {}, a1 = {}, a2 = {}; float ssq = 0.f;
        const LAS float* w0p = W + (size_t)m16 * RT_WSTR + 4 * q4; const LAS float* w1p = w0p + 16 * RT_WSTR; const LAS float* w2p = W + (size_t)(32 + (m16 & 3)) * RT_WSTR + 4 * q4;
        const bool v2 = m16 < 4;
        f32x4 xq[2][16];
#pragma unroll
        for (int j = 0; j < 16; ++j) xq[0][j] = *(const f32x4*)(xr + 16 * j);
#pragma unroll
        for (int jb = 0; jb < 4; ++jb) {
            if (jb < 3) {
#pragma unroll
                for (int j = 0; j < 16; ++j) xq[(jb + 1) & 1][j] = *(const f32x4*)(xr + 16 * (16 * (jb + 1) + j));
            }
            asm volatile("" ::: "memory");
#pragma unroll
            for (int jj = 0; jj < 16; ++jj) { const int j = 16 * jb + jj;
                const f32x4 xv = xq[jb & 1][jj];
                const f32x4 wa = *(const LAS f32x4*)(w0p + 16 * j), wb = *(const LAS f32x4*)(w1p + 16 * j); f32x4 wc_ = *(const LAS f32x4*)(w2p + 16 * j);
                if (!v2) wc_ = (f32x4){0.f, 0.f, 0.f, 0.f};
                ssq += (xv[0] * xv[0] + xv[1] * xv[1]) + (xv[2] * xv[2] + xv[3] * xv[3]);
                u32x2 w; w.x = pk2(xv[0], xv[1]); w.y = pk2(xv[2], xv[3]); *(u32x2*)(xbr + 16 * j) = w;
#pragma unroll
                for (int i = 0; i < 4; ++i) { a0 = __builtin_amdgcn_mfma_f32_16x16x4f32(xv[i], wa[i], a0, 0, 0, 0); a1 = __builtin_amdgcn_mfma_f32_16x16x4f32(xv[i], wb[i], a1, 0, 0, 0); a2 = __builtin_amdgcn_mfma_f32_16x16x4f32(xv[i], wc_[i], a2, 0, 0, 0); }
            }
            asm volatile("" ::: "memory");
        }
        ssq += __shfl_xor(ssq, 16); ssq += __shfl_xor(ssq, 32);
        __syncthreads();
#pragma unroll
        for (int jj = 0; jj < 4; ++jj) { wlog[(4 * q4 + jj) * 49 + m16] = a0[jj]; wlog[(4 * q4 + jj) * 49 + 16 + m16] = a1[jj]; wlog[(4 * q4 + jj) * 49 + 32 + m16] = a2[jj]; }
        asm volatile("s_waitcnt lgkmcnt(0)" ::: "memory");
        if (lane < 16) {
            const int r = lane, row = row0 + r;
            const float rstd = __builtin_amdgcn_rsqf(ssq * (1.f / 1024.f) + 1e-6f);
            WSP(float, WS_RSTD2)[row] = rstd;
            float gl[4]; int gs = 0; float gmax;
#pragma unroll
            for (int j = 0; j < 4; ++j) gl[j] = wlog[r * 49 + j] * rstd + bg[j];
            gmax = gl[0];
#pragma unroll
            for (int j = 1; j < 4; ++j) if (gl[j] > gmax) { gmax = gl[j]; gs = j; }
            float gsum = 0.f;
#pragma unroll
            for (int j = 0; j < 4; ++j) gsum += ex2((gl[j] - gmax) * LOG2E);
            const float ggate = 1.f / gsum;
            float el[8];
#pragma unroll
            for (int j = 0; j < 8; ++j) el[j] = wlog[r * 49 + 4 + gs * 8 + j] * rstd + be[gs * 8 + j];
            int i0 = 0; float m0 = el[0];
#pragma unroll
            for (int j = 1; j < 8; ++j) if (el[j] > m0) { m0 = el[j]; i0 = j; }
            int i1 = -1; float m1 = -3.0e38f;
#pragma unroll
            for (int j = 0; j < 8; ++j) if (j != i0 && (i1 < 0 || el[j] > m1)) { m1 = el[j]; i1 = j; }
            const float e1 = ex2((m1 - m0) * LOG2E), g0 = ggate / (1.f + e1), g1 = ggate * e1 / (1.f + e1);
            const int la = i0 < i1 ? i0 : i1, lb = i0 < i1 ? i1 : i0; const float ga = i0 < i1 ? g0 : g1, gb = i0 < i1 ? g1 : g0;
            const int ea = gs * 8 + la, eb = gs * 8 + lb, pid = gs * 28 + la * (15 - la) / 2 + (lb - la - 1);
            const int ra = atomicAdd((int*)&lcnt[ea], 1), rb = atomicAdd((int*)&lcnt[eb], 1), rp = atomicAdd((int*)&lcnt[32 + pid], 1);
            const int li = wid * 16 + r;
            ent[li * 8 + 0] = ea; ent[li * 8 + 1] = eb; ent[li * 8 + 2] = pid; ent[li * 8 + 3] = ra; ent[li * 8 + 4] = rb; ent[li * 8 + 5] = rp; ent[li * 8 + 6] = __builtin_bit_cast(int, rstd); entg[li * 2] = ga; entg[li * 2 + 1] = gb;
        }
        __syncthreads();
        if (tid < 144) { const int n = lcnt[tid]; lbase[tid] = (n && !dry) ? (int)xb_add(cnt + tid, (unsigned)n) : 0; }
        __syncthreads();
        if (tid < 128 && !dry) { const int row = blk * 128 + tid; const int ea = ent[tid * 8], eb = ent[tid * 8 + 1], pid = ent[tid * 8 + 2];
            const int pa = lbase[ea] + ent[tid * 8 + 3], pb = lbase[eb] + ent[tid * 8 + 4], pp = lbase[32 + pid] + ent[tid * 8 + 5];
            const float rsd = __builtin_bit_cast(float, ent[tid * 8 + 6]);
            elist[(size_t)ea * LCAP + pa] = row; egate[(size_t)ea * LCAP + pa] = (f32x2){entg[tid * 2], rsd};
            elist[(size_t)eb * LCAP + pb] = row; egate[(size_t)eb * LCAP + pb] = (f32x2){entg[tid * 2 + 1], rsd};
            plist[(size_t)pid * LCAP + pp] = (u32x2){(unsigned)row, (unsigned)pa | ((unsigned)pb << 16)}; }
    }
    __syncthreads();
}
DI void moe_tables(Frame& F, int layer) {
    LAS MoeTab* T = (LAS MoeTab*)(F.lds + LDS_AUX);
    unsigned* cnt = (unsigned*)(F.ws + WS_CTL) + CW_CNT + layer * 256;
    __syncthreads();
    if (F.tid < 32) T->ce[F.tid] = (int)xb_ld(cnt + F.tid); else if (F.tid < 144) T->cp[F.tid - 32] = (int)xb_ld(cnt + F.tid);
    __syncthreads();
    if (F.tid == 0) { int sb = 0, tg = 0;
        for (int e = 0; e < 32; ++e) { const int a = T->ce[e]; T->sb[e] = sb; T->tpg[e] = tg; sb += a; tg += (a + 255) >> 8; }
        T->tpg[32] = tg; }
    if (F.tid == 64) { int tf = 0, th = 0;
        for (int p = 0; p < 112; ++p) { const int n = T->cp[p], nt_ = (n + 255) >> 8, half = (nt_ > 0 && n - 256 * (nt_ - 1) <= 128) ? 1 : 0; T->tpf[p] = tf; T->tph[p] = th; tf += nt_ - half; th += half; }
        T->tpf[112] = tf; T->tph[112] = th; }
    __syncthreads();
}
DI void p_final(Frame& F) {
    const int gw = F.bid * 8 + F.wave, NGW = F.G * 8; const f32x4* gq = (const f32x4*)F.in[26] + F.lane;
    f32x4 gv[4];
#pragma unroll
    for (int j = 0; j < 4; ++j) gv[j] = gq[64 * j];
    for (int m0 = gw * 4; m0 < NT; m0 += NGW * 4) {
        f32x4 v[4][4];
#pragma unroll
        for (int r = 0; r < 4; ++r) { const f32x4* xr = (const f32x4*)(F.out + (size_t)(m0 + r) * D) + F.lane;
#pragma unroll
            for (int j = 0; j < 4; ++j) v[r][j] = xr[64 * j]; }
#pragma unroll
        for (int r = 0; r < 4; ++r) { float s = 0.f; f32x4* xw = (f32x4*)(F.out + (size_t)(m0 + r) * D) + F.lane;
#pragma unroll
            for (int j = 0; j < 4; ++j) s += (v[r][j][0] * v[r][j][0] + v[r][j][1] * v[r][j][1]) + (v[r][j][2] * v[r][j][2] + v[r][j][3] * v[r][j][3]);
            const float rstd = __builtin_amdgcn_rsqf(wave_sum(s) * (1.f / 1024.f) + 1e-6f);
#pragma unroll
            for (int j = 0; j < 4; ++j) xw[64 * j] = v[r][j] * rstd * gv[j]; }
    }
}


#ifndef DUP_PH
#define DUP_PH -1
#endif
#define NREP(n) ((DUP_PH == (n)) ? 2 : 1)
constexpr int PH_PER_LAYER = 6, N_PHASES = 1 + DEPTH * PH_PER_LAYER + 1;
__global__ void __launch_bounds__(512, 2) mk_fwd(Args args) {
    extern __shared__ __attribute__((aligned(16))) unsigned char lds_raw[];
    Frame F;
    F.lds = (LAS unsigned char*)lds_raw; F.tid = threadIdx.x; F.lane = F.tid & 63; F.wave = __builtin_amdgcn_readfirstlane(F.tid >> 6);
    F.G = gridDim.x; F.bid = blockIdx.x; F.in = (const __attribute__((address_space(4))) cfp_t*)__builtin_amdgcn_kernarg_segment_ptr(); F.out = args.out; F.ws = args.ws;
    volatile LAS unsigned* MISC = (volatile LAS unsigned*)(F.lds + LDS_MISC);
    if (F.tid < 64) MISC[F.tid] = 0u;
    __syncthreads();
    unsigned* ctl = (unsigned*)(F.ws + WS_CTL);
    const int lo = args.ph_lo, hi = args.ph_hi;
    const bool multi = (hi - lo) > 1;
    XcdBarrier bar; bar.bar = ctl + CW_BAR; bar.x = 0; bar.st = nullptr;
    if (multi) bar = xcd_barrier_post(ctl + CW_BAR, MISC + 8);
#ifndef PHSEL
#define PHSEL -1
#endif
#ifndef PHMASK
#define PHMASK 0xFFFF
#endif
#define PS(n) ((PHSEL < 0 || PHSEL == (n)) && ((PHMASK >> (n)) & 1))
#define LAUNDER() do { asm volatile("" : "+s"(F.in)); asm volatile("" : "+s"(F.ws)); asm volatile("" : "+s"(F.out)); asm volatile("" : "+v"(F.tid)); asm volatile("" : "+v"(F.lane)); asm volatile("" : "+s"(F.bid)); asm volatile("" : "+s"(F.G)); } while (0)
#define IN(k) (lo <= (k) && (k) < hi)
#define SEAM(k) do { if (IN(k) && IN((k) + 1)) { xcd_barrier(bar); if (DUP_PH == 99) xcd_barrier(bar); } LAUNDER(); } while (0)
#ifdef TPROBE
    unsigned long long tp_acc = 0, tp_prev = __builtin_amdgcn_s_memrealtime();
#define TP(k) do { const unsigned long long tp_now = __builtin_amdgcn_s_memrealtime(); if ((k) == TPROBE || (k) == TPROBE2) tp_acc += tp_now - tp_prev; tp_prev = tp_now; } while (0)
#else
#define TP(k) do { } while (0)
#endif
    LAUNDER();
    if (PS(0) && IN(0)) { _Pragma("unroll 1") for (int rep = 0; rep < NREP(0); ++rep) p0_prologue(F); }
    SEAM(0); TP(0);
#pragma unroll 1
    for (int layer = 0; layer < DEPTH; ++layer) {
        const int pb = 1 + layer * PH_PER_LAYER;
        LAUNDER();
        if (PS(1) && IN(pb + 0)) _Pragma("unroll 1") for (int rep = 0; rep < NREP(1); ++rep) {
            ProbIn P; P.K = D; P.A = WSP(bf16_t, WS_XB); P.Bt = WSP(bf16_t, WS_BIN) + (size_t)layer * NIN * D; P.G = F.G; P.c = F.bid;
            P.Pout = WSP(bf16_t, WS_P); P.ss1 = WSP(float, WS_SS1); P.lf = WSP(float, WS_LF); P.bfx = F.in[16] + layer * 4; P.kmax = (unsigned*)(F.ws + WS_CTL) + CW_KMAX + layer * 128;
            pg8::gemm_phase<ProbIn, true>(F.lds, P, F.tid);
        }
        SEAM(pb + 0); TP(1);
        if (IN(pb + 1)) _Pragma("unroll 1") for (int rep = 0; rep < NREP(2); ++rep) {
            if (PS(4)) {
                __syncthreads();
                { LAS float* PARW = (LAS float*)(F.lds + RG_PAR);
                  for (int i = F.tid; i < 1280; i += 512) { const int a = i >> 8, c = i & 255; PARW[i] = F.in[a == 0 ? 6 : (a == 1 ? 8 : (a == 2 ? 12 : (a == 3 ? 13 : 11)))][layer * 256 + c]; } }
                __syncthreads();
                if (F.wave < 4) { _Pragma("unroll 1") for (int it = F.bid; it < 1024; it += F.G) rw_group_compute(F, layer, it); } else rw_loader_loop(F, layer);
                __syncthreads();
            }
        }
        if (IN(pb + 1)) {
            unsigned* r1d = (unsigned*)(F.ws + WS_CTL) + CW_R1D + layer * 2048;
            xcd_arrive(bar, r1d); TP(2);
            bool fxw = false;
            unsigned* sdw = (unsigned*)(F.ws + WS_CTL) + CW_SD + layer * 64;
            if (PS(5)) { if (F.G >= 64) { if (F.bid < 32) { xcd_wait_all(bar, r1d); TP(8); rw_seq_wg(F, F.bid, sdw); TP(9); } } else { xcd_wait_all(bar, r1d); for (int i = F.bid; i < 32; i += F.G) rw_seq_wg(F, i, sdw); } }
            unsigned* wq = (unsigned*)(F.ws + WS_CTL) + CW_WQ + layer * 64;
            volatile LAS int* qslot = (volatile LAS int*)(F.lds + LDS_MISC + 64);
            __syncthreads();
            if (F.tid == 0) qslot[0] = (int)xb_add(wq, 1u);
            __syncthreads();
            int q = qslot[0];
#pragma unroll 1
            for (;;) {
                if (q >= 1024 + 256 + 256) break;
                unsigned nq = 0u; if (F.tid == 0) nq = xb_add(wq, 1u);
                LAUNDER();
                if (q < 512) { if (PS(6)) sb_unit(F, (q & 63) >> 2, q & 3, 7 - (q >> 6)); }
                else if (q < 1024) { const int r = q - 512; if (!fxw) { xcd_wait_all(bar, r1d); fxw = true; } if (PS(2)) fx_unit(F, layer, (r & 63) >> 2, r & 3, 7 - (r >> 6)); }
                else if (q < 1280) { if (PS(3)) gm_item(F, layer, (q - 1024) >> 4, (q - 1024) & 15); }
                else if (PS(7)) {
                    if (F.tid == 0) { unsigned sp = 0; while (xb_ld(sdw) < 32u) { __builtin_amdgcn_s_sleep(2); if (++sp > (1u << 22)) break; }
                        __builtin_amdgcn_fence(__ATOMIC_ACQUIRE, "agent"); asm volatile("s_waitcnt vmcnt(0)" ::: "memory"); }
                    __syncthreads();
                    rw_post_item(F, layer, (q - 1280) * 128);
                }
                TP(q < 512 ? 20 : (q < 1024 ? 21 : (q < 1280 ? 22 : 23)));
                __syncthreads();
                if (F.tid == 0) qslot[0] = (int)nq;
                __syncthreads();
                q = qslot[0];
            }
        }
        SEAM(pb + 1); TP(3);
        if (PS(8) && IN(pb + 2)) {
            ProbOut P; P.K = D; P.A = WSP(bf16_t, WS_MIX); P.Bt = WSP(bf16_t, WS_BOUT) + (size_t)layer * D * D; P.G = F.G; P.c = F.bid;
            P.base = (layer == 0) ? F.in[0] : F.out; P.out = F.out;
            if (DUP_PH == 8) { P.ascale = 0.f; P.base = F.out; pg8::gemm_phase<ProbOut, true>(F.lds, P, F.tid); P.base = (layer == 0) ? F.in[0] : F.out; }
            P.ascale = 1.f; pg8::gemm_phase<ProbOut, true>(F.lds, P, F.tid);
        }
        SEAM(pb + 2); TP(4);
        if (PS(9) && IN(pb + 3)) { if (DUP_PH == 9) p4_router(F, layer, true); p4_router(F, layer, false); }
        SEAM(pb + 3); TP(5);
        if (PS(10) && IN(pb + 4)) {
            moe_tables(F, layer);
            ProbGU P; P.K = D; P.A = WSP(bf16_t, WS_XB); P.Bt = WSP(bf16_t, WS_BGU) + (size_t)layer * NE * 1024 * D; P.G = F.G; P.c = F.bid;
            P.T = (const LAS MoeTab*)(F.lds + LDS_AUX); P.elist = WSP(int, WS_LIST); P.egate = WSP(f32x2, WS_GLIST); P.HB = WSP(bf16_t, WS_HB);
            pg8::gemm_phase<ProbGU, true>(F.lds, P, F.tid);
        }
        SEAM(pb + 4); TP(6);
        if (PS(11) && IN(pb + 5)) {
            moe_tables(F, layer);
            ProbDP P; P.A = WSP(bf16_t, WS_HB); P.Bt = WSP(bf16_t, WS_BDN) + (size_t)layer * NE * D * EH; P.G = F.G; P.c = F.bid;
            P.T = (const LAS MoeTab*)(F.lds + LDS_AUX); P.plist = WSP(u32x2, WS_PLIST); P.x = F.out; P.xb = WSP(bf16_t, WS_XB); P.ss1 = WSP(float, WS_SS1);
            pg8::gemm_phase_pair<ProbDP>(F.lds, P, F.tid);
        }
        SEAM(pb + 5); TP(7);
    }
    if (PS(13) && IN(N_PHASES - 1)) p_final(F);
#ifdef TPROBE
    TP(10);
    #ifdef TPSLOT
    __syncthreads(); tp_acc = *((volatile LAS unsigned long long*)(F.lds + LDS_MISC + 128) + TPSLOT);
#endif
    if (F.bid == TPWG) { const unsigned long long t0 = __builtin_amdgcn_s_memrealtime(); while (__builtin_amdgcn_s_memrealtime() - t0 < 8ull * tp_acc) __builtin_amdgcn_s_sleep(8); }
#endif
#undef IN
#undef SEAM
}

#ifndef MK_ONE_LAUNCH
#define MK_ONE_LAUNCH 1
#endif
extern "C" void kernel_launch(void* const* d_in, const int* in_sizes, int n_in, void* d_out, int out_size, void* d_ws, size_t ws_size, hipStream_t stream) {
    static int grid = 0;
    if (grid == 0) {
        if (n_in != 27 || out_size != NT * D || ws_size < WS_END) { fprintf(stderr, "kernel_launch: unexpected shapes (n_in %d out %d ws %zu)\n", n_in, out_size, ws_size); grid = -1; return; }
        int dev = 0, cus = 0;
        if (hipGetDevice(&dev) != hipSuccess || hipDeviceGetAttribute(&cus, hipDeviceAttributeMultiprocessorCount, dev) != hipSuccess) { grid = -1; return; }
        if (hipFuncSetAttribute((const void*)mk_fwd, hipFuncAttributeMaxDynamicSharedMemorySize, LDS_BYTES) != hipSuccess) { fprintf(stderr, "kernel_launch: hipFuncSetAttribute failed\n"); grid = -1; return; }
        (void)hipGetLastError();
        grid = cus;
    }
    if (grid < 0) return;
    (void)hipMemsetAsync((char*)d_ws + WS_CTL, 0, CTL_BYTES, stream);
    Args a{};
    for (int i = 0; i < 27; ++i) a.in[i] = (const float*)d_in[i];
    a.out = (float*)d_out; a.ws = (unsigned char*)d_ws; a.li = 0; a.pad = 0;
#if MK_ONE_LAUNCH
    a.ph_lo = 0; a.ph_hi = N_PHASES;
    hipLaunchKernelGGL(mk_fwd, dim3(grid), dim3(512), LDS_BYTES, stream, a);
#else
    for (int p = 0; p < N_PHASES; ++p) { a.ph_lo = p; a.ph_hi = p + 1; hipLaunchKernelGGL(mk_fwd, dim3(grid), dim3(512), LDS_BYTES, stream, a); }
#endif
}
```

```cpp
#include <hip/hip_runtime.h>
#include <cstdio>
#include <cstdint>

#define DI __device__ __forceinline__
#define LAS __attribute__((address_space(3)))
#define GLB __attribute__((address_space(1)))
#define GAS __attribute__((address_space(1)))
typedef unsigned short bf16_t;
typedef short bf16x8 __attribute__((ext_vector_type(8)));
typedef short s16x4 __attribute__((ext_vector_type(4)));
typedef float f32x2 __attribute__((ext_vector_type(2)));
typedef float f32x4 __attribute__((ext_vector_type(4)));
typedef float f32x16 __attribute__((ext_vector_type(16)));
typedef unsigned u32x2 __attribute__((ext_vector_type(2)));
typedef unsigned u32x4 __attribute__((ext_vector_type(4)));
typedef __bf16 bf16x2_t __attribute__((ext_vector_type(2)));
typedef GAS unsigned gu32;

constexpr int NT = 32768, SEQ = 2048, NB = 16, D = 1024, DEPTH = 4, NH = 4;
constexpr int PP = 3072;
constexpr int NIN = 3328;
constexpr int C_SBQ = 0, C_SBK = 256, C_SBV = 512, C_GMU = 768, C_GMV = 1024, C_RWR = 1280, C_RWK = 1536, C_RWV = 1792, C_RWX = 2048, C_FXQ = 2304, C_FXK = 2560, C_FXV = 2816;
constexpr int NE = 32, EH = 512;
constexpr float LOG2E = 1.4426950408889634f, LN2 = 0.6931471805599453f;
constexpr float QSCALE2 = 0.125f * LOG2E;

constexpr size_t MiB = 1u << 20;
constexpr size_t WS_CTL = 0, CTL_BYTES = 1 * MiB;
constexpr size_t WS_BIN = 1 * MiB;
constexpr size_t WS_BOUT = 28 * MiB;
constexpr size_t WS_BGU = 36 * MiB;
constexpr size_t WS_BDN = 292 * MiB;
constexpr size_t WS_WCAT = 420 * MiB;
constexpr size_t WS_RTW = 421 * MiB;
constexpr size_t WS_SS1 = 422 * MiB;
constexpr size_t WS_RSTD2 = 424 * MiB;
constexpr size_t WS_LF = 425 * MiB;
constexpr size_t WS_GMW = 426 * MiB;
constexpr size_t WS_LIST = 428 * MiB;
constexpr size_t WS_GLIST = 436 * MiB;
constexpr size_t WS_GBUF = 444 * MiB;
constexpr size_t WS_YBUF = 460 * MiB;
constexpr size_t WS_MIX = 492 * MiB;
constexpr size_t WS_P = 556 * MiB;
constexpr size_t WS_XB = 748 * MiB;
constexpr size_t WS_HB = 812 * MiB;
constexpr size_t WS_REC = 748 * MiB;
constexpr size_t WS_CHMT = 812 * MiB;
constexpr size_t WS_CHN = 844 * MiB;
constexpr size_t WS_CHFR = 812 * MiB;
constexpr size_t WS_CHRY = 877 * MiB;
constexpr size_t WS_CHY0 = 893 * MiB;
constexpr size_t WS_BONV = 909 * MiB;
constexpr size_t WS_PLIST = 940 * MiB;
constexpr size_t WS_END = 968 * MiB;

constexpr int CW_BAR = 4096;
constexpr int CW_CNT = 16384;
constexpr int CW_R1D = 40960;
constexpr int CW_SD = 28672;
constexpr int CW_WQ = 24576;
constexpr int CW_KMAX = 20480;

constexpr int LDS_BYTES = 163840;
constexpr int LDS_AUX = 131072;
constexpr int LDS_MISC = 163840 - 256;

DI float bf2f(unsigned b) { return __uint_as_float(b << 16); }
DI unsigned pk2(float lo, float hi) { f32x2 v = {lo, hi}; bf16x2_t b = __builtin_convertvector(v, bf16x2_t); return __builtin_bit_cast(unsigned, b); }
DI unsigned f2bf(float f) { return pk2(f, 0.f) & 0xffffu; }
DI bf16x8 pk8f(const float (&v)[8]) { u32x4 p; p.x = pk2(v[0], v[1]); p.y = pk2(v[2], v[3]); p.z = pk2(v[4], v[5]); p.w = pk2(v[6], v[7]); return __builtin_bit_cast(bf16x8, p); }
DI float ex2(float x) { return __builtin_amdgcn_exp2f(x); }
DI float lg2(float x) { return __builtin_amdgcn_logf(x); }
DI float rcpf_(float x) { return __builtin_amdgcn_rcpf(x); }
DI float sigmoidf_(float x) { return rcpf_(1.f + ex2(-x * LOG2E)); }
DI float tanhf_(float x) { return 1.f - 2.f * rcpf_(1.f + ex2(2.f * LOG2E * x)); }
DI float geluf_(float x) { const float u = 0.7978845608028654f * (x + 0.044715f * x * x * x); return x * rcpf_(1.f + ex2(-2.f * LOG2E * u)); }
DI float softplusf_(float x) { return fmaxf(x, 0.f) + LN2 * lg2(1.f + ex2(-fabsf(x) * LOG2E)); }
template <int CTRL, int RMASK, bool BC> DI float dppf(float x) { return __builtin_bit_cast(float, __builtin_amdgcn_update_dpp(0, __builtin_bit_cast(int, x), CTRL, RMASK, 0xf, BC)); }
DI float wave_sum(float v) {
    v += dppf<0xB1, 0xf, true>(v); v += dppf<0x4E, 0xf, true>(v); v += dppf<0x141, 0xf, true>(v); v += dppf<0x140, 0xf, true>(v);
    v += dppf<0x142, 0xa, false>(v); v += dppf<0x143, 0xc, false>(v);
    return __builtin_bit_cast(float, __builtin_amdgcn_readlane(__builtin_bit_cast(int, v), 63));
}
DI float swap32(float v) { return __shfl_xor(v, 32); }
#define MFMA32(a, b, c) __builtin_amdgcn_mfma_f32_32x32x16_bf16((a), (b), (c), 0, 0, 0)
DI int crow(int r, int h) { return (r & 3) + 8 * (r >> 2) + 4 * h; }

#define XB_TMO      128
#define XB_XCNT(j)  (256  + 64 * (j))
#define XB_XSUB(j)  (1280 + 64 * (j))
#define XB_XGEN(j)  (2304 + 64 * (j))
#define XB_TOP      3328
#define XB_TOPGEN   3392
#define XCD_BAR_WORDS 3456
#define XB_SPIN_CAP (1u << 18)
DI unsigned xb_ld(unsigned* p)              { return __hip_atomic_load(p, __ATOMIC_RELAXED, __HIP_MEMORY_SCOPE_AGENT); }
DI unsigned xb_add(unsigned* p, unsigned v) { return __hip_atomic_fetch_add(p, v, __ATOMIC_RELAXED, __HIP_MEMORY_SCOPE_AGENT); }
DI unsigned xb_xcc_id() { return (unsigned)__builtin_amdgcn_s_getreg((3 << 11) | 20) & 0xFu; }
#define XB_SPIN(cond, bar) do { unsigned _sp = 0; while (cond) { __builtin_amdgcn_s_sleep(1); \
    if ((++_sp & 255u) == 0u) { if (xb_ld(&(bar)[XB_TMO])) break; if (_sp > XB_SPIN_CAP) { atomicAdd(&(bar)[XB_TMO], 1u); break; } } } } while (0)
struct XcdBarrier { unsigned* bar; unsigned x; volatile LAS unsigned* st; };
DI XcdBarrier xcd_barrier_post(unsigned* bar, volatile LAS unsigned* st) {
    XcdBarrier b; b.bar = bar; b.x = xb_xcc_id(); b.st = st;
    if (threadIdx.x == 0) (void)xb_add(&bar[XB_XCNT(b.x)], 1u);
    return b;
}
DI void xcd_barrier_complete(unsigned* bar, unsigned x, unsigned& nloc, unsigned& nx) {
    const unsigned G = gridDim.x * gridDim.y * gridDim.z;
    unsigned sum, cnt, mine, sp = 0u;
    for (;;) {
        sum = 0u; cnt = 0u; mine = 0u;
#pragma unroll
        for (unsigned j = 0; j < 16; ++j) { const unsigned c = xb_ld(&bar[XB_XCNT(j)]); sum += c; cnt += (c > 0u) ? 1u : 0u; mine = (j == x) ? c : mine; }
        if (sum == G) break;
        __builtin_amdgcn_s_sleep(1);
        if ((++sp & 255u) == 0u) { if (xb_ld(&bar[XB_TMO])) break; if (sp > XB_SPIN_CAP) { atomicAdd(&bar[XB_TMO], 1u); break; } }
    }
    nloc = mine > 0u ? mine : 1u; nx = cnt > 0u ? cnt : 1u;
}
DI void xcd_barrier(const XcdBarrier& b) {
    asm volatile("s_waitcnt vmcnt(0)" ::: "memory");
    __syncthreads();
    if (threadIdx.x == 0) {
        unsigned* bar = b.bar;
        __builtin_amdgcn_s_waitcnt(0);
        unsigned nloc = b.st[0], nx = b.st[1];
        if (nloc == 0u) { xcd_barrier_complete(bar, b.x, nloc, nx); b.st[0] = nloc; b.st[1] = nx; }
        const unsigned old = xb_add(&bar[XB_XSUB(b.x)], 1u);
        const unsigned gen = old / nloc;
        if (old + 1u == (gen + 1u) * nloc) {
            __builtin_amdgcn_fence(__ATOMIC_RELEASE, "agent");
            asm volatile("s_waitcnt vmcnt(0)" ::: "memory");
            const unsigned og = xb_add(&bar[XB_TOP], 1u);
            const unsigned tg = og / nx;
            if (og + 1u == (tg + 1u) * nx) xb_add(&bar[XB_TOPGEN], 1u);
            else XB_SPIN(xb_ld(&bar[XB_TOPGEN]) == tg, bar);
            __builtin_amdgcn_fence(__ATOMIC_ACQUIRE, "agent");
            xb_add(&bar[XB_XGEN(b.x)], 1u);
            asm volatile("s_waitcnt vmcnt(0)" ::: "memory");
        } else {
            XB_SPIN(xb_ld(&bar[XB_XGEN(b.x)]) == gen, bar);
            __builtin_amdgcn_fence(__ATOMIC_ACQUIRE, "agent");
            asm volatile("s_waitcnt vmcnt(0)" ::: "memory");
        }
    }
    __syncthreads();
}

DI void xcd_arrive(const XcdBarrier& b, unsigned* w) {
    asm volatile("s_waitcnt vmcnt(0)" ::: "memory");
    __syncthreads();
    if (threadIdx.x == 0) {
        const unsigned nloc = b.st[0];
        const unsigned old = xb_add(&w[64 * b.x], 1u);
        if (old + 1u == nloc) { __builtin_amdgcn_fence(__ATOMIC_RELEASE, "agent"); asm volatile("s_waitcnt vmcnt(0)" ::: "memory"); (void)xb_add(&w[64 * 16], 1u); }
    }
}
DI void xcd_wait_all(const XcdBarrier& b, unsigned* w) {
    if (threadIdx.x == 0) { const unsigned nx = b.st[1]; unsigned sp = 0; while (xb_ld(&w[64 * 16]) < nx) { __builtin_amdgcn_s_sleep(1); if (++sp > (1u << 22)) break; }
        __builtin_amdgcn_fence(__ATOMIC_ACQUIRE, "agent"); asm volatile("s_waitcnt vmcnt(0)" ::: "memory"); }
    __syncthreads();
}

typedef const float* cfp_t;
struct Args { const float* in[27]; float* out; unsigned char* ws; int ph_lo, ph_hi, li, pad; };
struct Frame {
    LAS unsigned char* lds;
    int tid, lane, wave, G, bid;
    const __attribute__((address_space(4))) cfp_t* in;
    float* out; unsigned char* ws;
};
#define WSP(T, off) ((T*)(F.ws + (off)))

namespace pg8 {
constexpr int BM = 256, BK = 64, HALF = 128, HTB = HALF * BK * 2, STAGE_BYTES = 8 * HTB, NXCD = 8, WGM = 8;
DI int lds_byte(int r, int c) { const int st = (r >> 4) * 2 + (c >> 5), rr = r & 15, cc = c & 31, ob = rr * 64 + cc * 2; return st * 1024 + (ob ^ (((ob >> 9) & 1) << 5)); }
DI void stage_rc(int b, int& R, int& C) { const int st = b / 1024, sb = b % 1024, swz = sb ^ (((sb >> 9) & 1) << 5); R = (st >> 1) * 16 + swz / 64; C = (st & 1) * 32 + (swz % 64) / 2; }
DI int perm32(int rho) { const int n = rho >> 4, i = rho & 15; return 8 * (i >> 2) + 4 * n + (i & 3); }
struct Unit { int pm, pn, e, cnt, base, aux; };
DI bool static_next(int nM, int nN, int G, int c, int i, Unit& u) {
    const int nwg = nM * nN; const long L = (long)i * G + c; if (L >= nwg) return false;
    int wgid = (int)L; { const int q = nwg / NXCD, r = nwg % NXCD, xcd = wgid % NXCD, off = wgid / NXCD; wgid = (xcd < r ? xcd * (q + 1) : r * (q + 1) + (xcd - r) * q) + off; }
    const int nig = WGM * nN, gid = wgid / nig, fm = gid * WGM, gsz = (nM - fm) < WGM ? (nM - fm) : WGM;
    u.pm = fm + ((wgid % nig) % gsz); u.pn = (wgid % nig) / gsz; u.e = 0; u.cnt = 0; u.base = 0; u.aux = 0; return true;
}

template <class Prob, bool ALIGN_EPI>
DI void gemm_phase(LAS unsigned char* lds, const Prob& P, const int tid) {
    const int wid = __builtin_amdgcn_readfirstlane(tid >> 6), lane = tid & 63, wr = wid >> 2, wc = wid & 3, fr = lane & 15, fq = lane >> 4;
    const int K = P.K, nt = K / BK;
    constexpr bool GA = Prob::GATHER;
    unsigned voffB[2], voffA[2];
#pragma unroll
    for (int i = 0; i < 2; ++i) { int R, C; stage_rc(tid * 16 + i * 8192, R, C); const int Rb = Prob::PERM ? ((R & ~31) + perm32(R & 31)) : R; voffB[i] = (unsigned)(Rb * K + C) * 2u; voffA[i] = (unsigned)(R * K + C) * 2u; }
    const size_t kstep = (size_t)(BK * 2);
    const size_t hstepB = (size_t)HALF * K * 2;
    const unsigned ldsw = (unsigned)wid * 1024u;
    const int aoffL = lds_byte(wr * 64 + fr, fq * 8), boffL = lds_byte(wc * 32 + fr, fq * 8);
    const char* Abase = (const char*)P.A;
#define PG8_SA(b, h) (((b) * 2 + (h)) * HTB)
#define PG8_SB(b, h) ((4 + (b) * 2 + (h)) * HTB)
#define PG8_STG_B(bufoff, gbase) do { _Pragma("unroll") for (int _i = 0; _i < 2; ++_i) \
        __builtin_amdgcn_global_load_lds((const unsigned*)((const char*)(gbase) + voffB[_i]), (LAS unsigned*)(lds + (bufoff) + ldsw + _i * 8192), 16, 0, 0); } while (0)
#define PG8_STG_A(bufoff, h, kbyte) do { _Pragma("unroll") for (int _i = 0; _i < 2; ++_i) { \
        const char* _p; if constexpr (GA) _p = Abase + (size_t)(kbyte) + aoff[h][_i]; else _p = cA + (size_t)(h) * hstepB + (size_t)(kbyte) + voffA[_i]; \
        __builtin_amdgcn_global_load_lds((const unsigned*)_p, (LAS unsigned*)(lds + (bufoff) + ldsw + _i * 8192), 16, 0, 0); } } while (0)
#define PG8_LDA(dst, b, h) do { _Pragma("unroll") for (int m = 0; m < 4; ++m) _Pragma("unroll") for (int k = 0; k < 2; ++k) dst[m][k] = *(const LAS bf16x8*)(lds + PG8_SA(b, h) + aoffL + m * 2048 + k * 1024); } while (0)
#define PG8_LDB(dst, b, h) do { _Pragma("unroll") for (int n = 0; n < 2; ++n) _Pragma("unroll") for (int k = 0; k < 2; ++k) dst[n][k] = *(const LAS bf16x8*)(lds + PG8_SB(b, h) + boffL + n * 2048 + k * 1024); } while (0)
#define PG8_MMA(ai, bj, At, Bt) do { __builtin_amdgcn_s_setprio(1); _Pragma("unroll") for (int m = 0; m < 4; ++m) _Pragma("unroll") for (int n = 0; n < 2; ++n) _Pragma("unroll") for (int k = 0; k < 2; ++k) \
        acc[ai][bj][m][n] = __builtin_amdgcn_mfma_f32_16x16x32_bf16(Bt[n][k], At[m][k], acc[ai][bj][m][n], 0, 0, 0); __builtin_amdgcn_s_setprio(0); } while (0)
#define PG8_WAIT_V(n) asm volatile("s_waitcnt vmcnt(" #n ")" ::: "memory")
#define PG8_WAIT_L(n) asm volatile("s_waitcnt lgkmcnt(" #n ")" ::: "memory")
#define PG8_BAR __builtin_amdgcn_s_barrier()
#define PG8_SCHED __builtin_amdgcn_sched_barrier(0)
    Unit cur, nxt; int ui = 0;
    if (!P.next(0, cur)) return;
    f32x4 acc[2][2][4][2];
#pragma unroll
    for (int a = 0; a < 2; ++a)
#pragma unroll
        for (int b = 0; b < 2; ++b)
#pragma unroll
            for (int m = 0; m < 4; ++m)
#pragma unroll
                for (int n = 0; n < 2; ++n) acc[a][b][m][n] = (f32x4){0.f, 0.f, 0.f, 0.f};
    bf16x8 At[4][2], B0[2][2], B1[2][2];
    unsigned aoff[2][2] = {{0u, 0u}, {0u, 0u}}, noff[2][2] = {{0u, 0u}, {0u, 0u}};
    const char* cA = Abase; const char* nA = Abase;
    if constexpr (GA) P.aoffs(cur, tid, aoff); else cA = Abase + (size_t)P.arow0(cur) * K * 2;
    const char* cB = P.bbase(cur);
    PG8_STG_B(PG8_SB(0, 0), cB); PG8_STG_B(PG8_SB(0, 1), cB + hstepB); PG8_STG_A(PG8_SA(0, 0), 0, 0); PG8_STG_A(PG8_SA(0, 1), 1, 0);
    if (wr == 1) PG8_BAR;
    PG8_WAIT_V(2); PG8_BAR;
    PG8_STG_B(PG8_SB(1, 0), cB + kstep); PG8_STG_A(PG8_SA(1, 0), 0, kstep); PG8_STG_B(PG8_SB(1, 1), cB + hstepB + kstep);
    PG8_WAIT_V(6); PG8_BAR;
    for (;;) {
        const bool has_next = P.next(ui + 1, nxt);
        const char* nB = cB; nA = cA;
        if (has_next) { nB = P.bbase(nxt); if constexpr (GA) P.aoffs(nxt, tid, noff); else nA = Abase + (size_t)P.arow0(nxt) * K * 2; }
        else if constexpr (GA) { noff[0][0] = aoff[0][0]; noff[0][1] = aoff[0][1]; noff[1][0] = aoff[1][0]; noff[1][1] = aoff[1][1]; }
        if constexpr (GA) { *(LAS u32x4*)(lds + LDS_AUX + 2048 + tid * 16) = (u32x4){noff[0][0], noff[0][1], noff[1][0], noff[1][1]}; }
        for (int t = 0; t < nt; t += 2) {
            const bool last = (t == nt - 2);
            const size_t k1 = (size_t)(t + 1) * kstep;
            const size_t k2 = last ? (size_t)0 : (size_t)(t + 2) * kstep, k3 = k2 + kstep;
            const char* b2 = last ? nB : cB + (size_t)(t + 2) * kstep; const char* b3 = b2 + kstep;
            PG8_LDB(B0, 0, 0); PG8_LDB(B1, 0, 1); PG8_SCHED; PG8_LDA(At, 0, 0); PG8_STG_A(PG8_SA(1, 1), 1, k1);
            PG8_WAIT_V(8); PG8_WAIT_L(0); PG8_BAR; PG8_MMA(0, 0, At, B0); PG8_MMA(0, 1, At, B1); PG8_BAR; PG8_SCHED;
            if (last) { if constexpr (GA) { const u32x4 nq = *(const LAS u32x4*)(lds + LDS_AUX + 2048 + tid * 16); aoff[0][0] = nq[0]; aoff[0][1] = nq[1]; aoff[1][0] = nq[2]; aoff[1][1] = nq[3]; } else cA = nA; }
            PG8_LDA(At, 0, 1); PG8_STG_B(PG8_SB(0, 0), b2); PG8_STG_B(PG8_SB(0, 1), b2 + hstepB); PG8_STG_A(PG8_SA(0, 0), 0, k2);
            PG8_WAIT_V(8); PG8_WAIT_L(0); PG8_BAR; PG8_MMA(1, 0, At, B0); PG8_MMA(1, 1, At, B1); PG8_BAR; PG8_SCHED;
            PG8_LDB(B0, 1, 0); PG8_LDB(B1, 1, 1); PG8_SCHED; PG8_LDA(At, 1, 0); PG8_STG_A(PG8_SA(0, 1), 1, k2);
            PG8_WAIT_V(8); PG8_WAIT_L(0); PG8_BAR; PG8_MMA(0, 0, At, B0); PG8_MMA(0, 1, At, B1); PG8_BAR; PG8_SCHED;
            PG8_LDA(At, 1, 1); PG8_STG_B(PG8_SB(1, 0), b3); PG8_STG_B(PG8_SB(1, 1), b3 + hstepB); PG8_STG_A(PG8_SA(1, 0), 0, k3);
            PG8_WAIT_V(8); PG8_WAIT_L(0); PG8_BAR; PG8_MMA(1, 0, At, B0); PG8_MMA(1, 1, At, B1); PG8_BAR; PG8_SCHED;
        }
        if constexpr (ALIGN_EPI) { if (wr == 0) PG8_BAR; }
        P.epi(acc, cur, wr, wc, fr, fq);
        if (!has_next) break;
#pragma unroll
        for (int a = 0; a < 2; ++a)
#pragma unroll
            for (int b = 0; b < 2; ++b)
#pragma unroll
                for (int m = 0; m < 4; ++m)
#pragma unroll
                    for (int n = 0; n < 2; ++n) acc[a][b][m][n] = (f32x4){0.f, 0.f, 0.f, 0.f};
        cur = nxt; cB = nB; ++ui;
        if constexpr (ALIGN_EPI) { if (wr == 1) PG8_BAR; }
    }
    PG8_WAIT_V(0);
    if constexpr (!ALIGN_EPI) { if (wr == 0) PG8_BAR; }
    PG8_BAR;
#undef PG8_SA
#undef PG8_SB
#undef PG8_STG_A
#undef PG8_STG_B
#undef PG8_LDA
#undef PG8_LDB
#undef PG8_MMA
#undef PG8_WAIT_V
#undef PG8_WAIT_L
#undef PG8_BAR
#undef PG8_SCHED
}

template <class Prob>
DI void gemm_phase_pair(LAS unsigned char* lds, const Prob& P, const int tid) {
    const int wid = __builtin_amdgcn_readfirstlane(tid >> 6), lane = tid & 63, wr = wid >> 2, wc = wid & 3, fr = lane & 15, fq = lane >> 4;
    constexpr int KP = 512, nt = 16;
    unsigned voffB[2];
#pragma unroll
    for (int i = 0; i < 2; ++i) { int R, C; stage_rc(tid * 16 + i * 8192, R, C); const int Rb = Prob::PERM ? ((R & ~31) + perm32(R & 31)) : R; voffB[i] = (unsigned)(Rb * KP + C) * 2u; }
    const size_t kstep = (size_t)(BK * 2);
    const size_t hstepB = (size_t)HALF * KP * 2;
    const unsigned ldsw = (unsigned)wid * 1024u;
    const int aoffL = lds_byte(wr * 64 + fr, fq * 8), boffL = lds_byte(wc * 32 + fr, fq * 8);
    const char* Abase = (const char*)P.A;
    LAS unsigned char* park = lds + LDS_AUX + 2048 + tid * 48;
#define PG8_SA(b, h) (((b) * 2 + (h)) * HTB)
#define PG8_SB(b, h) ((4 + (b) * 2 + (h)) * HTB)
#define PG8_STG_B(bufoff, gbase) do { _Pragma("unroll") for (int _i = 0; _i < 2; ++_i) \
        __builtin_amdgcn_global_load_lds((const unsigned*)((const char*)(gbase) + voffB[_i]), (LAS unsigned*)(lds + (bufoff) + ldsw + _i * 8192), 16, 0, 0); } while (0)
#define PG8_STG_A(bufoff, h, kbyte) do { _Pragma("unroll") for (int _i = 0; _i < 2; ++_i) \
        __builtin_amdgcn_global_load_lds((const unsigned*)(Abase + (size_t)(kbyte) + aoff[h][_i]), (LAS unsigned*)(lds + (bufoff) + ldsw + _i * 8192), 16, 0, 0); } while (0)
#define PG8_LDA(dst, b, h) do { _Pragma("unroll") for (int m = 0; m < 4; ++m) _Pragma("unroll") for (int k = 0; k < 2; ++k) dst[m][k] = *(const LAS bf16x8*)(lds + PG8_SA(b, h) + aoffL + m * 2048 + k * 1024); } while (0)
#define PG8_LDB(dst, b, h) do { _Pragma("unroll") for (int n = 0; n < 2; ++n) _Pragma("unroll") for (int k = 0; k < 2; ++k) dst[n][k] = *(const LAS bf16x8*)(lds + PG8_SB(b, h) + boffL + n * 2048 + k * 1024); } while (0)
#define PG8_MMA(ai, bj, At, Bt) do { __builtin_amdgcn_s_setprio(1); _Pragma("unroll") for (int m = 0; m < 4; ++m) _Pragma("unroll") for (int n = 0; n < 2; ++n) _Pragma("unroll") for (int k = 0; k < 2; ++k) \
        acc[ai][bj][m][n] = __builtin_amdgcn_mfma_f32_16x16x32_bf16(Bt[n][k], At[m][k], acc[ai][bj][m][n], 0, 0, 0); __builtin_amdgcn_s_setprio(0); } while (0)
#define PG8_WAIT_V(n) asm volatile("s_waitcnt vmcnt(" #n ")" ::: "memory")
#define PG8_WAIT_L(n) asm volatile("s_waitcnt lgkmcnt(" #n ")" ::: "memory")
#define PG8_BAR __builtin_amdgcn_s_barrier()
#define PG8_SCHED __builtin_amdgcn_sched_barrier(0)
#define PG8_PARK(slot, v) (*(LAS u32x4*)(park + 16 * (slot)) = (u32x4){v[0][0], v[0][1], v[1][0], v[1][1]})
#define PG8_UNPARK(slot) do { const u32x4 _q = *(const LAS u32x4*)(park + 16 * (slot)); aoff[0][0] = _q[0]; aoff[0][1] = _q[1]; aoff[1][0] = _q[2]; aoff[1][1] = _q[3]; } while (0)
    Unit cur, nxt; int ui = 0;
    if (!P.next(0, cur)) return;
    f32x4 acc[2][2][4][2];
#pragma unroll
    for (int a = 0; a < 2; ++a)
#pragma unroll
        for (int b = 0; b < 2; ++b)
#pragma unroll
            for (int m = 0; m < 4; ++m)
#pragma unroll
                for (int n = 0; n < 2; ++n) acc[a][b][m][n] = (f32x4){0.f, 0.f, 0.f, 0.f};
    bf16x8 At[4][2], B0[2][2], B1[2][2];
    unsigned aoff[2][2];
    { unsigned tb[2][2]; P.aoffs2(cur, tid, aoff, tb); PG8_PARK(0, tb); }
    const char* cBa = P.bbase_a(cur); const char* cBb = P.bbase_b(cur);
    PG8_STG_B(PG8_SB(0, 0), cBa); PG8_STG_B(PG8_SB(0, 1), cBa + hstepB); PG8_STG_A(PG8_SA(0, 0), 0, 0); PG8_STG_A(PG8_SA(0, 1), 1, 0);
    if (wr == 1) PG8_BAR;
    PG8_WAIT_V(2); PG8_BAR;
    PG8_STG_B(PG8_SB(1, 0), cBa + kstep); PG8_STG_A(PG8_SA(1, 0), 0, kstep); PG8_STG_B(PG8_SB(1, 1), cBa + hstepB + kstep);
    PG8_WAIT_V(6); PG8_BAR;
    for (;;) {
        const bool has_next = P.next(ui + 1, nxt);
        const char* nBa = cBa; const char* nBb = cBb;
        {
            unsigned ta[2][2], tb[2][2];
            if (has_next) { P.aoffs2(nxt, tid, ta, tb); nBa = P.bbase_a(nxt); nBb = P.bbase_b(nxt); } else P.aoffs2(cur, tid, ta, tb);
            PG8_PARK(2, ta); PG8_PARK((ui + 1) & 1, tb);
        }
        const bool hu = (cur.cnt - cur.pm * 256) <= 128;
        for (int t = 0; t < nt; t += 2) {
            const bool last = (t == nt - 2);
            const size_t k1 = (size_t)((t + 1) & 7) * kstep;
            const int t2 = last ? 0 : t + 2;
            const size_t k2 = (size_t)(t2 & 7) * kstep, k3 = k2 + kstep;
            const char* b2 = last ? nBa : ((t2 < 8 ? cBa : cBb) + k2); const char* b3 = b2 + kstep;
            PG8_LDB(B0, 0, 0); PG8_LDB(B1, 0, 1); PG8_SCHED; PG8_LDA(At, 0, 0); PG8_STG_A(PG8_SA(1, 1), 1, k1);
            PG8_WAIT_V(8); PG8_WAIT_L(0); PG8_BAR; PG8_MMA(0, 0, At, B0); PG8_MMA(0, 1, At, B1); PG8_BAR; PG8_SCHED;
            if (t == 6) PG8_UNPARK(ui & 1);
            if (last) PG8_UNPARK(2);
            PG8_LDA(At, 0, 1); PG8_STG_B(PG8_SB(0, 0), b2); PG8_STG_B(PG8_SB(0, 1), b2 + hstepB); PG8_STG_A(PG8_SA(0, 0), 0, k2);
            PG8_WAIT_V(8); PG8_WAIT_L(0); PG8_BAR; if (!hu) { PG8_MMA(1, 0, At, B0); PG8_MMA(1, 1, At, B1); } PG8_BAR; PG8_SCHED;
            PG8_LDB(B0, 1, 0); PG8_LDB(B1, 1, 1); PG8_SCHED; PG8_LDA(At, 1, 0); PG8_STG_A(PG8_SA(0, 1), 1, k2);
            PG8_WAIT_V(8); PG8_WAIT_L(0); PG8_BAR; PG8_MMA(0, 0, At, B0); PG8_MMA(0, 1, At, B1); PG8_BAR; PG8_SCHED;
            PG8_LDA(At, 1, 1); PG8_STG_B(PG8_SB(1, 0), b3); PG8_STG_B(PG8_SB(1, 1), b3 + hstepB); PG8_STG_A(PG8_SA(1, 0), 0, k3);
            PG8_WAIT_V(8); PG8_WAIT_L(0); PG8_BAR; if (!hu) { PG8_MMA(1, 0, At, B0); PG8_MMA(1, 1, At, B1); } PG8_BAR; PG8_SCHED;
        }
        if (wr == 0) PG8_BAR;
        P.epi(acc, cur, wr, wc, fr, fq);
        if (!has_next) break;
#pragma unroll
        for (int a = 0; a < 2; ++a)
#pragma unroll
            for (int b = 0; b < 2; ++b)
#pragma unroll
                for (int m = 0; m < 4; ++m)
#pragma unroll
                    for (int n = 0; n < 2; ++n) acc[a][b][m][n] = (f32x4){0.f, 0.f, 0.f, 0.f};
        cur = nxt; cBa = nBa; cBb = nBb; ++ui;
        if (wr == 1) PG8_BAR;
    }
    PG8_WAIT_V(0);
    PG8_BAR;
#undef PG8_SA
#undef PG8_SB
#undef PG8_STG_A
#undef PG8_STG_B
#undef PG8_LDA
#undef PG8_LDB
#undef PG8_MMA
#undef PG8_WAIT_V
#undef PG8_WAIT_L
#undef PG8_BAR
#undef PG8_SCHED
#undef PG8_PARK
#undef PG8_UNPARK
}
}
using pg8::Unit;


struct MoeTab { int ce[32], sb[32], tpg[33], cp[112], tpf[113], tph[113]; };
constexpr int LCAP = 32768;
DI int pair_lo(int p) { int i = 0; _Pragma("unroll") for (int k = 1; k < 7; ++k) if (p >= k * (15 - k) / 2) i = k; return i; }
DI int pair_hi(int p, int i) { return p - i * (15 - i) / 2 + i + 1; }

struct ProbIn {
    static constexpr bool PERM = true, GATHER = false;
    int K; const bf16_t* A; const bf16_t* Bt; int G, c;
    bf16_t* Pout; const float* ss1; float* lf; const float* bfx; unsigned* kmax;
    DI bool next(int i, Unit& u) const { return pg8::static_next(128, 12, G, c, i, u); }
    DI int arow0(const Unit& u) const { return u.pm * 256; }
    DI const char* bbase(const Unit& u) const { return (const char*)Bt + (size_t)u.pn * 256 * K * 2; }
    DI void epi(const f32x4 (&acc)[2][2][4][2], const Unit& u, int wr, int wc, int fr, int fq) const {
        float km0 = 0.f, km1 = 0.f;
        float rs[8];
        {
            f32x4 sv[8];
#pragma unroll
            for (int g = 0; g < 8; ++g) sv[g] = *(GLB const f32x4*)(ss1 + (size_t)(u.pm * 256 + (g >> 2) * 128 + wr * 64 + (g & 3) * 16 + fr) * 16 + 4 * fq);
#pragma unroll
            for (int g = 0; g < 8; ++g) { float ss = (sv[g][0] + sv[g][1]) + (sv[g][2] + sv[g][3]); ss += __shfl_xor(ss, 16); ss += __shfl_xor(ss, 32);
                rs[g] = __builtin_amdgcn_rsqf(ss * (1.f / 1024.f) + 1e-6f); }
        }
#pragma unroll
        for (int ai = 0; ai < 2; ++ai)
#pragma unroll
            for (int m = 0; m < 4; ++m) {
                const int row = u.pm * 256 + ai * 128 + wr * 64 + m * 16 + fr;
                const float rstd = rs[ai * 4 + m];
                {
                    bf16_t* rowp = Pout + (size_t)row * PP + u.pn * 256 + wc * 32 + 8 * fq;
#pragma unroll
                    for (int bj = 0; bj < 2; ++bj) { const f32x4 v0 = acc[ai][bj][m][0] * rstd, v1 = acc[ai][bj][m][1] * rstd;
                        u32x4 w; w.x = pk2(v0[0], v0[1]); w.y = pk2(v0[2], v0[3]); w.z = pk2(v1[0], v1[1]); w.w = pk2(v1[2], v1[3]);
                        *(GLB u32x4*)(rowp + bj * 128) = w; }
                    if (u.pn == 10) {
#pragma unroll
                        for (int bj = 0; bj < 2; ++bj) { const f32x4 v0 = acc[ai][bj][m][0] * rstd, v1 = acc[ai][bj][m][1] * rstd;
                            float p = ((v0[0] * v0[0] + v0[1] * v0[1]) + (v0[2] * v0[2] + v0[3] * v0[3])) + ((v1[0] * v1[0] + v1[1] * v1[1]) + (v1[2] * v1[2] + v1[3] * v1[3]));
                            p += __shfl_xor(p, 16); p += __shfl_xor(p, 32);
                            if (bj == 0) km0 = fmaxf(km0, p); else km1 = fmaxf(km1, p); }
                    }
                }
            }
        if (u.pn == 10) {
#pragma unroll
            for (int o = 1; o < 16; o <<= 1) { km0 = fmaxf(km0, __shfl_xor(km0, o)); km1 = fmaxf(km1, __shfl_xor(km1, o)); }
            if (fr == 0 && fq == 0) { const int b = (u.pm * 256) >> 11;
                __hip_atomic_fetch_max(kmax + ((b * 4 + 0 + (wc >> 1)) * 2 + (wc & 1)), __float_as_uint(km0), __ATOMIC_RELAXED, __HIP_MEMORY_SCOPE_AGENT);
                __hip_atomic_fetch_max(kmax + ((b * 4 + 2 + (wc >> 1)) * 2 + (wc & 1)), __float_as_uint(km1), __ATOMIC_RELAXED, __HIP_MEMORY_SCOPE_AGENT); }
        }
    }
};

struct ProbOut {
    static constexpr bool PERM = true, GATHER = false;
    int K; const bf16_t* A; const bf16_t* Bt; int G, c;
    bf16_t* xb;
    DI bool next(int i, Unit& u) const { return pg8::static_next(128, 4, G, c, i, u); }
    DI int arow0(const Unit& u) const { return u.pm * 256; }
    DI const char* bbase(const Unit& u) const { return (const char*)Bt + (size_t)u.pn * 256 * K * 2; }
    DI void epi(const f32x4 (&acc)[2][2][4][2], const Unit& u, int wr, int wc, int fr, int fq) const {
        u32x4 bv[2][4][2];
#pragma unroll
        for (int ai = 0; ai < 2; ++ai)
#pragma unroll
            for (int m = 0; m < 4; ++m) { const bf16_t* rp = xb + (size_t)(u.pm * 256 + ai * 128 + wr * 64 + m * 16 + fr) * D + u.pn * 256 + wc * 32 + 8 * fq;
#pragma unroll
                for (int bj = 0; bj < 2; ++bj) bv[ai][m][bj] = *(GLB const u32x4*)(rp + bj * 128); }
        asm volatile("" ::: "memory");
#pragma unroll
        for (int ai = 0; ai < 2; ++ai)
#pragma unroll
            for (int m = 0; m < 4; ++m) { bf16_t* rp = xb + (size_t)(u.pm * 256 + ai * 128 + wr * 64 + m * 16 + fr) * D + u.pn * 256 + wc * 32 + 8 * fq;
#pragma unroll
                for (int bj = 0; bj < 2; ++bj) { const u32x4 b = bv[ai][m][bj]; const f32x4 a0 = acc[ai][bj][m][0], a1 = acc[ai][bj][m][1]; u32x4 w;
                    w.x = pk2(bf2f(b.x & 0xffffu) + a0[0], bf2f(b.x >> 16) + a0[1]); w.y = pk2(bf2f(b.y & 0xffffu) + a0[2], bf2f(b.y >> 16) + a0[3]);
                    w.z = pk2(bf2f(b.z & 0xffffu) + a1[0], bf2f(b.z >> 16) + a1[1]); w.w = pk2(bf2f(b.w & 0xffffu) + a1[2], bf2f(b.w >> 16) + a1[3]);
                    *(GLB u32x4*)(rp + bj * 128) = w; } }
    }
};

DI int moe_L(int i, int G, int c) {
    if ((G & 31) != 0) return i * G + c;
    const int x = c & 7, j = c >> 3, per = G >> 5;
    return ((i * (G >> 2) + x * per + (j >> 2)) << 2) + (j & 3);
}
template <int NL> DI bool moe_unit(const LAS int* tp, int L, Unit& u) {
    const int tt = L >> 2; if (tt >= tp[NL]) return false;
    int e = 0, hi = NL;
#pragma unroll 1
    while (hi - e > 1) { const int mid = (e + hi) >> 1; if (tp[mid] <= tt) e = mid; else hi = mid; }
    u.e = e; u.pm = tt - tp[e]; u.pn = L & 3; return true;
}

struct ProbGU {
    static constexpr bool PERM = true, GATHER = true;
    int K; const bf16_t* A; const bf16_t* Bt; int G, c;
    const LAS MoeTab* T; const int* elist; const f32x2* egate; bf16_t* HB;
    DI bool next(int i, Unit& u) const {
        if (!moe_unit<32>(T->tpg, moe_L(i, G, c), u)) return false;
        u.cnt = T->ce[u.e]; u.base = T->sb[u.e]; return true;
    }
    DI int tok_of(const Unit& u, int r) const { const int v = elist[(size_t)u.e * LCAP + (r < u.cnt ? r : u.cnt - 1)]; return (r < u.cnt) ? v : 0; }
    DI void aoffs(const Unit& u, int tid, unsigned (&o)[2][2]) const {
        int Rr[2], Cc[2]; pg8::stage_rc(tid * 16, Rr[0], Cc[0]); pg8::stage_rc(tid * 16 + 8192, Rr[1], Cc[1]);
#pragma unroll
        for (int h = 0; h < 2; ++h)
#pragma unroll
            for (int i = 0; i < 2; ++i) { const int tok = tok_of(u, u.pm * 256 + h * 128 + Rr[i]); o[h][i] = (unsigned)((tok * K + Cc[i]) * 2); }
    }
    DI const char* bbase(const Unit& u) const { return (const char*)Bt + ((size_t)u.e * 1024 + u.pn * 256) * K * 2; }
    DI void epi(const f32x4 (&acc)[2][2][4][2], const Unit& u, int wr, int wc, int fr, int fq) const {
        float rsv[8], gv[8];
#pragma unroll
        for (int g = 0; g < 8; ++g) { const int r = u.pm * 256 + (g >> 2) * 128 + wr * 64 + (g & 3) * 16 + fr; const f32x2 gr = egate[(size_t)u.e * LCAP + (r < u.cnt ? r : u.cnt - 1)]; gv[g] = (r < u.cnt) ? gr[0] : 0.f; rsv[g] = gr[1]; }
#pragma unroll
        for (int ai = 0; ai < 2; ++ai)
#pragma unroll
            for (int m = 0; m < 4; ++m) {
                const int r = u.pm * 256 + ai * 128 + wr * 64 + m * 16 + fr;
                if (r < u.cnt) {
                    const float rs = rsv[ai * 4 + m], gt = gv[ai * 4 + m];
                    float hv[8];
#pragma unroll
                    for (int n = 0; n < 2; ++n)
#pragma unroll
                        for (int j = 0; j < 4; ++j) { const float g = acc[ai][0][m][n][j] * rs, uu = acc[ai][1][m][n][j] * rs; hv[n * 4 + j] = g * sigmoidf_(g) * uu * gt; }
                    u32x4 w; w.x = pk2(hv[0], hv[1]); w.y = pk2(hv[2], hv[3]); w.z = pk2(hv[4], hv[5]); w.w = pk2(hv[6], hv[7]);
                    *(GLB u32x4*)(HB + (size_t)(u.base + r) * EH + u.pn * 128 + wc * 32 + 8 * fq) = w;
                }
            }
    }
};

struct ProbDP {
    static constexpr bool PERM = true;
    const bf16_t* A; const bf16_t* Bt; int G, c;
    const LAS MoeTab* T; const u32x2* plist; bf16_t* xb; float* ss1;
    DI bool next(int i, Unit& u) const {
        const int L = moe_L(i, G, c), tt = L >> 2, nf = T->tpf[112];
        if (tt < nf) { if (!moe_unit<112>(T->tpf, L, u)) return false; }
        else {
            const int tpr = G >> 2, r0t = ((nf + tpr - 1) / tpr) * tpr; int th = tt - nf;
            if (tt >= r0t) { const int rr = (tt - r0t) / tpr, pos = (tt - r0t) - rr * tpr; th = (r0t - nf) + rr * tpr + (tpr - 1 - pos); }
            if (!moe_unit<112>(T->tph, 4 * th + (L & 3), u)) return false; u.pm = (T->cp[u.e] - 1) >> 8; }
        u.cnt = T->cp[u.e]; const int g = u.e / 28, p = u.e - g * 28, lo = pair_lo(p); u.base = g * 8 + lo; u.aux = g * 8 + pair_hi(p, lo); return true;
    }
    DI void aoffs2(const Unit& u, int tid, unsigned (&oa)[2][2], unsigned (&ob)[2][2]) const {
        int Rr[2], Cc[2]; pg8::stage_rc(tid * 16, Rr[0], Cc[0]); pg8::stage_rc(tid * 16 + 8192, Rr[1], Cc[1]);
        const int sba = T->sb[u.base], sbb = T->sb[u.aux];
#pragma unroll
        for (int h = 0; h < 2; ++h)
#pragma unroll
            for (int i = 0; i < 2; ++i) { const int r = u.pm * 256 + h * 128 + Rr[i]; const unsigned pos = plist[(size_t)u.e * LCAP + (r < u.cnt ? r : u.cnt - 1)].y;
                const int ra = (r < u.cnt) ? sba + (int)(pos & 0xffffu) : 0, rb = (r < u.cnt) ? sbb + (int)(pos >> 16) : 0;
                oa[h][i] = (unsigned)((ra * EH + Cc[i]) * 2); ob[h][i] = (unsigned)((rb * EH + Cc[i]) * 2); }
    }
    DI const char* bbase_a(const Unit& u) const { return (const char*)Bt + ((size_t)u.base * 1024 + u.pn * 256) * EH * 2; }
    DI const char* bbase_b(const Unit& u) const { return (const char*)Bt + ((size_t)u.aux * 1024 + u.pn * 256) * EH * 2; }
    DI void epi(const f32x4 (&acc)[2][2][4][2], const Unit& u, int wr, int wc, int fr, int fq) const {
        int tk[8];
#pragma unroll
        for (int g = 0; g < 8; ++g) { const int r = u.pm * 256 + (g >> 2) * 128 + wr * 64 + (g & 3) * 16 + fr; tk[g] = (int)plist[(size_t)u.e * LCAP + (r < u.cnt ? r : u.cnt - 1)].x; }
#pragma unroll
        for (int ai = 0; ai < 2; ++ai) {
            u32x4 xv[4][2];
#pragma unroll
            for (int m = 0; m < 4; ++m) { const size_t off = (size_t)tk[ai * 4 + m] * D + u.pn * 256 + wc * 32 + 8 * fq;
#pragma unroll
                for (int bj = 0; bj < 2; ++bj) xv[m][bj] = *(GLB const u32x4*)(xb + off + bj * 128); }
#pragma unroll
            for (int m = 0; m < 4; ++m) {
                const int r = u.pm * 256 + ai * 128 + wr * 64 + m * 16 + fr; const bool val = r < u.cnt;
                const size_t off = (size_t)tk[ai * 4 + m] * D + u.pn * 256 + wc * 32 + 8 * fq;
                float ssp = 0.f;
#pragma unroll
                for (int bj = 0; bj < 2; ++bj) { const u32x4 b = xv[m][bj]; const f32x4 a0 = acc[ai][bj][m][0], a1 = acc[ai][bj][m][1]; u32x4 w;
                    w.x = pk2(bf2f(b.x & 0xffffu) + a0[0], bf2f(b.x >> 16) + a0[1]); w.y = pk2(bf2f(b.y & 0xffffu) + a0[2], bf2f(b.y >> 16) + a0[3]);
                    w.z = pk2(bf2f(b.z & 0xffffu) + a1[0], bf2f(b.z >> 16) + a1[1]); w.w = pk2(bf2f(b.w & 0xffffu) + a1[2], bf2f(b.w >> 16) + a1[3]);
                    if (val) *(GLB u32x4*)(xb + off + bj * 128) = w;
#pragma unroll
                    for (int q = 0; q < 4; ++q) { const float v0 = bf2f(w[q] & 0xffffu), v1 = bf2f(w[q] >> 16); ssp += v0 * v0 + v1 * v1; }
                }
                ssp += __shfl_xor(ssp, 16); ssp += __shfl_xor(ssp, 32);
                if (val && fq == 0) ss1[(size_t)tk[ai * 4 + m] * 16 + u.pn * 4 + wc] = ssp;
            }
            asm volatile("" ::: "memory");
        }
    }
};


DI void p0_transpose64(const float* W, int K, int N, int ldn, const float* gs, bf16_t* WT, int mode, LAS unsigned* T, int kb, int nb, int lane) {
    const int k0 = 64 * kb, n0 = 64 * nb, nq = lane & 15, kr = lane >> 4;
    const bool nv = (n0 + 4 * nq) < N;
    const int ncol = nv ? n0 + 4 * nq : N - 4;
    f32x4 a[8], b[8];
#pragma unroll
    for (int i = 0; i < 8; ++i) { const int k = k0 + 8 * i + 2 * kr;
        a[i] = __builtin_nontemporal_load((GLB const f32x4*)(W + (size_t)k * ldn + ncol));
        b[i] = __builtin_nontemporal_load((GLB const f32x4*)(W + (size_t)(k + 1) * ldn + ncol)); }
    f32x2 gq[8];
    { const float* gsp = gs ? gs : W;
#pragma unroll
      for (int i = 0; i < 8; ++i) gq[i] = *(GLB const f32x2*)(gsp + k0 + 8 * i + 2 * kr); }
    asm volatile("" ::: "memory");
    if (!nv) {
#pragma unroll
        for (int i = 0; i < 8; ++i) { a[i] = (f32x4){0.f, 0.f, 0.f, 0.f}; b[i] = (f32x4){0.f, 0.f, 0.f, 0.f}; } }
#pragma unroll
    for (int i = 0; i < 8; ++i) { const float g0 = gs ? gq[i][0] : 1.f, g1 = gs ? gq[i][1] : 1.f;
#pragma unroll
        for (int jj = 0; jj < 4; ++jj) T[(4 * nq + jj) * 36 + 4 * i + kr] = pk2(a[i][jj] * g0, b[i][jj] * g1); }
    asm volatile("s_waitcnt lgkmcnt(0)" ::: "memory");
    const int c = lane & 7;
#pragma unroll
    for (int p = 0; p < 8; ++p) { const int nl = 8 * p + (lane >> 3), n = n0 + nl;
        const u32x4 o = *(const LAS u32x4*)(T + nl * 36 + 4 * c);
        const int drow = (mode == 0) ? n : (((n >> 7) << 8) + (n & 127) + (mode == 2 ? 128 : 0));
        __builtin_nontemporal_store(o, (GLB u32x4*)(WT + (size_t)drow * K + k0 + 8 * c)); }
    asm volatile("s_waitcnt lgkmcnt(0)" ::: "memory");
}
constexpr int CONV_IN = 16 * 52, CONV_OUT = 16 * 16, CONV_GU = 16 * 8, CONV_DN = 8 * 16;
constexpr int CONV_ITEMS = CONV_IN + CONV_OUT + NE * (2 * CONV_GU + CONV_DN);
DI void conv_item(Frame& F, int l, int r, LAS unsigned* scr) {
    if (r < CONV_IN) { p0_transpose64(F.in[2] + (size_t)l * D * 3076, D, 3076, 3076, F.in[1] + l * D, WSP(bf16_t, WS_BIN) + (size_t)l * NIN * D, 0, scr, r / 52, r % 52, F.lane); return; }
    r -= CONV_IN;
    if (r < CONV_OUT) { p0_transpose64(F.in[17] + (size_t)l * D * D, D, D, D, nullptr, WSP(bf16_t, WS_BOUT) + (size_t)l * D * D, 0, scr, r / 16, r % 16, F.lane); return; }
    r -= CONV_OUT;
    if (r < 2 * NE * CONV_GU) { const int up = r >= NE * CONV_GU, q = r - (up ? NE * CONV_GU : 0), le = l * NE + q / CONV_GU, t = q % CONV_GU;
        p0_transpose64(F.in[up ? 24 : 23] + (size_t)le * D * EH, D, EH, EH, F.in[18] + l * D, WSP(bf16_t, WS_BGU) + (size_t)le * 1024 * D, up ? 2 : 1, scr, t / 8, t % 8, F.lane); return; }
    r -= 2 * NE * CONV_GU;
    { const int le = l * NE + r / CONV_DN, t = r % CONV_DN;
      p0_transpose64(F.in[25] + (size_t)le * EH * D, EH, D, D, nullptr, WSP(bf16_t, WS_BDN) + (size_t)le * D * EH, 0, scr, t / 16, t % 16, F.lane); }
}
DI void p0_prologue(Frame& F) {
    LAS unsigned* scr = (LAS unsigned*)(F.lds + F.wave * 16384);
    const int gw = F.bid * 8 + F.wave, NGW = F.G * 8;
    for (int it = gw; it < CONV_ITEMS; it += NGW) conv_item(F, 0, it, scr);
    const int gt = F.bid * 512 + F.tid, NGT = F.G * 512;
    for (int i = gt; i < DEPTH * 256 * 256; i += NGT) { const int l = i >> 16, c = (i >> 8) & 255, k = i & 255;
        const float v = k < 64 ? F.in[7][((size_t)l * 64 + k) * 256 + c] : (k < 128 ? F.in[9][((size_t)l * 64 + (k - 64)) * 256 + c] : F.in[10][((size_t)l * 128 + (k - 128)) * 256 + c]);
        WSP(bf16_t, WS_WCAT)[i] = (bf16_t)f2bf(v); }
    for (int i = gt; i < DEPTH * 4 * 128 * 128; i += NGT) { const int t = (i >> 7) & 127, p = i & 15, hh = p >> 3, j = p & 7, s = (i & 112) + (j < 4 ? 4 * hh + j : 8 + 4 * hh + (j - 4));
        WSP(bf16_t, WS_GMW)[i] = (bf16_t)f2bf(s <= t ? F.in[3][(i & ~127) + s] : 0.f); }
    for (int i = gt; i < DEPTH * 36 * 1024; i += NGT) { const int l = i / (36 * 1024), j = (i / 1024) % 36, k = i & 1023;
        const float g = F.in[18][l * D + k];
        const float w = j < 4 ? F.in[19][((size_t)l * D + k) * 4 + j] : F.in[21][((size_t)l * D + k) * 32 + (j - 4)];
        const float v = g * w; const unsigned hi = f2bf(v), lo = f2bf(v - bf2f(hi));
        WSP(bf16_t, WS_RTW)[((size_t)(l * 2 + 0) * 36 + j) * 1024 + k] = (bf16_t)hi; WSP(bf16_t, WS_RTW)[((size_t)(l * 2 + 1) * 36 + j) * 1024 + k] = (bf16_t)lo; }
    for (int m0 = gw * 4; m0 < NT; m0 += NGW * 4) {
        f32x4 v[4][4];
#pragma unroll
        for (int r = 0; r < 4; ++r) { const f32x4* xr = (const f32x4*)(F.in[0] + (size_t)(m0 + r) * D) + F.lane;
#pragma unroll
            for (int j = 0; j < 4; ++j) v[r][j] = __builtin_nontemporal_load(xr + 64 * j); }
#pragma unroll
        for (int r = 0; r < 4; ++r) { float s = 0.f; u32x2* o8 = (u32x2*)(WSP(bf16_t, WS_XB) + (size_t)(m0 + r) * D) + F.lane;
#pragma unroll
            for (int j = 0; j < 4; ++j) { const f32x4 q = v[r][j]; s += (q[0] * q[0] + q[1] * q[1]) + (q[2] * q[2] + q[3] * q[3]); u32x2 w; w.x = pk2(q[0], q[1]); w.y = pk2(q[2], q[3]); o8[64 * j] = w; }
            s = wave_sum(s);
            if (F.lane < 16) WSP(float, WS_SS1)[(size_t)(m0 + r) * 16 + F.lane] = (F.lane == 0) ? s : 0.f; }
    }
}

constexpr int AT_KOFF = 0, AT_VOFF = 18432, AT_CUM = 36864, AT_MISC = 45056, AT_ROWB = 144, AT_BUFB = 64 * 144;
DI void at_load_tile(const bf16_t* Pb, int colK, int colV, int jt, int tid, u32x4& kreg, u32x4& vreg) {
    const int row = tid >> 3, ch = tid & 7; const bf16_t* p = Pb + (size_t)(64 * jt + row) * PP + ch * 8;
    kreg = *(GLB const u32x4*)(p + colK); vreg = *(GLB const u32x4*)(p + colV);
}
DI void at_store_tile(LAS unsigned char* lds, int buf, int tid, const u32x4& kreg, const u32x4& vreg) {
    const int row = tid >> 3, ch = tid & 7;
    *(LAS u32x4*)(lds + AT_KOFF + buf * AT_BUFB + row * AT_ROWB + ch * 16) = kreg;
    { const int pos = 32 * (ch >> 2) + 16 * (ch & 1) + 4 * ((ch >> 1) & 1);
      LAS unsigned char* vrow = lds + AT_VOFF + buf * AT_BUFB + row * AT_ROWB;
      *(LAS u32x2*)(vrow + pos * 2) = (u32x2){vreg.x, vreg.y}; *(LAS u32x2*)(vrow + (pos + 8) * 2) = (u32x2){vreg.z, vreg.w}; }
}
DI void at_qk(const LAS unsigned char* kb, const bf16x8 (&qf)[4], int r32, int h2, f32x16& s0, f32x16& s1) {
    const LAS unsigned char* p = kb + r32 * AT_ROWB + h2 * 16;
#pragma unroll
    for (int d0 = 0; d0 < 4; ++d0) {
        const bf16x8 a0 = *(const LAS bf16x8*)(p + d0 * 32), a1 = *(const LAS bf16x8*)(p + 32 * AT_ROWB + d0 * 32);
        s0 = MFMA32(a0, qf[d0], s0); s1 = MFMA32(a1, qf[d0], s1);
    }
}
DI bf16x8 pack8(const f32x16& x, int s) {
    u32x4 p; p.x = pk2(x[8 * s], x[8 * s + 1]); p.y = pk2(x[8 * s + 2], x[8 * s + 3]); p.z = pk2(x[8 * s + 4], x[8 * s + 5]); p.w = pk2(x[8 * s + 6], x[8 * s + 7]);
    return __builtin_bit_cast(bf16x8, p);
}
DI s16x4 tr_read(const LAS unsigned char* p) { return __builtin_bit_cast(s16x4, __builtin_amdgcn_ds_read_tr16_b64_v4i16((LAS s16x4*)p)); }
DI void at_pv(const LAS unsigned char* vb, const bf16x8 (&pb)[4], int lane, f32x16& o0, f32x16& o1) {
    const int h2 = lane >> 5;
    const LAS unsigned char* base = vb + (4 * h2 + ((lane & 15) >> 2)) * AT_ROWB + (16 * ((lane >> 4) & 1) + 4 * (lane & 3)) * 2;
#pragma unroll
    for (int s = 0; s < 4; ++s) {
        const LAS unsigned char* p = base + 16 * s * AT_ROWB;
        const s16x4 l0 = tr_read(p), h0 = tr_read(p + 8 * AT_ROWB), l1 = tr_read(p + 64), h1 = tr_read(p + 8 * AT_ROWB + 64);
        const bf16x8 a0 = __builtin_shufflevector(l0, h0, 0, 1, 2, 3, 4, 5, 6, 7), a1 = __builtin_shufflevector(l1, h1, 0, 1, 2, 3, 4, 5, 6, 7);
        o0 = MFMA32(a0, pb[s], o0); o1 = MFMA32(a1, pb[s], o1);
    }
}
DI void at_store_out(bf16_t* dst  , const f32x16& o0, const f32x16& o1, float scale, int h2) {
#pragma unroll
    for (int g = 0; g < 2; ++g) {
        u32x4 w0, w1;
        w0.x = pk2(o0[8 * g] * scale, o0[8 * g + 1] * scale); w0.y = pk2(o0[8 * g + 2] * scale, o0[8 * g + 3] * scale); w0.z = pk2(o0[8 * g + 4] * scale, o0[8 * g + 5] * scale); w0.w = pk2(o0[8 * g + 6] * scale, o0[8 * g + 7] * scale);
        w1.x = pk2(o1[8 * g] * scale, o1[8 * g + 1] * scale); w1.y = pk2(o1[8 * g + 2] * scale, o1[8 * g + 3] * scale); w1.z = pk2(o1[8 * g + 4] * scale, o1[8 * g + 5] * scale); w1.w = pk2(o1[8 * g + 6] * scale, o1[8 * g + 7] * scale);
        *(GLB u32x4*)(dst + 16 * h2 + 8 * g) = w0; *(GLB u32x4*)(dst + 32 + 16 * h2 + 8 * g) = w1;
    }
}
DI void block_cumsum(f32x4 v, int n, LAS float* cum, LAS float* wtot, int tid, int lane, int wave) {
    v[1] += v[0]; v[2] += v[1]; v[3] += v[2];
    float t = v[3];
#pragma unroll
    for (int o = 1; o < 64; o <<= 1) { const float u = __shfl_up(t, o); if (lane >= o) t += u; }
    if (lane == 63) wtot[wave] = t;
    __syncthreads();
    float pre = t - v[3];
    for (int w = 0; w < wave; ++w) pre += wtot[w];
    if (4 * tid < n) { v[0] += pre; v[1] += pre; v[2] += pre; v[3] += pre; *(LAS f32x4*)(cum + 4 * tid) = v; }
    __syncthreads();
}

DI void fx_unit(Frame& F, int layer, int b, int h, int qb) {
    LAS unsigned char* L = F.lds; const int tid = F.tid, lane = F.lane, wid = F.wave, r32 = lane & 31, h2 = lane >> 5;
    const bf16_t* Pb = WSP(bf16_t, WS_P) + (size_t)b * SEQ * PP;
    LAS float* cum = (LAS float*)(L + AT_CUM);
    const int kend = 256 * qb + 256;
    const int tw0 = 256 * qb + 32 * wid, tq = tw0 + r32, jtop = 4 * qb + 3;
    f32x4 lfv = (f32x4){0.f, 0.f, 0.f, 0.f};
    if (4 * tid < kend) lfv = *(GLB const f32x4*)(WSP(float, WS_LF) + (size_t)(b * 4 + h) * SEQ + 4 * tid);
    bf16x8 qf[4];
#pragma unroll
    for (int d0 = 0; d0 < 4; ++d0) qf[d0] = *(GLB const bf16x8*)(Pb + (size_t)tq * PP + C_FXQ + h * 64 + 16 * d0 + 8 * h2);
    const u32x2 kmq = *(GLB const u32x2*)((const unsigned*)(F.ws + WS_CTL) + CW_KMAX + layer * 128 + (b * 4 + h) * 2);
    u32x4 kreg, vreg;
    at_load_tile(Pb, C_FXK + h * 64, C_FXV + h * 64, jtop, tid, kreg, vreg);
    asm volatile("" ::: "memory");
    __syncthreads();
    block_cumsum(lfv, kend, cum, (LAS float*)(L + AT_MISC), tid, lane, wid);
    const float ct2 = cum[tq] * LOG2E;
    float qb2;
    { float qn = 0.f;
#pragma unroll
      for (int d0 = 0; d0 < 4; ++d0) { const u32x4 qq = __builtin_bit_cast(u32x4, qf[d0]);
#pragma unroll
        for (int j = 0; j < 4; ++j) { const float a = bf2f(qq[j] & 0xffffu), c = bf2f(qq[j] >> 16); qn += a * a + c * c; } }
      qn += swap32(qn);
      const float kk2 = __uint_as_float(kmq.x) + __uint_as_float(kmq.y);
      qb2 = sqrtf(qn * kk2) * QSCALE2 * 1.01f + 1e-3f; }
    float mrun = -1e30f, lrun = 0.f; f32x16 o0 = {}, o1 = {};
    at_store_tile(L, 0, tid, kreg, vreg);
    __syncthreads();
    int buf = 0; bool wskip = false;
    for (int jt = jtop; jt >= 0; --jt) {
        if (jt > 0) at_load_tile(Pb, C_FXK + h * 64, C_FXV + h * 64, jt - 1, tid, kreg, vreg);
        if (64 * jt <= tw0 + 31 && !wskip) {
            f32x16 s0 = {}, s1 = {};
            at_qk(L + AT_KOFF + buf * AT_BUFB, qf, r32, h2, s0, s1);
            const bool needmask = (64 * jt + 63 > tw0);
            float mx = -1e30f;
#pragma unroll
            for (int g = 0; g < 4; ++g) {
                const f32x4 c0 = *(const LAS f32x4*)(cum + 64 * jt + 8 * g + 4 * h2), c1 = *(const LAS f32x4*)(cum + 64 * jt + 32 + 8 * g + 4 * h2);
#pragma unroll
                for (int j = 0; j < 4; ++j) {
                    const int r = 4 * g + j, kv = 64 * jt + 8 * g + 4 * h2 + j;
                    (void)kv;
                    s0[r] = s0[r] * QSCALE2 + (ct2 - c0[j] * LOG2E); s1[r] = s1[r] * QSCALE2 + (ct2 - c1[j] * LOG2E);
                }
            }
            if (needmask) {
#pragma unroll
                for (int r = 0; r < 16; ++r) { const int kv = 64 * jt + crow(r, h2); if (kv > tq) s0[r] = -1e30f; if (kv + 32 > tq) s1[r] = -1e30f; }
            }
#pragma unroll
            for (int r = 0; r < 16; ++r) mx = fmaxf(mx, fmaxf(s0[r], s1[r]));
            mx = fmaxf(mx, swap32(mx));
            const float mnew = fmaxf(mrun, mx), alpha = ex2(mrun - mnew);
            mrun = mnew;
            float ps = 0.f;
#pragma unroll
            for (int r = 0; r < 16; ++r) { s0[r] = ex2(s0[r] - mnew); s1[r] = ex2(s1[r] - mnew); ps += s0[r] + s1[r]; }
            lrun = lrun * alpha + ps;
#pragma unroll
            for (int r = 0; r < 16; ++r) { o0[r] *= alpha; o1[r] *= alpha; }
            bf16x8 pb[4]; pb[0] = pack8(s0, 0); pb[1] = pack8(s0, 1); pb[2] = pack8(s1, 0); pb[3] = pack8(s1, 1);
            at_pv(L + AT_VOFF + buf * AT_BUFB, pb, lane, o0, o1);
        }
        if (jt > 0) at_store_tile(L, buf ^ 1, tid, kreg, vreg);
        { int wdone = 0; if (jt > 0) wdone = __all(qb2 + (ct2 - cum[64 * jt - 1] * LOG2E) - mrun < -150.f) ? 1 : 0; wskip = wdone != 0; if (lane == 0) *(LAS int*)(L + AT_MISC + 64 + 32 * (jt & 1) + 4 * wid) = wdone; }
        __syncthreads();
        buf ^= 1;
        { const LAS int* fl = (const LAS int*)(L + AT_MISC + 64 + 32 * (jt & 1)); const int alld = fl[0] & fl[1] & fl[2] & fl[3] & fl[4] & fl[5] & fl[6] & fl[7]; if (alld) break; }
    }
    const float ltot = lrun + swap32(lrun);
    at_store_out(WSP(bf16_t, WS_MIX) + (size_t)(b * SEQ + tq) * D + 768 + h * 64, o0, o1, rcpf_(ltot), h2);
}

DI void sb_unit(Frame& F, int b, int h, int qb) {
    LAS unsigned char* L = F.lds; const int tid = F.tid, lane = F.lane, wid = F.wave, r32 = lane & 31, h2 = lane >> 5;
    const bf16_t* Pb = WSP(bf16_t, WS_P) + (size_t)b * SEQ * PP;
    const int tw0 = 256 * qb + 32 * wid, tq = tw0 + r32;
    bf16x8 qf[4];
#pragma unroll
    for (int d0 = 0; d0 < 4; ++d0) qf[d0] = *(GLB const bf16x8*)(Pb + (size_t)tq * PP + C_SBQ + h * 64 + 16 * d0 + 8 * h2);
    bf16x8 uf[2], onesf;
#pragma unroll
    for (int s = 0; s < 2; ++s)
#pragma unroll
        for (int j = 0; j < 8; ++j) uf[s][j] = ((16 * s + 8 * (j >> 2) + 4 * h2 + (j & 3)) > r32) ? (short)0x3F80 : (short)0;
#pragma unroll
    for (int j = 0; j < 8; ++j) onesf[j] = (short)0x3F80;
    float R2 = 0.f; f32x16 o0 = {}, o1 = {};
    const int jtop = 4 * qb + 3;
    u32x4 kreg, vreg;
    at_load_tile(Pb, C_SBK + h * 64, C_SBV + h * 64, jtop, tid, kreg, vreg);
    __syncthreads();
    at_store_tile(L, 0, tid, kreg, vreg);
    __syncthreads();
    int buf = 0; bool wskip = false;
    for (int jt = jtop; jt >= 0; --jt) {
        if (jt > 0) at_load_tile(Pb, C_SBK + h * 64, C_SBV + h * 64, jt - 1, tid, kreg, vreg);
        if (64 * jt <= tw0 + 31 && !wskip) {
            f32x16 s0 = {}, s1 = {};
            at_qk(L + AT_KOFF + buf * AT_BUFB, qf, r32, h2, s0, s1);
            const bool needmask = (64 * jt + 63 >= tw0);
            f32x16 l0, l1;
            float cs = 0.f;
#pragma unroll
            for (int r = 0; r < 16; ++r) {
                const int kv = 64 * jt + crow(r, h2);
                const float z0 = s0[r] * QSCALE2, z1 = s1[r] * QSCALE2;
                const float sp0 = fmaxf(z0, 0.f) + lg2(1.f + ex2(-fabsf(z0))), sp1 = fmaxf(z1, 0.f) + lg2(1.f + ex2(-fabsf(z1)));
                (void)kv;
                l0[r] = sp0; l1[r] = sp1; s0[r] = z0 - sp0; s1[r] = z1 - sp1;
            }
            if (needmask) {
#pragma unroll
                for (int r = 0; r < 16; ++r) { const int kv = 64 * jt + crow(r, h2);
                    if (kv >= tq) { l0[r] = 0.f; s0[r] = -1e30f; } if (kv + 32 >= tq) { l1[r] = 0.f; s1[r] = -1e30f; } }
            }
#pragma unroll
            for (int r = 0; r < 16; ++r) cs += l0[r] + l1[r];
            f32x16 t0 = {}, t1 = {};
#pragma unroll
            for (int s = 0; s < 2; ++s) {
                const bf16x8 h0 = pack8(l0, s), h1 = pack8(l1, s);
                f32x16 d0_, d1_;
#pragma unroll
                for (int j = 0; j < 8; ++j) { d0_[j] = l0[8 * s + j] - bf2f((unsigned short)h0[j]); d1_[j] = l1[8 * s + j] - bf2f((unsigned short)h1[j]); }
                u32x4 q0, q1; q0.x = pk2(d0_[0], d0_[1]); q0.y = pk2(d0_[2], d0_[3]); q0.z = pk2(d0_[4], d0_[5]); q0.w = pk2(d0_[6], d0_[7]);
                q1.x = pk2(d1_[0], d1_[1]); q1.y = pk2(d1_[2], d1_[3]); q1.z = pk2(d1_[4], d1_[5]); q1.w = pk2(d1_[6], d1_[7]);
                const bf16x8 e0 = __builtin_bit_cast(bf16x8, q0), e1 = __builtin_bit_cast(bf16x8, q1);
                t0 = MFMA32(uf[s], h0, t0); t0 = MFMA32(uf[s], e0, t0); t0 = MFMA32(onesf, h1, t0); t0 = MFMA32(onesf, e1, t0);
                t1 = MFMA32(uf[s], h1, t1); t1 = MFMA32(uf[s], e1, t1);
            }
#pragma unroll
            for (int r = 0; r < 16; ++r) { s0[r] = ex2(s0[r] + R2 - t0[r]); s1[r] = ex2(s1[r] + R2 - t1[r]); }
            R2 -= cs + swap32(cs);
            bf16x8 pb[4]; pb[0] = pack8(s0, 0); pb[1] = pack8(s0, 1); pb[2] = pack8(s1, 0); pb[3] = pack8(s1, 1);
            at_pv(L + AT_VOFF + buf * AT_BUFB, pb, lane, o0, o1);
        }
        if (jt > 0) at_store_tile(L, buf ^ 1, tid, kreg, vreg);
        { const int wdone = __all(R2 < -150.f) ? 1 : 0; wskip = wdone != 0; if (lane == 0) *(LAS int*)(L + AT_MISC + 64 + 32 * (jt & 1) + 4 * wid) = wdone; }
        __syncthreads();
        buf ^= 1;
        { const LAS int* fl = (const LAS int*)(L + AT_MISC + 64 + 32 * (jt & 1)); const int alld = fl[0] & fl[1] & fl[2] & fl[3] & fl[4] & fl[5] & fl[6] & fl[7]; if (alld) break; }
    }
    at_store_out(WSP(bf16_t, WS_MIX) + (size_t)(b * SEQ + tq) * D + 0 + h * 64, o0, o1, 1.f, h2);
}
DI void attn_rank_to_unit(int r, int& bh, int& qb) { if (r < 256) { qb = 7 - (r >> 6); bh = r & 63; } else { const int p = r - 256; qb = p >> 6; bh = p & 63; } }

constexpr int GV_ROWB = 544, GO_ROWB = 528, GM_OUTOFF = 128 * GV_ROWB;
DI float sum8(float v) { v += dppf<0xB1, 0xf, true>(v); v += dppf<0x4E, 0xf, true>(v); v += dppf<0x141, 0xf, true>(v); return v; }
DI bf16x8 gm_trfrag(const LAS unsigned char* vn, int lane, int ks, int col0) {
    const int h2 = lane >> 5;
    const LAS unsigned char* p = vn + (16 * ks + 4 * h2 + ((lane & 15) >> 2)) * GV_ROWB + (col0 + 16 * ((lane >> 4) & 1) + 4 * (lane & 3)) * 2;
    const s16x4 lo = tr_read(p), hi = tr_read(p + 8 * GV_ROWB);
    return __builtin_shufflevector(lo, hi, 0, 1, 2, 3, 4, 5, 6, 7);
}
DI void gm_item(Frame& F, int layer, int b, int c) {
    LAS unsigned char* L = F.lds; const int tid = F.tid, lane = F.lane, wid = F.wave, r32 = lane & 31, h2 = lane >> 5;
    const int cg = tid & 31, c0 = 8 * cg, tr = tid >> 5;
    const bf16_t* Pb = WSP(bf16_t, WS_P) + (size_t)(b * SEQ + c * 128) * PP;
    __syncthreads();
#pragma unroll
    for (int hf = 0; hf < 2; ++hf) {
        u32x4 vq[4];
#pragma unroll
        for (int i = 0; i < 4; ++i) vq[i] = *(GLB const u32x4*)(Pb + (size_t)(tr + 16 * (4 * hf + i)) * PP + C_GMV + c0);
#pragma unroll
        for (int i = 0; i < 4; ++i) {
            float ge[8];
#pragma unroll
            for (int j = 0; j < 4; ++j) { ge[2 * j] = geluf_(bf2f(vq[i][j] & 0xffffu)); ge[2 * j + 1] = geluf_(bf2f(vq[i][j] >> 16)); }
            const float mean = sum8(((ge[0] + ge[1]) + (ge[2] + ge[3])) + ((ge[4] + ge[5]) + (ge[6] + ge[7]))) * (1.f / 64.f);
            float sq = 0.f;
#pragma unroll
            for (int j = 0; j < 8; ++j) { ge[j] -= mean; sq += ge[j] * ge[j]; }
            const float rs = __builtin_amdgcn_rsqf(sum8(sq) * (1.f / 64.f) + 1e-5f);
#pragma unroll
            for (int j = 0; j < 8; ++j) ge[j] *= rs;
            *(LAS u32x4*)(L + (tr + 16 * (4 * hf + i)) * GV_ROWB + c0 * 2) = __builtin_bit_cast(u32x4, pk8f(ge));
        }
    }
    u32x4 uq[8];
#pragma unroll
    for (int i = 0; i < 8; ++i) uq[i] = *(GLB const u32x4*)(Pb + (size_t)(tr + 16 * i) * PP + C_GMU + c0);
    __syncthreads();
    const int db = wid & 1;
#pragma unroll
    for (int g = 0; g < 4; ++g) {
        const int tb = ((wid >> 1) + g) & 3, t = 32 * tb + r32;
        const bf16_t* wrow = WSP(bf16_t, WS_GMW) + ((size_t)(layer * 4 + g) * 128 + t) * 128 + 8 * h2;
        const float bias = F.in[4][(size_t)(layer * 4 + g) * 128 + t];
        f32x16 acc = {};
        bf16x8 wf[8];
#pragma unroll
        for (int ks = 0; ks < 8; ++ks) wf[ks] = *(GLB const bf16x8*)(wrow + 16 * ks);
        asm volatile("" ::: "memory");
#pragma unroll
        for (int ks = 0; ks < 8; ++ks)
            acc = MFMA32(gm_trfrag(L, lane, ks, 64 * g + 32 * db), wf[ks], acc);
#pragma unroll
        for (int q = 0; q < 4; ++q)
            *(LAS u32x2*)(L + GM_OUTOFF + t * GO_ROWB + (64 * g + 32 * db + 8 * q + 4 * h2) * 2) = (u32x2){pk2(acc[4 * q] + bias, acc[4 * q + 1] + bias), pk2(acc[4 * q + 2] + bias, acc[4 * q + 3] + bias)};
    }
    __syncthreads();
    bf16_t* mo = WSP(bf16_t, WS_MIX) + (size_t)(b * SEQ + c * 128) * D + 256 + c0;
#pragma unroll
    for (int i = 0; i < 8; ++i) {
        const u32x4 mq = *(const LAS u32x4*)(L + GM_OUTOFF + (tr + 16 * i) * GO_ROWB + c0 * 2);
        float o[8];
#pragma unroll
        for (int j = 0; j < 4; ++j) { o[2 * j] = geluf_(bf2f(uq[i][j] & 0xffffu)) * bf2f(mq[j] & 0xffffu); o[2 * j + 1] = geluf_(bf2f(uq[i][j] >> 16)) * bf2f(mq[j] >> 16); }
        *(GLB u32x4*)(mo + (size_t)(tr + 16 * i) * D) = __builtin_bit_cast(u32x4, pk8f(o));
    }
}

DI void rw_load_shift8(const bf16_t* Pt, bool hasprev, int col, const float* mu, float (&o)[8]) {
    const u32x4 cu = *(GLB const u32x4*)(Pt + col); u32x4 pr = (u32x4){0u, 0u, 0u, 0u}; if (hasprev) pr = *(GLB const u32x4*)(Pt - PP + col);
    const f32x4 m0 = *(GLB const f32x4*)(mu), m1 = *(GLB const f32x4*)(mu + 4);
    const float mm[8] = {m0[0], m0[1], m0[2], m0[3], m1[0], m1[1], m1[2], m1[3]};
#pragma unroll
    for (int j = 0; j < 4; ++j) { const float c0 = bf2f(cu[j] & 0xffffu), c1 = bf2f(cu[j] >> 16), p0 = bf2f(pr[j] & 0xffffu), p1 = bf2f(pr[j] >> 16);
        o[2 * j] = c0 + (p0 - c0) * mm[2 * j]; o[2 * j + 1] = c1 + (p1 - c1) * mm[2 * j + 1]; }
}
DI void rw_load_shift4(const bf16_t* Pt, bool hasprev, int col, const float* mu, float (&o)[4]) {
    const u32x2 cu = *(GLB const u32x2*)(Pt + col); u32x2 pr = (u32x2){0u, 0u}; if (hasprev) pr = *(GLB const u32x2*)(Pt - PP + col);
    const f32x4 m0 = *(GLB const f32x4*)(mu);
#pragma unroll
    for (int j = 0; j < 2; ++j) { const float c0 = bf2f(cu[j] & 0xffffu), c1 = bf2f(cu[j] >> 16), p0 = bf2f(pr[j] & 0xffffu), p1 = bf2f(pr[j] >> 16);
        o[2 * j] = c0 + (p0 - c0) * m0[2 * j]; o[2 * j + 1] = c1 + (p1 - c1) * m0[2 * j + 1]; }
}
DI bf16x8 rw_act_frag(const bf16_t* Pt, bool hasprev, const float* mu, int ks, int h2, int mode) {
    float v[8]; rw_load_shift8(Pt, hasprev, C_RWX + 16 * ks + 8 * h2, mu + 768 + 16 * ks + 8 * h2, v);
    if (mode == 1) {
#pragma unroll
        for (int j = 0; j < 8; ++j) v[j] = tanhf_(v[j]);
    } else if (mode == 2) {
#pragma unroll
        for (int j = 0; j < 8; ++j) v[j] = sigmoidf_(v[j]);
    }
    u32x4 pb; pb.x = pk2(v[0], v[1]); pb.y = pk2(v[2], v[3]); pb.z = pk2(v[4], v[5]); pb.w = pk2(v[6], v[7]);
    return __builtin_bit_cast(bf16x8, pb);
}

constexpr int RC_V = 0, RC_KB = 4608, RC_BB = 9216, RC_KT = 13824, RC_CF = 13824, RC_PC = 18432, RC_WAVE = 18688, RC_ROWB = 144;
DI float scan32(float x) {
    x += dppf<0x111, 0xf, true>(x); x += dppf<0x112, 0xf, true>(x); x += dppf<0x114, 0xf, true>(x); x += dppf<0x118, 0xf, true>(x);
    x += dppf<0x142, 0xa, false>(x);
    return x;
}
DI bf16x8 rc_trfrag(const LAS unsigned char* tile, int lane, int s, int colblk) {
    const int h2 = lane >> 5;
    const LAS unsigned char* p = tile + (16 * s + 4 * h2 + ((lane & 15) >> 2)) * RC_ROWB + (32 * colblk + 16 * ((lane >> 4) & 1) + 4 * (lane & 3)) * 2;
    const s16x4 lo = tr_read(p), hi = tr_read(p + 8 * RC_ROWB);
    return __builtin_shufflevector(lo, hi, 0, 1, 2, 3, 4, 5, 6, 7);
}
#ifdef TPROBE
#define TPB_T0 const unsigned long long tpb0 = __builtin_amdgcn_s_memrealtime()
#define TPB_ACC(slot, tidv) do { const unsigned long long tpb1 = __builtin_amdgcn_s_memrealtime(); if (F.tid == (tidv)) { volatile LAS unsigned long long* a_ = (volatile LAS unsigned long long*)(F.lds + LDS_MISC + 128) + (slot); *a_ = *a_ + (tpb1 - tpb0); } } while (0)
#else
#define TPB_T0 do { } while (0)
#define TPB_ACC(slot, tidv) do { } while (0)
#endif
constexpr int RG_ACT = 4 * RC_WAVE, RG_RKV = RG_ACT + 16384, RG_PAR = RG_RKV + 12 * 4608, RG_END = RG_PAR + 5120;
static_assert(RG_END <= LDS_MISC, "chunk-pass LDS map");
DI void rw_loader_loop(Frame& F, int layer) {
    int lwl = F.wave - 4; asm volatile("" : "+s"(lwl));
    const int lane = F.lane, r32 = lane & 31, h2 = lane >> 5, lw = lwl;
    LAS unsigned char* L = F.lds;
    const float* mu = F.in[5] + (size_t)layer * 1024;
    const int prow = lane >> 3, pc = lane & 7;
    const int amode = lw == 0 ? 1 : (lw == 1 ? 0 : 2);
    const float asc = amode == 1 ? 2.f * LOG2E : -LOG2E, aa = amode == 1 ? 1.f : 0.f, ab = amode == 1 ? -2.f : 1.f;
    f32x4 mq[4][2];
    { const int o0 = 768 + 8 * (8 * lw + pc), o1 = 64 * lw + 8 * pc;
      mq[0][0] = *(GLB const f32x4*)(mu + o0); mq[0][1] = *(GLB const f32x4*)(mu + o0 + 4);
#pragma unroll
      for (int a = 0; a < 3; ++a) { mq[1 + a][0] = *(GLB const f32x4*)(mu + 256 * a + o1); mq[1 + a][1] = *(GLB const f32x4*)(mu + 256 * a + o1 + 4); } }
    u32x4 wv[4][2];
    { const bf16_t* wp = WSP(bf16_t, WS_BIN) + (size_t)layer * NIN * D + (size_t)3072 * D + 8 * lane;
#pragma unroll
      for (int c = 0; c < 4; ++c) { wv[c][0] = *(GLB const u32x4*)(wp + (size_t)c * D); wv[c][1] = *(GLB const u32x4*)(wp + (size_t)c * D + 512); } }
    const float fbias = F.in[16][layer * 4 + (lane & 3)];
    const bf16_t* wcg = WSP(bf16_t, WS_WCAT) + (size_t)layer * 65536 + (size_t)(64 * lw + 16 * ((r32 >> 2) & 1) + (r32 & 3) + 4 * (r32 >> 3)) * 256 + 8 * h2;
#define RW_SHIFT8(cu, pr, hp, m0, m1, o) do { _Pragma("unroll") for (int j_ = 0; j_ < 4; ++j_) { \
        const float c0_ = bf2f(cu[j_] & 0xffffu), c1_ = bf2f(cu[j_] >> 16), p0_ = (hp) ? bf2f(pr[j_] & 0xffffu) : 0.f, p1_ = (hp) ? bf2f(pr[j_] >> 16) : 0.f; \
        const float ma_ = j_ < 2 ? m0[2 * (j_ & 1)] : m1[2 * (j_ & 1)], mb_ = j_ < 2 ? m0[2 * (j_ & 1) + 1] : m1[2 * (j_ & 1) + 1]; \
        o[2 * j_] = c0_ + (p0_ - c0_) * ma_; o[2 * j_ + 1] = c1_ + (p1_ - c1_) * mb_; } } while (0)
#pragma unroll 1
    for (int tg = F.bid; tg < 1024; tg += F.G) {
        const int bb = tg >> 6, ch = tg & 63;
        const bf16_t* Pg = WSP(bf16_t, WS_P) + (size_t)(bb * SEQ + 32 * ch) * PP;
        const bool nop0 = (ch == 0) && (prow == 0);
        {
            u32x4 cu[4][4], pr[4][4];
            const int cols[4] = {C_RWX + 8 * (8 * lw + pc), C_RWR + 64 * lw + 8 * pc, C_RWK + 64 * lw + 8 * pc, C_RWV + 64 * lw + 8 * pc};
#pragma unroll
            for (int i = 0; i < 4; ++i) { const bf16_t* rowp = Pg + (size_t)(prow + 8 * i) * PP; const bf16_t* prevp = rowp - ((i == 0 && nop0) ? 0 : PP);
#pragma unroll
                for (int a = 0; a < 4; ++a) { cu[a][i] = *(GLB const u32x4*)(rowp + cols[a]); pr[a][i] = *(GLB const u32x4*)(prevp + cols[a]); } }
            asm volatile("" ::: "memory");
#pragma unroll
            for (int i = 0; i < 4; ++i) { const int t = prow + 8 * i; const bool hp = !(i == 0 && nop0); float v[8]; RW_SHIFT8(cu[0][i], pr[0][i], hp, mq[0][0], mq[0][1], v);
#pragma unroll
                for (int k = 0; k < 8; ++k) { const float q = rcpf_(1.f + ex2(asc * v[k])); v[k] = amode == 0 ? v[k] : aa + ab * q; }
                *(LAS bf16x8*)(L + RG_ACT + (4 * lw + (pc >> 1)) * 1024 + (t + 32 * (pc & 1)) * 16) = pk8f(v);
#pragma unroll
                for (int a = 0; a < 3; ++a) { float o[8]; RW_SHIFT8(cu[1 + a][i], pr[1 + a][i], hp, mq[1 + a][0], mq[1 + a][1], o);
                    *(LAS bf16x8*)(L + RG_RKV + (lw * 3 + a) * 4608 + t * RC_ROWB + pc * 16) = pk8f(o); } }
        }
        asm volatile("" ::: "memory");
        {
            const int t0 = bb * SEQ + 32 * ch + 8 * lw;
            u32x4 xr[8][2]; float sp[8];
#pragma unroll
            for (int i = 0; i < 8; ++i) { const bf16_t* xp = WSP(bf16_t, WS_XB) + (size_t)(t0 + i) * D + 8 * lane; xr[i][0] = *(GLB const u32x4*)(xp); xr[i][1] = *(GLB const u32x4*)(xp + 512);
                sp[i] = (lane < 16) ? WSP(float, WS_SS1)[(size_t)(t0 + i) * 16 + lane] : 0.f; }
            asm volatile("" ::: "memory");
#pragma unroll
            for (int i = 0; i < 8; ++i) {
                const float rstd = __builtin_amdgcn_rsqf(wave_sum(sp[i]) * (1.f / 1024.f) + 1e-6f);
                float res = 0.f;
#pragma unroll
                for (int c = 0; c < 4; ++c) { float a = 0.f;
                    asm("v_dot2c_f32_bf16 %0, %1, %9\n\tv_dot2c_f32_bf16 %0, %2, %10\n\tv_dot2c_f32_bf16 %0, %3, %11\n\tv_dot2c_f32_bf16 %0, %4, %12\n\t"
                        "v_dot2c_f32_bf16 %0, %5, %13\n\tv_dot2c_f32_bf16 %0, %6, %14\n\tv_dot2c_f32_bf16 %0, %7, %15\n\tv_dot2c_f32_bf16 %0, %8, %16\n\ts_nop 4"
                        : "+v"(a) : "v"(xr[i][0][0]), "v"(xr[i][0][1]), "v"(xr[i][0][2]), "v"(xr[i][0][3]), "v"(xr[i][1][0]), "v"(xr[i][1][1]), "v"(xr[i][1][2]), "v"(xr[i][1][3]),
                                    "v"(wv[c][0][0]), "v"(wv[c][0][1]), "v"(wv[c][0][2]), "v"(wv[c][0][3]), "v"(wv[c][1][0]), "v"(wv[c][1][1]), "v"(wv[c][1][2]), "v"(wv[c][1][3]));
                    a = wave_sum(a); if ((lane & 3) == c) res = a; }
                if (lane < 4) { const int row = t0 + i; WSP(float, WS_LF)[(size_t)((row >> 11) * 4 + lane) * SEQ + (row & 2047)] = -softplusf_(-(res * rstd + fbias)); }
            }
        }
        asm volatile("s_waitcnt lgkmcnt(0)" ::: "memory");
        { TPB_T0; asm volatile("" ::: "memory"); __builtin_amdgcn_s_barrier(); asm volatile("" ::: "memory"); TPB_ACC(0, 256); }
        {
            const int tok = bb * SEQ + 32 * ch + r32;
            const bf16_t* wcl = wcg; asm volatile("" : "+v"(wcl));
            bf16x8 wg[2][8];
#pragma unroll
            for (int blk = 0; blk < 2; ++blk)
#pragma unroll
                for (int ks = 0; ks < 8; ++ks) wg[blk][ks] = *(GLB const bf16x8*)(wcl + (size_t)blk * 32 * 256 + 16 * (8 + ks));
            asm volatile("" ::: "memory");
#pragma unroll
            for (int blk = 0; blk < 2; ++blk) { f32x16 aG = {};
#pragma unroll
                for (int ks = 0; ks < 8; ++ks) aG = MFMA32(wg[blk][ks], *(const LAS bf16x8*)(L + RG_ACT + (8 + ks) * 1024 + lane * 16), aG);
#pragma unroll
                for (int g = 0; g < 2; ++g) { const int cl = 32 * blk + 16 * h2 + 8 * g; u32x4 gq;
                    gq.x = pk2(aG[8 * g], aG[8 * g + 1]); gq.y = pk2(aG[8 * g + 2], aG[8 * g + 3]); gq.z = pk2(aG[8 * g + 4], aG[8 * g + 5]); gq.w = pk2(aG[8 * g + 6], aG[8 * g + 7]);
                    *(GLB u32x4*)(WSP(bf16_t, WS_GBUF) + (size_t)tok * 256 + 64 * lw + cl) = gq; } }
            asm volatile("s_waitcnt lgkmcnt(0)" ::: "memory");
        }
        { TPB_T0; asm volatile("" ::: "memory"); __builtin_amdgcn_s_barrier(); asm volatile("" ::: "memory"); TPB_ACC(1, 256); }
    }
#undef RW_SHIFT8
}
DI void rw_group_compute(Frame& F, int layer, int tg) {
    asm volatile("" : "+s"(F.in)); asm volatile("" : "+s"(F.ws)); asm volatile("" : "+v"(F.lane));
    const int lane = F.lane, r32 = lane & 31, h2 = lane >> 5, hd = F.wave, bb = tg >> 6, ch = tg & 63, bh = bb * 4 + hd;
    LAS unsigned char* L = F.lds;
    LAS unsigned char* W = L + F.wave * RC_WAVE;
    const int tl = 32 * ch + r32, tok = bb * SEQ + tl;
    const bf16_t* wc = WSP(bf16_t, WS_WCAT) + (size_t)layer * 65536 + (size_t)(64 * hd + r32) * 256 + 8 * h2;
    const int chunk = bh * 64 + ch;
    const LAS float* PAR = (const LAS float*)(L + RG_PAR) + 64 * hd;
    const LAS unsigned char* TR = L + RG_RKV + (hd * 3 + 0) * 4608 + r32 * RC_ROWB;
    const LAS unsigned char* TK = TR + 4608; const LAS unsigned char* TV = TR + 2 * 4608;
    u32x4 FRr[16];
    bf16x8 wfr[2][8];
#pragma unroll
    for (int blk = 0; blk < 2; ++blk)
#pragma unroll
        for (int ks = 0; ks < 8; ++ks) wfr[blk][ks] = *(const __attribute__((address_space(1))) bf16x8*)(wc + (size_t)blk * 32 * 256 + 16 * ks);
    { TPB_T0; asm volatile("" ::: "memory"); __builtin_amdgcn_s_barrier(); asm volatile("" ::: "memory"); TPB_ACC(2, 0); }
    float n2 = 0.f;
#pragma unroll
    for (int g8 = 0; g8 < 4; ++g8) { const u32x4 kq = *(const LAS u32x4*)(TK + 64 * h2 + 16 * g8); const f32x4 k0 = *(const LAS f32x4*)(PAR + 1024 + 32 * h2 + 8 * g8), k1 = *(const LAS f32x4*)(PAR + 1024 + 32 * h2 + 8 * g8 + 4);
#pragma unroll
        for (int j = 0; j < 4; ++j) { const float a = bf2f(kq[j] & 0xffffu) * (j < 2 ? k0[2 * j] : k1[2 * j - 4]), c = bf2f(kq[j] >> 16) * (j < 2 ? k0[2 * j + 1] : k1[2 * j - 3]); n2 += a * a + c * c; } }
    n2 += swap32(n2);
    const float inv = 1.f / fmaxf(sqrtf(n2), 1e-12f);
    float bon = 0.f;
#pragma unroll
    for (int blk = 0; blk < 2; ++blk) {
        f32x16 aW = {}, aA = {};
#pragma unroll
        for (int ks = 0; ks < 4; ++ks) aW = MFMA32(wfr[blk][ks], *(const LAS bf16x8*)(L + RG_ACT + ks * 1024 + lane * 16), aW);
#pragma unroll
        for (int ks = 4; ks < 8; ++ks) aA = MFMA32(wfr[blk][ks], *(const LAS bf16x8*)(L + RG_ACT + ks * 1024 + lane * 16), aA);
#pragma unroll
        for (int s = 0; s < 2; ++s) {
            float e_kat[8], e_rt[8], e_kt[8], e_bt[8], e_kb[8], e_bb[8];
#pragma unroll
            for (int q = 0; q < 2; ++q) { const int g = 2 * s + q, cl = 32 * blk + 8 * g + 4 * h2;
                const u32x2 rq = *(const LAS u32x2*)(TR + cl * 2), kq = *(const LAS u32x2*)(TK + cl * 2), vq = *(const LAS u32x2*)(TV + cl * 2);
                const float rv[4] = {bf2f(rq.x & 0xffffu), bf2f(rq.x >> 16), bf2f(rq.y & 0xffffu), bf2f(rq.y >> 16)}, kv[4] = {bf2f(kq.x & 0xffffu), bf2f(kq.x >> 16), bf2f(kq.y & 0xffffu), bf2f(kq.y >> 16)};
                const f32x4 w0v = *(const LAS f32x4*)(PAR + cl), a0v = *(const LAS f32x4*)(PAR + 256 + cl), kav = *(const LAS f32x4*)(PAR + 512 + cl), rkv = *(const LAS f32x4*)(PAR + 768 + cl), kwv = *(const LAS f32x4*)(PAR + 1024 + cl);
#pragma unroll
                for (int j = 0; j < 4; ++j) { const int r = 4 * g + j, jj = 4 * q + j;
                    const float w = -softplusf_(-(w0v[j] + aW[r])) - 0.5f;
                    const float l2d = -LOG2E * ex2(w * LOG2E);
                    const float a = sigmoidf_(a0v[j] + aA[r]);
                    const float kkv = kv[j] * kwv[j] * inv, bev = kkv * a, kpv = kv[j] * (1.f + (a - 1.f) * kav[j]);
                    bon += rv[j] * kpv * rkv[j];
                    const float Li = scan32(l2d), Lex = Li - l2d, LC = __shfl(Li, 31 + 32 * h2);
                    const float pin = ex2(Li), pex = ex2(Lex), pinv = ex2(-Li), pc = ex2(LC - Li);
                    e_kat[jj] = kkv * pex; e_rt[jj] = rv[j] * pin; e_kt[jj] = kpv * pinv; e_bt[jj] = bev * pinv; e_kb[jj] = kpv * pc; e_bb[jj] = bev * pc;
                    if (r32 == 31) *(LAS float*)(W + RC_PC + (cl + j) * 4) = ex2(LC); }
                *(LAS u32x2*)(W + RC_V + r32 * RC_ROWB + cl * 2) = vq;
                *(LAS u32x2*)(W + RC_KB + r32 * RC_ROWB + cl * 2) = (u32x2){pk2(e_kb[4 * q], e_kb[4 * q + 1]), pk2(e_kb[4 * q + 2], e_kb[4 * q + 3])};
                *(LAS u32x2*)(W + RC_BB + r32 * RC_ROWB + cl * 2) = (u32x2){pk2(e_bb[4 * q], e_bb[4 * q + 1]), pk2(e_bb[4 * q + 2], e_bb[4 * q + 3])};
                *(LAS u32x2*)(W + RC_KT + r32 * RC_ROWB + cl * 2) = (u32x2){pk2(e_kat[4 * q], e_kat[4 * q + 1]), pk2(e_kat[4 * q + 2], e_kat[4 * q + 3])};
            }
            { const int ks = 2 * blk + s; FRr[ks * 4 + 0] = __builtin_bit_cast(u32x4, pk8f(e_kat)); FRr[ks * 4 + 1] = __builtin_bit_cast(u32x4, pk8f(e_rt)); FRr[ks * 4 + 2] = __builtin_bit_cast(u32x4, pk8f(e_kt)); FRr[ks * 4 + 3] = __builtin_bit_cast(u32x4, pk8f(e_bt)); }
        }
    }
    asm volatile("s_waitcnt lgkmcnt(0)" ::: "memory");
    { TPB_T0; asm volatile("" ::: "memory"); __builtin_amdgcn_s_barrier(); asm volatile("" ::: "memory"); TPB_ACC(3, 0); }
    bon += swap32(bon);
    asm volatile("" ::: "memory");
#pragma unroll
    for (int blk = 0; blk < 2; ++blk)
#pragma unroll
        for (int g = 0; g < 4; ++g) { const int cl = 32 * blk + 8 * g + 4 * h2; const u32x2 vq = *(const LAS u32x2*)(W + RC_V + r32 * RC_ROWB + cl * 2); u32x2 q;
            q.x = pk2(bon * bf2f(vq.x & 0xffffu), bon * bf2f(vq.x >> 16)); q.y = pk2(bon * bf2f(vq.y & 0xffffu), bon * bf2f(vq.y >> 16));
            *(GLB u32x2*)(WSP(bf16_t, WS_BONV) + (size_t)tok * 256 + 64 * hd + cl) = q; }
    const float pc_lo = *(const LAS float*)(W + RC_PC + r32 * 4), pc_hi = *(const LAS float*)(W + RC_PC + (32 + r32) * 4);
    bf16x8 akkf[2], arkf[2], arbf[2];
    f32x16 Tt;
    {
        f32x16 skk = {}, skb = {}, sl = {};
#pragma unroll
        for (int ks = 0; ks < 4; ++ks) { const bf16x8 katf = __builtin_bit_cast(bf16x8, FRr[ks * 4 + 0]), ktf = __builtin_bit_cast(bf16x8, FRr[ks * 4 + 2]), btf = __builtin_bit_cast(bf16x8, FRr[ks * 4 + 3]);
            skk = MFMA32(ktf, katf, skk); skb = MFMA32(btf, katf, skb); sl = MFMA32(katf, btf, sl); }
#pragma unroll
        for (int r = 0; r < 16; ++r) { const int i = crow(r, h2); if (i >= r32) { skk[r] = 0.f; skb[r] = 0.f; } if (i <= r32) sl[r] = 0.f; }
#pragma unroll
        for (int s = 0; s < 2; ++s) akkf[s] = pack8(skk, s);
        bf16x8 fx[2], fxt[2];
#pragma unroll
        for (int s = 0; s < 2; ++s) { fx[s] = pack8(sl, s); fxt[s] = pack8(skb, s); }
#pragma unroll
        for (int r = 0; r < 16; ++r) Tt[r] = ((crow(r, h2) == r32) ? 1.f : 0.f) - skb[r];
#pragma unroll
        for (int lvl = 0; lvl < 4; ++lvl) {
            f32x16 p = {}, pt = {};
#pragma unroll
            for (int s = 0; s < 2; ++s) { p = MFMA32(fxt[s], fx[s], p); if (lvl < 3) pt = MFMA32(fx[s], fxt[s], pt); }
#pragma unroll
            for (int s = 0; s < 2; ++s) fx[s] = pack8(p, s);
            const bf16x8 t0 = pack8(Tt, 0), t1 = pack8(Tt, 1);
            Tt = MFMA32(fx[0], t0, Tt); Tt = MFMA32(fx[1], t1, Tt);
            if (lvl < 3) {
#pragma unroll
                for (int s = 0; s < 2; ++s) fxt[s] = pack8(pt, s); }
        }
    }
    {
        f32x16 srk = {}, srb = {};
#pragma unroll
        for (int ks = 0; ks < 4; ++ks) { const bf16x8 rtf = __builtin_bit_cast(bf16x8, FRr[ks * 4 + 1]), ktf = __builtin_bit_cast(bf16x8, FRr[ks * 4 + 2]), btf = __builtin_bit_cast(bf16x8, FRr[ks * 4 + 3]);
            srk = MFMA32(ktf, rtf, srk); srb = MFMA32(btf, rtf, srb); }
#pragma unroll
        for (int r = 0; r < 16; ++r) if (crow(r, h2) > r32) { srk[r] = 0.f; srb[r] = 0.f; }
#pragma unroll
        for (int s = 0; s < 2; ++s) { arkf[s] = pack8(srk, s); arbf[s] = pack8(srb, s); }
    }
    asm volatile("" ::: "memory");
    bf16x8 ng1f[2][2], ng2f[2][2];
    {
        const bf16x8 tf0 = pack8(Tt, 0), tf1 = pack8(Tt, 1);
#pragma unroll
        for (int cb = 0; cb < 2; ++cb) {
            f32x16 g = {};
            g = MFMA32(tf0, rc_trfrag(W + RC_KT, lane, 0, cb), g); g = MFMA32(tf1, rc_trfrag(W + RC_KT, lane, 1, cb), g);
#pragma unroll
            for (int r = 0; r < 16; ++r) g[r] = -g[r];
            ng1f[cb][0] = pack8(g, 0); ng1f[cb][1] = pack8(g, 1);
        }
#pragma unroll
        for (int vb = 0; vb < 2; ++vb) {
            f32x16 x1 = {};
#pragma unroll
            for (int s = 0; s < 2; ++s) x1 = MFMA32(akkf[s], rc_trfrag(W + RC_V, lane, s, vb), x1);
            f32x16 g = {};
            g = MFMA32(tf0, pack8(x1, 0), g); g = MFMA32(tf1, pack8(x1, 1), g);
#pragma unroll
            for (int r = 0; r < 16; ++r) g[r] = -g[r];
            ng2f[vb][0] = pack8(g, 0); ng2f[vb][1] = pack8(g, 1);
        }
    }
    asm volatile("" ::: "memory");
    u32x4* mt = WSP(u32x4, WS_CHMT) + (size_t)chunk * 8 * 64 + lane;
#pragma unroll
    for (int bip = 0; bip < 2; ++bip)
#pragma unroll
        for (int bi = 0; bi < 2; ++bi) {
            f32x16 m = {};
#pragma unroll
            for (int s = 0; s < 2; ++s) m = MFMA32(ng1f[bi][s], rc_trfrag(W + RC_BB, lane, s, bip), m);
            if (bi == bip) {
#pragma unroll
                for (int r = 0; r < 16; ++r) if (crow(r, h2) == r32) m[r] += (bi ? pc_hi : pc_lo); }
#pragma unroll
            for (int s = 0; s < 2; ++s) mt[(bip * 4 + bi * 2 + s) * 64] = __builtin_bit_cast(u32x4, pack8(m, s));
        }
    asm volatile("" ::: "memory");
    u32x4* nb_ = WSP(u32x4, WS_CHN) + (size_t)chunk * 8 * 64 + lane;
#pragma unroll
    for (int vb = 0; vb < 2; ++vb)
#pragma unroll
        for (int bip = 0; bip < 2; ++bip) {
            f32x16 n = {};
#pragma unroll
            for (int s = 0; s < 2; ++s) { n = MFMA32(rc_trfrag(W + RC_KB, lane, s, bip), rc_trfrag(W + RC_V, lane, s, vb), n); n = MFMA32(rc_trfrag(W + RC_BB, lane, s, bip), ng2f[vb][s], n); }
#pragma unroll
            for (int s = 0; s < 2; ++s) nb_[((vb * 2 + bip) * 2 + s) * 64] = __builtin_bit_cast(u32x4, pack8(n, s));
        }
    asm volatile("" ::: "memory");
    u32x4* ry = WSP(u32x4, WS_CHRY) + (size_t)chunk * 4 * 64 + lane;
#pragma unroll
    for (int bi = 0; bi < 2; ++bi) {
        f32x16 q = {};
#pragma unroll
        for (int s = 0; s < 2; ++s) q = MFMA32(ng1f[bi][s], arbf[s], q);
#pragma unroll
        for (int s = 0; s < 2; ++s) { const u32x4 rq = FRr[(2 * bi + s) * 4 + 1]; float o[8];
#pragma unroll
            for (int j = 0; j < 4; ++j) { o[2 * j] = q[8 * s + 2 * j] + bf2f(rq[j] & 0xffffu); o[2 * j + 1] = q[8 * s + 2 * j + 1] + bf2f(rq[j] >> 16); }
            ry[(bi * 2 + s) * 64] = __builtin_bit_cast(u32x4, pk8f(o)); }
    }
    asm volatile("" ::: "memory");
    u32x4* y0 = WSP(u32x4, WS_CHY0) + (size_t)chunk * 4 * 64 + lane;
#pragma unroll
    for (int vb = 0; vb < 2; ++vb) {
        f32x16 yy = {};
#pragma unroll
        for (int s = 0; s < 2; ++s) { yy = MFMA32(arkf[s], rc_trfrag(W + RC_V, lane, s, vb), yy); yy = MFMA32(arbf[s], ng2f[vb][s], yy); }
#pragma unroll
        for (int s = 0; s < 2; ++s) y0[(vb * 2 + s) * 64] = __builtin_bit_cast(u32x4, pack8(yy, s));
    }
    asm volatile("s_waitcnt lgkmcnt(0)" ::: "memory");
}
DI void unpack16(const u32x4& a, const u32x4& b, f32x16& o) {
#pragma unroll
    for (int j = 0; j < 4; ++j) { o[2 * j] = bf2f(a[j] & 0xffffu); o[2 * j + 1] = bf2f(a[j] >> 16); o[8 + 2 * j] = bf2f(b[j] & 0xffffu); o[8 + 2 * j + 1] = bf2f(b[j] >> 16); }
}
constexpr int SQ_BH = 24576, SQ_STAGE = 2 * SQ_BH;
DI void rw_seq_wg(Frame& F, int item, unsigned* sd) {
    LAS unsigned char* L = F.lds; const int lane = F.lane, wid = F.wave, r32 = lane & 31, h2 = lane >> 5;
    __syncthreads();
    if (wid >= 4) {
        const int slot = (wid - 4) >> 1, half = (wid - 4) & 1, bh = 2 * item + slot;
        const u32x4* mtb = WSP(u32x4, WS_CHMT) + (size_t)bh * 64 * 8 * 64 + lane;
        const u32x4* nbb = WSP(u32x4, WS_CHN) + (size_t)bh * 64 * 8 * 64 + lane;
        const u32x4* ryb = WSP(u32x4, WS_CHRY) + (size_t)bh * 64 * 4 * 64 + lane;
        const u32x4* y0b = WSP(u32x4, WS_CHY0) + (size_t)bh * 64 * 4 * 64 + lane;
#define SQ_ISSUE(CH) do { const int ch_ = (CH); LAS unsigned char* st_ = L + (ch_ % 3) * SQ_STAGE + slot * SQ_BH; \
            if (half == 0) { _Pragma("unroll") for (int i = 0; i < 8; ++i) __builtin_amdgcn_global_load_lds((const unsigned*)(mtb + (size_t)ch_ * 512 + i * 64), (LAS unsigned*)(st_ + i * 1024), 16, 0, 0); \
                             _Pragma("unroll") for (int i = 0; i < 4; ++i) __builtin_amdgcn_global_load_lds((const unsigned*)(ryb + (size_t)ch_ * 256 + i * 64), (LAS unsigned*)(st_ + (8 + i) * 1024), 16, 0, 0); } \
            else { _Pragma("unroll") for (int i = 0; i < 8; ++i) __builtin_amdgcn_global_load_lds((const unsigned*)(nbb + (size_t)ch_ * 512 + i * 64), (LAS unsigned*)(st_ + (12 + i) * 1024), 16, 0, 0); \
                   _Pragma("unroll") for (int i = 0; i < 4; ++i) __builtin_amdgcn_global_load_lds((const unsigned*)(y0b + (size_t)ch_ * 256 + i * 64), (LAS unsigned*)(st_ + (20 + i) * 1024), 16, 0, 0); } } while (0)
        SQ_ISSUE(0); SQ_ISSUE(1);
        asm volatile("s_waitcnt vmcnt(12)" ::: "memory");
        __builtin_amdgcn_s_barrier();
#pragma unroll 1
        for (int ch = 0; ch < 64; ++ch) {
            if (ch + 2 < 64) { SQ_ISSUE(ch + 2); asm volatile("s_waitcnt vmcnt(12)" ::: "memory"); }
            else asm volatile("s_waitcnt vmcnt(0)" ::: "memory");
            __builtin_amdgcn_s_barrier();
        }
#undef SQ_ISSUE
    } else {
        const int slot = wid >> 1, vb = wid & 1, bh = 2 * item + slot;
        f32x16 H0 = {}, H1 = {};
        float* yb = WSP(float, WS_YBUF) + (size_t)(bh >> 2) * SEQ * 256 + (bh & 3) * 64 + 32 * vb + r32;
        __builtin_amdgcn_s_barrier();
#pragma unroll 1
        for (int ch = 0; ch < 64; ++ch) {
            const LAS unsigned char* st = L + (ch % 3) * SQ_STAGE + slot * SQ_BH + lane * 16;
            u32x4 cmt[8], cry[4], cnn[4], cy0[2];
#pragma unroll
            for (int i = 0; i < 8; ++i) cmt[i] = *(const LAS u32x4*)(st + i * 1024);
#pragma unroll
            for (int i = 0; i < 4; ++i) { cry[i] = *(const LAS u32x4*)(st + (8 + i) * 1024); cnn[i] = *(const LAS u32x4*)(st + (12 + 4 * vb + i) * 1024); }
            cy0[0] = *(const LAS u32x4*)(st + (20 + 2 * vb) * 1024); cy0[1] = *(const LAS u32x4*)(st + (21 + 2 * vb) * 1024);
            bf16x8 hb[4]; hb[0] = pack8(H0, 0); hb[1] = pack8(H0, 1); hb[2] = pack8(H1, 0); hb[3] = pack8(H1, 1);
            f32x16 y, n0, n1;
            unpack16(cy0[0], cy0[1], y); unpack16(cnn[0], cnn[1], n0); unpack16(cnn[2], cnn[3], n1);
            asm volatile("s_waitcnt lgkmcnt(0)" ::: "memory");
#pragma unroll
            for (int ks = 0; ks < 4; ++ks) { n0 = MFMA32(__builtin_bit_cast(bf16x8, cmt[ks]), hb[ks], n0); n1 = MFMA32(__builtin_bit_cast(bf16x8, cmt[4 + ks]), hb[ks], n1); y = MFMA32(__builtin_bit_cast(bf16x8, cry[ks]), hb[ks], y); }
            H0 = n0; H1 = n1;
#pragma unroll
            for (int r = 0; r < 16; ++r) yb[(size_t)(32 * ch + crow(r, h2)) * 256] = y[r];
            __builtin_amdgcn_s_barrier();
        }
        asm volatile("s_waitcnt vmcnt(0)" ::: "memory");
    }
    __syncthreads();
    if (F.tid == 0) {
        __builtin_amdgcn_fence(__ATOMIC_RELEASE, "agent");
        asm volatile("s_waitcnt vmcnt(0)" ::: "memory");
        (void)xb_add(sd, 1u);
    }
}
DI void rw_post_item(Frame& F, int layer, int tok0) {
    const int tid = F.tid, cg = tid & 31, c0 = 8 * cg, tr = tid >> 5;
    const f32x4 gw0 = *(GLB const f32x4*)(F.in[14] + layer * 256 + c0), gw1 = *(GLB const f32x4*)(F.in[14] + layer * 256 + c0 + 4);
    const f32x4 gb0 = *(GLB const f32x4*)(F.in[15] + layer * 256 + c0), gb1 = *(GLB const f32x4*)(F.in[15] + layer * 256 + c0 + 4);
    const float gw[8] = {gw0[0], gw0[1], gw0[2], gw0[3], gw1[0], gw1[1], gw1[2], gw1[3]}, gb[8] = {gb0[0], gb0[1], gb0[2], gb0[3], gb1[0], gb1[1], gb1[2], gb1[3]};
#pragma unroll
    for (int hf = 0; hf < 2; ++hf) {
        f32x4 ya[4], yb[4]; u32x4 bq[4], gq[4];
#pragma unroll
        for (int i = 0; i < 4; ++i) { const size_t o = (size_t)(tok0 + tr + 16 * (4 * hf + i)) * 256 + c0;
            ya[i] = *(GLB const f32x4*)(WSP(float, WS_YBUF) + o); yb[i] = *(GLB const f32x4*)(WSP(float, WS_YBUF) + o + 4);
            bq[i] = *(GLB const u32x4*)(WSP(bf16_t, WS_BONV) + o); gq[i] = *(GLB const u32x4*)(WSP(bf16_t, WS_GBUF) + o); }
#pragma unroll
        for (int i = 0; i < 4; ++i) {
            float y[8] = {ya[i][0], ya[i][1], ya[i][2], ya[i][3], yb[i][0], yb[i][1], yb[i][2], yb[i][3]};
            const float mean = sum8(((y[0] + y[1]) + (y[2] + y[3])) + ((y[4] + y[5]) + (y[6] + y[7]))) * (1.f / 64.f);
            float sq = 0.f;
#pragma unroll
            for (int j = 0; j < 8; ++j) { y[j] -= mean; sq += y[j] * y[j]; }
            const float rs = __builtin_amdgcn_rsqf(sum8(sq) * (1.f / 64.f) + 64e-5f);
#pragma unroll
            for (int j = 0; j < 8; ++j) { const float bo = bf2f((j & 1) ? (bq[i][j >> 1] >> 16) : (bq[i][j >> 1] & 0xffffu)), gg = bf2f((j & 1) ? (gq[i][j >> 1] >> 16) : (gq[i][j >> 1] & 0xffffu));
                y[j] = (y[j] * rs * gw[j] + gb[j] + bo) * gg; }
            *(GLB u32x4*)(WSP(bf16_t, WS_MIX) + (size_t)(tok0 + tr + 16 * (4 * hf + i)) * D + 512 + c0) = __builtin_bit_cast(u32x4, pk8f(y));
        }
    }
}

constexpr int RT_WP = 2064, RT_PLANE = 36 * RT_WP, RT_WEND = 2 * RT_PLANE;
DI void p4_router(Frame& F, int layer, bool dry) {
    LAS unsigned char* L = F.lds; const int tid = F.tid, lane = F.lane, wid = F.wave, m16 = lane & 15, q4 = lane >> 4;
    LAS float* wlog = (LAS float*)L + wid * (16 * 49);
    LAS int* ent = (LAS int*)(L + RT_WEND);
    LAS float* entg = (LAS float*)(L + RT_WEND + 4096);
    LAS int* lcnt = (LAS int*)(L + RT_WEND + 5120);
    LAS int* lbase = lcnt + 144;
    const bf16_t* xb = WSP(bf16_t, WS_XB);
    const float *bg = F.in[20] + layer * 4, *be = F.in[22] + layer * 32;
    unsigned* cnt = (unsigned*)(F.ws + WS_CTL) + CW_CNT + layer * 256;
    int* elist = WSP(int, WS_LIST); f32x2* egate = WSP(f32x2, WS_GLIST); u32x2* plist = WSP(u32x2, WS_PLIST);
    for (int blk = F.bid; blk < NT / 128; blk += F.G) {
        __syncthreads();
        { const u32x4* src = (const u32x4*)(WSP(bf16_t, WS_RTW) + (size_t)layer * 2 * 36 * 1024);
          u32x4 wq[18];
#pragma unroll
          for (int k = 0; k < 18; ++k) wq[k] = src[tid + 512 * k];
          asm volatile("" ::: "memory");
#pragma unroll
          for (int k = 0; k < 18; ++k) { const int i = tid + 512 * k; *(LAS u32x4*)(L + (i >> 7) * RT_WP + 16 * (i & 127)) = wq[k]; } }
        if (tid < 144) lcnt[tid] = 0;
        __syncthreads();
        const int row0 = blk * 128 + wid * 16;
        const bf16_t* xr = xb + (size_t)(row0 + m16) * D + 8 * q4;
        f32x4 a0 = {}, a1 = {}, a2 = {}; float ssq = 0.f;
        const LAS unsigned char* w0p = L + m16 * RT_WP + 16 * q4; const LAS unsigned char* w1p = w0p + 16 * RT_WP; const LAS unsigned char* w2p = L + (32 + (m16 & 3)) * RT_WP + 16 * q4;
        const bool v2 = m16 < 4;
#pragma unroll
        for (int jh = 0; jh < 2; ++jh) {
        u32x4 xq[16];
#pragma unroll
        for (int jj = 0; jj < 16; ++jj) xq[jj] = *(GLB const u32x4*)(xr + 32 * (16 * jh + jj));
        asm volatile("" ::: "memory");
#pragma unroll
        for (int j16 = 0; j16 < 16; ++j16) { const int jj = 16 * jh + j16;
            const bf16x8 xa = __builtin_bit_cast(bf16x8, xq[j16]);
            const bf16x8 h0 = *(const LAS bf16x8*)(w0p + 64 * jj), l0 = *(const LAS bf16x8*)(w0p + RT_PLANE + 64 * jj);
            const bf16x8 h1 = *(const LAS bf16x8*)(w1p + 64 * jj), l1 = *(const LAS bf16x8*)(w1p + RT_PLANE + 64 * jj);
            u32x4 h2q = *(const LAS u32x4*)(w2p + 64 * jj), l2q = *(const LAS u32x4*)(w2p + RT_PLANE + 64 * jj);
            if (!v2) { h2q = (u32x4){0u, 0u, 0u, 0u}; l2q = (u32x4){0u, 0u, 0u, 0u}; }
            a0 = __builtin_amdgcn_mfma_f32_16x16x32_bf16(xa, h0, a0, 0, 0, 0); a0 = __builtin_amdgcn_mfma_f32_16x16x32_bf16(xa, l0, a0, 0, 0, 0);
            a1 = __builtin_amdgcn_mfma_f32_16x16x32_bf16(xa, h1, a1, 0, 0, 0); a1 = __builtin_amdgcn_mfma_f32_16x16x32_bf16(xa, l1, a1, 0, 0, 0);
            a2 = __builtin_amdgcn_mfma_f32_16x16x32_bf16(xa, __builtin_bit_cast(bf16x8, h2q), a2, 0, 0, 0); a2 = __builtin_amdgcn_mfma_f32_16x16x32_bf16(xa, __builtin_bit_cast(bf16x8, l2q), a2, 0, 0, 0);
#pragma unroll
            for (int e2 = 0; e2 < 4; ++e2) { const float xl = bf2f(xq[j16][e2] & 0xffffu), xh = bf2f(xq[j16][e2] >> 16); ssq += xl * xl + xh * xh; }
        }
        asm volatile("" ::: "memory");
        }
        ssq += __shfl_xor(ssq, 16); ssq += __shfl_xor(ssq, 32);
        __syncthreads();
#pragma unroll
        for (int jj = 0; jj < 4; ++jj) { wlog[(4 * q4 + jj) * 49 + m16] = a0[jj]; wlog[(4 * q4 + jj) * 49 + 16 + m16] = a1[jj]; wlog[(4 * q4 + jj) * 49 + 32 + m16] = a2[jj]; }
        asm volatile("s_waitcnt lgkmcnt(0)" ::: "memory");
        if (lane < 16) {
            const int r = lane, row = row0 + r;
            const float rstd = __builtin_amdgcn_rsqf(ssq * (1.f / 1024.f) + 1e-6f);
            WSP(float, WS_RSTD2)[row] = rstd;
            float gl[4]; int gs = 0; float gmax;
#pragma unroll
            for (int j = 0; j < 4; ++j) gl[j] = wlog[r * 49 + j] * rstd + bg[j];
            gmax = gl[0];
#pragma unroll
            for (int j = 1; j < 4; ++j) if (gl[j] > gmax) { gmax = gl[j]; gs = j; }
            float gsum = 0.f;
#pragma unroll
            for (int j = 0; j < 4; ++j) gsum += ex2((gl[j] - gmax) * LOG2E);
            const float ggate = 1.f / gsum;
            float el[8];
#pragma unroll
            for (int j = 0; j < 8; ++j) el[j] = wlog[r * 49 + 4 + gs * 8 + j] * rstd + be[gs * 8 + j];
            int i0 = 0; float m0 = el[0];
#pragma unroll
            for (int j = 1; j < 8; ++j) if (el[j] > m0) { m0 = el[j]; i0 = j; }
            int i1 = -1; float m1 = -3.0e38f;
#pragma unroll
            for (int j = 0; j < 8; ++j) if (j != i0 && (i1 < 0 || el[j] > m1)) { m1 = el[j]; i1 = j; }
            const float e1 = ex2((m1 - m0) * LOG2E), g0 = ggate / (1.f + e1), g1 = ggate * e1 / (1.f + e1);
            const int la = i0 < i1 ? i0 : i1, lb = i0 < i1 ? i1 : i0; const float ga = i0 < i1 ? g0 : g1, gb = i0 < i1 ? g1 : g0;
            const int ea = gs * 8 + la, eb = gs * 8 + lb, pid = gs * 28 + la * (15 - la) / 2 + (lb - la - 1);
            const int ra = atomicAdd((int*)&lcnt[ea], 1), rb = atomicAdd((int*)&lcnt[eb], 1), rp = atomicAdd((int*)&lcnt[32 + pid], 1);
            const int li = wid * 16 + r;
            ent[li * 8 + 0] = ea; ent[li * 8 + 1] = eb; ent[li * 8 + 2] = pid; ent[li * 8 + 3] = ra; ent[li * 8 + 4] = rb; ent[li * 8 + 5] = rp; ent[li * 8 + 6] = __builtin_bit_cast(int, rstd); entg[li * 2] = ga; entg[li * 2 + 1] = gb;
        }
        __syncthreads();
        if (tid < 144) { const int n = lcnt[tid]; lbase[tid] = (n && !dry) ? (int)xb_add(cnt + tid, (unsigned)n) : 0; }
        __syncthreads();
        if (tid < 128 && !dry) { const int row = blk * 128 + tid; const int ea = ent[tid * 8], eb = ent[tid * 8 + 1], pid = ent[tid * 8 + 2];
            const int pa = lbase[ea] + ent[tid * 8 + 3], pb = lbase[eb] + ent[tid * 8 + 4], pp = lbase[32 + pid] + ent[tid * 8 + 5];
            const float rsd = __builtin_bit_cast(float, ent[tid * 8 + 6]);
            elist[(size_t)ea * LCAP + pa] = row; egate[(size_t)ea * LCAP + pa] = (f32x2){entg[tid * 2], rsd};
            elist[(size_t)eb * LCAP + pb] = row; egate[(size_t)eb * LCAP + pb] = (f32x2){entg[tid * 2 + 1], rsd};
            plist[(size_t)pid * LCAP + pp] = (u32x2){(unsigned)row, (unsigned)pa | ((unsigned)pb << 16)}; }
    }
    __syncthreads();
}
DI void moe_tables(Frame& F, int layer) {
    LAS MoeTab* T = (LAS MoeTab*)(F.lds + LDS_AUX);
    unsigned* cnt = (unsigned*)(F.ws + WS_CTL) + CW_CNT + layer * 256;
    __syncthreads();
    if (F.tid < 32) T->ce[F.tid] = (int)xb_ld(cnt + F.tid); else if (F.tid < 144) T->cp[F.tid - 32] = (int)xb_ld(cnt + F.tid);
    __syncthreads();
    if (F.tid == 0) { int sb = 0, tg = 0;
        for (int e = 0; e < 32; ++e) { const int a = T->ce[e]; T->sb[e] = sb; T->tpg[e] = tg; sb += a; tg += (a + 255) >> 8; }
        T->tpg[32] = tg; }
    if (F.wave == 1) {
        const int l = F.lane; int f[2], h[2];
#pragma unroll
        for (int q = 0; q < 2; ++q) { const int p = l + 64 * q, n = (p < 112) ? T->cp[p] : 0, nt_ = (n + 255) >> 8, half = (nt_ > 0 && n - 256 * (nt_ - 1) <= 128) ? 1 : 0; f[q] = nt_ - half; h[q] = half; }
        int sf[2] = {f[0], f[1]}, sh[2] = {h[0], h[1]};
#pragma unroll
        for (int o = 1; o < 64; o <<= 1) {
#pragma unroll
            for (int q = 0; q < 2; ++q) { const int uf = __shfl_up(sf[q], o), uh = __shfl_up(sh[q], o); if (l >= o) { sf[q] += uf; sh[q] += uh; } } }
        const int tf0 = __builtin_amdgcn_readlane(sf[0], 63), th0 = __builtin_amdgcn_readlane(sh[0], 63);
        T->tpf[l] = sf[0] - f[0]; T->tph[l] = sh[0] - h[0];
        if (l < 48) { T->tpf[64 + l] = tf0 + sf[1] - f[1]; T->tph[64 + l] = th0 + sh[1] - h[1]; }
        if (l == 47) { T->tpf[112] = tf0 + sf[1]; T->tph[112] = th0 + sh[1]; }
    }
    __syncthreads();
}
DI void p_final(Frame& F) {
    const int gw = F.bid * 8 + F.wave, NGW = F.G * 8;
    f32x4 gv[2][2];
#pragma unroll
    for (int j = 0; j < 2; ++j) { gv[j][0] = *(GLB const f32x4*)(F.in[26] + 8 * F.lane + 512 * j); gv[j][1] = *(GLB const f32x4*)(F.in[26] + 8 * F.lane + 512 * j + 4); }
    for (int m0 = gw * 8; m0 < NT; m0 += NGW * 8) {
        u32x4 v[8][2];
#pragma unroll
        for (int r = 0; r < 8; ++r) { const bf16_t* xr = WSP(bf16_t, WS_XB) + (size_t)(m0 + r) * D + 8 * F.lane; v[r][0] = *(GLB const u32x4*)(xr); v[r][1] = *(GLB const u32x4*)(xr + 512); }
#pragma unroll
        for (int r = 0; r < 8; ++r) { float s = 0.f; float f[2][8];
#pragma unroll
            for (int j = 0; j < 2; ++j)
#pragma unroll
                for (int e2 = 0; e2 < 4; ++e2) { f[j][2 * e2] = bf2f(v[r][j][e2] & 0xffffu); f[j][2 * e2 + 1] = bf2f(v[r][j][e2] >> 16); s += f[j][2 * e2] * f[j][2 * e2] + f[j][2 * e2 + 1] * f[j][2 * e2 + 1]; }
            const float rstd = __builtin_amdgcn_rsqf(wave_sum(s) * (1.f / 1024.f) + 1e-6f);
            float* xw = F.out + (size_t)(m0 + r) * D + 8 * F.lane;
#pragma unroll
            for (int j = 0; j < 2; ++j) { *(GLB f32x4*)(xw + 512 * j) = (f32x4){f[j][0], f[j][1], f[j][2], f[j][3]} * rstd * gv[j][0]; *(GLB f32x4*)(xw + 512 * j + 4) = (f32x4){f[j][4], f[j][5], f[j][6], f[j][7]} * rstd * gv[j][1]; }
        }
    }
}


#ifndef DUP_PH
#define DUP_PH -1
#endif
#define NREP(n) ((DUP_PH == (n)) ? 2 : 1)
constexpr int PH_PER_LAYER = 6, N_PHASES = 1 + DEPTH * PH_PER_LAYER + 1;
__global__ void __launch_bounds__(512, 2) mk_fwd(Args args) {
    extern __shared__ __attribute__((aligned(16))) unsigned char lds_raw[];
    Frame F;
    F.lds = (LAS unsigned char*)lds_raw; F.tid = threadIdx.x; F.lane = F.tid & 63; F.wave = __builtin_amdgcn_readfirstlane(F.tid >> 6);
    F.G = gridDim.x; F.bid = blockIdx.x; F.in = (const __attribute__((address_space(4))) cfp_t*)__builtin_amdgcn_kernarg_segment_ptr(); F.out = args.out; F.ws = args.ws;
    volatile LAS unsigned* MISC = (volatile LAS unsigned*)(F.lds + LDS_MISC);
    if (F.tid < 64) MISC[F.tid] = 0u;
    __syncthreads();
    unsigned* ctl = (unsigned*)(F.ws + WS_CTL);
    const int lo = args.ph_lo, hi = args.ph_hi;
    const bool multi = (hi - lo) > 1;
    XcdBarrier bar; bar.bar = ctl + CW_BAR; bar.x = 0; bar.st = nullptr;
    if (multi) bar = xcd_barrier_post(ctl + CW_BAR, MISC + 8);
#ifndef PHSEL
#define PHSEL -1
#endif
#ifndef PHMASK
#define PHMASK 0xFFFF
#endif
#define PS(n) ((PHSEL < 0 || PHSEL == (n)) && ((PHMASK >> (n)) & 1))
#define LAUNDER() do { asm volatile("" : "+s"(F.in)); asm volatile("" : "+s"(F.ws)); asm volatile("" : "+s"(F.out)); asm volatile("" : "+v"(F.tid)); asm volatile("" : "+v"(F.lane)); asm volatile("" : "+s"(F.bid)); asm volatile("" : "+s"(F.G)); } while (0)
#define IN(k) (lo <= (k) && (k) < hi)
#define SEAM(k) do { if (IN(k) && IN((k) + 1)) { xcd_barrier(bar); if (DUP_PH == 99) xcd_barrier(bar); } LAUNDER(); } while (0)
#ifdef TPROBE
    unsigned long long tp_acc = 0, tp_prev = __builtin_amdgcn_s_memrealtime();
#define TP(k) do { const unsigned long long tp_now = __builtin_amdgcn_s_memrealtime(); if ((k) == TPROBE || (k) == TPROBE2) tp_acc += tp_now - tp_prev; tp_prev = tp_now; } while (0)
#else
#define TP(k) do { } while (0)
#endif
    LAUNDER();
    if (PS(0) && IN(0)) { _Pragma("unroll 1") for (int rep = 0; rep < NREP(0); ++rep) p0_prologue(F); }
    SEAM(0); TP(0);
#pragma unroll 1
    for (int layer = 0; layer < DEPTH; ++layer) {
        const int pb = 1 + layer * PH_PER_LAYER;
        LAUNDER();
        if (PS(1) && IN(pb + 0)) _Pragma("unroll 1") for (int rep = 0; rep < NREP(1); ++rep) {
            ProbIn P; P.K = D; P.A = WSP(bf16_t, WS_XB); P.Bt = WSP(bf16_t, WS_BIN) + (size_t)layer * NIN * D; P.G = F.G; P.c = F.bid;
            P.Pout = WSP(bf16_t, WS_P); P.ss1 = WSP(float, WS_SS1); P.lf = WSP(float, WS_LF); P.bfx = F.in[16] + layer * 4; P.kmax = (unsigned*)(F.ws + WS_CTL) + CW_KMAX + layer * 128;
            pg8::gemm_phase<ProbIn, true>(F.lds, P, F.tid);
        }
        SEAM(pb + 0); TP(1);
        if (IN(pb + 1)) _Pragma("unroll 1") for (int rep = 0; rep < NREP(2); ++rep) {
            if (PS(4)) {
                __syncthreads();
                { LAS float* PARW = (LAS float*)(F.lds + RG_PAR);
                  const float *p6 = F.in[6], *p8 = F.in[8], *p12 = F.in[12], *p13 = F.in[13], *p11 = F.in[11];
                  const bool lo = F.tid < 256; const int c = layer * 256 + (F.tid & 255);
                  const float v0 = (lo ? p6 : p8)[c], v1 = (lo ? p12 : p13)[c], v2 = p11[c];
                  PARW[F.tid] = v0; PARW[512 + F.tid] = v1; if (lo) PARW[1024 + F.tid] = v2; }
                __syncthreads();
                if (F.wave < 4) { _Pragma("unroll 1") for (int it = F.bid; it < 1024; it += F.G) rw_group_compute(F, layer, it); } else rw_loader_loop(F, layer);
                __syncthreads();
            }
        }
        if (IN(pb + 1)) {
            unsigned* r1d = (unsigned*)(F.ws + WS_CTL) + CW_R1D + layer * 2048;
            xcd_arrive(bar, r1d); TP(2);
            bool fxw = false;
            unsigned* sdw = (unsigned*)(F.ws + WS_CTL) + CW_SD + layer * 64;
            if (PS(5)) { if (F.G >= 64) { if (F.bid < 32) { xcd_wait_all(bar, r1d); TP(8); rw_seq_wg(F, F.bid, sdw); TP(9); } } else { xcd_wait_all(bar, r1d); for (int i = F.bid; i < 32; i += F.G) rw_seq_wg(F, i, sdw); } }
            unsigned* wq = (unsigned*)(F.ws + WS_CTL) + CW_WQ + layer * 64;
            volatile LAS int* qslot = (volatile LAS int*)(F.lds + LDS_MISC + 64);
            __syncthreads();
            if (F.tid == 0) qslot[0] = (int)xb_add(wq, 1u);
            __syncthreads();
            int qq = qslot[0];
            constexpr int NCONV = CONV_ITEMS / 32;
            const int nconv = (layer + 1 < DEPTH) ? NCONV : 0;
#pragma unroll 1
            for (;;) {
                const int cb = (qq >> 2) < nconv ? (qq >> 2) : nconv;
                const bool isconv = ((qq & 3) == 3) && ((qq >> 2) < nconv);
                const int q = isconv ? -1 : qq - cb;
                if (q >= 1024 + 256 + 256) break;
                unsigned nq = 0u; if (F.tid == 0) nq = xb_add(wq, 1u);
                LAUNDER();
                if (isconv) { __syncthreads(); LAS unsigned* scr = (LAS unsigned*)(F.lds + F.wave * 16384);
                    _Pragma("unroll 1") for (int k = 0; k < 4; ++k) conv_item(F, layer + 1, (qq >> 2) * 32 + 8 * k + F.wave, scr); }
                else if (q < 512) { if (PS(6)) sb_unit(F, (q & 63) >> 2, q & 3, 7 - (q >> 6)); }
                else if (q < 1024) { const int r = q - 512; if (!fxw) { xcd_wait_all(bar, r1d); fxw = true; } if (PS(2)) fx_unit(F, layer, (r & 63) >> 2, r & 3, 7 - (r >> 6)); }
                else if (q < 1280) { if (PS(3)) gm_item(F, layer, (q - 1024) >> 4, (q - 1024) & 15); }
                else if (PS(7)) {
                    if (F.tid == 0) { unsigned sp = 0; while (xb_ld(sdw) < 32u) { __builtin_amdgcn_s_sleep(2); if (++sp > (1u << 22)) break; }
                        __builtin_amdgcn_fence(__ATOMIC_ACQUIRE, "agent"); asm volatile("s_waitcnt vmcnt(0)" ::: "memory"); }
                    __syncthreads();
                    rw_post_item(F, layer, (q - 1280) * 128);
                }
                TP(q < 512 ? 20 : (q < 1024 ? 21 : (q < 1280 ? 22 : 23)));
                __syncthreads();
                if (F.tid == 0) qslot[0] = (int)nq;
                __syncthreads();
                qq = qslot[0];
            }
        }
        SEAM(pb + 1); TP(3);
        if (PS(8) && IN(pb + 2)) {
            ProbOut P; P.K = D; P.A = WSP(bf16_t, WS_MIX); P.Bt = WSP(bf16_t, WS_BOUT) + (size_t)layer * D * D; P.G = F.G; P.c = F.bid;
            P.xb = WSP(bf16_t, WS_XB);
            pg8::gemm_phase<ProbOut, true>(F.lds, P, F.tid);
        }
        SEAM(pb + 2); TP(4);
        if (PS(9) && IN(pb + 3)) { if (DUP_PH == 9) p4_router(F, layer, true); p4_router(F, layer, false); }
        SEAM(pb + 3); TP(5);
        if (PS(10) && IN(pb + 4)) {
            moe_tables(F, layer);
            ProbGU P; P.K = D; P.A = WSP(bf16_t, WS_XB); P.Bt = WSP(bf16_t, WS_BGU) + (size_t)layer * NE * 1024 * D; P.G = F.G; P.c = F.bid;
            P.T = (const LAS MoeTab*)(F.lds + LDS_AUX); P.elist = WSP(int, WS_LIST); P.egate = WSP(f32x2, WS_GLIST); P.HB = WSP(bf16_t, WS_HB);
            pg8::gemm_phase<ProbGU, true>(F.lds, P, F.tid);
        }
        SEAM(pb + 4); TP(6);
        if (PS(11) && IN(pb + 5)) {
            if (!IN(pb + 4)) moe_tables(F, layer);
            ProbDP P; P.A = WSP(bf16_t, WS_HB); P.Bt = WSP(bf16_t, WS_BDN) + (size_t)layer * NE * D * EH; P.G = F.G; P.c = F.bid;
            P.T = (const LAS MoeTab*)(F.lds + LDS_AUX); P.plist = WSP(u32x2, WS_PLIST); P.xb = WSP(bf16_t, WS_XB); P.ss1 = WSP(float, WS_SS1);
            pg8::gemm_phase_pair<ProbDP>(F.lds, P, F.tid);
        }
        SEAM(pb + 5); TP(7);
    }
    if (PS(13) && IN(N_PHASES - 1)) p_final(F);
#ifdef TPROBE
    TP(10);
    #ifdef TPSLOT
    __syncthreads(); tp_acc = *((volatile LAS unsigned long long*)(F.lds + LDS_MISC + 128) + TPSLOT);
#endif
    if (F.bid == TPWG) { const unsigned long long t0 = __builtin_amdgcn_s_memrealtime(); while (__builtin_amdgcn_s_memrealtime() - t0 < 8ull * tp_acc) __builtin_amdgcn_s_sleep(8); }
#endif
#undef IN
#undef SEAM
}

#ifndef MK_ONE_LAUNCH
#define MK_ONE_LAUNCH 1
#endif
extern "C" void kernel_launch(void* const* d_in, const int* in_sizes, int n_in, void* d_out, int out_size, void* d_ws, size_t ws_size, hipStream_t stream) {
    static int grid = 0;
    if (grid == 0) {
        if (n_in != 27 || out_size != NT * D || ws_size < WS_END) { fprintf(stderr, "kernel_launch: unexpected shapes (n_in %d out %d ws %zu)\n", n_in, out_size, ws_size); grid = -1; return; }
        int dev = 0, cus = 0;
        if (hipGetDevice(&dev) != hipSuccess || hipDeviceGetAttribute(&cus, hipDeviceAttributeMultiprocessorCount, dev) != hipSuccess) { grid = -1; return; }
        if (hipFuncSetAttribute((const void*)mk_fwd, hipFuncAttributeMaxDynamicSharedMemorySize, LDS_BYTES) != hipSuccess) { fprintf(stderr, "kernel_launch: hipFuncSetAttribute failed\n"); grid = -1; return; }
        (void)hipGetLastError();
        grid = cus;
    }
    if (grid < 0) return;
    (void)hipMemsetAsync((char*)d_ws + WS_CTL, 0, CTL_BYTES, stream);
    Args a{};
    for (int i = 0; i < 27; ++i) a.in[i] = (const float*)d_in[i];
    a.out = (float*)d_out; a.ws = (unsigned char*)d_ws; a.li = 0; a.pad = 0;
#if MK_ONE_LAUNCH
    a.ph_lo = 0; a.ph_hi = N_PHASES;
    hipLaunchKernelGGL(mk_fwd, dim3(grid), dim3(512), LDS_BYTES, stream, a);
#else
    for (int p = 0; p < N_PHASES; ++p) { a.ph_lo = p; a.ph_hi = p + 1; hipLaunchKernelGGL(mk_fwd, dim3(grid), dim3(512), LDS_BYTES, stream, a); }
#endif
}
```
